# Optimizing an MI355X kernel written in HIP

```python
import math
import jax, jax.numpy as jnp
from jax import lax
import numpy as np

D_MODEL = 1024
BATCH = 8
SEQ = 2048
DEPTH = 2

N_HEADS = 4
HEAD_DIM = 64
V_DIM = 2 * HEAD_DIM
ATTN_QK = N_HEADS * 2 * HEAD_DIM
ATTN_V = N_HEADS * V_DIM
ROPE_THETA = 10000.0
Q_BLOCK = 128
CONV_CH = 512
CONV_K = 31
CONV_PAD = (CONV_K - 1) // 2
IN_SPLITS = (ATTN_QK, 2 * ATTN_QK, 2 * ATTN_QK + ATTN_V,
             2 * ATTN_QK + ATTN_V + 2 * CONV_CH)
IN_COLS = 2 * ATTN_QK + ATTN_V + 2 * CONV_CH + 2 * D_MODEL
D_FF = 2816
N_EXPERTS = 8
TOP_K = 2
D_EXPERT = 3584
N_DENSE = (DEPTH + 1) // 2
N_MOE = DEPTH // 2
PLE_DIM = 256
EPS = 1e-6

kernel_name = "hybrid_diffattn_conformer_moe_encoder"


def rms_norm(x, g):
    xf = x.astype(jnp.float32)
    y = xf * lax.rsqrt(jnp.mean(xf * xf, axis=-1, keepdims=True) + EPS)
    return (y * g.astype(jnp.float32)).astype(x.dtype)


def layer_norm(x, g, b):
    xf = x.astype(jnp.float32)
    mu = jnp.mean(xf, axis=-1, keepdims=True)
    xc = xf - mu
    y = xc * lax.rsqrt(jnp.mean(xc * xc, axis=-1, keepdims=True) + EPS)
    return (y * g.astype(jnp.float32) + b.astype(jnp.float32)).astype(x.dtype)


def rope_tables(seq, dtype):
    inv_freq = ROPE_THETA ** (-jnp.arange(0, HEAD_DIM, 2, dtype=jnp.float32) / HEAD_DIM)
    ang = jnp.arange(seq, dtype=jnp.float32)[:, None] * inv_freq[None, :]
    return jnp.cos(ang).astype(dtype), jnp.sin(ang).astype(dtype)


def apply_rope(t, cos, sin):
    t1, t2 = jnp.split(t, 2, axis=-1)
    c = cos[:, None, None, :]
    s = sin[:, None, None, :]
    return jnp.concatenate([t1 * c - t2 * s, t2 * c + t1 * s], axis=-1)


def diff_attention(q, k, v, lam):
    b, s = q.shape[0], q.shape[1]
    nb = s // Q_BLOCK
    qb = q.reshape(b, nb, Q_BLOCK, N_HEADS, 2, HEAD_DIM).transpose(1, 0, 2, 3, 4, 5)
    scale = HEAD_DIM ** -0.5

    def one_block(qi):
        sc = jnp.einsum('bqhcd,bkhcd->bhcqk', qi, k).astype(jnp.float32) * scale
        pr = jax.nn.softmax(sc, axis=-1)
        a = pr[:, :, 0] - lam * pr[:, :, 1]
        return jnp.einsum('bhqk,bkhe->bqhe', a.astype(v.dtype), v)

    o = lax.map(one_block, qb)
    return o.transpose(1, 0, 2, 3, 4).reshape(b, s, N_HEADS, V_DIM)


def conformer_conv(u, conv_w, conv_b, ln_g, ln_b, w_out):
    a, g = jnp.split(u, 2, axis=-1)
    z = a * jax.nn.sigmoid(g)
    z = lax.conv_general_dilated(
        z, conv_w[:, None, :], window_strides=(1,), padding=[(CONV_PAD, CONV_PAD)],
        dimension_numbers=('NWC', 'WIO', 'NWC'), feature_group_count=CONV_CH) + conv_b
    z = jax.nn.silu(layer_norm(z, ln_g, ln_b))
    return z @ w_out


def swiglu(h, w_gu, w_down):
    g, u = jnp.split(h @ w_gu, 2, axis=-1)
    return (jax.nn.silu(g) * u) @ w_down


def moe_swiglu(h, w_router, b_router, we_gu, we_down):
    b, s, d = h.shape
    t = h.reshape(b * s, d)
    logits = (t @ w_router).astype(jnp.float32) + b_router.astype(jnp.float32)
    top_v, top_i = lax.top_k(logits, TOP_K)
    top_w = jax.nn.softmax(top_v, axis=-1)
    combine = jnp.sum(jax.nn.one_hot(top_i, N_EXPERTS, dtype=jnp.float32) * top_w[..., None], axis=1)
    combine = combine.astype(h.dtype)
    out = jnp.zeros_like(t)
    for e in range(N_EXPERTS):
        out = out + combine[:, e:e + 1] * swiglu(t, we_gu[e], we_down[e])
    return out.reshape(b, s, d)


def setup_inputs(seed: int = 0) -> dict:
    key = jax.random.key(seed)
    ks = iter(jax.random.split(key, 40))

    def w(shape, fan_in):
        return jax.random.normal(next(ks), shape, jnp.float32) * (fan_in ** -0.5)

    def gain(shape):
        return 1.0 + 0.02 * jax.random.normal(next(ks), shape, jnp.float32)

    def bias(shape, scale=0.02):
        return scale * jax.random.normal(next(ks), shape, jnp.float32)

    return {
        "x": jax.random.normal(next(ks), (BATCH, SEQ, D_MODEL), jnp.float32),
        "p": jax.random.normal(next(ks), (DEPTH, BATCH, SEQ, PLE_DIM), jnp.float32),
        "g_mix": gain((DEPTH, D_MODEL)),
        "w_in": w((DEPTH, D_MODEL, IN_COLS), D_MODEL),
        "lam": 0.1 * jax.random.normal(next(ks), (DEPTH, 4, HEAD_DIM), jnp.float32),
        "g_subln": gain((DEPTH, V_DIM)),
        "w_attn_out": w((DEPTH, ATTN_V, D_MODEL), ATTN_V),
        "conv_w": w((DEPTH, CONV_K, CONV_CH), CONV_K),
        "conv_b": bias((DEPTH, CONV_CH)),
        "conv_ln_g": gain((DEPTH, CONV_CH)),
        "conv_ln_b": bias((DEPTH, CONV_CH)),
        "w_conv_out": w((DEPTH, CONV_CH, D_MODEL), CONV_CH),
        "w_o": w((DEPTH, D_MODEL, D_MODEL), D_MODEL),
        "g_ffn": gain((DEPTH, D_MODEL)),
        "w_ff_gu": w((N_DENSE, D_MODEL, 2 * D_FF), D_MODEL),
        "w_ff_down": w((N_DENSE, D_FF, D_MODEL), D_FF),
        "w_router": w((N_MOE, D_MODEL, N_EXPERTS), D_MODEL),
        "b_router": bias((N_MOE, N_EXPERTS), 0.01),
        "we_gu": w((N_MOE, N_EXPERTS, D_MODEL, 2 * D_EXPERT), D_MODEL),
        "we_down": w((N_MOE, N_EXPERTS, D_EXPERT, D_MODEL), D_EXPERT),
        "g_ple": gain((DEPTH, D_MODEL)),
        "w_ple_gate": w((DEPTH, D_MODEL, D_MODEL), D_MODEL),
        "w_ple_proj": w((DEPTH, PLE_DIM, D_MODEL), PLE_DIM),
        "g_final": gain((D_MODEL,)),
    }


def reference(x, p, g_mix, w_in, lam, g_subln, w_attn_out, conv_w, conv_b, conv_ln_g,
              conv_ln_b, w_conv_out, w_o, g_ffn, w_ff_gu, w_ff_down, w_router, b_router,
              we_gu, we_down, g_ple, w_ple_gate, w_ple_proj, g_final):
    b, s, _ = x.shape
    cos, sin = rope_tables(s, x.dtype)
    for i in range(DEPTH):
        h = rms_norm(x, g_mix[i])
        q, k, v, u, gl = jnp.split(h @ w_in[i], IN_SPLITS, axis=-1)
        q = apply_rope(q.reshape(b, s, N_HEADS, 2, HEAD_DIM), cos, sin)
        k = apply_rope(k.reshape(b, s, N_HEADS, 2, HEAD_DIM), cos, sin)
        v = v.reshape(b, s, N_HEADS, V_DIM)
        lam_init = 0.8 - 0.6 * math.exp(-0.3 * i)
        lf = lam[i].astype(jnp.float32)
        lam_full = (jnp.exp(jnp.sum(lf[0] * lf[1])) - jnp.exp(jnp.sum(lf[2] * lf[3]))
                    + lam_init)
        o = diff_attention(q, k, v, lam_full)
        o = rms_norm(o, g_subln[i]) * (1.0 - lam_init)
        attn_d = o.reshape(b, s, ATTN_V) @ w_attn_out[i]
        conv_d = conformer_conv(u, conv_w[i], conv_b[i], conv_ln_g[i], conv_ln_b[i],
                                w_conv_out[i])
        ga, gc = jnp.split(gl, 2, axis=-1)
        x = x + (jax.nn.sigmoid(ga) * attn_d + jax.nn.sigmoid(gc) * conv_d) @ w_o[i]
        h = rms_norm(x, g_ffn[i])
        if i % 2 == 0:
            x = x + swiglu(h, w_ff_gu[i // 2], w_ff_down[i // 2])
        else:
            m = i // 2
            x = x + moe_swiglu(h, w_router[m], b_router[m], we_gu[m], we_down[m])
        h = rms_norm(x, g_ple[i])
        x = x + jax.nn.sigmoid(h @ w_ple_gate[i]) * (p[i] @ w_ple_proj[i])
    return rms_norm(x, g_final)
```

```cpp
#include <hip/hip_runtime.h>
#include <cstdio>
#include <cstdint>
#define MK_SP2 false
#define MK_ALIGN false
#define MK_NAIVE_ATTN 1
namespace pg8 {
#define PG8_LAS __attribute__((address_space(3)))
typedef unsigned short bf16_t;
typedef short bf16x8 __attribute__((ext_vector_type(8)));
typedef float f32x4 __attribute__((ext_vector_type(4)));
typedef unsigned u32x4 __attribute__((ext_vector_type(4)));
constexpr int BM = 256, BK = 64, HALF = 128, HTB = HALF * BK * 2  , STAGE_BYTES = 8 * HTB, NXCD = 8, WGM = 8;

__host__ __device__ __forceinline__ int lds_byte(int r, int c) { const int st = (r >> 4) * 2 + (c >> 5), rr = r & 15, cc = c & 31, ob = rr * 64 + cc * 2; return st * 1024 + (ob ^ (((ob >> 9) & 1) << 5)); }
__host__ __device__ __forceinline__ void stage_rc(int b, int& R, int& C) { const int st = b / 1024, sb = b % 1024, swz = sb ^ (((sb >> 9) & 1) << 5); R = (st >> 1) * 16 + swz / 64; C = (st & 1) * 32 + (swz % 64) / 2; }
__host__ __device__ __forceinline__ int perm32(int rho) { const int n = rho >> 4, i = rho & 15; return 8 * (i >> 2) + 4 * n + (i & 3); }

struct Unit { int pm, pn; };
struct Gemm { const bf16_t* A; const bf16_t* Bt; int M, N, K; };

typedef float cvt_f32x2_t __attribute__((ext_vector_type(2))); typedef __bf16 cvt_bf16x2_t __attribute__((ext_vector_type(2)));
__device__ __forceinline__ unsigned cvt_pk_bf16(float lo, float hi) { cvt_f32x2_t v = {lo, hi}; cvt_bf16x2_t b = __builtin_convertvector(v, cvt_bf16x2_t); return __builtin_bit_cast(unsigned, b); }
typedef float f32x2 __attribute__((ext_vector_type(2)));
typedef unsigned u32x2 __attribute__((ext_vector_type(2)));
__device__ __forceinline__ float sigm(float x) { return __builtin_amdgcn_rcpf(1.0f + __builtin_amdgcn_exp2f(-1.4426950408889634f * x)); }
__device__ __forceinline__ float bf_lo(unsigned w) { return __uint_as_float(w << 16); }
__device__ __forceinline__ float bf_hi(unsigned w) { return __uint_as_float(w & 0xffff0000u); }

struct GroupOrder {
    int ng, nN, nwg, G, c, TM; PG8_LAS int* tp;
    __device__ __forceinline__ void init_equal(int ngroups, int rows_per_group, int N, int G_, int c_, PG8_LAS int* tp_) {
        ng = ngroups; nN = N / BM; const int t = rows_per_group / BM; TM = t * ngroups; nwg = TM * nN; G = G_; c = c_; tp = tp_;
        if (ngroups > 1) { int tx = threadIdx.x; asm volatile("" : "+v"(tx)); if (tx < 9) tp[tx] = (tx < ngroups ? tx : ngroups) * t; __syncthreads(); }
    }
    __device__ __forceinline__ void init_dense(int M, int N, int G_, int c_) { init_equal(1, M, N, G_, c_, nullptr); }
    __device__ __forceinline__ void init_counts(const unsigned (&cnt)[8], int N, int G_, int c_, PG8_LAS int* tp_) {
        ng = 8; nN = N / BM; G = G_; c = c_; tp = tp_; int s = 0; int tx = threadIdx.x; asm volatile("" : "+v"(tx));
        if (tx == 0) tp[0] = 0;
#pragma unroll
        for (int e = 0; e < 8; ++e) { s += (int)((cnt[e] + 255u) >> 8); if (tx == 0) tp[e + 1] = s; }
        TM = s; nwg = TM * nN; __syncthreads();
    }
    __device__ __forceinline__ bool next(int i, Unit& u) const {
        const long L = (long)i * G + c; if (L >= nwg) return false;
        int wgid = (int)L; { const int q = nwg / NXCD, r = nwg % NXCD, xcd = wgid % NXCD, off = wgid / NXCD; wgid = (xcd < r ? xcd * (q + 1) : r * (q + 1) + (xcd - r) * q) + off; }
        const int nig = WGM * nN, gid = wgid / nig, fm = gid * WGM, gsz = (TM - fm) < WGM ? (TM - fm) : WGM;
        const int rt = fm + ((wgid % nig) % gsz), pl = (wgid % nig) / gsz;
        int e = 0;
        if (ng > 1) {
#pragma unroll
            for (int j = 1; j < 8; ++j) e += (j < ng && rt >= __builtin_amdgcn_readfirstlane(tp[j])) ? 1 : 0; }
        u.pm = rt; u.pn = e * nN + pl; return true;
    }
    __device__ __forceinline__ void a_ready(const Unit&) const {}
    __device__ __forceinline__ void done(const Unit&) const {}
};

#define EPI_ROWS(row0) _Pragma("unroll") for (int ai = 0; ai < 2; ++ai) _Pragma("unroll") for (int m = 0; m < 4; ++m)
__device__ __forceinline__ u32x4 pack8(const f32x4 a, const f32x4 b) { u32x4 w; w.x = cvt_pk_bf16(a[0], a[1]); w.y = cvt_pk_bf16(a[2], a[3]); w.z = cvt_pk_bf16(b[0], b[1]); w.w = cvt_pk_bf16(b[2], b[3]); return w; }
__device__ __forceinline__ f32x4 sigm4(const f32x4 v) { return (f32x4){sigm(v[0]), sigm(v[1]), sigm(v[2]), sigm(v[3])}; }

struct EpiInProj {
    static constexpr bool PERM = true, AFTER_DRAIN = false;
    bf16_t *Q, *K, *V, *Z, *SG; const float* rope; float qscale;
    __device__ __forceinline__ void operator()(const f32x4 (&acc)[2][2][4][2], const Unit& u, int wr, int wc, int fr, int fq) const {
        const int pn = u.pn, row0 = u.pm * BM + wr * 64 + fr, cl = wc * 32 + 8 * fq;
        if (pn < 4) {
            bf16_t* base = (pn < 2) ? Q : K; const float sc = (pn < 2) ? qscale : 1.0f; const int colt = (pn & 1) * 256, g4 = 4 * (4 * (wc & 1) + fq);
            EPI_ROWS(row0) { const int row = row0 + ai * HALF + m * 16; const float* rp = rope + (size_t)(row & 2047) * 64 + g4;
                const f32x4 cs = *(const f32x4*)rp, sn = *(const f32x4*)(rp + 32);
#pragma unroll
                for (int bj = 0; bj < 2; ++bj) { const f32x4 v0 = acc[ai][bj][m][0], v1 = acc[ai][bj][m][1];
                    const f32x4 lo = (v0 * cs - v1 * sn) * sc, hi = (v1 * cs + v0 * sn) * sc;
                    bf16_t* p = base + (size_t)row * 512 + colt + (2 * bj + (wc >> 1)) * 64 + g4;
                    u32x2 a; a.x = cvt_pk_bf16(lo[0], lo[1]); a.y = cvt_pk_bf16(lo[2], lo[3]); *(u32x2*)p = a;
                    u32x2 b; b.x = cvt_pk_bf16(hi[0], hi[1]); b.y = cvt_pk_bf16(hi[2], hi[3]); *(u32x2*)(p + 32) = b; } }
        } else if (pn < 6) {
            EPI_ROWS(row0) { bf16_t* p = V + (size_t)(row0 + ai * HALF + m * 16) * 512 + (pn - 4) * 256 + cl;
#pragma unroll
                for (int bj = 0; bj < 2; ++bj) *(u32x4*)(p + bj * HALF) = pack8(acc[ai][bj][m][0], acc[ai][bj][m][1]); }
        } else if (pn < 10) {
            EPI_ROWS(row0) { bf16_t* p = Z + (size_t)(row0 + ai * HALF + m * 16) * 512 + (pn - 6) * 128 + cl;
                *(u32x4*)p = pack8(acc[ai][0][m][0] * sigm4(acc[ai][1][m][0]), acc[ai][0][m][1] * sigm4(acc[ai][1][m][1])); }
        } else {
            EPI_ROWS(row0) { bf16_t* p = SG + (size_t)(row0 + ai * HALF + m * 16) * 2048 + (pn - 10) * 256 + cl;
#pragma unroll
                for (int bj = 0; bj < 2; ++bj) *(u32x4*)(p + bj * HALF) = pack8(sigm4(acc[ai][bj][m][0]), sigm4(acc[ai][bj][m][1])); }
        }
    }
};
template <int MODE> struct EpiGate {
    static constexpr bool PERM = false, AFTER_DRAIN = false;
    float* P; bf16_t* MIX; const bf16_t* SG;
    __device__ __forceinline__ void operator()(const f32x4 (&acc)[2][2][4][2], const Unit& u, int wr, int wc, int fr, int fq) const {
        const int row0 = u.pm * BM + wr * 64 + fr, col0 = u.pn * BM + wc * 32 + 4 * fq;
        EPI_ROWS(row0) { const size_t row = (size_t)(row0 + ai * HALF + m * 16);
#pragma unroll
            for (int bj = 0; bj < 2; ++bj)
#pragma unroll
                for (int n = 0; n < 2; ++n) { const int col = col0 + bj * HALF + n * 16;
                    const u32x2 gw = *(const u32x2*)(SG + row * 2048 + MODE * 1024 + col);
                    const f32x4 gt = (f32x4){bf_lo(gw.x), bf_hi(gw.x), bf_lo(gw.y), bf_hi(gw.y)};
                    if (MODE == 0) *(f32x4*)(P + row * 1024 + col) = gt * acc[ai][bj][m][n];
                    else { const f32x4 r = *(const f32x4*)(P + row * 1024 + col) + gt * acc[ai][bj][m][n];
                        u32x2 w; w.x = cvt_pk_bf16(r[0], r[1]); w.y = cvt_pk_bf16(r[2], r[3]); *(u32x2*)(MIX + row * 1024 + col) = w; } } }
    }
};
struct EpiResid {
    static constexpr bool PERM = false, AFTER_DRAIN = false;
    const float* base; float* out; int nN;
    __device__ __forceinline__ void operator()(const f32x4 (&acc)[2][2][4][2], const Unit& u, int wr, int wc, int fr, int fq) const {
        const int row0 = u.pm * BM + wr * 64 + fr, col0 = (u.pn % nN) * BM + wc * 32 + 4 * fq;
        EPI_ROWS(row0) { const size_t off = (size_t)(row0 + ai * HALF + m * 16) * 1024 + col0;
#pragma unroll
            for (int bj = 0; bj < 2; ++bj)
#pragma unroll
                for (int n = 0; n < 2; ++n) { f32x4 r = acc[ai][bj][m][n]; if (base) r += *(const f32x4*)(base + off + bj * HALF + n * 16); *(f32x4*)(out + off + bj * HALF + n * 16) = r; } }
    }
};
struct EpiSwiGLU {
    static constexpr bool PERM = true, AFTER_DRAIN = false;
    bf16_t* ACT; int ldc, nN;
    __device__ __forceinline__ void operator()(const f32x4 (&acc)[2][2][4][2], const Unit& u, int wr, int wc, int fr, int fq) const {
        const int row0 = u.pm * BM + wr * 64 + fr, cl = (u.pn % nN) * 128 + wc * 32 + 8 * fq;
        EPI_ROWS(row0) { bf16_t* p = ACT + (size_t)(row0 + ai * HALF + m * 16) * ldc + cl;
            const f32x4 g0 = acc[ai][0][m][0], g1 = acc[ai][0][m][1];
            *(u32x4*)p = pack8(g0 * sigm4(g0) * acc[ai][1][m][0], g1 * sigm4(g1) * acc[ai][1][m][1]); }
    }
};
struct EpiStore {
    static constexpr bool PERM = true, AFTER_DRAIN = false;
    bf16_t* O; int ldc, nN;
    __device__ __forceinline__ void operator()(const f32x4 (&acc)[2][2][4][2], const Unit& u, int wr, int wc, int fr, int fq) const {
        const int row0 = u.pm * BM + wr * 64 + fr, cl = (u.pn % nN) * BM + wc * 32 + 8 * fq;
        EPI_ROWS(row0) { bf16_t* p = O + (size_t)(row0 + ai * HALF + m * 16) * ldc + cl;
#pragma unroll
            for (int bj = 0; bj < 2; ++bj) *(u32x4*)(p + bj * HALF) = pack8(acc[ai][bj][m][0], acc[ai][bj][m][1]); }
    }
};
struct EpiPleGate {
    static constexpr bool PERM = false, AFTER_DRAIN = false;
    float* X; const bf16_t* PROJ;
    __device__ __forceinline__ void operator()(const f32x4 (&acc)[2][2][4][2], const Unit& u, int wr, int wc, int fr, int fq) const {
        const int row0 = u.pm * BM + wr * 64 + fr, col0 = u.pn * BM + wc * 32 + 4 * fq;
        EPI_ROWS(row0) { const size_t off = (size_t)(row0 + ai * HALF + m * 16) * 1024 + col0;
#pragma unroll
            for (int bj = 0; bj < 2; ++bj)
#pragma unroll
                for (int n = 0; n < 2; ++n) { const size_t o = off + bj * HALF + n * 16; const u32x2 pw = *(const u32x2*)(PROJ + o);
                    const f32x4 pr = (f32x4){bf_lo(pw.x), bf_hi(pw.x), bf_lo(pw.y), bf_hi(pw.y)};
                    *(f32x4*)(X + o) = *(const f32x4*)(X + o) + sigm4(acc[ai][bj][m][n]) * pr; } }
    }
};

template <class Epi, class Sched>
__device__ __forceinline__ void gemm_phase_naive(const Gemm g, const Sched& S, const Epi& E) {
    int tid_ = threadIdx.x; asm volatile("" : "+v"(tid_));
    const int tid = tid_, wid = __builtin_amdgcn_readfirstlane(tid >> 6), lane = tid & 63, wr = wid >> 2, wc = wid & 3, fr = lane & 15, fq = lane >> 4;
    const int K = g.K; Unit u;
    for (int ui = 0; S.next(ui, u); ++ui) {
        f32x4 acc[2][2][4][2];
#pragma unroll
        for (int ai = 0; ai < 2; ++ai)
#pragma unroll
            for (int m = 0; m < 4; ++m) {
                const bf16_t* ap = g.A + (size_t)(u.pm * BM + ai * HALF + wr * 64 + m * 16 + fr) * K;
#pragma unroll
                for (int bj = 0; bj < 2; ++bj)
#pragma unroll
                    for (int n = 0; n < 2; ++n) { f32x4 r = (f32x4){0.f, 0.f, 0.f, 0.f};
#pragma unroll
                        for (int j = 0; j < 4; ++j) { const int col = u.pn * BM + bj * HALF + wc * 32 + (Epi::PERM ? (8 * fq + 4 * n + j) : (16 * n + 4 * fq + j));
                            const bf16_t* bp = g.Bt + (size_t)col * K; float s = 0.f;
                            for (int k = 0; k < K; k += 8) { const u32x4 a = *(const u32x4*)(ap + k), b = *(const u32x4*)(bp + k);
                                s += bf_lo(a.x) * bf_lo(b.x) + bf_hi(a.x) * bf_hi(b.x) + bf_lo(a.y) * bf_lo(b.y) + bf_hi(a.y) * bf_hi(b.y)
                                   + bf_lo(a.z) * bf_lo(b.z) + bf_hi(a.z) * bf_hi(b.z) + bf_lo(a.w) * bf_lo(b.w) + bf_hi(a.w) * bf_hi(b.w); }
                            r[j] = s; }
                        acc[ai][bj][m][n] = r; } }
        E(acc, u, wr, wc, fr, fq);
    }
}
template <class Epi, class Sched, bool ALIGN_EPI = false, bool SP2 = false>
__device__ __forceinline__ void gemm_phase(PG8_LAS unsigned char* lds, const Gemm g, const Sched& S, const Epi& E) {
    int tid_ = threadIdx.x; asm volatile("" : "+v"(tid_));
    const int tid = tid_, wid = __builtin_amdgcn_readfirstlane(tid >> 6), lane = tid & 63, wr = wid >> 2, wc = wid & 3, fr = lane & 15, fq = lane >> 4;
    int K_ = g.K; asm volatile("" : "+s"(K_));
    const int K = K_, nt = K / BK;
    unsigned voffA[2], voffB[2];
#pragma unroll
    for (int i = 0; i < 2; ++i) { int R, C; stage_rc(tid * 16 + i * 8192, R, C); const int Rb = Epi::PERM ? ((R & ~31) + perm32(R & 31)) : R;
        voffA[i] = (unsigned)(R * K + C) * 2u; voffB[i] = (unsigned)(Rb * K + C) * 2u; }
    const size_t kstep = (size_t)(BK * 2);
    const size_t hstep = (size_t)HALF * K * 2;
    const size_t tstep = 2 * hstep;
    const unsigned ldsw = (unsigned)wid * 1024u;
    const int aoff = lds_byte(wr * 64 + fr, fq * 8), boff = lds_byte(wc * 32 + fr, fq * 8);
#define PG8_SA(b, h) (((b) * 2 + (h)) * HTB)
#define PG8_SB(b, h) ((4 + (b) * 2 + (h)) * HTB)
#define PG8_STAGE(bufoff, gbase, voff) do { _Pragma("unroll") for (int _i = 0; _i < 2; ++_i) \
        __builtin_amdgcn_global_load_lds((const unsigned*)((const char*)(gbase) + (voff)[_i]), (PG8_LAS unsigned*)(lds + (bufoff) + ldsw + _i * 8192), 16, 0, 0); } while (0)
#define PG8_LDA(dst, b, h) do { _Pragma("unroll") for (int m = 0; m < 4; ++m) _Pragma("unroll") for (int k = 0; k < 2; ++k) dst[m][k] = *(const PG8_LAS bf16x8*)(lds + PG8_SA(b, h) + aoff + m * 2048 + k * 1024); } while (0)
#define PG8_LDB(dst, b, h) do { _Pragma("unroll") for (int n = 0; n < 2; ++n) _Pragma("unroll") for (int k = 0; k < 2; ++k) dst[n][k] = *(const PG8_LAS bf16x8*)(lds + PG8_SB(b, h) + boff + n * 2048 + k * 1024); } while (0)
#define PG8_MMA(ai, bj, At, Bt) do { __builtin_amdgcn_s_setprio(1); _Pragma("unroll") for (int m = 0; m < 4; ++m) _Pragma("unroll") for (int n = 0; n < 2; ++n) _Pragma("unroll") for (int k = 0; k < 2; ++k) \
        acc[ai][bj][m][n] = __builtin_amdgcn_mfma_f32_16x16x32_bf16(Bt[n][k], At[m][k], acc[ai][bj][m][n], 0, 0, 0); __builtin_amdgcn_s_setprio(0); } while (0)
#define PG8_WAIT_V(n) asm volatile("s_waitcnt vmcnt(" #n ")" ::: "memory")
#define PG8_WAIT_L(n) asm volatile("s_waitcnt lgkmcnt(" #n ")" ::: "memory")
#define PG8_BAR __builtin_amdgcn_s_barrier()
#define PG8_SCHED __builtin_amdgcn_sched_barrier(0)
    Unit cur, nxt; int ui = 0;
    if (!S.next(0, cur)) return;
    f32x4 acc[2][2][4][2];
#pragma unroll
    for (int a = 0; a < 2; ++a)
#pragma unroll
        for (int b = 0; b < 2; ++b)
#pragma unroll
            for (int m = 0; m < 4; ++m)
#pragma unroll
                for (int n = 0; n < 2; ++n) acc[a][b][m][n] = (f32x4){0.f, 0.f, 0.f, 0.f};
    bf16x8 At[4][2], B0[2][2], B1[2][2];
    const char* cA = (const char*)g.A + (size_t)cur.pm * tstep; const char* cB = (const char*)g.Bt + (size_t)cur.pn * tstep;
    S.a_ready(cur);
    if constexpr (SP2) {
        PG8_STAGE(PG8_SB(0, 0), cB, voffB); PG8_STAGE(PG8_SB(0, 1), cB + hstep, voffB); PG8_STAGE(PG8_SA(0, 0), cA, voffA); PG8_STAGE(PG8_SA(0, 1), cA + hstep, voffA);
        if (wr == 1) PG8_BAR;
        PG8_WAIT_V(2); PG8_BAR;
        PG8_STAGE(PG8_SB(1, 0), cB + kstep, voffB); PG8_STAGE(PG8_SA(1, 0), cA + kstep, voffA); PG8_STAGE(PG8_SB(1, 1), cB + hstep + kstep, voffB);
        PG8_WAIT_V(6); PG8_BAR;
    } else {
        PG8_STAGE(PG8_SB(0, 0), cB, voffB); PG8_STAGE(PG8_SA(0, 0), cA, voffA); PG8_STAGE(PG8_SB(0, 1), cB + hstep, voffB); PG8_STAGE(PG8_SA(0, 1), cA + hstep, voffA);
        if (wr == 1) PG8_BAR;
        PG8_WAIT_V(4); PG8_BAR;
        PG8_STAGE(PG8_SB(1, 0), cB + kstep, voffB); PG8_STAGE(PG8_SA(1, 0), cA + kstep, voffA); PG8_STAGE(PG8_SB(1, 1), cB + hstep + kstep, voffB);
        PG8_WAIT_V(6); PG8_BAR;
    }
    for (;;) {
        const bool has_next = S.next(ui + 1, nxt);
        const char* nA = has_next ? (const char*)g.A + (size_t)nxt.pm * tstep : cA; const char* nB = has_next ? (const char*)g.Bt + (size_t)nxt.pn * tstep : cB;
#pragma nounroll
        for (int t = 0; t < nt; t += 2) {
            const bool last = (t == nt - 2);
            const char* a1 = cA + (size_t)(t + 1) * kstep;
            const char* a2 = last ? nA : cA + (size_t)(t + 2) * kstep; const char* b2 = last ? nB : cB + (size_t)(t + 2) * kstep;
            const char* a3 = a2 + kstep; const char* b3 = b2 + kstep;
            if (last && has_next) S.a_ready(nxt);
            if constexpr (SP2) {
            PG8_LDB(B0, 0, 0); PG8_LDB(B1, 0, 1); PG8_SCHED; PG8_LDA(At, 0, 0); PG8_STAGE(PG8_SA(1, 1), a1 + hstep, voffA);
            PG8_WAIT_V(8); PG8_WAIT_L(0); PG8_BAR; PG8_MMA(0, 0, At, B0); PG8_MMA(0, 1, At, B1); PG8_BAR; PG8_SCHED;
            PG8_LDA(At, 0, 1); PG8_STAGE(PG8_SB(0, 0), b2, voffB); PG8_STAGE(PG8_SB(0, 1), b2 + hstep, voffB); PG8_STAGE(PG8_SA(0, 0), a2, voffA);
            PG8_WAIT_V(8); PG8_WAIT_L(0); PG8_BAR; PG8_MMA(1, 0, At, B0); PG8_MMA(1, 1, At, B1); PG8_BAR; PG8_SCHED;
            PG8_LDB(B0, 1, 0); PG8_LDB(B1, 1, 1); PG8_SCHED; PG8_LDA(At, 1, 0); PG8_STAGE(PG8_SA(0, 1), a2 + hstep, voffA);
            PG8_WAIT_V(8); PG8_WAIT_L(0); PG8_BAR; PG8_MMA(0, 0, At, B0); PG8_MMA(0, 1, At, B1); PG8_BAR; PG8_SCHED;
            PG8_LDA(At, 1, 1); PG8_STAGE(PG8_SB(1, 0), b3, voffB); PG8_STAGE(PG8_SB(1, 1), b3 + hstep, voffB); PG8_STAGE(PG8_SA(1, 0), a3, voffA);
            PG8_WAIT_V(8); PG8_WAIT_L(0); PG8_BAR; PG8_MMA(1, 0, At, B0); PG8_MMA(1, 1, At, B1); PG8_BAR; PG8_SCHED;
            } else {
            PG8_LDB(B0, 0, 0); PG8_SCHED; PG8_LDA(At, 0, 0); PG8_STAGE(PG8_SA(1, 1), a1 + hstep, voffA);
            PG8_WAIT_L(8); PG8_BAR; PG8_WAIT_L(0); PG8_MMA(0, 0, At, B0); PG8_BAR; PG8_SCHED;
            PG8_LDB(B1, 0, 1); PG8_STAGE(PG8_SB(0, 0), b2, voffB);
            PG8_BAR; PG8_WAIT_L(0); PG8_MMA(0, 1, At, B1); PG8_BAR;
            PG8_LDA(At, 0, 1); PG8_STAGE(PG8_SA(0, 0), a2, voffA);
            PG8_BAR; PG8_WAIT_L(0); PG8_MMA(1, 0, At, B0); PG8_BAR; PG8_SCHED;
            PG8_STAGE(PG8_SB(0, 1), b2 + hstep, voffB);
            PG8_WAIT_V(6); PG8_BAR; PG8_MMA(1, 1, At, B1); PG8_BAR;
            PG8_LDB(B0, 1, 0); PG8_SCHED; PG8_LDA(At, 1, 0); PG8_STAGE(PG8_SA(0, 1), a2 + hstep, voffA);
            PG8_WAIT_L(8); PG8_BAR; PG8_WAIT_L(0); PG8_MMA(0, 0, At, B0); PG8_BAR; PG8_SCHED;
            PG8_LDB(B1, 1, 1); PG8_STAGE(PG8_SB(1, 0), b3, voffB);
            PG8_BAR; PG8_WAIT_L(0); PG8_MMA(0, 1, At, B1); PG8_BAR;
            PG8_LDA(At, 1, 1); PG8_STAGE(PG8_SA(1, 0), a3, voffA);
            PG8_BAR; PG8_WAIT_L(0); PG8_MMA(1, 0, At, B0); PG8_BAR; PG8_SCHED;
            PG8_STAGE(PG8_SB(1, 1), b3 + hstep, voffB);
            PG8_WAIT_V(6); PG8_BAR; PG8_MMA(1, 1, At, B1); PG8_BAR;
            }
        }
        if constexpr (ALIGN_EPI) { if (wr == 0) PG8_BAR; }
        if constexpr (!Epi::AFTER_DRAIN) { E(acc, cur, wr, wc, fr, fq); S.done(cur); }
        if (!has_next) break;
#pragma unroll
        for (int a = 0; a < 2; ++a)
#pragma unroll
            for (int b = 0; b < 2; ++b)
#pragma unroll
                for (int m = 0; m < 4; ++m)
#pragma unroll
                    for (int n = 0; n < 2; ++n) acc[a][b][m][n] = (f32x4){0.f, 0.f, 0.f, 0.f};
        cur = nxt; cA = nA; cB = nB; ++ui;
        if constexpr (ALIGN_EPI) { if (wr == 1) PG8_BAR; }
    }
    PG8_WAIT_V(0);
    if constexpr (!ALIGN_EPI) { if (wr == 0) PG8_BAR; }
    PG8_BAR;
    if constexpr (Epi::AFTER_DRAIN) { E.fused(acc, cur, wr, wc, fr, fq, lds, wid, lane); S.done(cur); }
#undef PG8_SA
#undef PG8_SB
#undef PG8_STAGE
#undef PG8_LDA
#undef PG8_LDB
#undef PG8_MMA
#undef PG8_WAIT_V
#undef PG8_WAIT_L
#undef PG8_BAR
#undef PG8_SCHED
}
}

constexpr int NWAVES = 8;
#ifndef MK_PER_PHASE
#define MK_PER_PHASE 0
#endif
#ifndef MK_NAIVE_GEMM
#define MK_NAIVE_GEMM 0
#endif
#ifndef MK_SP2
#define MK_SP2 true
#endif
#ifndef MK_ALIGN
#define MK_ALIGN true
#endif
#ifdef DBG_TWOPASS
#define DBG_TWOPASS_ON 1
#else
#define DBG_TWOPASS_ON 0
#endif
#ifndef DBG_LAYER
#define DBG_LAYER 0
#endif
#ifndef DBG_INJECT
#define DBG_INJECT 0.f
#endif
#ifndef MK_NAIVE_ATTN
#define MK_NAIVE_ATTN 1
#endif

constexpr int BATCH = 8, SEQ = 2048, D = 1024, T = BATCH * SEQ, DEPTH = 2;
constexpr int NH = 4, HD = 64, VD = 128, AQK = 512, AV = 512, CCH = 512, CK = 31, CPAD = 15;
constexpr int INC = 2 * AQK + AV + 2 * CCH + 2 * D;
constexpr int FF = 2816, NE = 8, FE = 3584, PLE = 256;
constexpr float EPS = 1e-6f;
constexpr float QSCALE = 0.125f * 1.4426950408889634f;
constexpr int MOE_ROWS = 2 * T + NE * 256;
enum { I_X = 0, I_P, I_GMIX, I_WIN, I_LAM, I_GSUB, I_WAO, I_CW, I_CB, I_CLG, I_CLB, I_WCO, I_WO, I_GFFN, I_WFGU, I_WFDN, I_WR, I_BR, I_WEGU, I_WEDN, I_GPLE, I_WPG, I_WPP, I_GFIN, N_IN };

constexpr size_t MiB = 1u << 20;
constexpr size_t WS_CTL = 0, CTL_ZERO_BYTES = 1 * MiB;
constexpr size_t WS_ROPE = 1 * MiB;
constexpr size_t WS_SCAL = 1 * MiB + 512 * 1024;
constexpr size_t WS_RTI = WS_SCAL + 4096;
constexpr size_t WS_RTW = WS_RTI + (size_t)T * 16;
constexpr size_t WS_RSEL = WS_RTW + (size_t)T * 8;
static_assert(WS_RSEL + (size_t)T * 8 <= 4 * MiB, "misc region");
constexpr size_t WS_WIN = 4 * MiB, WS_WA = 22 * MiB, WS_WC = 24 * MiB, WS_WO = 26 * MiB, WS_WFGU = 30 * MiB, WS_WFDN = 41 * MiB, WS_WPG = 47 * MiB, WS_WPP = 51 * MiB;
constexpr size_t WS_WEGU = 52 * MiB, WS_WEDN = 164 * MiB;
constexpr size_t WS_X = 220 * MiB, WS_H = 284 * MiB, WS_PROJ = 316 * MiB, WS_PB = 380 * MiB, WS_R = 396 * MiB;
constexpr size_t WS_Q = WS_R, WS_K = WS_R + 16 * MiB, WS_V = WS_R + 32 * MiB, WS_Z = WS_R + 48 * MiB, WS_SG = WS_R + 64 * MiB, WS_OB = WS_R + 128 * MiB, WS_ZC = WS_R + 144 * MiB,
                 WS_P = WS_R + 160 * MiB, WS_MIX = WS_R + 224 * MiB;
constexpr size_t WS_ACT = WS_R, WS_HP = WS_R + 240 * MiB, WS_Y = WS_R + 308 * MiB, WS_END = WS_R + 444 * MiB;
static_assert((size_t)MOE_ROWS * FE * 2 <= 240 * MiB && (size_t)MOE_ROWS * D * 2 <= 68 * MiB && (size_t)MOE_ROWS * D * 4 <= 136 * MiB && (size_t)T * FF * 2 <= 240 * MiB, "region R");
constexpr int CW_TMO = 0, CW_CODE = 1, CW_BAR = 4096, CW_GCNT = 8192;

constexpr int RING_OFF = 0, RING_BYTES = 131072;
constexpr int LDSCTL_OFF = RING_BYTES, MISC_OFF = LDSCTL_OFF + 320;
constexpr int TP_OFF = MISC_OFF + 64;
constexpr int LDS_BYTES = 147456;

#define GAS __attribute__((address_space(1)))
#define LAS __attribute__((address_space(3)))
typedef unsigned short bf16;
typedef unsigned v4u __attribute__((ext_vector_type(4)));
typedef unsigned v2u __attribute__((ext_vector_type(2)));
typedef float f32x4 __attribute__((ext_vector_type(4)));
typedef GAS unsigned gu32;
#define RLX_AGENT __ATOMIC_RELAXED, __HIP_MEMORY_SCOPE_AGENT
#define LDS_WAIT() asm volatile("s_waitcnt lgkmcnt(0)" ::: "memory")
#define VM_WAIT() asm volatile("s_waitcnt vmcnt(0)" ::: "memory")
__device__ __forceinline__ unsigned f2bf(float f) { unsigned u = __builtin_bit_cast(unsigned, f); return (u + 0x7fffu + ((u >> 16) & 1u)) >> 16; }
__device__ __forceinline__ unsigned pk2(float lo, float hi) { return f2bf(lo) | (f2bf(hi) << 16); }
using pg8::bf_lo; using pg8::bf_hi; using pg8::sigm;

#define XB_TMO      128
#define XB_XCNT(j)  (256  + 64 * (j))
#define XB_XSUB(j)  (1280 + 64 * (j))
#define XB_XGEN(j)  (2304 + 64 * (j))
#define XB_TOP      3328
#define XB_TOPGEN   3392
#define XCD_BAR_WORDS 3456
#define XB_SPIN_CAP (1u << 18)

__device__ __forceinline__ unsigned xb_ld(unsigned* p)              { return __hip_atomic_load(p, __ATOMIC_RELAXED, __HIP_MEMORY_SCOPE_AGENT); }
__device__ __forceinline__ unsigned xb_add(unsigned* p, unsigned v) { return __hip_atomic_fetch_add(p, v, __ATOMIC_RELAXED, __HIP_MEMORY_SCOPE_AGENT); }
__device__ __forceinline__ unsigned xb_xcc_id() { return (unsigned)__builtin_amdgcn_s_getreg((3 << 11) | 20) & 0xFu; }
#define XB_SPIN(cond, bar) do { unsigned _sp = 0; while (cond) { __builtin_amdgcn_s_sleep(1); \
    if ((++_sp & 255u) == 0u) { if (xb_ld(&(bar)[XB_TMO])) break; if (_sp > XB_SPIN_CAP) { atomicAdd(&(bar)[XB_TMO], 1u); break; } } } } while (0)

struct XcdBarrier {
    unsigned* bar; unsigned x;
    volatile LAS unsigned* st;
};

__device__ __forceinline__ XcdBarrier xcd_barrier_post(unsigned* bar, volatile LAS unsigned* st) {
    XcdBarrier b; b.bar = bar; b.x = xb_xcc_id(); b.st = st;
    if (threadIdx.x == 0) (void)xb_add(&bar[XB_XCNT(b.x)], 1u);
    return b;
}
__device__ __forceinline__ void xcd_barrier_complete(unsigned* bar, unsigned x, unsigned& nloc, unsigned& nx) {
    const unsigned G = gridDim.x * gridDim.y * gridDim.z;
    unsigned sum, cnt, mine, sp = 0u;
    for (;;) {
        sum = 0u; cnt = 0u; mine = 0u;
#pragma unroll
        for (unsigned j = 0; j < 16; ++j) { const unsigned c = xb_ld(&bar[XB_XCNT(j)]); sum += c; cnt += (c > 0u) ? 1u : 0u; mine = (j == x) ? c : mine; }
        if (sum == G) break;
        __builtin_amdgcn_s_sleep(1);
        if ((++sp & 255u) == 0u) { if (xb_ld(&bar[XB_TMO])) break; if (sp > XB_SPIN_CAP) { atomicAdd(&bar[XB_TMO], 1u); break; } }
    }
    nloc = mine > 0u ? mine : 1u; nx = cnt > 0u ? cnt : 1u;
}

__device__ __forceinline__ void xcd_barrier(const XcdBarrier& b) {
    asm volatile("s_waitcnt vmcnt(0)" ::: "memory");
    __syncthreads();
    if (threadIdx.x == 0) {
        GAS unsigned* gbar_ = (GAS unsigned*)b.bar; unsigned bx = b.x; asm volatile("" : "+s"(gbar_), "+s"(bx)); unsigned* bar = (unsigned*)gbar_;
        __builtin_amdgcn_s_waitcnt(0);
        unsigned nloc = b.st[0], nx = b.st[1];
        if (nloc == 0u) { xcd_barrier_complete(bar, bx, nloc, nx); b.st[0] = nloc; b.st[1] = nx; }
        const unsigned old = xb_add(&bar[XB_XSUB(bx)], 1u);
        const unsigned gen = old / nloc;
        if (old + 1u == (gen + 1u) * nloc) {
            __builtin_amdgcn_fence(__ATOMIC_RELEASE, "agent");
            asm volatile("s_waitcnt vmcnt(0)" ::: "memory");
            const unsigned og = xb_add(&bar[XB_TOP], 1u);
            const unsigned tg = og / nx;
            if (og + 1u == (tg + 1u) * nx) xb_add(&bar[XB_TOPGEN], 1u);
            else XB_SPIN(xb_ld(&bar[XB_TOPGEN]) == tg, bar);
            __builtin_amdgcn_fence(__ATOMIC_ACQUIRE, "agent");
            xb_add(&bar[XB_XGEN(bx)], 1u);
            asm volatile("s_waitcnt vmcnt(0)" ::: "memory");
        } else {
            XB_SPIN(xb_ld(&bar[XB_XGEN(bx)]) == gen, bar);
            __builtin_amdgcn_fence(__ATOMIC_ACQUIRE, "agent");
            asm volatile("s_waitcnt vmcnt(0)" ::: "memory");
        }
    }
    __syncthreads();
}

struct Frame {
    LAS unsigned char* lds;
    volatile LAS unsigned* MISC;
    gu32* ctl;
    GAS unsigned char* ws;
    int tid, lane, wave, G;
};
#define CAS __attribute__((address_space(4)))
__device__ __forceinline__ const float* inp(int i) {
    const CAS unsigned char* k = (const CAS unsigned char*)__builtin_amdgcn_kernarg_segment_ptr();
    asm volatile("" : "+s"(k));
    return (const float*)*(GAS const float* const CAS*)(k + 8 * i);
}
__device__ __forceinline__ float* outp() {
    const CAS unsigned char* k = (const CAS unsigned char*)__builtin_amdgcn_kernarg_segment_ptr();
    asm volatile("" : "+s"(k));
    return (float*)*(GAS float* const CAS*)(k + 8 * N_IN);
}
template <class TP> __device__ __forceinline__ TP* wsp(Frame& F, size_t off) { GAS unsigned char* w = F.ws; asm volatile("" : "+s"(w)); return (TP*)(w + off); }

__device__ __forceinline__ float wave_sum(float v) {
#pragma unroll
    for (int o = 1; o < 64; o <<= 1) v += __shfl_xor(v, o);
    return v;
}
__device__ __forceinline__ float dot4(const f32x4 a, const f32x4 b) { return (a.x * b.x + a.y * b.y) + (a.z * b.z + a.w * b.w); }

__device__ __forceinline__ unsigned dbg_hash(unsigned a, unsigned b) { unsigned x = a * 2654435761u + b * 40503u + 0x9e3779b9u; x ^= x >> 15; x *= 2246822519u; x ^= x >> 13; x *= 3266489917u; x ^= x >> 16; return x; }
__device__ __forceinline__ void cksum_ptr(Frame& F, const v4u* p, size_t bytes, int slot) {
    const size_t n = bytes / 16, gt = (size_t)blockIdx.x * (NWAVES * 64) + F.tid, NGT = (size_t)F.G * NWAVES * 64; unsigned s = 0u;
    for (size_t i = gt; i < n; i += NGT) { const v4u v = p[i]; s += (v.x + v.y) + (v.z + v.w); }
#pragma unroll
    for (int o = 1; o < 64; o <<= 1) s += (unsigned)__shfl_xor((int)s, o);
    if (F.lane == 0) __hip_atomic_fetch_add((unsigned*)(F.ctl + slot), s, RLX_AGENT);
}
__device__ __forceinline__ void cksum(Frame& F, size_t off, size_t bytes, int slot) { cksum_ptr(F, wsp<v4u>(F, off), bytes, slot); }

enum { PK_ID = 0, PK_INPROJ = 1, PK_SWIGLU = 2 };
struct TEntry { int in_idx, K, N, kind, F, item0; unsigned src_off; unsigned pad; unsigned long long dst_off; };
struct TTable { TEntry e[32]; int n, total; };
constexpr TTable make_table() {
    TTable t{}; int n = 0, it = 0;
    auto add = [&](int in_idx, size_t src_off, int K, int N, int kind, int F, size_t dst) {
        t.e[n].in_idx = in_idx; t.e[n].K = K; t.e[n].N = N; t.e[n].kind = kind; t.e[n].F = F; t.e[n].item0 = it; t.e[n].src_off = (unsigned)src_off; t.e[n].pad = 0; t.e[n].dst_off = dst;
        it += (K / 64) * (N / 32); ++n; };
    for (int l = 0; l < 2; ++l) add(I_WIN, (size_t)l * D * INC, D, INC, PK_INPROJ, 0, WS_WIN + (size_t)l * INC * D * 2);
    for (int l = 0; l < 2; ++l) add(I_WAO, (size_t)l * AV * D, AV, D, PK_ID, 0, WS_WA + (size_t)l * D * AV * 2);
    for (int l = 0; l < 2; ++l) add(I_WCO, (size_t)l * CCH * D, CCH, D, PK_ID, 0, WS_WC + (size_t)l * D * CCH * 2);
    for (int l = 0; l < 2; ++l) add(I_WO, (size_t)l * D * D, D, D, PK_ID, 0, WS_WO + (size_t)l * D * D * 2);
    add(I_WFGU, 0, D, 2 * FF, PK_SWIGLU, FF, WS_WFGU);
    add(I_WFDN, 0, FF, D, PK_ID, 0, WS_WFDN);
    for (int l = 0; l < 2; ++l) add(I_WPG, (size_t)l * D * D, D, D, PK_ID, 0, WS_WPG + (size_t)l * D * D * 2);
    for (int l = 0; l < 2; ++l) add(I_WPP, (size_t)l * PLE * D, PLE, D, PK_ID, 0, WS_WPP + (size_t)l * D * PLE * 2);
    for (int e = 0; e < NE; ++e) add(I_WEGU, (size_t)e * D * 2 * FE, D, 2 * FE, PK_SWIGLU, FE, WS_WEGU + (size_t)e * 2 * FE * D * 2);
    for (int e = 0; e < NE; ++e) add(I_WEDN, (size_t)e * FE * D, FE, D, PK_ID, 0, WS_WEDN + (size_t)e * D * FE * 2);
    t.n = n; t.total = it; return t;
}
__constant__ TTable g_tt = make_table();
static_assert(make_table().n == 30, "transpose table");

__device__ __forceinline__ int dest_row(int kind, int F, int c) {
    if (kind == PK_INPROJ) {
        if (c < 1024) { const int d = c & 63, dd = d & 31; return (c & ~63) + ((dd >> 2) << 3) + ((d >> 5) << 2) + (dd & 3); }
        if (c >= 1536 && c < 2560) { const int cc = c - 1536, h = cc >= 512 ? 1 : 0, r = cc - h * 512; return 1536 + ((r >> 7) << 8) + (h << 7) + (r & 127); }
        return c;
    }
    if (kind == PK_SWIGLU) { const int h = c >= F ? 1 : 0, r = c - h * F; return ((r >> 7) << 8) + (h << 7) + (r & 127); }
    return c;
}
__device__ __forceinline__ void p0_transpose_item(const float* W, int K, int N, bf16* WT, int kind, int FFd, LAS float* scr, int item, int lane) {
    const int nblk = N / 32, kb = item / nblk, nb = item % nblk, k0 = 64 * kb, n0 = 32 * nb;
#pragma unroll 8
    for (int i = 0; i < 32; ++i) { const int kk = 2 * i + (lane >> 5); scr[kk * 33 + (lane & 31)] = W[(size_t)(k0 + kk) * N + n0 + (lane & 31)]; }
    LDS_WAIT(); asm volatile("" ::: "memory");
    const int c = lane & 7;
#pragma unroll
    for (int j = 0; j < 4; ++j) { const int n = (lane >> 3) + 8 * j; const LAS float* s = scr + (8 * c) * 33 + n;
        v4u o; o.x = pk2(s[0 * 33], s[1 * 33]); o.y = pk2(s[2 * 33], s[3 * 33]); o.z = pk2(s[4 * 33], s[5 * 33]); o.w = pk2(s[6 * 33], s[7 * 33]);
        *(v4u*)(WT + (size_t)dest_row(kind, FFd, n0 + n) * K + k0 + 8 * c) = o; }
    LDS_WAIT(); asm volatile("" ::: "memory");
}
__device__ __forceinline__ void norm_rows(Frame& F, const float* src, const float* gain, bf16* dst) {
    const int gw = blockIdx.x * NWAVES + F.wave, NGW = F.G * NWAVES;
    f32x4 g[4];
#pragma unroll
    for (int j = 0; j < 4; ++j) g[j] = ((const f32x4*)gain)[F.lane + 64 * j];
    for (int m = gw; m < T; m += NGW) {
        const f32x4* xr = (const f32x4*)(src + (size_t)m * D) + F.lane;
        f32x4 v[4]; float s = 0.f;
#pragma unroll
        for (int j = 0; j < 4; ++j) { v[j] = xr[64 * j]; s += dot4(v[j], v[j]); }
        const float rstd = 1.f / sqrtf(wave_sum(s) * (1.f / D) + EPS);
        unsigned long long* o8 = (unsigned long long*)(dst + (size_t)m * D) + F.lane;
#pragma unroll
        for (int j = 0; j < 4; ++j) { const f32x4 y = v[j] * rstd * g[j]; o8[64 * j] = (unsigned long long)pk2(y.x, y.y) | ((unsigned long long)pk2(y.z, y.w) << 32); }
    }
}
__device__ __forceinline__ void final_norm(Frame& F, const float* src, const float* gain, float* dst, float dbg_scale = 1.f) {
    const int gw = blockIdx.x * NWAVES + F.wave, NGW = F.G * NWAVES;
    f32x4 g[4];
#pragma unroll
    for (int j = 0; j < 4; ++j) g[j] = ((const f32x4*)gain)[F.lane + 64 * j];
    for (int m = gw; m < T; m += NGW) {
        const f32x4* xr = (const f32x4*)(src + (size_t)m * D) + F.lane;
        f32x4 v[4]; float s = 0.f;
#pragma unroll
        for (int j = 0; j < 4; ++j) { v[j] = xr[64 * j]; s += dot4(v[j], v[j]); }
        const float rstd = 1.f / sqrtf(wave_sum(s) * (1.f / D) + EPS);
        f32x4* o = (f32x4*)(dst + (size_t)m * D) + F.lane;
#pragma unroll
        for (int j = 0; j < 4; ++j) o[64 * j] = v[j] * rstd * g[j] * dbg_scale;
    }
}
__device__ __forceinline__ void p0_prologue(Frame& F) {
    LAS float* scr = (LAS float*)(F.lds + RING_OFF + F.wave * 16384);
    const int gw = blockIdx.x * NWAVES + F.wave, NGW = F.G * NWAVES;
    const int ntot = g_tt.total, nent = g_tt.n;
    for (int it = gw; it < ntot; it += NGW) {
        int ei = 0;
        while (ei + 1 < nent && it >= g_tt.e[ei + 1].item0) ++ei;
        const TEntry& te = g_tt.e[ei];
        p0_transpose_item(inp(te.in_idx) + te.src_off, te.K, te.N, wsp<bf16>(F, te.dst_off), te.kind, te.F, scr, it - te.item0, F.lane);
    }
    { const int gt = blockIdx.x * (NWAVES * 64) + F.tid, NGT = F.G * NWAVES * 64; const float* p = inp(I_P); bf16* pb = wsp<bf16>(F, WS_PB);
      for (int i = gt; i < 2 * T * PLE / 8; i += NGT) { const f32x4 a = *(const f32x4*)(p + (size_t)i * 8), b = *(const f32x4*)(p + (size_t)i * 8 + 4);
          v4u o; o.x = pk2(a.x, a.y); o.y = pk2(a.z, a.w); o.z = pk2(b.x, b.y); o.w = pk2(b.z, b.w); *(v4u*)(pb + (size_t)i * 8) = o; } }
    { const int gt = blockIdx.x * (NWAVES * 64) + F.tid, NGT = F.G * NWAVES * 64; float* rope = wsp<float>(F, WS_ROPE);
      for (int i = gt; i < SEQ * 32; i += NGT) { const int pos = i >> 5, f = i & 31;
          const float inv = exp2f(-(float)(2 * f) * (1.0f / 64.0f) * 13.287712379549449f); const float ang = (float)pos * inv;
          double rev = (double)ang * 0.15915494309189535; rev -= floor(rev); const float rv = (float)rev;
          rope[pos * 64 + f] = __builtin_amdgcn_cosf(rv); rope[pos * 64 + 32 + f] = __builtin_amdgcn_sinf(rv); } }
    if (blockIdx.x == 0 && F.wave == 0) {
        for (int l = 0; l < DEPTH; ++l) { const float* lf = inp(I_LAM) + l * 4 * HD;
            const float a = wave_sum(lf[F.lane] * lf[HD + F.lane]), b = wave_sum(lf[2 * HD + F.lane] * lf[3 * HD + F.lane]);
            const float lam_init = 0.8f - 0.6f * expf(-0.3f * (float)l);
            if (F.lane == 0) wsp<float>(F, WS_SCAL)[l] = expf(a) - expf(b) + lam_init; }
    }
#ifdef DBG_TWOPASS
    if (blockIdx.x == 0 && F.tid < 8) __hip_atomic_store((unsigned*)(F.ctl + CW_GCNT + 64 * F.tid), 0u, RLX_AGENT);
#endif
    norm_rows(F, inp(I_X), inp(I_GMIX), wsp<bf16>(F, WS_H));
}

__device__ __forceinline__ void route_phase(Frame& F, const float* src, const float* gain, bf16* dst) {
    LAS float* wrT = (LAS float*)(F.lds);
    LAS unsigned* lcnt = (LAS unsigned*)(F.lds + 32768);
    LAS unsigned* gbase = lcnt + 8;
    LAS int* rinfo = (LAS int*)(F.lds + 32768 + 64);
    const float* wr = inp(I_WR); const float* br = inp(I_BR);
    int* rti = wsp<int>(F, WS_RTI); float* rtw = wsp<float>(F, WS_RTW);
    for (int i = F.tid; i < NE * D; i += NWAVES * 64) wrT[(i & 7) * D + (i >> 3)] = wr[i];
    f32x4 g[4];
#pragma unroll
    for (int j = 0; j < 4; ++j) g[j] = ((const f32x4*)gain)[F.lane + 64 * j];
    __syncthreads();
    for (int item = blockIdx.x; item < T / 64; item += F.G) {
        if (F.tid < 8) lcnt[F.tid] = 0u;
        __syncthreads();
        for (int rr = 0; rr < 8; ++rr) {
            const int lr = F.wave * 8 + rr, m = item * 64 + lr;
            const f32x4* xr = (const f32x4*)(src + (size_t)m * D) + F.lane;
            f32x4 v[4]; float s = 0.f;
#pragma unroll
            for (int j = 0; j < 4; ++j) { v[j] = xr[64 * j]; s += dot4(v[j], v[j]); }
            const float rstd = 1.f / sqrtf(wave_sum(s) * (1.f / D) + EPS);
            unsigned long long* o8 = (unsigned long long*)(dst + (size_t)m * D) + F.lane;
#pragma unroll
            for (int j = 0; j < 4; ++j) { v[j] = v[j] * rstd * g[j]; o8[64 * j] = (unsigned long long)pk2(v[j].x, v[j].y) | ((unsigned long long)pk2(v[j].z, v[j].w) << 32); }
            float lg[8];
#pragma unroll
            for (int e = 0; e < 8; ++e) { float t = 0.f;
#pragma unroll
                for (int j = 0; j < 4; ++j) t += dot4(v[j], ((const LAS f32x4*)(wrT + e * D))[F.lane + 64 * j]);
                lg[e] = wave_sum(t) + br[e]; }
            int e1 = 0; float v1 = lg[0];
#pragma unroll
            for (int e = 1; e < 8; ++e) if (lg[e] > v1) { v1 = lg[e]; e1 = e; }
            int e2 = -1; float v2 = -INFINITY;
#pragma unroll
            for (int e = 0; e < 8; ++e) if (e != e1 && lg[e] > v2) { v2 = lg[e]; e2 = e; }
            if (e2 < 0) e2 = (e1 == 0) ? 1 : 0;
            const float ex = expf(v2 - v1), w1 = 1.f / (1.f + ex), w2 = ex / (1.f + ex);
            if (F.lane == 0) {
                const unsigned lp1 = __hip_atomic_fetch_add((unsigned*)&lcnt[e1], 1u, __ATOMIC_RELAXED, __HIP_MEMORY_SCOPE_WORKGROUP);
                const unsigned lp2 = __hip_atomic_fetch_add((unsigned*)&lcnt[e2], 1u, __ATOMIC_RELAXED, __HIP_MEMORY_SCOPE_WORKGROUP);
                rinfo[lr * 4 + 0] = e1; rinfo[lr * 4 + 1] = (int)lp1; rinfo[lr * 4 + 2] = e2; rinfo[lr * 4 + 3] = (int)lp2;
                rtw[(size_t)m * 2] = w1; rtw[(size_t)m * 2 + 1] = w2; }
        }
        __syncthreads();
        if (F.tid < 8) gbase[F.tid] = __hip_atomic_fetch_add((unsigned*)(F.ctl + CW_GCNT + 64 * F.tid), lcnt[F.tid], RLX_AGENT);
        __syncthreads();
        if (F.tid < 64) { const int m = item * 64 + F.tid; const int e1 = rinfo[F.tid * 4], lp1 = rinfo[F.tid * 4 + 1], e2 = rinfo[F.tid * 4 + 2], lp2 = rinfo[F.tid * 4 + 3];
            int* o = rti + (size_t)m * 4; o[0] = e1; o[1] = (int)gbase[e1] + lp1; o[2] = e2; o[3] = (int)gbase[e2] + lp2; }
        __syncthreads();
    }
}
__device__ __forceinline__ void load_counts(Frame& F, unsigned (&cnt)[8]) {
#pragma unroll
    for (int e = 0; e < 8; ++e) cnt[e] = (unsigned)__builtin_amdgcn_readfirstlane((int)__hip_atomic_load((unsigned*)(F.ctl + CW_GCNT + 64 * e), RLX_AGENT));
}
__device__ __forceinline__ void scatter_phase(Frame& F) {
    unsigned cnt[8]; load_counts(F, cnt);
    int coff[8]; { int s = 0;
#pragma unroll
        for (int e = 0; e < 8; ++e) { coff[e] = s; s += (int)((cnt[e] + 255u) & ~255u); } }
    const int gw = blockIdx.x * NWAVES + F.wave, NGW = F.G * NWAVES;
    const int* rti = wsp<int>(F, WS_RTI); int* rsel = wsp<int>(F, WS_RSEL); const bf16* H = wsp<bf16>(F, WS_H); bf16* HP = wsp<bf16>(F, WS_HP);
    for (int m = gw; m < T; m += NGW) {
        const int e1 = rti[(size_t)m * 4], p1 = rti[(size_t)m * 4 + 1], e2 = rti[(size_t)m * 4 + 2], p2 = rti[(size_t)m * 4 + 3];
        int c1 = 0, c2 = 0;
#pragma unroll
        for (int e = 0; e < 8; ++e) { c1 = (e1 == e) ? coff[e] : c1; c2 = (e2 == e) ? coff[e] : c2; }
        const int r1 = c1 + p1, r2 = c2 + p2;
        const v4u* s = (const v4u*)(H + (size_t)m * D); const v4u a = s[F.lane], b = s[F.lane + 64];
        v4u* d1 = (v4u*)(HP + (size_t)r1 * D); v4u* d2 = (v4u*)(HP + (size_t)r2 * D);
        d1[F.lane] = a; d1[F.lane + 64] = b; d2[F.lane] = a; d2[F.lane + 64] = b;
        if (F.lane == 0) { rsel[(size_t)m * 2] = r1; rsel[(size_t)m * 2 + 1] = r2; }
    }
}
__device__ __forceinline__ void combine_norm_phase(Frame& F, float* X, const float* gain, bf16* dst) {
    const int gw = blockIdx.x * NWAVES + F.wave, NGW = F.G * NWAVES;
    const int* rsel = wsp<int>(F, WS_RSEL); const float* rtw = wsp<float>(F, WS_RTW); const float* Y = wsp<float>(F, WS_Y);
    f32x4 g[4];
#pragma unroll
    for (int j = 0; j < 4; ++j) g[j] = ((const f32x4*)gain)[F.lane + 64 * j];
    for (int m = gw; m < T; m += NGW) {
        const int r1 = rsel[(size_t)m * 2], r2 = rsel[(size_t)m * 2 + 1]; const float w1 = rtw[(size_t)m * 2], w2 = rtw[(size_t)m * 2 + 1];
        f32x4* xr = (f32x4*)(X + (size_t)m * D) + F.lane; const f32x4* y1 = (const f32x4*)(Y + (size_t)r1 * D) + F.lane; const f32x4* y2 = (const f32x4*)(Y + (size_t)r2 * D) + F.lane;
        f32x4 v[4]; float s = 0.f;
#pragma unroll
        for (int j = 0; j < 4; ++j) { v[j] = xr[64 * j] + (y1[64 * j] * w1 + y2[64 * j] * w2); xr[64 * j] = v[j]; s += dot4(v[j], v[j]); }
        const float rstd = 1.f / sqrtf(wave_sum(s) * (1.f / D) + EPS);
        unsigned long long* o8 = (unsigned long long*)(dst + (size_t)m * D) + F.lane;
#pragma unroll
        for (int j = 0; j < 4; ++j) { const f32x4 y = v[j] * rstd * g[j]; o8[64 * j] = (unsigned long long)pk2(y.x, y.y) | ((unsigned long long)pk2(y.z, y.w) << 32); }
    }
}

__device__ __forceinline__ void conv_phase(Frame& F, int layer) {
    LAS bf16* zt = (LAS bf16*)(F.lds);
    LAS float* wl = (LAS float*)(F.lds + 65536);
    const float* cw = inp(I_CW) + (size_t)layer * CK * CCH; const float* cb = inp(I_CB) + layer * CCH;
    const float* lg = inp(I_CLG) + layer * CCH; const float* lb = inp(I_CLB) + layer * CCH;
    const bf16* Z = wsp<bf16>(F, WS_Z); bf16* ZC = wsp<bf16>(F, WS_ZC);
    for (int i = F.tid; i < CK * CCH; i += NWAVES * 64) { const int tap = i >> 9, ch = i & 511; wl[((tap * 2 + ((ch >> 2) & 1)) * 64 + (ch >> 3)) * 4 + (ch & 3)] = cw[i]; }
    const int c0 = 8 * F.lane;
    const f32x4 b_lo = *(const f32x4*)(cb + c0), b_hi = *(const f32x4*)(cb + c0 + 4), g_lo = *(const f32x4*)(lg + c0), g_hi = *(const f32x4*)(lg + c0 + 4), o_lo = *(const f32x4*)(lb + c0), o_hi = *(const f32x4*)(lb + c0 + 4);
    for (int unit = blockIdx.x; unit < BATCH * (SEQ / 32); unit += F.G) {
        const int b = unit / (SEQ / 32), t0 = (unit % (SEQ / 32)) * 32;
        __syncthreads();
        for (int i = F.tid; i < 62 * 64; i += NWAVES * 64) { const int r = i >> 6, c16 = i & 63, t = t0 - CPAD + r;
            v4u val = (v4u){0u, 0u, 0u, 0u}; if (t >= 0 && t < SEQ) val = *(const v4u*)(Z + ((size_t)(b * SEQ + t)) * CCH + c16 * 8);
            *(LAS v4u*)(zt + r * CCH + c16 * 8) = val; }
        __syncthreads();
        const int r0 = 4 * F.wave;
        f32x4 alo[4], ahi[4];
#pragma unroll
        for (int rr = 0; rr < 4; ++rr) { alo[rr] = b_lo; ahi[rr] = b_hi; }
        f32x4 zlo[4], zhi[4];
#define CONV_LDZ(slot, rowi) do { const v4u zz = *(const LAS v4u*)(zt + (r0 + (rowi)) * CCH + c0); \
        zlo[slot] = (f32x4){bf_lo(zz.x), bf_hi(zz.x), bf_lo(zz.y), bf_hi(zz.y)}; zhi[slot] = (f32x4){bf_lo(zz.z), bf_hi(zz.z), bf_lo(zz.w), bf_hi(zz.w)}; } while (0)
        CONV_LDZ(0, 0); CONV_LDZ(1, 1); CONV_LDZ(2, 2);
#pragma unroll
        for (int tap = 0; tap < CK; ++tap) {
            CONV_LDZ((tap + 3) & 3, tap + 3);
            const f32x4 wlo = *(const LAS f32x4*)(wl + ((tap * 2 + 0) * 64 + F.lane) * 4), whi = *(const LAS f32x4*)(wl + ((tap * 2 + 1) * 64 + F.lane) * 4);
#pragma unroll
            for (int rr = 0; rr < 4; ++rr) { alo[rr] += wlo * zlo[(tap + rr) & 3]; ahi[rr] += whi * zhi[(tap + rr) & 3]; }
        }
#undef CONV_LDZ
#pragma unroll
        for (int rr = 0; rr < 4; ++rr) {
            const float mean = wave_sum((alo[rr].x + alo[rr].y) + (alo[rr].z + alo[rr].w) + (ahi[rr].x + ahi[rr].y) + (ahi[rr].z + ahi[rr].w)) * (1.f / CCH);
            const f32x4 dl = alo[rr] - mean, dh = ahi[rr] - mean;
            const float rstd = 1.f / sqrtf(wave_sum(dot4(dl, dl) + dot4(dh, dh)) * (1.f / CCH) + EPS);
            f32x4 yl = dl * rstd * g_lo + o_lo, yh = dh * rstd * g_hi + o_hi;
            yl = yl * pg8::sigm4(yl); yh = yh * pg8::sigm4(yh);
            *(v4u*)(ZC + ((size_t)(b * SEQ + t0 + r0 + rr)) * CCH + c0) = pg8::pack8(yl, yh);
        }
    }
    __syncthreads();
}

__device__ __forceinline__ void conv_naive_phase(Frame& F, int layer) {
    const float* cw = inp(I_CW) + (size_t)layer * CK * CCH; const float* cb = inp(I_CB) + layer * CCH;
    const float* lg = inp(I_CLG) + layer * CCH; const float* lb = inp(I_CLB) + layer * CCH;
    const bf16* Z = wsp<bf16>(F, WS_Z); bf16* ZC = wsp<bf16>(F, WS_ZC);
    const int gw = blockIdx.x * NWAVES + F.wave, NGW = F.G * NWAVES, c0 = 8 * F.lane;
    for (int m = gw; m < T; m += NGW) {
        const int b = m / SEQ, t = m % SEQ;
        f32x4 alo = *(const f32x4*)(cb + c0), ahi = *(const f32x4*)(cb + c0 + 4);
        for (int tap = 0; tap < CK; ++tap) { const int tt = t + tap - CPAD; if (tt < 0 || tt >= SEQ) continue;
            const v4u zz = *(const v4u*)(Z + ((size_t)(b * SEQ + tt)) * CCH + c0);
            const f32x4 wlo = *(const f32x4*)(cw + tap * CCH + c0), whi = *(const f32x4*)(cw + tap * CCH + c0 + 4);
            alo += wlo * (f32x4){bf_lo(zz.x), bf_hi(zz.x), bf_lo(zz.y), bf_hi(zz.y)}; ahi += whi * (f32x4){bf_lo(zz.z), bf_hi(zz.z), bf_lo(zz.w), bf_hi(zz.w)}; }
        const float mean = wave_sum((alo.x + alo.y) + (alo.z + alo.w) + (ahi.x + ahi.y) + (ahi.z + ahi.w)) * (1.f / CCH);
        const f32x4 dl = alo - mean, dh = ahi - mean;
        const float rstd = 1.f / sqrtf(wave_sum(dot4(dl, dl) + dot4(dh, dh)) * (1.f / CCH) + EPS);
        f32x4 yl = dl * rstd * *(const f32x4*)(lg + c0) + *(const f32x4*)(lb + c0), yh = dh * rstd * *(const f32x4*)(lg + c0 + 4) + *(const f32x4*)(lb + c0 + 4);
        yl = yl * pg8::sigm4(yl); yh = yh * pg8::sigm4(yh);
        *(v4u*)(ZC + (size_t)m * CCH + c0) = pg8::pack8(yl, yh);
    }
}

#ifdef DBG_CHECK_INPROJ
__device__ __forceinline__ float chk_col(const float* w, const f32x4 (&hv)[4], int lane, int c) {
    float t = 0.f;
#pragma unroll
    for (int j = 0; j < 4; ++j) { const int k = 4 * (lane + 64 * j); t += hv[j].x * w[(size_t)(k + 0) * INC + c] + hv[j].y * w[(size_t)(k + 1) * INC + c] + hv[j].z * w[(size_t)(k + 2) * INC + c] + hv[j].w * w[(size_t)(k + 3) * INC + c]; }
    return wave_sum(t);
}
__device__ __forceinline__ bool chk_bad(float got, float exp_) { return !(fabsf(got - exp_) <= 0.02f + 0.02f * fabsf(exp_)); }
__device__ __forceinline__ void check_inproj(Frame& F, int layer) {
    const int gw = blockIdx.x * NWAVES + F.wave; const int m = (int)(dbg_hash((unsigned)gw, 5u) % (unsigned)T), pos = m % SEQ;
    const float* x = layer == 0 ? inp(I_X) : (const float*)wsp<float>(F, WS_X); const float* gain = inp(I_GMIX) + (size_t)layer * D; const float* w = inp(I_WIN) + (size_t)layer * D * INC; const float* rope = wsp<float>(F, WS_ROPE);
    const bf16* Q = wsp<bf16>(F, WS_Q); const bf16* K = wsp<bf16>(F, WS_K); const bf16* V = wsp<bf16>(F, WS_V); const bf16* Z = wsp<bf16>(F, WS_Z); const bf16* SG = wsp<bf16>(F, WS_SG);
    f32x4 hv[4]; float s = 0.f;
#pragma unroll
    for (int j = 0; j < 4; ++j) { hv[j] = ((const f32x4*)(x + (size_t)m * D))[F.lane + 64 * j]; s += dot4(hv[j], hv[j]); }
    const float rstd = 1.f / sqrtf(wave_sum(s) * (1.f / D) + EPS);
#pragma unroll
    for (int j = 0; j < 4; ++j) hv[j] = hv[j] * rstd * ((const f32x4*)gain)[F.lane + 64 * j];
    unsigned flags = 0u;
    { for (int i = 0; i < 2; ++i) { const int c0_ = (int)(dbg_hash((unsigned)gw, 100u + i) % 512u), c = (c0_ & ~63) | (c0_ & 31), f = c & 31; const float t1 = chk_col(w, hv, F.lane, c), t2 = chk_col(w, hv, F.lane, c + 32);
        const float cs = rope[pos * 64 + f], sn = rope[pos * 64 + 32 + f];
        if (chk_bad(bf_lo((unsigned)Q[(size_t)m * 512 + c]), (t1 * cs - t2 * sn) * QSCALE) || chk_bad(bf_lo((unsigned)Q[(size_t)m * 512 + c + 32]), (t2 * cs + t1 * sn) * QSCALE)) flags |= 1u; } }
    { const int c0_ = (int)(dbg_hash((unsigned)gw, 102u) % 512u), c = (c0_ & ~63) | (c0_ & 31), f = c & 31; const float t1 = chk_col(w, hv, F.lane, 512 + c), t2 = chk_col(w, hv, F.lane, 512 + c + 32);
        const float cs = rope[pos * 64 + f], sn = rope[pos * 64 + 32 + f];
        if (chk_bad(bf_lo((unsigned)K[(size_t)m * 512 + c]), t1 * cs - t2 * sn) || chk_bad(bf_lo((unsigned)K[(size_t)m * 512 + c + 32]), t2 * cs + t1 * sn)) flags |= 1u; }
    { const int cv = (int)(dbg_hash((unsigned)gw, 103u) % 512u); const float v = chk_col(w, hv, F.lane, 1024 + cv); if (chk_bad(bf_lo((unsigned)V[(size_t)m * 512 + cv]), v)) flags |= 2u; }
    { int cz[2]; cz[0] = (int)(dbg_hash((unsigned)gw, 104u) % 512u); cz[1] = (int)(dbg_hash((unsigned)gw, 105u) % 512u); for (int i = 0; i < 2; ++i) { const float a = chk_col(w, hv, F.lane, 1536 + cz[i]), g = chk_col(w, hv, F.lane, 2048 + cz[i]);
        if (chk_bad(bf_lo((unsigned)Z[(size_t)m * 512 + cz[i]]), a / (1.f + expf(-g)))) flags |= 2u; } }
    { const int ca = (int)(dbg_hash((unsigned)gw, 106u) % 1024u), cb = (int)(dbg_hash((unsigned)gw, 107u) % 1024u); const float a = chk_col(w, hv, F.lane, 2560 + ca), b = chk_col(w, hv, F.lane, 2560 + 1024 + cb);
#ifdef DBG_SG_DETAIL
        unsigned code = 0u;
        if (chk_bad(bf_lo((unsigned)SG[(size_t)m * 2048 + ca]), 1.f / (1.f + expf(-a)))) code = (unsigned)(DBG_SG_DETAIL == 1 ? 18 - (10 + ca / 256) : (DBG_SG_DETAIL == 2 ? 1 + ((m % 256) >> 4) : DBG_SG_DETAIL == 3 ? 16 - ((m % 256) >> 4) : 1 + ((m >> 8) & 15)));
        if (chk_bad(bf_lo((unsigned)SG[(size_t)m * 2048 + 1024 + cb]), 1.f / (1.f + expf(-b)))) { const unsigned c2 = (unsigned)(DBG_SG_DETAIL == 1 ? 18 - (14 + cb / 256) : (DBG_SG_DETAIL == 2 ? 1 + ((m % 256) >> 4) : DBG_SG_DETAIL == 3 ? 16 - ((m % 256) >> 4) : 1 + ((m >> 8) & 15))); code = code > c2 ? code : c2; }
#if DBG_SG_DETAIL == 5
        if (F.lane == 0 && code) __hip_atomic_fetch_add((unsigned*)(F.ctl + 17), 1u, RLX_AGENT);
#else
        if (F.lane == 0 && code) __hip_atomic_fetch_max((unsigned*)(F.ctl + 16), code, RLX_AGENT);
#endif
#else
        if (chk_bad(bf_lo((unsigned)SG[(size_t)m * 2048 + ca]), 1.f / (1.f + expf(-a))) || chk_bad(bf_lo((unsigned)SG[(size_t)m * 2048 + 1024 + cb]), 1.f / (1.f + expf(-b)))) flags |= 4u;
#endif
    }
    if (F.lane == 0 && flags) __hip_atomic_fetch_or((unsigned*)(F.ctl + 16), flags, RLX_AGENT);
}
#endif

#ifdef DBG_CHECK_ACT
__device__ __forceinline__ void check_act(Frame& F) {
    const int gw = blockIdx.x * NWAVES + F.wave; const int m = (int)(dbg_hash((unsigned)gw, 3u) % (unsigned)T);
    const float* x = wsp<float>(F, WS_X); const float* gain = inp(I_GFFN); const float* w = inp(I_WFGU); const bf16* ACT = wsp<bf16>(F, WS_ACT);
    f32x4 hv[4]; float s = 0.f;
#pragma unroll
    for (int j = 0; j < 4; ++j) { hv[j] = ((const f32x4*)(x + (size_t)m * D))[F.lane + 64 * j]; s += dot4(hv[j], hv[j]); }
    const float rstd = 1.f / sqrtf(wave_sum(s) * (1.f / D) + EPS);
#pragma unroll
    for (int j = 0; j < 4; ++j) hv[j] = hv[j] * rstd * ((const f32x4*)gain)[F.lane + 64 * j];
    unsigned flags = 0u; int cj[4]; for (int i = 0; i < 4; ++i) cj[i] = (int)(dbg_hash((unsigned)gw, 110u + i) % (unsigned)FF);
    for (int i = 0; i < 4; ++i) { float g = 0.f, u = 0.f;
#pragma unroll
        for (int j = 0; j < 4; ++j) { const int k = 4 * (F.lane + 64 * j);
            g += hv[j].x * w[(size_t)(k + 0) * (2 * FF) + cj[i]] + hv[j].y * w[(size_t)(k + 1) * (2 * FF) + cj[i]] + hv[j].z * w[(size_t)(k + 2) * (2 * FF) + cj[i]] + hv[j].w * w[(size_t)(k + 3) * (2 * FF) + cj[i]];
            u += hv[j].x * w[(size_t)(k + 0) * (2 * FF) + FF + cj[i]] + hv[j].y * w[(size_t)(k + 1) * (2 * FF) + FF + cj[i]] + hv[j].z * w[(size_t)(k + 2) * (2 * FF) + FF + cj[i]] + hv[j].w * w[(size_t)(k + 3) * (2 * FF) + FF + cj[i]]; }
        g = wave_sum(g); u = wave_sum(u);
        const float ex = g / (1.f + expf(-g)) * u, got = bf_lo((unsigned)ACT[(size_t)m * FF + cj[i]]);
        if (!(fabsf(got - ex) <= 0.03f + 0.03f * fabsf(ex))) flags |= 8u; }
    if (F.lane == 0 && flags) __hip_atomic_fetch_or((unsigned*)(F.ctl + 16), flags, RLX_AGENT);
}
#endif

#ifdef DBG_CHECK_MIX
__device__ __forceinline__ float chk_dot_bf(const bf16* a, int K, const float* w, int ldw, int c, int lane) {
    float t = 0.f; for (int k = lane; k < K; k += 64) t += bf_lo((unsigned)a[k]) * w[(size_t)k * ldw + c]; return wave_sum(t); }
__device__ __forceinline__ void check_mix(Frame& F, int layer) {
    const int gw = blockIdx.x * NWAVES + F.wave; const int m = (int)(dbg_hash((unsigned)gw, 1u) % (unsigned)T);
    const bf16* OB = wsp<bf16>(F, WS_OB); const bf16* ZC = wsp<bf16>(F, WS_ZC); const bf16* SG = wsp<bf16>(F, WS_SG); const bf16* MIX = wsp<bf16>(F, WS_MIX);
    unsigned flags = 0u; int cc[4]; for (int i = 0; i < 4; ++i) cc[i] = (int)(dbg_hash((unsigned)gw, 120u + i) % (unsigned)D);
    for (int i = 0; i < 4; ++i) { const int c = cc[i];
        const float ad = chk_dot_bf(OB + (size_t)m * AV, AV, inp(I_WAO) + (size_t)layer * AV * D, D, c, F.lane), cd = chk_dot_bf(ZC + (size_t)m * CCH, CCH, inp(I_WCO) + (size_t)layer * CCH * D, D, c, F.lane);
        const float ex = bf_lo((unsigned)SG[(size_t)m * 2048 + c]) * ad + bf_lo((unsigned)SG[(size_t)m * 2048 + 1024 + c]) * cd, got = bf_lo((unsigned)MIX[(size_t)m * D + c]);
        if (!(fabsf(got - ex) <= 0.02f + 0.02f * fabsf(ex))) flags |= 16u; }
    if (F.lane == 0 && flags) __hip_atomic_fetch_or((unsigned*)(F.ctl + 16), flags, RLX_AGENT);
}
__device__ __forceinline__ void snap_wo(Frame& F) { const int gw = blockIdx.x * NWAVES + F.wave; const int m = (int)(dbg_hash((unsigned)gw, 6u) % (unsigned)T);
    if (F.lane < 4) wsp<float>(F, 3 * MiB + 768 * 1024)[(size_t)gw * 4 + F.lane] = wsp<float>(F, WS_X)[(size_t)m * D + (int)(dbg_hash((unsigned)gw, 130u + F.lane) % (unsigned)D)]; }
__device__ __forceinline__ void check_wo(Frame& F, int layer) {
    const int gw = blockIdx.x * NWAVES + F.wave; const int m = (int)(dbg_hash((unsigned)gw, 6u) % (unsigned)T);
    const bf16* MIX = wsp<bf16>(F, WS_MIX); const float* X = wsp<float>(F, WS_X); const float* xin = inp(I_X);
    unsigned flags = 0u; int cc[4]; for (int i_ = 0; i_ < 4; ++i_) cc[i_] = (int)(dbg_hash((unsigned)gw, 130u + i_) % (unsigned)D);
    for (int i = 0; i < 4; ++i) { const int c = cc[i];
        const float ex = (layer == 0 ? xin[(size_t)m * D + c] : wsp<float>(F, 3 * MiB + 768 * 1024)[(size_t)gw * 4 + i]) + chk_dot_bf(MIX + (size_t)m * D, D, inp(I_WO) + (size_t)layer * D * D, D, c, F.lane), got = X[(size_t)m * D + c];
        if (!(fabsf(got - ex) <= 0.02f + 0.02f * fabsf(ex))) flags |= 32u; }
    if (F.lane == 0 && flags) __hip_atomic_fetch_or((unsigned*)(F.ctl + 16), flags, RLX_AGENT);
}
#endif

#ifdef DBG_CHECK_FFN
constexpr size_t WS_DBG = 3 * MiB;
__device__ __forceinline__ void snap_x(Frame& F, int slot, int samp) {
    const int gw = blockIdx.x * NWAVES + F.wave; const int m = (int)(dbg_hash((unsigned)gw, (unsigned)samp) % (unsigned)T);
    if (F.lane < 4) wsp<float>(F, WS_DBG)[(size_t)gw * 16 + slot * 4 + F.lane] = wsp<float>(F, WS_X)[(size_t)m * D + (int)(dbg_hash((unsigned)gw, 140u + F.lane) % (unsigned)D)];
}
__device__ __forceinline__ float chk_dot_f(const float* a, int K, const float* w, int ldw, int c, int lane) { float t = 0.f; for (int k = lane; k < K; k += 64) t += a[k] * w[(size_t)k * ldw + c]; return wave_sum(t); }
__device__ __forceinline__ void check_down(Frame& F) {
    const int gw = blockIdx.x * NWAVES + F.wave; const int m = (int)(dbg_hash((unsigned)gw, 2u) % (unsigned)T); int cc[4]; for (int i_ = 0; i_ < 4; ++i_) cc[i_] = (int)(dbg_hash((unsigned)gw, 140u + i_) % (unsigned)D); unsigned flags = 0u;
    for (int i = 0; i < 4; ++i) { const float d = chk_dot_bf(wsp<bf16>(F, WS_ACT) + (size_t)m * FF, FF, inp(I_WFDN), D, cc[i], F.lane);
        const float ex = wsp<float>(F, WS_DBG)[(size_t)gw * 16 + i] + d, got = wsp<float>(F, WS_X)[(size_t)m * D + cc[i]];
        if (!(fabsf(got - ex) <= 0.02f + 0.02f * fabsf(ex))) flags |= 64u; }
    if (F.lane == 0 && flags) __hip_atomic_fetch_or((unsigned*)(F.ctl + 16), flags, RLX_AGENT);
}
__device__ __forceinline__ void check_norm3(Frame& F, int layer) {
    const int gw = blockIdx.x * NWAVES + F.wave; const int m = (int)(dbg_hash((unsigned)gw, 4u) % (unsigned)T); const float* x = wsp<float>(F, WS_X) + (size_t)m * D; const float* g = inp(I_GPLE) + (size_t)layer * D;
    float s = 0.f; for (int k = F.lane; k < D; k += 64) s += x[k] * x[k];
    const float rstd = 1.f / sqrtf(wave_sum(s) * (1.f / D) + EPS); unsigned flags = 0u;
    for (int k = F.lane; k < D; k += 64) { const float ex = x[k] * rstd * g[k], got = bf_lo((unsigned)wsp<bf16>(F, WS_H)[(size_t)m * D + k]); if (!(fabsf(got - ex) <= 0.01f + 0.01f * fabsf(ex))) flags |= 256u; }
    if (flags) __hip_atomic_fetch_or((unsigned*)(F.ctl + 16), flags, RLX_AGENT);
}
__device__ __forceinline__ void check_ple(Frame& F, int layer) {
    const int gw = blockIdx.x * NWAVES + F.wave; const int m = (int)(dbg_hash((unsigned)gw, 4u) % (unsigned)T); int cc[4]; for (int i_ = 0; i_ < 4; ++i_) cc[i_] = (int)(dbg_hash((unsigned)gw, 140u + i_) % (unsigned)D); unsigned flags = 0u;
    for (int i = 0; i < 4; ++i) { const float gl = chk_dot_bf(wsp<bf16>(F, WS_H) + (size_t)m * D, D, inp(I_WPG) + (size_t)layer * D * D, D, cc[i], F.lane);
        const float pj = chk_dot_f(inp(I_P) + ((size_t)layer * T + m) * PLE, PLE, inp(I_WPP) + (size_t)layer * PLE * D, D, cc[i], F.lane);
        const float ex = wsp<float>(F, WS_DBG)[(size_t)gw * 16 + 4 + i] + pj / (1.f + expf(-gl)) + DBG_INJECT, got = wsp<float>(F, WS_X)[(size_t)m * D + cc[i]];
        if (!(fabsf(got - ex) <= 0.02f + 0.02f * fabsf(ex))) flags |= 128u; }
    if (F.lane == 0 && flags) __hip_atomic_fetch_or((unsigned*)(F.ctl + 16), flags, RLX_AGENT);
}
#endif

#ifdef DBG_CHECK_ATTN
__device__ __forceinline__ void check_attn(Frame& F, int layer) {
    const int gw = blockIdx.x * NWAVES + F.wave; const int m = (int)(dbg_hash((unsigned)gw, 7u) % (unsigned)T), h = gw & 3, b = m / SEQ;
    const float lam = wsp<float>(F, WS_SCAL)[layer]; const float lam_init = 0.8f - 0.6f * expf(-0.3f * (float)layer), post = 1.f - lam_init;
    const float* gsub = inp(I_GSUB) + layer * VD;
    const bf16* Q = wsp<bf16>(F, WS_Q); const bf16* Kb = wsp<bf16>(F, WS_K) + (size_t)b * SEQ * AQK; const bf16* Vb = wsp<bf16>(F, WS_V) + (size_t)b * SEQ * AV; const bf16* OB = wsp<bf16>(F, WS_OB);
    LAS float* S = (LAS float*)(F.lds) + F.wave * 2048; LAS float* O = (LAS float*)(F.lds + 65536) + F.wave * 256;
    for (int c = 0; c < 2; ++c) {
        float qf[64];
#pragma unroll
        for (int i = 0; i < 8; ++i) { const v4u t = *(const v4u*)(Q + (size_t)m * AQK + h * 128 + c * 64 + i * 8);
            qf[8 * i] = bf_lo(t.x); qf[8 * i + 1] = bf_hi(t.x); qf[8 * i + 2] = bf_lo(t.y); qf[8 * i + 3] = bf_hi(t.y); qf[8 * i + 4] = bf_lo(t.z); qf[8 * i + 5] = bf_hi(t.z); qf[8 * i + 6] = bf_lo(t.w); qf[8 * i + 7] = bf_hi(t.w); }
        float mx = -1e30f;
        for (int i = 0; i < 32; ++i) { const int j = F.lane + 64 * i; const bf16* kr = Kb + (size_t)j * AQK + h * 128 + c * 64; float sc = 0.f;
#pragma unroll
            for (int t8 = 0; t8 < 8; ++t8) { const v4u t = *(const v4u*)(kr + t8 * 8);
                sc += qf[8 * t8] * bf_lo(t.x) + qf[8 * t8 + 1] * bf_hi(t.x) + qf[8 * t8 + 2] * bf_lo(t.y) + qf[8 * t8 + 3] * bf_hi(t.y) + qf[8 * t8 + 4] * bf_lo(t.z) + qf[8 * t8 + 5] * bf_hi(t.z) + qf[8 * t8 + 6] * bf_lo(t.w) + qf[8 * t8 + 7] * bf_hi(t.w); }
            S[j] = sc; mx = fmaxf(mx, sc); }
#pragma unroll
        for (int o = 1; o < 64; o <<= 1) mx = fmaxf(mx, __shfl_xor(mx, o));
        float l = 0.f;
        for (int i = 0; i < 32; ++i) { const int j = F.lane + 64 * i; const float p = exp2f(S[j] - mx); S[j] = p; l += p; }
        l = wave_sum(l);
        for (int ch = 0; ch < 4; ++ch) { float a[32];
#pragma unroll
            for (int k = 0; k < 32; ++k) a[k] = 0.f;
            for (int i = 0; i < 32; ++i) { const int j = F.lane + 64 * i; const float p = S[j]; const bf16* vr = Vb + (size_t)j * AV + h * 128 + ch * 32;
#pragma unroll
                for (int t8 = 0; t8 < 4; ++t8) { const v4u t = *(const v4u*)(vr + t8 * 8);
                    a[8 * t8] += p * bf_lo(t.x); a[8 * t8 + 1] += p * bf_hi(t.x); a[8 * t8 + 2] += p * bf_lo(t.y); a[8 * t8 + 3] += p * bf_hi(t.y); a[8 * t8 + 4] += p * bf_lo(t.z); a[8 * t8 + 5] += p * bf_hi(t.z); a[8 * t8 + 6] += p * bf_lo(t.w); a[8 * t8 + 7] += p * bf_hi(t.w); } }
#pragma unroll
            for (int k = 0; k < 32; ++k) { const float r = wave_sum(a[k]); if (F.lane == 0) O[c * 128 + ch * 32 + k] = r / l; } }
    }
    LDS_WAIT();
    const float d0 = O[F.lane] - lam * O[128 + F.lane], d1 = O[64 + F.lane] - lam * O[128 + 64 + F.lane];
    const float rstd = post / sqrtf(wave_sum(d0 * d0 + d1 * d1) * (1.f / VD) + EPS);
    const float e0 = d0 * rstd * gsub[F.lane], e1 = d1 * rstd * gsub[64 + F.lane];
    const float g0 = bf_lo((unsigned)OB[(size_t)m * AV + h * 128 + F.lane]), g1 = bf_lo((unsigned)OB[(size_t)m * AV + h * 128 + 64 + F.lane]);
    if (!(fabsf(g0 - e0) <= 0.03f + 0.03f * fabsf(e0)) || !(fabsf(g1 - e1) <= 0.03f + 0.03f * fabsf(e1))) __hip_atomic_fetch_or((unsigned*)(F.ctl + 16), 512u, RLX_AGENT);
}
#endif

#ifdef DBG_CHECK_MOE
__device__ __forceinline__ void check_route(Frame& F) {
    const int gw = blockIdx.x * NWAVES + F.wave; const int m = (int)(dbg_hash((unsigned)gw, 6u) % (unsigned)T);
    const float* x = wsp<float>(F, WS_X) + (size_t)m * D; const float* g = inp(I_GFFN) + D; const float* wr = inp(I_WR); const float* br = inp(I_BR);
    float s = 0.f; for (int k = F.lane; k < D; k += 64) s += x[k] * x[k];
    const float rstd = 1.f / sqrtf(wave_sum(s) * (1.f / D) + EPS);
    float lg[8];
#pragma unroll
    for (int e = 0; e < 8; ++e) lg[e] = 0.f;
    for (int k = F.lane; k < D; k += 64) { const float hk = x[k] * rstd * g[k];
#pragma unroll
        for (int e = 0; e < 8; ++e) lg[e] += hk * wr[k * 8 + e]; }
#pragma unroll
    for (int e = 0; e < 8; ++e) lg[e] = wave_sum(lg[e]) + br[e];
    int e1 = 0; float v1 = lg[0];
#pragma unroll
    for (int e = 1; e < 8; ++e) if (lg[e] > v1) { v1 = lg[e]; e1 = e; }
    int e2 = -1; float v2 = -INFINITY;
#pragma unroll
    for (int e = 0; e < 8; ++e) if (e != e1 && lg[e] > v2) { v2 = lg[e]; e2 = e; }
    const float ex = expf(v2 - v1), w1 = 1.f / (1.f + ex), w2 = ex / (1.f + ex);
    const int* rti = wsp<int>(F, WS_RTI) + (size_t)m * 4; const float* rtw = wsp<float>(F, WS_RTW) + (size_t)m * 2;
    const bool tie = (v1 - v2) < 1e-3f;
    bool bad = !(fabsf(rtw[0] + rtw[1] - 1.f) < 1e-3f);
    if (!tie) bad = bad || rti[0] != e1 || rti[2] != e2 || !(fabsf(rtw[0] - w1) < 2e-3f) || !(fabsf(rtw[1] - w2) < 2e-3f);
    if (bad && F.lane == 0) __hip_atomic_fetch_or((unsigned*)(F.ctl + 16), 1024u, RLX_AGENT);
}
__device__ __forceinline__ void check_experts(Frame& F) {
    const int gw = blockIdx.x * NWAVES + F.wave; const int m = (int)(dbg_hash((unsigned)gw, 6u) % (unsigned)T);
    const int* rti = wsp<int>(F, WS_RTI) + (size_t)m * 4; const int* rsel = wsp<int>(F, WS_RSEL) + (size_t)m * 2;
    const bf16* H = wsp<bf16>(F, WS_H) + (size_t)m * D; unsigned flags = 0u;
    for (int t = 0; t < 2; ++t) { const int e = rti[2 * t], r = rsel[t];
        const bf16* hp = wsp<bf16>(F, WS_HP) + (size_t)r * D; const bf16* act = wsp<bf16>(F, WS_ACT) + (size_t)r * FE; const float* y = wsp<float>(F, WS_Y) + (size_t)r * D;
        for (int k = F.lane; k < D; k += 64) if (hp[k] != H[k]) flags |= 2048u;
        const float* wgu = inp(I_WEGU) + (size_t)e * D * 2 * FE; const float* wdn = inp(I_WEDN) + (size_t)e * FE * D;
        int cj[3]; for (int i_ = 0; i_ < 3; ++i_) cj[i_] = (int)(dbg_hash((unsigned)gw, 150u + i_ + 8 * t) % (unsigned)FE);
        for (int i = 0; i < 3; ++i) { float gg = 0.f, uu = 0.f;
            for (int k = F.lane; k < D; k += 64) { const float hk = bf_lo((unsigned)hp[k]); gg += hk * wgu[(size_t)k * (2 * FE) + cj[i]]; uu += hk * wgu[(size_t)k * (2 * FE) + FE + cj[i]]; }
            gg = wave_sum(gg); uu = wave_sum(uu);
            const float ex = gg / (1.f + expf(-gg)) * uu, got = bf_lo((unsigned)act[cj[i]]);
            if (!(fabsf(got - ex) <= 0.03f + 0.03f * fabsf(ex))) flags |= 4096u; }
        int cc[2]; for (int i_ = 0; i_ < 2; ++i_) cc[i_] = (int)(dbg_hash((unsigned)gw, 160u + i_) % (unsigned)D);
        for (int i = 0; i < 2; ++i) { float d = 0.f; for (int k = F.lane; k < FE; k += 64) d += bf_lo((unsigned)act[k]) * wdn[(size_t)k * D + cc[i]];
            d = wave_sum(d); if (!(fabsf(y[cc[i]] - d) <= 0.02f + 0.02f * fabsf(d))) flags |= 8192u; }
    }
    if (F.lane < 2) wsp<float>(F, 3 * MiB + 512 * 1024)[(size_t)gw * 2 + F.lane] = wsp<float>(F, WS_X)[(size_t)m * D + (int)(dbg_hash((unsigned)gw, 160u + F.lane) % (unsigned)D)];
    if (flags) __hip_atomic_fetch_or((unsigned*)(F.ctl + 16), flags, RLX_AGENT);
}
__device__ __forceinline__ void check_combine(Frame& F) {
    const int gw = blockIdx.x * NWAVES + F.wave; const int m = (int)(dbg_hash((unsigned)gw, 6u) % (unsigned)T);
    const int* rsel = wsp<int>(F, WS_RSEL) + (size_t)m * 2; const float* rtw = wsp<float>(F, WS_RTW) + (size_t)m * 2; const float* Y = wsp<float>(F, WS_Y);
    if (F.lane < 2) { const int c = (int)(dbg_hash((unsigned)gw, 160u + F.lane) % (unsigned)D);
        const float ex = wsp<float>(F, 3 * MiB + 512 * 1024)[(size_t)gw * 2 + F.lane] + rtw[0] * Y[(size_t)rsel[0] * D + c] + rtw[1] * Y[(size_t)rsel[1] * D + c], got = wsp<float>(F, WS_X)[(size_t)m * D + c];
        if (!(fabsf(got - ex) <= 1e-3f + 1e-3f * fabsf(ex))) __hip_atomic_fetch_or((unsigned*)(F.ctl + 16), 16384u, RLX_AGENT); }
}
#endif

__device__ __forceinline__ void attn_naive_phase(Frame& F, int layer) {
    const float lam = wsp<float>(F, WS_SCAL)[layer]; const float lam_init = 0.8f - 0.6f * expf(-0.3f * (float)layer), post = 1.f - lam_init;
    const float* gsub = inp(I_GSUB) + layer * VD;
    const bf16* Q = wsp<bf16>(F, WS_Q); const bf16* Kb = wsp<bf16>(F, WS_K); const bf16* Vb = wsp<bf16>(F, WS_V); bf16* OB = wsp<bf16>(F, WS_OB);
    for (int unit = blockIdx.x; unit < BATCH * NH * (SEQ / 256); unit += F.G) {
        const int b = unit >> 5, h = (unit >> 3) & 3, qb = unit & 7, q = qb * 256 + (F.tid >> 1), c = F.tid & 1;
        const bf16* qp = Q + ((size_t)(b * SEQ + q)) * AQK + h * 128 + c * 64;
        unsigned qv[32];
#pragma unroll
        for (int i = 0; i < 8; ++i) { const v4u t = *(const v4u*)(qp + i * 8); qv[4 * i] = t.x; qv[4 * i + 1] = t.y; qv[4 * i + 2] = t.z; qv[4 * i + 3] = t.w; }
        float o[128];
#pragma unroll
        for (int e = 0; e < 128; ++e) o[e] = 0.f;
        float mx = -1e30f, l = 0.f;
        const bf16* kp = Kb + (size_t)b * SEQ * AQK + h * 128 + c * 64; const bf16* vp = Vb + (size_t)b * SEQ * AV + h * 128;
        for (int key = 0; key < SEQ; ++key) {
            float s = 0.f;
#pragma unroll
            for (int i = 0; i < 8; ++i) { const v4u kk = *(const v4u*)(kp + (size_t)key * AQK + i * 8);
                s += bf_lo(qv[4 * i]) * bf_lo(kk.x) + bf_hi(qv[4 * i]) * bf_hi(kk.x) + bf_lo(qv[4 * i + 1]) * bf_lo(kk.y) + bf_hi(qv[4 * i + 1]) * bf_hi(kk.y)
                   + bf_lo(qv[4 * i + 2]) * bf_lo(kk.z) + bf_hi(qv[4 * i + 2]) * bf_hi(kk.z) + bf_lo(qv[4 * i + 3]) * bf_lo(kk.w) + bf_hi(qv[4 * i + 3]) * bf_hi(kk.w); }
            const float mn = fmaxf(mx, s), alpha = __builtin_amdgcn_exp2f(mx - mn), p = __builtin_amdgcn_exp2f(s - mn); mx = mn; l = l * alpha + p;
#pragma unroll
            for (int i = 0; i < 16; ++i) { const v4u vv = *(const v4u*)(vp + (size_t)key * AV + i * 8);
                o[8 * i + 0] = o[8 * i + 0] * alpha + p * bf_lo(vv.x); o[8 * i + 1] = o[8 * i + 1] * alpha + p * bf_hi(vv.x);
                o[8 * i + 2] = o[8 * i + 2] * alpha + p * bf_lo(vv.y); o[8 * i + 3] = o[8 * i + 3] * alpha + p * bf_hi(vv.y);
                o[8 * i + 4] = o[8 * i + 4] * alpha + p * bf_lo(vv.z); o[8 * i + 5] = o[8 * i + 5] * alpha + p * bf_hi(vv.z);
                o[8 * i + 6] = o[8 * i + 6] * alpha + p * bf_lo(vv.w); o[8 * i + 7] = o[8 * i + 7] * alpha + p * bf_hi(vv.w); }
        }
        const float inv = 1.f / l; float rs = 0.f;
#pragma unroll
        for (int e = 0; e < 128; ++e) { const float mine = o[e] * inv, other = __shfl_xor(mine, 1); const float d = (c == 0) ? (mine - lam * other) : (other - lam * mine); o[e] = d; rs += d * d; }
        const float rstd = 1.f / sqrtf(rs * (1.f / VD) + EPS) * post;
        bf16* op = OB + ((size_t)(b * SEQ + q)) * AV + h * 128 + c * 64;
#pragma unroll
        for (int i = 0; i < 8; ++i) { float y[8];
#pragma unroll
            for (int j = 0; j < 8; ++j) y[j] = (c ? o[64 + 8 * i + j] : o[8 * i + j]) * rstd * gsub[c * 64 + 8 * i + j];
            v4u w; w.x = pk2(y[0], y[1]); w.y = pk2(y[2], y[3]); w.z = pk2(y[4], y[5]); w.w = pk2(y[6], y[7]); *(v4u*)(op + 8 * i) = w; }
    }
}

namespace dattn {
using bf16x8 = __attribute__((ext_vector_type(8))) short;
using s16x4  = __attribute__((ext_vector_type(4))) short;
using f32x16 = __attribute__((ext_vector_type(16))) float;
using u32x4  = __attribute__((ext_vector_type(4))) unsigned;
constexpr int NW = 8, QBLK = 32, KVBLK = 64, LDK = 512;
constexpr float THRL = 11.5f;
constexpr size_t SHM_V = KVBLK * 128 * 2, SHM_K = KVBLK * 128 * 2, SHM_ATTN = 2 * SHM_V + 2 * SHM_K + NW * 64 * 4;
#define KSWZ(row, colB) ((row) * 256 + ((colB) ^ (((row) & 7) << 4)))
#define SBAR() __builtin_amdgcn_sched_barrier(0)
__device__ __forceinline__ int crow(int r, int hi) { return (r & 3) + 8 * (r >> 2) + 4 * hi; }
__device__ __forceinline__ unsigned cvtpk(float lo, float hi) { return pg8::cvt_pk_bf16(lo, hi); }
__device__ __forceinline__ void partialSM(f32x16& p0, f32x16& p1, float& m_reg, float& mn, float& alpha) {
  float pmax = p0[0]; for (int r = 1; r < 16; ++r) pmax = fmaxf(pmax, p0[r]); for (int r = 0; r < 16; ++r) pmax = fmaxf(pmax, p1[r]);
  { auto rr = __builtin_amdgcn_permlane32_swap(__float_as_uint(pmax), __float_as_uint(pmax), false, false);
    pmax = fmaxf(__uint_as_float(rr[0]), __uint_as_float(rr[1])); }
  if (__builtin_expect(__all(pmax - m_reg <= THRL), 1)) { mn = m_reg; alpha = 1.f; }
  else { mn = fmaxf(m_reg, pmax); alpha = __builtin_amdgcn_exp2f(m_reg - mn); m_reg = mn; }
  for (int r = 0; r < 16; ++r) p0[r] = p0[r] - mn; for (int r = 0; r < 16; ++r) p1[r] = p1[r] - mn;
  for (int r = 0; r < 16; ++r) p0[r] = __builtin_amdgcn_exp2f(p0[r]);
}
__device__ __forceinline__ void finishSM(f32x16& p0, f32x16& p1, float alpha, float& l_reg, bf16x8& pa0, bf16x8& pa1, bf16x8& pa2, bf16x8& pa3) {
  for (int r = 0; r < 16; ++r) p1[r] = __builtin_amdgcn_exp2f(p1[r]);
  float ps = 0; for (int r = 0; r < 16; ++r) ps += p0[r]; for (int r = 0; r < 16; ++r) ps += p1[r];
  { auto rr = __builtin_amdgcn_permlane32_swap(__float_as_uint(ps), __float_as_uint(ps), false, false);
    ps = __uint_as_float(rr[0]) + __uint_as_float(rr[1]); }
  l_reg = l_reg * alpha + ps;
#define PK4(P, BASE, OUT) do { unsigned a0 = cvtpk(P[BASE + 0], P[BASE + 1]), a1 = cvtpk(P[BASE + 2], P[BASE + 3]);   \
    unsigned b0 = cvtpk(P[BASE + 4], P[BASE + 5]), b1 = cvtpk(P[BASE + 6], P[BASE + 7]);                              \
    auto r0 = __builtin_amdgcn_permlane32_swap(a0, b0, false, false); auto r1 = __builtin_amdgcn_permlane32_swap(a1, b1, false, false); \
    u32x4 w = {r0[0], r1[0], r0[1], r1[1]}; OUT = *reinterpret_cast<bf16x8*>(&w); } while (0)
  PK4(p0, 0, pa0); PK4(p0, 8, pa1); PK4(p1, 0, pa2); PK4(p1, 8, pa3);
#undef PK4
}
__device__ __forceinline__ void qkt(f32x16& p0, f32x16& p1, const char* Ks, const bf16x8* qr, int r32, int hi, int c) {
  p0 = f32x16{}; p1 = f32x16{};
  for (int d0 = 0; d0 < 4; ++d0) { int cb = (c * 64 + d0 * 16 + hi * 8) * 2;
    bf16x8 b0 = *reinterpret_cast<const bf16x8*>(Ks + KSWZ(r32, cb));
    bf16x8 b1 = *reinterpret_cast<const bf16x8*>(Ks + KSWZ(32 + r32, cb));
    p0 = __builtin_amdgcn_mfma_f32_32x32x16_bf16(b0, qr[d0], p0, 0, 0, 0);
    p1 = __builtin_amdgcn_mfma_f32_32x32x16_bf16(b1, qr[d0], p1, 0, 0, 0); }
}
__device__ __forceinline__ int v_st(int k, int c) { const int kk = (k & ~0xC) | ((k & 4) << 1) | ((k & 8) >> 1); return ((kk >> 3) * 4 + (c >> 5)) * 512 + ((kk & 7) * 32 + (c & 31)) * 2; }
__device__ __forceinline__ int v_rd_base(int lane) { return ((lane & 3) << 3) | (((lane >> 2) & 3) << 6) | (((lane >> 4) & 1) << 5) | (((lane >> 5) & 1) << 8); }
constexpr int v_rd_off(int d0, int ks, int half) { return d0 * 512 + ks * 4096 + half * 2048; }
template <int OFF> __device__ __forceinline__ s16x4 tr_read(int vb) {
  s16x4 r; asm volatile("ds_read_b64_tr_b16 %0, %1 offset:%2" : "=&v"(r) : "v"(vb), "i"(OFF) : "memory"); return r;
}
template <int D0> __device__ __forceinline__ void pv_one(f32x16& od, int vb, bf16x8 pa0, bf16x8 pa1, bf16x8 pa2, bf16x8 pa3) {
  const s16x4 l0 = tr_read<v_rd_off(D0, 0, 0)>(vb), h0 = tr_read<v_rd_off(D0, 0, 1)>(vb), l1 = tr_read<v_rd_off(D0, 1, 0)>(vb), h1 = tr_read<v_rd_off(D0, 1, 1)>(vb);
  const s16x4 l2 = tr_read<v_rd_off(D0, 2, 0)>(vb), h2 = tr_read<v_rd_off(D0, 2, 1)>(vb), l3 = tr_read<v_rd_off(D0, 3, 0)>(vb), h3 = tr_read<v_rd_off(D0, 3, 1)>(vb);
  asm volatile("s_waitcnt lgkmcnt(0)" ::: "memory"); SBAR();
#define PK(L, H) (bf16x8){L[0], L[1], L[2], L[3], H[0], H[1], H[2], H[3]}
  od = __builtin_amdgcn_mfma_f32_32x32x16_bf16(pa0, PK(l0, h0), od, 0, 0, 0);
  od = __builtin_amdgcn_mfma_f32_32x32x16_bf16(pa1, PK(l1, h1), od, 0, 0, 0);
  od = __builtin_amdgcn_mfma_f32_32x32x16_bf16(pa2, PK(l2, h2), od, 0, 0, 0);
  od = __builtin_amdgcn_mfma_f32_32x32x16_bf16(pa3, PK(l3, h3), od, 0, 0, 0);
#undef PK
}
__device__ __forceinline__ void pv_d0(f32x16* o, int vb, bf16x8 pa0, bf16x8 pa1, bf16x8 pa2, bf16x8 pa3) {
  pv_one<0>(o[0], vb, pa0, pa1, pa2, pa3); pv_one<1>(o[1], vb, pa0, pa1, pa2, pa3); pv_one<2>(o[2], vb, pa0, pa1, pa2, pa3); pv_one<3>(o[3], vb, pa0, pa1, pa2, pa3);
}
__device__ __forceinline__ void unit(const unsigned short* Qb, const unsigned short* Kh, const unsigned short* Vh, unsigned short* Ob, int seq, char* lds, float lam, float post, const float* gsub) {
  int tid_ = threadIdx.x; asm volatile("" : "+v"(tid_));
  const int tid = tid_, wid = tid >> 6, lane = tid & 63, r32 = lane & 31, hi = lane >> 5, c = wid >> 2, wq = wid & 3;
  char* V_lds = lds; char* K_lds = lds + 2 * SHM_V;
  float* ws = (float*)(lds + 2 * SHM_V + 2 * SHM_K) + wid * 64; float* li_l = ws; float* al_l = ws + 32;
  float m_reg = -1e30f, l_reg = 0; f32x16 o[4] = {}; bf16x8 qr[4];
  const unsigned short* Qw = Qb + (long)(wq * QBLK + r32) * LDK + c * 64 + hi * 8;
#pragma unroll
  for (int d0 = 0; d0 < 4; ++d0) qr[d0] = *reinterpret_cast<const bf16x8*>(Qw + d0 * 16);
  const int sr = tid >> 4, sc = (tid & 15) * 8, vst0 = v_st(sr, sc), vst1 = v_st(32 + sr, sc);
  const int vb0 = (int)(uintptr_t)V_lds + v_rd_base(lane);
  struct { bf16x8 vs0, vs1, ks0, ks1; } sr_[2];
#define SLOAD(i, k0) do { sr_[i].vs0 = *reinterpret_cast<const bf16x8*>(&Vh[(long)((k0) + sr) * LDK + sc]); sr_[i].vs1 = *reinterpret_cast<const bf16x8*>(&Vh[(long)((k0) + 32 + sr) * LDK + sc]); \
    sr_[i].ks0 = *reinterpret_cast<const bf16x8*>(&Kh[(long)((k0) + sr) * LDK + sc]); sr_[i].ks1 = *reinterpret_cast<const bf16x8*>(&Kh[(long)((k0) + 32 + sr) * LDK + sc]); } while (0)
#define SWRITE(b, i) do { *(bf16x8*)(V_lds + (b) * SHM_V + vst0) = sr_[i].vs0; *(bf16x8*)(V_lds + (b) * SHM_V + vst1) = sr_[i].vs1; int kc = sc * 2; \
    *(bf16x8*)(K_lds + (b) * SHM_K + KSWZ(sr, kc)) = sr_[i].ks0; *(bf16x8*)(K_lds + (b) * SHM_K + KSWZ(32 + sr, kc)) = sr_[i].ks1; } while (0)
#define SWAIT() asm volatile("s_waitcnt vmcnt(4)" ::: "memory")
#define RESC(a) do { if (__any((a) < 1.f)) { if (hi == 0) al_l[r32] = (a); asm volatile("s_waitcnt lgkmcnt(0)" ::: "memory"); \
    for (int d = 0; d < 4; ++d) for (int r = 0; r < 16; ++r) o[d][r] *= al_l[crow(r, hi)]; } } while (0)
  f32x16 pA0, pA1, pB0, pB1; float mnA, mnB, alA, alB; bf16x8 pa0, pa1, pa2, pa3; const int NT = seq / KVBLK;
  constexpr int SE = 0, SO = 1;
  SLOAD(SE, 0); asm volatile("s_waitcnt vmcnt(0)" ::: "memory"); SWRITE(0, SE); __syncthreads();
  qkt(pA0, pA1, K_lds, qr, r32, hi, c); partialSM(pA0, pA1, m_reg, mnA, alA);
  SLOAD(SO, KVBLK); if (2 < NT) SLOAD(SE, 2 * KVBLK);
  SWAIT(); SWRITE(1, SO); __syncthreads();
  for (int j = 1; j + 1 < NT; j += 2) {
    SBAR(); qkt(pB0, pB1, K_lds + SHM_K, qr, r32, hi, c);
    finishSM(pA0, pA1, alA, l_reg, pa0, pa1, pa2, pa3); SBAR();
    SLOAD(SO, (j + 2) * KVBLK); SBAR();
    pv_d0(o, vb0, pa0, pa1, pa2, pa3); partialSM(pB0, pB1, m_reg, mnB, alB);
    __syncthreads(); SWAIT(); SWRITE(0, SE);
    RESC(alB); __syncthreads();
    SBAR(); qkt(pA0, pA1, K_lds, qr, r32, hi, c);
    finishSM(pB0, pB1, alB, l_reg, pa0, pa1, pa2, pa3); SBAR();
    if (j + 3 < NT) SLOAD(SE, (j + 3) * KVBLK); SBAR();
    pv_d0(o, vb0 + (int)SHM_V, pa0, pa1, pa2, pa3); partialSM(pA0, pA1, m_reg, mnA, alA);
    __syncthreads(); SWAIT(); SWRITE(1, SO);
    RESC(alA); __syncthreads();
  }
  SBAR(); qkt(pB0, pB1, K_lds + SHM_K, qr, r32, hi, c);
  finishSM(pA0, pA1, alA, l_reg, pa0, pa1, pa2, pa3); SBAR();
  pv_d0(o, vb0, pa0, pa1, pa2, pa3); partialSM(pB0, pB1, m_reg, mnB, alB);
  __syncthreads(); RESC(alB);
  finishSM(pB0, pB1, alB, l_reg, pa0, pa1, pa2, pa3); SBAR();
  pv_d0(o, vb0 + (int)SHM_V, pa0, pa1, pa2, pa3);
  if (hi == 0) li_l[r32] = l_reg; asm volatile("s_waitcnt vmcnt(0) lgkmcnt(0)" ::: "memory");
  float rli[16];
#pragma unroll
  for (int r = 0; r < 16; ++r) rli[r] = __builtin_amdgcn_rcpf(li_l[crow(r, hi)]);
  __syncthreads();
  float* xch = (float*)lds + (size_t)wq * 64 * 64 + lane;
  if (c == 1) {
#pragma unroll
    for (int d0 = 0; d0 < 4; ++d0)
#pragma unroll
      for (int r = 0; r < 16; ++r) xch[(d0 * 16 + r) * 64] = o[d0][r] * rli[r] * lam;
  }
  __syncthreads();
  if (c == 0) {
    float ss[16];
#pragma unroll
    for (int r = 0; r < 16; ++r) { float a = 0.f;
#pragma unroll
      for (int d0 = 0; d0 < 4; ++d0) { const float d = o[d0][r] * rli[r] - xch[(d0 * 16 + r) * 64]; o[d0][r] = d; a += d * d; }
      ss[r] = a; }
#pragma unroll
    for (int r = 0; r < 16; ++r) {
#pragma unroll
      for (int off = 1; off < 32; off <<= 1) ss[r] += __shfl_xor(ss[r], off);
      ss[r] = post / sqrtf(ss[r] * (1.f / 128.f) + 1e-6f); }
    float gs[4];
#pragma unroll
    for (int d0 = 0; d0 < 4; ++d0) gs[d0] = gsub[32 * d0 + r32];
    unsigned short* Ow = Ob + (long)(wq * QBLK) * LDK;
#pragma unroll
    for (int r = 0; r < 16; ++r) { const int orow = crow(r, hi);
#pragma unroll
      for (int d0 = 0; d0 < 4; ++d0) Ow[(long)orow * LDK + d0 * 32 + r32] = (unsigned short)f2bf(o[d0][r] * ss[r] * gs[d0]); }
  }
  __syncthreads();
#undef SLOAD
#undef SWRITE
#undef SWAIT
#undef RESC
}
#undef KSWZ
#undef SBAR
}

__device__ __forceinline__ void attn_mfma_phase(Frame& F, int layer) {
    const float lam = wsp<float>(F, WS_SCAL)[layer]; const float lam_init = 0.8f - 0.6f * expf(-0.3f * (float)layer), post = 1.f - lam_init;
    const float* gsub = inp(I_GSUB) + layer * VD;
    const bf16* Q = wsp<bf16>(F, WS_Q); const bf16* Kb = wsp<bf16>(F, WS_K); const bf16* Vb = wsp<bf16>(F, WS_V); bf16* OB = wsp<bf16>(F, WS_OB);
    for (int u = blockIdx.x; u < BATCH * NH * (SEQ / 128); u += F.G) {
        const int b = u >> 6, h = (u >> 4) & 3, qb = u & 15;
        const size_t rb = (size_t)b * SEQ;
        dattn::unit(Q + (rb + qb * 128) * AQK + h * 128, Kb + rb * AQK + h * 128, Vb + rb * AV + h * 128, OB + (rb + qb * 128) * AV + h * 128, SEQ, (char*)F.lds, lam, post, gsub);
    }
}

constexpr int NSTEP = 11, NPH = 1 + DEPTH * NSTEP;
struct Args { const float* in[N_IN]; float* out; unsigned char* ws; int ph_lo, ph_hi, pass, pad; };
#ifndef DBG_SITES
#define DBG_SITES 0xFF
#endif
#define GEMM_SITE(ID, EpiT, g, S, E) do { if (!((DBG_SITES >> (ID)) & 1)) {} else if ((MK_NAIVE_GEMM >> (ID)) & 1) pg8::gemm_phase_naive<EpiT, pg8::GroupOrder>(g, S, E); \
    else pg8::gemm_phase<EpiT, pg8::GroupOrder, MK_ALIGN, MK_SP2>(F.lds + RING_OFF, g, S, E); } while (0)

__global__ void __launch_bounds__(NWAVES * 64, 2) mk_fwd(Args args) {
    extern __shared__ __attribute__((aligned(16))) unsigned char lds[];
    Frame F;
    F.lds = (LAS unsigned char*)lds;
    F.MISC = (volatile LAS unsigned*)(F.lds + MISC_OFF);
    F.tid = threadIdx.x; F.lane = F.tid & 63; F.wave = __builtin_amdgcn_readfirstlane(F.tid >> 6);
    F.G = gridDim.x; F.ws = (GAS unsigned char*)args.ws; F.ctl = (gu32*)(F.ws + WS_CTL);
    for (int u = F.tid; u < (LDS_BYTES - LDSCTL_OFF) / 4; u += NWAVES * 64) ((LAS unsigned*)(F.lds + LDSCTL_OFF))[u] = 0u;
    __syncthreads();
    const int lo = args.ph_lo, hi = args.ph_hi;
#ifdef DBG_START_DELAY
    if (lo == 0) { const unsigned long long t0 = __builtin_amdgcn_s_memrealtime(); while (__builtin_amdgcn_s_memrealtime() - t0 < (unsigned long long)DBG_START_DELAY) __builtin_amdgcn_s_sleep(32); }
#endif
    XcdBarrier bar; bar.bar = (unsigned*)(F.ctl + CW_BAR); bar.x = 0; bar.st = nullptr;
    if (hi - lo > 1) bar = xcd_barrier_post((unsigned*)(F.ctl + CW_BAR), F.MISC + 8);
#define PHASE_BEGIN() do { const CAS unsigned char* k_ = (const CAS unsigned char*)__builtin_amdgcn_kernarg_segment_ptr(); asm volatile("" : "+s"(k_)); \
    F.ws = *(GAS unsigned char* const CAS*)(k_ + 8 * (N_IN + 1)); F.ctl = (gu32*)(F.ws + WS_CTL); int t_ = threadIdx.x; asm volatile("" : "+v"(t_)); \
    F.tid = t_; F.lane = t_ & 63; F.wave = __builtin_amdgcn_readfirstlane(t_ >> 6); F.G = gridDim.x; } while (0)
#define IN(k) (lo <= (k) && (k) < hi)
#define SEAM(k) do { if (IN(k) && IN((k) + 1)) xcd_barrier(bar); } while (0)
#define H wsp<bf16>(F, WS_H)
#define X wsp<float>(F, WS_X)

#ifdef DBG_STOP
    if (lo == 100) {
        PHASE_BEGIN();
        float* o = outp(); const size_t gt = (size_t)blockIdx.x * (NWAVES * 64) + F.tid, NGT = (size_t)F.G * NWAVES * 64;
        for (size_t i = gt; i < (size_t)T * D; i += NGT) { float v = 0.f;
#define DG_BF(off, len) v += bf_lo((unsigned)wsp<bf16>(F, off)[i % (size_t)(len)]);
#define DG_F32(off, len) v += wsp<float>(F, off)[i % (size_t)(len)];
            DBG_DIGEST
            o[i] = v; }
        return;
    }
#endif
#ifdef DBG_TWOPASS
#define CW_CK 2048
#define CK(slot, off, bytes) cksum(F, off, bytes, CW_CK + dbg_pass * 64 + (slot))
#define CKBAR() xcd_barrier(bar)
    const int dbg_pass = args.pass;
#else
#define CK(slot, off, bytes) do {} while (0)
#define CKBAR() do {} while (0)
#endif
    if (IN(0)) { PHASE_BEGIN(); p0_prologue(F); }
    SEAM(0);
#ifdef DBG_TWOPASS
    { PHASE_BEGIN(); CK(0, WS_WIN, WS_X - WS_WIN); CK(0, WS_H, (size_t)T * D * 2); CK(0, WS_PB, (size_t)2 * T * PLE * 2); CK(0, WS_ROPE, (size_t)SEQ * 64 * 4); CKBAR(); }
#endif

#pragma nounroll
    for (int layer = 0; layer < DEPTH; ++layer) {
        const int pb = 1 + layer * NSTEP;
#ifdef DBG_SKIP_MOE
        const bool moe = false; const bool skipffn = (layer & 1) != 0;
#elif defined(DBG_SKIP_DENSE)
        const bool moe = (layer & 1) != 0; const bool skipffn = (layer & 1) == 0;
#else
        const bool moe = (layer & 1) != 0; const bool skipffn = false;
#endif
        if (IN(pb + 0)) { PHASE_BEGIN();
            if (layer == 0) {
                pg8::Gemm g{wsp<bf16>(F, WS_PB), wsp<bf16>(F, WS_WPP), 2 * T, D, PLE}; pg8::GroupOrder S; S.init_equal(2, T, D, F.G, (int)blockIdx.x, (LAS int*)(F.lds + TP_OFF));
                pg8::EpiStore E{wsp<bf16>(F, WS_PROJ), D, D / 256};
                GEMM_SITE(0, pg8::EpiStore, g, S, E);
            }
            pg8::Gemm g{H, wsp<bf16>(F, WS_WIN) + (size_t)layer * INC * D, T, INC, D}; pg8::GroupOrder S; S.init_dense(T, INC, F.G, (int)blockIdx.x);
            pg8::EpiInProj E{wsp<bf16>(F, WS_Q), wsp<bf16>(F, WS_K), wsp<bf16>(F, WS_V), wsp<bf16>(F, WS_Z), wsp<bf16>(F, WS_SG), wsp<float>(F, WS_ROPE), QSCALE};
            GEMM_SITE(1, pg8::EpiInProj, g, S, E);
        }
        SEAM(pb + 0);
#ifdef DBG_TWOPASS
        { PHASE_BEGIN(); CK(pb + 0, WS_Q, 128 * MiB); if (layer == 0) CK(pb + 0, WS_PROJ, (size_t)2 * T * D * 2); if (layer == 1) { CK(32, WS_Q, 16 * MiB); CK(33, WS_K, 16 * MiB); CK(34, WS_V, 16 * MiB); CK(35, WS_Z, 16 * MiB); CK(36, WS_SG, 64 * MiB); } CKBAR(); }
#endif
        if (IN(pb + 1)) { PHASE_BEGIN();
#ifdef DBG_CHECK_INPROJ
            if (layer == DBG_LAYER) check_inproj(F, layer);
#endif
#if !defined(DBG_NO_ATTN) && MK_NAIVE_ATTN
            attn_naive_phase(F, layer);
#elif !defined(DBG_NO_ATTN)
            attn_mfma_phase(F, layer);
#else
            { bf16* ob = wsp<bf16>(F, WS_OB); const size_t gt = (size_t)blockIdx.x * (NWAVES * 64) + F.tid, NGT = (size_t)F.G * NWAVES * 64;
              for (size_t i = gt; i < (size_t)T * AV / 8; i += NGT) *(v4u*)(ob + i * 8) = (v4u){0u, 0u, 0u, 0u}; }
#endif
#if defined(DBG_NAIVE_CONV)
            conv_naive_phase(F, layer);
#elif !defined(DBG_NO_CONV)
            conv_phase(F, layer);
#else
            { bf16* ob = wsp<bf16>(F, WS_ZC); const size_t gt = (size_t)blockIdx.x * (NWAVES * 64) + F.tid, NGT = (size_t)F.G * NWAVES * 64;
              for (size_t i = gt; i < (size_t)T * CCH / 8; i += NGT) *(v4u*)(ob + i * 8) = (v4u){0u, 0u, 0u, 0u}; }
#endif
        }
        SEAM(pb + 1);
#ifdef DBG_CHECK_ATTN
        if (layer == DBG_CHECK_ATTN - 1) { PHASE_BEGIN(); check_attn(F, layer); xcd_barrier(bar); }
#endif
#ifdef DBG_TWOPASS
        { PHASE_BEGIN(); CK(pb + 1, WS_OB, 32 * MiB); CKBAR(); }
#endif
        if (IN(pb + 2)) { PHASE_BEGIN();
            { pg8::Gemm g{wsp<bf16>(F, WS_OB), wsp<bf16>(F, WS_WA) + (size_t)layer * D * AV, T, D, AV}; pg8::GroupOrder S; S.init_dense(T, D, F.G, (int)blockIdx.x);
              pg8::EpiGate<0> E{wsp<float>(F, WS_P), wsp<bf16>(F, WS_MIX), wsp<bf16>(F, WS_SG)};
              GEMM_SITE(2, pg8::EpiGate<0>, g, S, E); }
            { pg8::Gemm g{wsp<bf16>(F, WS_ZC), wsp<bf16>(F, WS_WC) + (size_t)layer * D * CCH, T, D, CCH}; pg8::GroupOrder S; S.init_dense(T, D, F.G, (int)blockIdx.x);
              pg8::EpiGate<1> E{wsp<float>(F, WS_P), wsp<bf16>(F, WS_MIX), wsp<bf16>(F, WS_SG)};
              GEMM_SITE(3, pg8::EpiGate<1>, g, S, E); }
        }
        SEAM(pb + 2);
#ifdef DBG_CHECK_MIX
        if (layer == DBG_LAYER) { PHASE_BEGIN(); check_mix(F, layer); snap_wo(F); xcd_barrier(bar); }
#endif
#ifdef DBG_TWOPASS
        { PHASE_BEGIN(); CK(pb + 2, WS_P, 96 * MiB); CKBAR(); }
#endif
        if (IN(pb + 3)) { PHASE_BEGIN();
            pg8::Gemm g{wsp<bf16>(F, WS_MIX), wsp<bf16>(F, WS_WO) + (size_t)layer * D * D, T, D, D}; pg8::GroupOrder S; S.init_dense(T, D, F.G, (int)blockIdx.x);
            pg8::EpiResid E{layer == 0 ? inp(I_X) : (const float*)X, X, D / 256};
            GEMM_SITE(4, pg8::EpiResid, g, S, E);
        }
        SEAM(pb + 3);
#ifdef DBG_CHECK_MIX
        if (layer == DBG_LAYER) { PHASE_BEGIN(); check_wo(F, layer); xcd_barrier(bar); }
#endif
#ifdef DBG_TWOPASS
        { PHASE_BEGIN(); CK(pb + 3, WS_X, (size_t)T * D * 4); CKBAR(); }
#endif
        if (IN(pb + 4)) { PHASE_BEGIN();
            if (moe) route_phase(F, X, inp(I_GFFN) + (size_t)layer * D, H);
            else norm_rows(F, X, inp(I_GFFN) + (size_t)layer * D, H);
        }
        SEAM(pb + 4);
#ifdef DBG_CHECK_MOE
        if (moe) { PHASE_BEGIN(); check_route(F); xcd_barrier(bar); }
#endif
#ifdef DBG_TWOPASS
        { PHASE_BEGIN(); CK(pb + 4, WS_H, (size_t)T * D * 2); if (moe) CK(pb + 4, WS_RTW, (size_t)T * 8); CKBAR(); }
#endif
        if (moe) {
            if (IN(pb + 5)) { PHASE_BEGIN(); scatter_phase(F); }
            SEAM(pb + 5);
        }
        if (IN(pb + 6) && !skipffn) { PHASE_BEGIN();
            pg8::Gemm g; pg8::GroupOrder S; pg8::EpiSwiGLU E;
            if (moe) { unsigned cnt[8]; load_counts(F, cnt); g = pg8::Gemm{wsp<bf16>(F, WS_HP), wsp<bf16>(F, WS_WEGU), MOE_ROWS, 2 * FE, D}; S.init_counts(cnt, 2 * FE, F.G, (int)blockIdx.x, (LAS int*)(F.lds + TP_OFF)); E = pg8::EpiSwiGLU{wsp<bf16>(F, WS_ACT), FE, 2 * FE / 256}; }
            else { g = pg8::Gemm{H, wsp<bf16>(F, WS_WFGU), T, 2 * FF, D}; S.init_dense(T, 2 * FF, F.G, (int)blockIdx.x); E = pg8::EpiSwiGLU{wsp<bf16>(F, WS_ACT), FF, 2 * FF / 256}; }
            GEMM_SITE(5, pg8::EpiSwiGLU, g, S, E);
        }
        SEAM(pb + 6);
#ifdef DBG_CHECK_FFN
        if (layer == 0) { PHASE_BEGIN(); snap_x(F, 0, 2); xcd_barrier(bar); }
#endif
#ifdef DBG_CHECK_ACT
        if (layer == 0) { PHASE_BEGIN(); check_act(F); xcd_barrier(bar); }
#endif
#ifdef DBG_TWOPASS
        { PHASE_BEGIN(); if (!moe) CK(pb + 6, WS_ACT, (size_t)T * FF * 2); CKBAR(); }
#endif
        if (IN(pb + 7) && !skipffn) { PHASE_BEGIN();
            pg8::Gemm g; pg8::GroupOrder S; pg8::EpiResid E;
            if (moe) { unsigned cnt[8]; load_counts(F, cnt); g = pg8::Gemm{wsp<bf16>(F, WS_ACT), wsp<bf16>(F, WS_WEDN), MOE_ROWS, D, FE}; S.init_counts(cnt, D, F.G, (int)blockIdx.x, (LAS int*)(F.lds + TP_OFF)); E = pg8::EpiResid{nullptr, wsp<float>(F, WS_Y), D / 256}; }
            else { g = pg8::Gemm{wsp<bf16>(F, WS_ACT), wsp<bf16>(F, WS_WFDN), T, D, FF}; S.init_dense(T, D, F.G, (int)blockIdx.x); E = pg8::EpiResid{X, X, D / 256}; }
            GEMM_SITE(6, pg8::EpiResid, g, S, E);
        }
        SEAM(pb + 7);
#ifdef DBG_CHECK_MOE
        if (moe) { PHASE_BEGIN(); check_experts(F); xcd_barrier(bar); }
#endif
#ifdef DBG_CHECK_FFN
        if (layer == 0) { PHASE_BEGIN(); check_down(F); xcd_barrier(bar); }
#endif
#ifdef DBG_TWOPASS
        { PHASE_BEGIN(); if (!moe) CK(pb + 7, WS_X, (size_t)T * D * 4); CKBAR(); }
#endif
        if (IN(pb + 8)) { PHASE_BEGIN();
            if (moe) combine_norm_phase(F, X, inp(I_GPLE) + (size_t)layer * D, H);
            else norm_rows(F, X, inp(I_GPLE) + (size_t)layer * D, H);
        }
        SEAM(pb + 8);
#ifdef DBG_CHECK_MOE
        if (moe) { PHASE_BEGIN(); check_combine(F); xcd_barrier(bar); }
#endif
#ifdef DBG_CHECK_FFN
        if (layer == DBG_LAYER) { PHASE_BEGIN(); check_norm3(F, layer); snap_x(F, 1, 4); xcd_barrier(bar); }
#endif
#ifdef DBG_TWOPASS
        { PHASE_BEGIN(); CK(pb + 8, WS_X, (size_t)T * D * 4); CK(pb + 8, WS_H, (size_t)T * D * 2); CKBAR(); }
#endif
#ifdef DBG_SKIP_PLE
        if (false) {
#else
        if (IN(pb + 9)) { PHASE_BEGIN();
#endif
            pg8::Gemm g{H, wsp<bf16>(F, WS_WPG) + (size_t)layer * D * D, T, D, D}; pg8::GroupOrder S; S.init_dense(T, D, F.G, (int)blockIdx.x);
            pg8::EpiPleGate E{X, wsp<bf16>(F, WS_PROJ) + (size_t)layer * T * D};
            GEMM_SITE(7, pg8::EpiPleGate, g, S, E);
        }
        SEAM(pb + 9);
#ifdef DBG_CHECK_FFN
        if (layer == DBG_LAYER) { PHASE_BEGIN(); check_ple(F, layer); xcd_barrier(bar); }
#endif
#ifdef DBG_TWOPASS
        { PHASE_BEGIN(); CK(pb + 9, WS_X, (size_t)T * D * 4); CKBAR(); }
#endif
        if (IN(pb + 10)) { PHASE_BEGIN();
            if (layer + 1 < DEPTH) norm_rows(F, X, inp(I_GMIX) + (size_t)(layer + 1) * D, H);
            else final_norm(F, X, inp(I_GFIN), outp());
        }
        if (layer + 1 < DEPTH) SEAM(pb + 10);
#ifdef DBG_TWOPASS
        if (layer + 1 < DEPTH) { PHASE_BEGIN(); CK(pb + 10, WS_H, (size_t)T * D * 2); CKBAR(); }
        else { xcd_barrier(bar); PHASE_BEGIN(); cksum_ptr(F, (const v4u*)outp(), (size_t)T * D * 4, CW_CK + dbg_pass * 64 + pb + 10); CKBAR(); }
#endif
    }
#ifdef DBG_TWOPASS
    if (dbg_pass == 1) { PHASE_BEGIN();
      if (blockIdx.x == 0 && F.tid == 0) { unsigned idx = 0u;
          for (int k = NPH - 1; k >= 0; --k) if (__hip_atomic_load((unsigned*)(F.ctl + CW_CK + k), RLX_AGENT) != __hip_atomic_load((unsigned*)(F.ctl + CW_CK + 64 + k), RLX_AGENT)) idx = (unsigned)(k + 1);
          unsigned idx2 = 0u; for (int k = 36; k >= 32; --k) if (__hip_atomic_load((unsigned*)(F.ctl + CW_CK + k), RLX_AGENT) != __hip_atomic_load((unsigned*)(F.ctl + CW_CK + 64 + k), RLX_AGENT)) idx2 = (unsigned)(k - 31);
          __hip_atomic_store((unsigned*)(F.ctl + 16), idx + 32u * idx2, RLX_AGENT); }
      xcd_barrier(bar); }
#endif
#ifdef DBG_CODE_OUT
    if (args.pass == 1 || !DBG_TWOPASS_ON) { xcd_barrier(bar); PHASE_BEGIN(); final_norm(F, inp(I_X), inp(I_GFIN), outp(), 1.f + (float)__hip_atomic_load((unsigned*)(F.ctl + 16), RLX_AGENT) + (float)((__hip_atomic_load((unsigned*)(F.ctl + 17), RLX_AGENT) + 63u) / 64u)); }
#endif
#undef IN
#undef SEAM
#undef H
#undef X
}

extern "C" void kernel_launch(void* const* d_in, const int* in_sizes, int n_in, void* d_out, int out_size, void* d_ws, size_t ws_size, hipStream_t stream) {
    static int grid = 0;
    if (grid == 0) {
        if (n_in != N_IN || in_sizes[0] != T * D || out_size != T * D || ws_size < WS_END) {
            fprintf(stderr, "kernel_launch: built for %d inputs, x/out of %d floats, >= %zu bytes of workspace; got n_in %d, in0 %d, out %d, ws %zu; nothing launched\n", N_IN, T * D, (size_t)WS_END, n_in, n_in > 0 ? in_sizes[0] : -1, out_size, ws_size);
            grid = -1; return; }
        int dev = 0, cus = 0, per_cu = 0;
        if (hipGetDevice(&dev) != hipSuccess || hipDeviceGetAttribute(&cus, hipDeviceAttributeMultiprocessorCount, dev) != hipSuccess) { fprintf(stderr, "kernel_launch: device query failed\n"); grid = -1; return; }
        if (hipFuncSetAttribute((const void*)mk_fwd, hipFuncAttributeMaxDynamicSharedMemorySize, LDS_BYTES) != hipSuccess) { fprintf(stderr, "kernel_launch: hipFuncSetAttribute failed\n"); grid = -1; return; }
        if (hipOccupancyMaxActiveBlocksPerMultiprocessor(&per_cu, (const void*)mk_fwd, NWAVES * 64, LDS_BYTES) != hipSuccess || per_cu < 1) { fprintf(stderr, "kernel_launch: occupancy query reports %d workgroups per CU\n", per_cu); }
        (void)hipGetLastError();
        grid = cus;
    }
    if (grid < 0) return;
    if (hipMemsetAsync((char*)d_ws + WS_CTL, 0, CTL_ZERO_BYTES, stream) != hipSuccess) { fprintf(stderr, "kernel_launch: hipMemsetAsync failed\n"); return; }
    Args a{};
    for (int i = 0; i < N_IN; ++i) a.in[i] = (const float*)d_in[i];
    a.out = (float*)d_out; a.ws = (unsigned char*)d_ws;
#if MK_PER_PHASE
#ifdef DBG_STOP
    for (int ph = 0; ph <= DBG_STOP; ++ph) { a.ph_lo = ph; a.ph_hi = ph + 1; hipLaunchKernelGGL(mk_fwd, dim3(grid), dim3(NWAVES * 64), LDS_BYTES, stream, a); }
    a.ph_lo = 100; a.ph_hi = 101; hipLaunchKernelGGL(mk_fwd, dim3(grid), dim3(NWAVES * 64), LDS_BYTES, stream, a);
#else
    for (int ph = 0; ph < NPH; ++ph) { a.ph_lo = ph; a.ph_hi = ph + 1; hipLaunchKernelGGL(mk_fwd, dim3(grid), dim3(NWAVES * 64), LDS_BYTES, stream, a); }
#endif
#else
#ifdef DBG_TWOPASS
    a.ph_lo = 0; a.ph_hi = NPH; a.pass = 0; hipLaunchKernelGGL(mk_fwd, dim3(grid), dim3(NWAVES * 64), LDS_BYTES, stream, a);
    (void)hipMemsetAsync((char*)d_ws + WS_CTL + CW_BAR * 4, 0, XCD_BAR_WORDS * 4, stream); (void)hipMemsetAsync((char*)d_ws + WS_CTL + CW_GCNT * 4, 0, 2048, stream);
    a.pass = 1; hipLaunchKernelGGL(mk_fwd, dim3(grid), dim3(NWAVES * 64), LDS_BYTES, stream, a);
#else
    a.ph_lo = 0; a.ph_hi = NPH; hipLaunchKernelGGL(mk_fwd, dim3(grid), dim3(NWAVES * 64), LDS_BYTES, stream, a);
#endif
#endif
    const hipError_t le = hipPeekAtLastError();
    if (le != hipSuccess) fprintf(stderr, "kernel_launch: launch failed: %s\n", hipGetErrorName(le));
}
```

```cpp
#include <hip/hip_runtime.h>
#include <cstdio>
#include <cstdint>
#define MK_SP2 false
#define MK_ALIGN false
#define MK_NAIVE_ATTN 0
namespace pg8 {
#define PG8_LAS __attribute__((address_space(3)))
typedef unsigned short bf16_t;
typedef short bf16x8 __attribute__((ext_vector_type(8)));
typedef float f32x4 __attribute__((ext_vector_type(4)));
typedef unsigned u32x4 __attribute__((ext_vector_type(4)));
constexpr int BM = 256, BK = 64, HALF = 128, HTB = HALF * BK * 2  , STAGE_BYTES = 8 * HTB, NXCD = 8, WGM = 8;

__host__ __device__ __forceinline__ int lds_byte(int r, int c) { const int st = (r >> 4) * 2 + (c >> 5), rr = r & 15, cc = c & 31, ob = rr * 64 + cc * 2; return st * 1024 + (ob ^ (((ob >> 9) & 1) << 5)); }
__host__ __device__ __forceinline__ void stage_rc(int b, int& R, int& C) { const int st = b / 1024, sb = b % 1024, swz = sb ^ (((sb >> 9) & 1) << 5); R = (st >> 1) * 16 + swz / 64; C = (st & 1) * 32 + (swz % 64) / 2; }
__host__ __device__ __forceinline__ int perm32(int rho) { const int n = rho >> 4, i = rho & 15; return 8 * (i >> 2) + 4 * n + (i & 3); }

struct Unit { int pm, pn; };
struct Gemm { const bf16_t* A; const bf16_t* Bt; int M, N, K; };

typedef float cvt_f32x2_t __attribute__((ext_vector_type(2))); typedef __bf16 cvt_bf16x2_t __attribute__((ext_vector_type(2)));
__device__ __forceinline__ unsigned cvt_pk_bf16(float lo, float hi) { cvt_f32x2_t v = {lo, hi}; cvt_bf16x2_t b = __builtin_convertvector(v, cvt_bf16x2_t); return __builtin_bit_cast(unsigned, b); }
typedef float f32x2 __attribute__((ext_vector_type(2)));
typedef unsigned u32x2 __attribute__((ext_vector_type(2)));
__device__ __forceinline__ float sigm(float x) { return __builtin_amdgcn_rcpf(1.0f + __builtin_amdgcn_exp2f(-1.4426950408889634f * x)); }
__device__ __forceinline__ float bf_lo(unsigned w) { return __uint_as_float(w << 16); }
__device__ __forceinline__ float bf_hi(unsigned w) { return __uint_as_float(w & 0xffff0000u); }

struct GroupOrder {
    int ng, nN, nwg, G, c, TM; PG8_LAS int* tp;
    __device__ __forceinline__ void init_equal(int ngroups, int rows_per_group, int N, int G_, int c_, PG8_LAS int* tp_) {
        ng = ngroups; nN = N / BM; const int t = rows_per_group / BM; TM = t * ngroups; nwg = TM * nN; G = G_; c = c_; tp = tp_;
        if (ngroups > 1) { int tx = threadIdx.x; asm volatile("" : "+v"(tx)); if (tx < 9) tp[tx] = (tx < ngroups ? tx : ngroups) * t; __syncthreads(); }
    }
    __device__ __forceinline__ void init_dense(int M, int N, int G_, int c_) { init_equal(1, M, N, G_, c_, nullptr); }
    __device__ __forceinline__ void init_counts(const unsigned (&cnt)[8], int N, int G_, int c_, PG8_LAS int* tp_) {
        ng = 8; nN = N / BM; G = G_; c = c_; tp = tp_; int s = 0; int tx = threadIdx.x; asm volatile("" : "+v"(tx));
        if (tx == 0) tp[0] = 0;
#pragma unroll
        for (int e = 0; e < 8; ++e) { s += (int)((cnt[e] + 255u) >> 8); if (tx == 0) tp[e + 1] = s; }
        TM = s; nwg = TM * nN; __syncthreads();
    }
    __device__ __forceinline__ bool next(int i, Unit& u) const {
        const long L = (long)i * G + c; if (L >= nwg) return false;
        int wgid = (int)L; { const int q = nwg / NXCD, r = nwg % NXCD, xcd = wgid % NXCD, off = wgid / NXCD; wgid = (xcd < r ? xcd * (q + 1) : r * (q + 1) + (xcd - r) * q) + off; }
        const int nig = WGM * nN, gid = wgid / nig, fm = gid * WGM, gsz = (TM - fm) < WGM ? (TM - fm) : WGM;
        const int rt = fm + ((wgid % nig) % gsz), pl = (wgid % nig) / gsz;
        int e = 0;
        if (ng > 1) {
#pragma unroll
            for (int j = 1; j < 8; ++j) e += (j < ng && rt >= __builtin_amdgcn_readfirstlane(tp[j])) ? 1 : 0; }
        u.pm = rt; u.pn = e * nN + pl; return true;
    }
    __device__ __forceinline__ void a_ready(const Unit&) const {}
    __device__ __forceinline__ void done(const Unit&) const {}
};

#define EPI_ROWS(row0) _Pragma("unroll") for (int ai = 0; ai < 2; ++ai) _Pragma("unroll") for (int m = 0; m < 4; ++m)
__device__ __forceinline__ u32x4 pack8(const f32x4 a, const f32x4 b) { u32x4 w; w.x = cvt_pk_bf16(a[0], a[1]); w.y = cvt_pk_bf16(a[2], a[3]); w.z = cvt_pk_bf16(b[0], b[1]); w.w = cvt_pk_bf16(b[2], b[3]); return w; }
__device__ __forceinline__ f32x4 sigm4(const f32x4 v) { return (f32x4){sigm(v[0]), sigm(v[1]), sigm(v[2]), sigm(v[3])}; }

struct EpiInProj {
    static constexpr bool PERM = true, AFTER_DRAIN = false;
    bf16_t *Q, *K, *V, *Z, *SG; const float* rope; float qscale;
    __device__ __forceinline__ void operator()(const f32x4 (&acc)[2][2][4][2], const Unit& u, int wr, int wc, int fr, int fq) const {
        const int pn = u.pn, row0 = u.pm * BM + wr * 64 + fr, cl = wc * 32 + 8 * fq;
        if (pn < 4) {
            bf16_t* base = (pn < 2) ? Q : K; const float sc = (pn < 2) ? qscale : 1.0f; const int colt = (pn & 1) * 256, g4 = 4 * (4 * (wc & 1) + fq);
            EPI_ROWS(row0) { const int row = row0 + ai * HALF + m * 16; const float* rp = rope + (size_t)(row & 2047) * 64 + g4;
                const f32x4 cs = *(const f32x4*)rp, sn = *(const f32x4*)(rp + 32);
#pragma unroll
                for (int bj = 0; bj < 2; ++bj) { const f32x4 v0 = acc[ai][bj][m][0], v1 = acc[ai][bj][m][1];
                    const f32x4 lo = (v0 * cs - v1 * sn) * sc, hi = (v1 * cs + v0 * sn) * sc;
                    bf16_t* p = base + (size_t)row * 512 + colt + (2 * bj + (wc >> 1)) * 64 + g4;
                    u32x2 a; a.x = cvt_pk_bf16(lo[0], lo[1]); a.y = cvt_pk_bf16(lo[2], lo[3]); *(u32x2*)p = a;
                    u32x2 b; b.x = cvt_pk_bf16(hi[0], hi[1]); b.y = cvt_pk_bf16(hi[2], hi[3]); *(u32x2*)(p + 32) = b; } }
        } else if (pn < 6) {
            EPI_ROWS(row0) { bf16_t* p = V + (size_t)(row0 + ai * HALF + m * 16) * 512 + (pn - 4) * 256 + cl;
#pragma unroll
                for (int bj = 0; bj < 2; ++bj) *(u32x4*)(p + bj * HALF) = pack8(acc[ai][bj][m][0], acc[ai][bj][m][1]); }
        } else if (pn < 10) {
            EPI_ROWS(row0) { bf16_t* p = Z + (size_t)(row0 + ai * HALF + m * 16) * 512 + (pn - 6) * 128 + cl;
                *(u32x4*)p = pack8(acc[ai][0][m][0] * sigm4(acc[ai][1][m][0]), acc[ai][0][m][1] * sigm4(acc[ai][1][m][1])); }
        } else {
            EPI_ROWS(row0) { bf16_t* p = SG + (size_t)(row0 + ai * HALF + m * 16) * 2048 + (pn - 10) * 256 + cl;
#pragma unroll
                for (int bj = 0; bj < 2; ++bj) *(u32x4*)(p + bj * HALF) = pack8(sigm4(acc[ai][bj][m][0]), sigm4(acc[ai][bj][m][1])); }
        }
    }
};
template <int MODE> struct EpiGate {
    static constexpr bool PERM = false, AFTER_DRAIN = false;
    float* P; bf16_t* MIX; const bf16_t* SG;
    __device__ __forceinline__ void operator()(const f32x4 (&acc)[2][2][4][2], const Unit& u, int wr, int wc, int fr, int fq) const {
        const int row0 = u.pm * BM + wr * 64 + fr, col0 = u.pn * BM + wc * 32 + 4 * fq;
        EPI_ROWS(row0) { const size_t row = (size_t)(row0 + ai * HALF + m * 16);
#pragma unroll
            for (int bj = 0; bj < 2; ++bj)
#pragma unroll
                for (int n = 0; n < 2; ++n) { const int col = col0 + bj * HALF + n * 16;
                    const u32x2 gw = *(const u32x2*)(SG + row * 2048 + MODE * 1024 + col);
                    const f32x4 gt = (f32x4){bf_lo(gw.x), bf_hi(gw.x), bf_lo(gw.y), bf_hi(gw.y)};
                    if (MODE == 0) *(f32x4*)(P + row * 1024 + col) = gt * acc[ai][bj][m][n];
                    else { const f32x4 r = *(const f32x4*)(P + row * 1024 + col) + gt * acc[ai][bj][m][n];
                        u32x2 w; w.x = cvt_pk_bf16(r[0], r[1]); w.y = cvt_pk_bf16(r[2], r[3]); *(u32x2*)(MIX + row * 1024 + col) = w; } } }
    }
};
struct EpiResid {
    static constexpr bool PERM = false, AFTER_DRAIN = false;
    const float* base; float* out; int nN;
    __device__ __forceinline__ void operator()(const f32x4 (&acc)[2][2][4][2], const Unit& u, int wr, int wc, int fr, int fq) const {
        const int row0 = u.pm * BM + wr * 64 + fr, col0 = (u.pn % nN) * BM + wc * 32 + 4 * fq;
        EPI_ROWS(row0) { const size_t off = (size_t)(row0 + ai * HALF + m * 16) * 1024 + col0;
#pragma unroll
            for (int bj = 0; bj < 2; ++bj)
#pragma unroll
                for (int n = 0; n < 2; ++n) { f32x4 r = acc[ai][bj][m][n]; if (base) r += *(const f32x4*)(base + off + bj * HALF + n * 16); *(f32x4*)(out + off + bj * HALF + n * 16) = r; } }
    }
};
struct EpiSwiGLU {
    static constexpr bool PERM = true, AFTER_DRAIN = false;
    bf16_t* ACT; int ldc, nN;
    __device__ __forceinline__ void operator()(const f32x4 (&acc)[2][2][4][2], const Unit& u, int wr, int wc, int fr, int fq) const {
        const int row0 = u.pm * BM + wr * 64 + fr, cl = (u.pn % nN) * 128 + wc * 32 + 8 * fq;
        EPI_ROWS(row0) { bf16_t* p = ACT + (size_t)(row0 + ai * HALF + m * 16) * ldc + cl;
            const f32x4 g0 = acc[ai][0][m][0], g1 = acc[ai][0][m][1];
            *(u32x4*)p = pack8(g0 * sigm4(g0) * acc[ai][1][m][0], g1 * sigm4(g1) * acc[ai][1][m][1]); }
    }
};
struct EpiStore {
    static constexpr bool PERM = true, AFTER_DRAIN = false;
    bf16_t* O; int ldc, nN;
    __device__ __forceinline__ void operator()(const f32x4 (&acc)[2][2][4][2], const Unit& u, int wr, int wc, int fr, int fq) const {
        const int row0 = u.pm * BM + wr * 64 + fr, cl = (u.pn % nN) * BM + wc * 32 + 8 * fq;
        EPI_ROWS(row0) { bf16_t* p = O + (size_t)(row0 + ai * HALF + m * 16) * ldc + cl;
#pragma unroll
            for (int bj = 0; bj < 2; ++bj) *(u32x4*)(p + bj * HALF) = pack8(acc[ai][bj][m][0], acc[ai][bj][m][1]); }
    }
};
struct EpiPleGate {
    static constexpr bool PERM = false, AFTER_DRAIN = false;
    float* X; const bf16_t* PROJ;
    __device__ __forceinline__ void operator()(const f32x4 (&acc)[2][2][4][2], const Unit& u, int wr, int wc, int fr, int fq) const {
        const int row0 = u.pm * BM + wr * 64 + fr, col0 = u.pn * BM + wc * 32 + 4 * fq;
        EPI_ROWS(row0) { const size_t off = (size_t)(row0 + ai * HALF + m * 16) * 1024 + col0;
#pragma unroll
            for (int bj = 0; bj < 2; ++bj)
#pragma unroll
                for (int n = 0; n < 2; ++n) { const size_t o = off + bj * HALF + n * 16; const u32x2 pw = *(const u32x2*)(PROJ + o);
                    const f32x4 pr = (f32x4){bf_lo(pw.x), bf_hi(pw.x), bf_lo(pw.y), bf_hi(pw.y)};
                    *(f32x4*)(X + o) = *(const f32x4*)(X + o) + sigm4(acc[ai][bj][m][n]) * pr; } }
    }
};

template <class Epi, class Sched>
__device__ __forceinline__ void gemm_phase_naive(const Gemm g, const Sched& S, const Epi& E) {
    int tid_ = threadIdx.x; asm volatile("" : "+v"(tid_));
    const int tid = tid_, wid = __builtin_amdgcn_readfirstlane(tid >> 6), lane = tid & 63, wr = wid >> 2, wc = wid & 3, fr = lane & 15, fq = lane >> 4;
    const int K = g.K; Unit u;
    for (int ui = 0; S.next(ui, u); ++ui) {
        f32x4 acc[2][2][4][2];
#pragma unroll
        for (int ai = 0; ai < 2; ++ai)
#pragma unroll
            for (int m = 0; m < 4; ++m) {
                const bf16_t* ap = g.A + (size_t)(u.pm * BM + ai * HALF + wr * 64 + m * 16 + fr) * K;
#pragma unroll
                for (int bj = 0; bj < 2; ++bj)
#pragma unroll
                    for (int n = 0; n < 2; ++n) { f32x4 r = (f32x4){0.f, 0.f, 0.f, 0.f};
#pragma unroll
                        for (int j = 0; j < 4; ++j) { const int col = u.pn * BM + bj * HALF + wc * 32 + (Epi::PERM ? (8 * fq + 4 * n + j) : (16 * n + 4 * fq + j));
                            const bf16_t* bp = g.Bt + (size_t)col * K; float s = 0.f;
                            for (int k = 0; k < K; k += 8) { const u32x4 a = *(const u32x4*)(ap + k), b = *(const u32x4*)(bp + k);
                                s += bf_lo(a.x) * bf_lo(b.x) + bf_hi(a.x) * bf_hi(b.x) + bf_lo(a.y) * bf_lo(b.y) + bf_hi(a.y) * bf_hi(b.y)
                                   + bf_lo(a.z) * bf_lo(b.z) + bf_hi(a.z) * bf_hi(b.z) + bf_lo(a.w) * bf_lo(b.w) + bf_hi(a.w) * bf_hi(b.w); }
                            r[j] = s; }
                        acc[ai][bj][m][n] = r; } }
        E(acc, u, wr, wc, fr, fq);
    }
}
template <class Epi, class Sched, bool ALIGN_EPI = false, bool SP2 = false>
__device__ __forceinline__ void gemm_phase(PG8_LAS unsigned char* lds, const Gemm g, const Sched& S, const Epi& E) {
    int tid_ = threadIdx.x; asm volatile("" : "+v"(tid_));
    const int tid = tid_, wid = __builtin_amdgcn_readfirstlane(tid >> 6), lane = tid & 63, wr = wid >> 2, wc = wid & 3, fr = lane & 15, fq = lane >> 4;
    int K_ = g.K; asm volatile("" : "+s"(K_));
    const int K = K_, nt = K / BK;
    unsigned voffA[2], voffB[2];
#pragma unroll
    for (int i = 0; i < 2; ++i) { int R, C; stage_rc(tid * 16 + i * 8192, R, C); const int Rb = Epi::PERM ? ((R & ~31) + perm32(R & 31)) : R;
        voffA[i] = (unsigned)(R * K + C) * 2u; voffB[i] = (unsigned)(Rb * K + C) * 2u; }
    const size_t kstep = (size_t)(BK * 2);
    const size_t hstep = (size_t)HALF * K * 2;
    const size_t tstep = 2 * hstep;
    const unsigned ldsw = (unsigned)wid * 1024u;
    const int aoff = lds_byte(wr * 64 + fr, fq * 8), boff = lds_byte(wc * 32 + fr, fq * 8);
#define PG8_SA(b, h) (((b) * 2 + (h)) * HTB)
#define PG8_SB(b, h) ((4 + (b) * 2 + (h)) * HTB)
#define PG8_STAGE(bufoff, gbase, voff) do { _Pragma("unroll") for (int _i = 0; _i < 2; ++_i) \
        __builtin_amdgcn_global_load_lds((const unsigned*)((const char*)(gbase) + (voff)[_i]), (PG8_LAS unsigned*)(lds + (bufoff) + ldsw + _i * 8192), 16, 0, 0); } while (0)
#define PG8_LDA(dst, b, h) do { _Pragma("unroll") for (int m = 0; m < 4; ++m) _Pragma("unroll") for (int k = 0; k < 2; ++k) dst[m][k] = *(const PG8_LAS bf16x8*)(lds + PG8_SA(b, h) + aoff + m * 2048 + k * 1024); } while (0)
#define PG8_LDB(dst, b, h) do { _Pragma("unroll") for (int n = 0; n < 2; ++n) _Pragma("unroll") for (int k = 0; k < 2; ++k) dst[n][k] = *(const PG8_LAS bf16x8*)(lds + PG8_SB(b, h) + boff + n * 2048 + k * 1024); } while (0)
#define PG8_MMA(ai, bj, At, Bt) do { __builtin_amdgcn_s_setprio(1); _Pragma("unroll") for (int m = 0; m < 4; ++m) _Pragma("unroll") for (int n = 0; n < 2; ++n) _Pragma("unroll") for (int k = 0; k < 2; ++k) \
        acc[ai][bj][m][n] = __builtin_amdgcn_mfma_f32_16x16x32_bf16(Bt[n][k], At[m][k], acc[ai][bj][m][n], 0, 0, 0); __builtin_amdgcn_s_setprio(0); } while (0)
#define PG8_WAIT_V(n) asm volatile("s_waitcnt vmcnt(" #n ")" ::: "memory")
#define PG8_WAIT_L(n) asm volatile("s_waitcnt lgkmcnt(" #n ")" ::: "memory")
#define PG8_BAR __builtin_amdgcn_s_barrier()
#define PG8_SCHED __builtin_amdgcn_sched_barrier(0)
    Unit cur, nxt; int ui = 0;
    if (!S.next(0, cur)) return;
    f32x4 acc[2][2][4][2];
#pragma unroll
    for (int a = 0; a < 2; ++a)
#pragma unroll
        for (int b = 0; b < 2; ++b)
#pragma unroll
            for (int m = 0; m < 4; ++m)
#pragma unroll
                for (int n = 0; n < 2; ++n) acc[a][b][m][n] = (f32x4){0.f, 0.f, 0.f, 0.f};
    bf16x8 At[4][2], B0[2][2], B1[2][2];
    const char* cA = (const char*)g.A + (size_t)cur.pm * tstep; const char* cB = (const char*)g.Bt + (size_t)cur.pn * tstep;
    S.a_ready(cur);
    if constexpr (SP2) {
        PG8_STAGE(PG8_SB(0, 0), cB, voffB); PG8_STAGE(PG8_SB(0, 1), cB + hstep, voffB); PG8_STAGE(PG8_SA(0, 0), cA, voffA); PG8_STAGE(PG8_SA(0, 1), cA + hstep, voffA);
        if (wr == 1) PG8_BAR;
        PG8_WAIT_V(2); PG8_BAR;
        PG8_STAGE(PG8_SB(1, 0), cB + kstep, voffB); PG8_STAGE(PG8_SA(1, 0), cA + kstep, voffA); PG8_STAGE(PG8_SB(1, 1), cB + hstep + kstep, voffB);
        PG8_WAIT_V(6); PG8_BAR;
    } else {
        PG8_STAGE(PG8_SB(0, 0), cB, voffB); PG8_STAGE(PG8_SA(0, 0), cA, voffA); PG8_STAGE(PG8_SB(0, 1), cB + hstep, voffB); PG8_STAGE(PG8_SA(0, 1), cA + hstep, voffA);
        if (wr == 1) PG8_BAR;
        PG8_WAIT_V(4); PG8_BAR;
        PG8_STAGE(PG8_SB(1, 0), cB + kstep, voffB); PG8_STAGE(PG8_SA(1, 0), cA + kstep, voffA); PG8_STAGE(PG8_SB(1, 1), cB + hstep + kstep, voffB);
        PG8_WAIT_V(6); PG8_BAR;
    }
    for (;;) {
        const bool has_next = S.next(ui + 1, nxt);
        const char* nA = has_next ? (const char*)g.A + (size_t)nxt.pm * tstep : cA; const char* nB = has_next ? (const char*)g.Bt + (size_t)nxt.pn * tstep : cB;
#pragma nounroll
        for (int t = 0; t < nt; t += 2) {
            const bool last = (t == nt - 2);
            const char* a1 = cA + (size_t)(t + 1) * kstep;
            const char* a2 = last ? nA : cA + (size_t)(t + 2) * kstep; const char* b2 = last ? nB : cB + (size_t)(t + 2) * kstep;
            const char* a3 = a2 + kstep; const char* b3 = b2 + kstep;
            if (last && has_next) S.a_ready(nxt);
            if constexpr (SP2) {
            PG8_LDB(B0, 0, 0); PG8_LDB(B1, 0, 1); PG8_SCHED; PG8_LDA(At, 0, 0); PG8_STAGE(PG8_SA(1, 1), a1 + hstep, voffA);
            PG8_WAIT_V(8); PG8_WAIT_L(0); PG8_BAR; PG8_MMA(0, 0, At, B0); PG8_MMA(0, 1, At, B1); PG8_BAR; PG8_SCHED;
            PG8_LDA(At, 0, 1); PG8_STAGE(PG8_SB(0, 0), b2, voffB); PG8_STAGE(PG8_SB(0, 1), b2 + hstep, voffB); PG8_STAGE(PG8_SA(0, 0), a2, voffA);
            PG8_WAIT_V(8); PG8_WAIT_L(0); PG8_BAR; PG8_MMA(1, 0, At, B0); PG8_MMA(1, 1, At, B1); PG8_BAR; PG8_SCHED;
            PG8_LDB(B0, 1, 0); PG8_LDB(B1, 1, 1); PG8_SCHED; PG8_LDA(At, 1, 0); PG8_STAGE(PG8_SA(0, 1), a2 + hstep, voffA);
            PG8_WAIT_V(8); PG8_WAIT_L(0); PG8_BAR; PG8_MMA(0, 0, At, B0); PG8_MMA(0, 1, At, B1); PG8_BAR; PG8_SCHED;
            PG8_LDA(At, 1, 1); PG8_STAGE(PG8_SB(1, 0), b3, voffB); PG8_STAGE(PG8_SB(1, 1), b3 + hstep, voffB); PG8_STAGE(PG8_SA(1, 0), a3, voffA);
            PG8_WAIT_V(8); PG8_WAIT_L(0); PG8_BAR; PG8_MMA(1, 0, At, B0); PG8_MMA(1, 1, At, B1); PG8_BAR; PG8_SCHED;
            } else {
            PG8_LDB(B0, 0, 0); PG8_SCHED; PG8_LDA(At, 0, 0); PG8_STAGE(PG8_SA(1, 1), a1 + hstep, voffA);
            PG8_WAIT_L(8); PG8_BAR; PG8_WAIT_L(0); PG8_MMA(0, 0, At, B0); PG8_BAR; PG8_SCHED;
            PG8_LDB(B1, 0, 1); PG8_STAGE(PG8_SB(0, 0), b2, voffB);
            PG8_BAR; PG8_WAIT_L(0); PG8_MMA(0, 1, At, B1); PG8_BAR;
            PG8_LDA(At, 0, 1); PG8_STAGE(PG8_SA(0, 0), a2, voffA);
            PG8_BAR; PG8_WAIT_L(0); PG8_MMA(1, 0, At, B0); PG8_BAR; PG8_SCHED;
            PG8_STAGE(PG8_SB(0, 1), b2 + hstep, voffB);
            PG8_WAIT_V(6); PG8_BAR; PG8_MMA(1, 1, At, B1); PG8_BAR;
            PG8_LDB(B0, 1, 0); PG8_SCHED; PG8_LDA(At, 1, 0); PG8_STAGE(PG8_SA(0, 1), a2 + hstep, voffA);
            PG8_WAIT_L(8); PG8_BAR; PG8_WAIT_L(0); PG8_MMA(0, 0, At, B0); PG8_BAR; PG8_SCHED;
            PG8_LDB(B1, 1, 1); PG8_STAGE(PG8_SB(1, 0), b3, voffB);
            PG8_BAR; PG8_WAIT_L(0); PG8_MMA(0, 1, At, B1); PG8_BAR;
            PG8_LDA(At, 1, 1); PG8_STAGE(PG8_SA(1, 0), a3, voffA);
            PG8_BAR; PG8_WAIT_L(0); PG8_MMA(1, 0, At, B0); PG8_BAR; PG8_SCHED;
            PG8_STAGE(PG8_SB(1, 1), b3 + hstep, voffB);
            PG8_WAIT_V(6); PG8_BAR; PG8_MMA(1, 1, At, B1); PG8_BAR;
            }
        }
        if constexpr (ALIGN_EPI) { if (wr == 0) PG8_BAR; }
        if constexpr (!Epi::AFTER_DRAIN) { E(acc, cur, wr, wc, fr, fq); S.done(cur); }
        if (!has_next) break;
#pragma unroll
        for (int a = 0; a < 2; ++a)
#pragma unroll
            for (int b = 0; b < 2; ++b)
#pragma unroll
                for (int m = 0; m < 4; ++m)
#pragma unroll
                    for (int n = 0; n < 2; ++n) acc[a][b][m][n] = (f32x4){0.f, 0.f, 0.f, 0.f};
        cur = nxt; cA = nA; cB = nB; ++ui;
        if constexpr (ALIGN_EPI) { if (wr == 1) PG8_BAR; }
    }
    PG8_WAIT_V(0);
    if constexpr (!ALIGN_EPI) { if (wr == 0) PG8_BAR; }
    PG8_BAR;
    if constexpr (Epi::AFTER_DRAIN) { E.fused(acc, cur, wr, wc, fr, fq, lds, wid, lane); S.done(cur); }
#undef PG8_SA
#undef PG8_SB
#undef PG8_STAGE
#undef PG8_LDA
#undef PG8_LDB
#undef PG8_MMA
#undef PG8_WAIT_V
#undef PG8_WAIT_L
#undef PG8_BAR
#undef PG8_SCHED
}
}

constexpr int NWAVES = 8;
#ifndef MK_PER_PHASE
#define MK_PER_PHASE 0
#endif
#ifndef MK_NAIVE_GEMM
#define MK_NAIVE_GEMM 0
#endif
#ifndef MK_SP2
#define MK_SP2 true
#endif
#ifndef MK_ALIGN
#define MK_ALIGN true
#endif
#ifdef DBG_TWOPASS
#define DBG_TWOPASS_ON 1
#else
#define DBG_TWOPASS_ON 0
#endif
#ifndef DBG_LAYER
#define DBG_LAYER 0
#endif
#ifndef DBG_INJECT
#define DBG_INJECT 0.f
#endif
#ifndef MK_NAIVE_ATTN
#define MK_NAIVE_ATTN 1
#endif

constexpr int BATCH = 8, SEQ = 2048, D = 1024, T = BATCH * SEQ, DEPTH = 2;
constexpr int NH = 4, HD = 64, VD = 128, AQK = 512, AV = 512, CCH = 512, CK = 31, CPAD = 15;
constexpr int INC = 2 * AQK + AV + 2 * CCH + 2 * D;
constexpr int FF = 2816, NE = 8, FE = 3584, PLE = 256;
constexpr float EPS = 1e-6f;
constexpr float QSCALE = 0.125f * 1.4426950408889634f;
constexpr int MOE_ROWS = 2 * T + NE * 256;
enum { I_X = 0, I_P, I_GMIX, I_WIN, I_LAM, I_GSUB, I_WAO, I_CW, I_CB, I_CLG, I_CLB, I_WCO, I_WO, I_GFFN, I_WFGU, I_WFDN, I_WR, I_BR, I_WEGU, I_WEDN, I_GPLE, I_WPG, I_WPP, I_GFIN, N_IN };

constexpr size_t MiB = 1u << 20;
constexpr size_t WS_CTL = 0, CTL_ZERO_BYTES = 1 * MiB;
constexpr size_t WS_ROPE = 1 * MiB;
constexpr size_t WS_SCAL = 1 * MiB + 512 * 1024;
constexpr size_t WS_RTI = WS_SCAL + 4096;
constexpr size_t WS_RTW = WS_RTI + (size_t)T * 16;
constexpr size_t WS_RSEL = WS_RTW + (size_t)T * 8;
static_assert(WS_RSEL + (size_t)T * 8 <= 4 * MiB, "misc region");
constexpr size_t WS_WIN = 4 * MiB, WS_WA = 22 * MiB, WS_WC = 24 * MiB, WS_WO = 26 * MiB, WS_WFGU = 30 * MiB, WS_WFDN = 41 * MiB, WS_WPG = 47 * MiB, WS_WPP = 51 * MiB;
constexpr size_t WS_WEGU = 52 * MiB, WS_WEDN = 164 * MiB;
constexpr size_t WS_X = 220 * MiB, WS_H = 284 * MiB, WS_PROJ = 316 * MiB, WS_PB = 380 * MiB, WS_R = 396 * MiB;
constexpr size_t WS_Q = WS_R, WS_K = WS_R + 16 * MiB, WS_V = WS_R + 32 * MiB, WS_Z = WS_R + 48 * MiB, WS_SG = WS_R + 64 * MiB, WS_OB = WS_R + 128 * MiB, WS_ZC = WS_R + 144 * MiB,
                 WS_P = WS_R + 160 * MiB, WS_MIX = WS_R + 224 * MiB;
constexpr size_t WS_ACT = WS_R, WS_HP = WS_R + 240 * MiB, WS_Y = WS_R + 308 * MiB, WS_END = WS_R + 444 * MiB;
static_assert((size_t)MOE_ROWS * FE * 2 <= 240 * MiB && (size_t)MOE_ROWS * D * 2 <= 68 * MiB && (size_t)MOE_ROWS * D * 4 <= 136 * MiB && (size_t)T * FF * 2 <= 240 * MiB, "region R");
constexpr int CW_TMO = 0, CW_CODE = 1, CW_BAR = 4096, CW_GCNT = 8192;

constexpr int RING_OFF = 0, RING_BYTES = 131072;
constexpr int LDSCTL_OFF = RING_BYTES, MISC_OFF = LDSCTL_OFF + 320;
constexpr int TP_OFF = MISC_OFF + 64;
constexpr int LDS_BYTES = 147456;

#define GAS __attribute__((address_space(1)))
#define LAS __attribute__((address_space(3)))
typedef unsigned short bf16;
typedef unsigned v4u __attribute__((ext_vector_type(4)));
typedef unsigned v2u __attribute__((ext_vector_type(2)));
typedef float f32x4 __attribute__((ext_vector_type(4)));
typedef GAS unsigned gu32;
#define RLX_AGENT __ATOMIC_RELAXED, __HIP_MEMORY_SCOPE_AGENT
#define LDS_WAIT() asm volatile("s_waitcnt lgkmcnt(0)" ::: "memory")
#define VM_WAIT() asm volatile("s_waitcnt vmcnt(0)" ::: "memory")
__device__ __forceinline__ unsigned f2bf(float f) { unsigned u = __builtin_bit_cast(unsigned, f); return (u + 0x7fffu + ((u >> 16) & 1u)) >> 16; }
__device__ __forceinline__ unsigned pk2(float lo, float hi) { return f2bf(lo) | (f2bf(hi) << 16); }
using pg8::bf_lo; using pg8::bf_hi; using pg8::sigm;

#define XB_TMO      128
#define XB_XCNT(j)  (256  + 64 * (j))
#define XB_XSUB(j)  (1280 + 64 * (j))
#define XB_XGEN(j)  (2304 + 64 * (j))
#define XB_TOP      3328
#define XB_TOPGEN   3392
#define XCD_BAR_WORDS 3456
#define XB_SPIN_CAP (1u << 18)

__device__ __forceinline__ unsigned xb_ld(unsigned* p)              { return __hip_atomic_load(p, __ATOMIC_RELAXED, __HIP_MEMORY_SCOPE_AGENT); }
__device__ __forceinline__ unsigned xb_add(unsigned* p, unsigned v) { return __hip_atomic_fetch_add(p, v, __ATOMIC_RELAXED, __HIP_MEMORY_SCOPE_AGENT); }
__device__ __forceinline__ unsigned xb_xcc_id() { return (unsigned)__builtin_amdgcn_s_getreg((3 << 11) | 20) & 0xFu; }
#define XB_SPIN(cond, bar) do { unsigned _sp = 0; while (cond) { __builtin_amdgcn_s_sleep(1); \
    if ((++_sp & 255u) == 0u) { if (xb_ld(&(bar)[XB_TMO])) break; if (_sp > XB_SPIN_CAP) { atomicAdd(&(bar)[XB_TMO], 1u); break; } } } } while (0)

struct XcdBarrier {
    unsigned* bar; unsigned x;
    volatile LAS unsigned* st;
};

__device__ __forceinline__ XcdBarrier xcd_barrier_post(unsigned* bar, volatile LAS unsigned* st) {
    XcdBarrier b; b.bar = bar; b.x = xb_xcc_id(); b.st = st;
    if (threadIdx.x == 0) (void)xb_add(&bar[XB_XCNT(b.x)], 1u);
    return b;
}
__device__ __forceinline__ void xcd_barrier_complete(unsigned* bar, unsigned x, unsigned& nloc, unsigned& nx) {
    const unsigned G = gridDim.x * gridDim.y * gridDim.z;
    unsigned sum, cnt, mine, sp = 0u;
    for (;;) {
        sum = 0u; cnt = 0u; mine = 0u;
#pragma unroll
        for (unsigned j = 0; j < 16; ++j) { const unsigned c = xb_ld(&bar[XB_XCNT(j)]); sum += c; cnt += (c > 0u) ? 1u : 0u; mine = (j == x) ? c : mine; }
        if (sum == G) break;
        __builtin_amdgcn_s_sleep(1);
        if ((++sp & 255u) == 0u) { if (xb_ld(&bar[XB_TMO])) break; if (sp > XB_SPIN_CAP) { atomicAdd(&bar[XB_TMO], 1u); break; } }
    }
    nloc = mine > 0u ? mine : 1u; nx = cnt > 0u ? cnt : 1u;
}

__device__ __forceinline__ void xcd_barrier(const XcdBarrier& b) {
    asm volatile("s_waitcnt vmcnt(0)" ::: "memory");
    __syncthreads();
    if (threadIdx.x == 0) {
        GAS unsigned* gbar_ = (GAS unsigned*)b.bar; unsigned bx = b.x; asm volatile("" : "+s"(gbar_), "+s"(bx)); unsigned* bar = (unsigned*)gbar_;
        __builtin_amdgcn_s_waitcnt(0);
        unsigned nloc = b.st[0], nx = b.st[1];
        if (nloc == 0u) { xcd_barrier_complete(bar, bx, nloc, nx); b.st[0] = nloc; b.st[1] = nx; }
        const unsigned old = xb_add(&bar[XB_XSUB(bx)], 1u);
        const unsigned gen = old / nloc;
        if (old + 1u == (gen + 1u) * nloc) {
            __builtin_amdgcn_fence(__ATOMIC_RELEASE, "agent");
            asm volatile("s_waitcnt vmcnt(0)" ::: "memory");
            const unsigned og = xb_add(&bar[XB_TOP], 1u);
            const unsigned tg = og / nx;
            if (og + 1u == (tg + 1u) * nx) xb_add(&bar[XB_TOPGEN], 1u);
            else XB_SPIN(xb_ld(&bar[XB_TOPGEN]) == tg, bar);
            __builtin_amdgcn_fence(__ATOMIC_ACQUIRE, "agent");
            xb_add(&bar[XB_XGEN(bx)], 1u);
            asm volatile("s_waitcnt vmcnt(0)" ::: "memory");
        } else {
            XB_SPIN(xb_ld(&bar[XB_XGEN(bx)]) == gen, bar);
            __builtin_amdgcn_fence(__ATOMIC_ACQUIRE, "agent");
            asm volatile("s_waitcnt vmcnt(0)" ::: "memory");
        }
    }
    __syncthreads();
}

struct Frame {
    LAS unsigned char* lds;
    volatile LAS unsigned* MISC;
    gu32* ctl;
    GAS unsigned char* ws;
    int tid, lane, wave, G;
};
#define CAS __attribute__((address_space(4)))
__device__ __forceinline__ const float* inp(int i) {
    const CAS unsigned char* k = (const CAS unsigned char*)__builtin_amdgcn_kernarg_segment_ptr();
    asm volatile("" : "+s"(k));
    return (const float*)*(GAS const float* const CAS*)(k + 8 * i);
}
__device__ __forceinline__ float* outp() {
    const CAS unsigned char* k = (const CAS unsigned char*)__builtin_amdgcn_kernarg_segment_ptr();
    asm volatile("" : "+s"(k));
    return (float*)*(GAS float* const CAS*)(k + 8 * N_IN);
}
template <class TP> __device__ __forceinline__ TP* wsp(Frame& F, size_t off) { GAS unsigned char* w = F.ws; asm volatile("" : "+s"(w)); return (TP*)(w + off); }

__device__ __forceinline__ float wave_sum(float v) {
#pragma unroll
    for (int o = 1; o < 64; o <<= 1) v += __shfl_xor(v, o);
    return v;
}
__device__ __forceinline__ float dot4(const f32x4 a, const f32x4 b) { return (a.x * b.x + a.y * b.y) + (a.z * b.z + a.w * b.w); }

__device__ __forceinline__ unsigned dbg_hash(unsigned a, unsigned b) { unsigned x = a * 2654435761u + b * 40503u + 0x9e3779b9u; x ^= x >> 15; x *= 2246822519u; x ^= x >> 13; x *= 3266489917u; x ^= x >> 16; return x; }
__device__ __forceinline__ void cksum_ptr(Frame& F, const v4u* p, size_t bytes, int slot) {
    const size_t n = bytes / 16, gt = (size_t)blockIdx.x * (NWAVES * 64) + F.tid, NGT = (size_t)F.G * NWAVES * 64; unsigned s = 0u;
    for (size_t i = gt; i < n; i += NGT) { const v4u v = p[i]; s += (v.x + v.y) + (v.z + v.w); }
#pragma unroll
    for (int o = 1; o < 64; o <<= 1) s += (unsigned)__shfl_xor((int)s, o);
    if (F.lane == 0) __hip_atomic_fetch_add((unsigned*)(F.ctl + slot), s, RLX_AGENT);
}
__device__ __forceinline__ void cksum(Frame& F, size_t off, size_t bytes, int slot) { cksum_ptr(F, wsp<v4u>(F, off), bytes, slot); }

enum { PK_ID = 0, PK_INPROJ = 1, PK_SWIGLU = 2 };
struct TEntry { int in_idx, K, N, kind, F, item0; unsigned src_off; unsigned pad; unsigned long long dst_off; };
struct TTable { TEntry e[32]; int n, total; };
constexpr TTable make_table() {
    TTable t{}; int n = 0, it = 0;
    auto add = [&](int in_idx, size_t src_off, int K, int N, int kind, int F, size_t dst) {
        t.e[n].in_idx = in_idx; t.e[n].K = K; t.e[n].N = N; t.e[n].kind = kind; t.e[n].F = F; t.e[n].item0 = it; t.e[n].src_off = (unsigned)src_off; t.e[n].pad = 0; t.e[n].dst_off = dst;
        it += (K / 64) * (N / 32); ++n; };
    for (int l = 0; l < 2; ++l) add(I_WIN, (size_t)l * D * INC, D, INC, PK_INPROJ, 0, WS_WIN + (size_t)l * INC * D * 2);
    for (int l = 0; l < 2; ++l) add(I_WAO, (size_t)l * AV * D, AV, D, PK_ID, 0, WS_WA + (size_t)l * D * AV * 2);
    for (int l = 0; l < 2; ++l) add(I_WCO, (size_t)l * CCH * D, CCH, D, PK_ID, 0, WS_WC + (size_t)l * D * CCH * 2);
    for (int l = 0; l < 2; ++l) add(I_WO, (size_t)l * D * D, D, D, PK_ID, 0, WS_WO + (size_t)l * D * D * 2);
    add(I_WFGU, 0, D, 2 * FF, PK_SWIGLU, FF, WS_WFGU);
    add(I_WFDN, 0, FF, D, PK_ID, 0, WS_WFDN);
    for (int l = 0; l < 2; ++l) add(I_WPG, (size_t)l * D * D, D, D, PK_ID, 0, WS_WPG + (size_t)l * D * D * 2);
    for (int l = 0; l < 2; ++l) add(I_WPP, (size_t)l * PLE * D, PLE, D, PK_ID, 0, WS_WPP + (size_t)l * D * PLE * 2);
    for (int e = 0; e < NE; ++e) add(I_WEGU, (size_t)e * D * 2 * FE, D, 2 * FE, PK_SWIGLU, FE, WS_WEGU + (size_t)e * 2 * FE * D * 2);
    for (int e = 0; e < NE; ++e) add(I_WEDN, (size_t)e * FE * D, FE, D, PK_ID, 0, WS_WEDN + (size_t)e * D * FE * 2);
    t.n = n; t.total = it; return t;
}
__constant__ TTable g_tt = make_table();
static_assert(make_table().n == 30, "transpose table");

__device__ __forceinline__ int dest_row(int kind, int F, int c) {
    if (kind == PK_INPROJ) {
        if (c < 1024) { const int d = c & 63, dd = d & 31; return (c & ~63) + ((dd >> 2) << 3) + ((d >> 5) << 2) + (dd & 3); }
        if (c >= 1536 && c < 2560) { const int cc = c - 1536, h = cc >= 512 ? 1 : 0, r = cc - h * 512; return 1536 + ((r >> 7) << 8) + (h << 7) + (r & 127); }
        return c;
    }
    if (kind == PK_SWIGLU) { const int h = c >= F ? 1 : 0, r = c - h * F; return ((r >> 7) << 8) + (h << 7) + (r & 127); }
    return c;
}
__device__ __forceinline__ void p0_transpose_item(const float* W, int K, int N, bf16* WT, int kind, int FFd, LAS float* scr, int item, int lane) {
    const int nblk = N / 32, kb = item / nblk, nb = item % nblk, k0 = 64 * kb, n0 = 32 * nb;
#pragma unroll 8
    for (int i = 0; i < 32; ++i) { const int kk = 2 * i + (lane >> 5); scr[kk * 33 + (lane & 31)] = W[(size_t)(k0 + kk) * N + n0 + (lane & 31)]; }
    LDS_WAIT(); asm volatile("" ::: "memory");
    const int c = lane & 7;
#pragma unroll
    for (int j = 0; j < 4; ++j) { const int n = (lane >> 3) + 8 * j; const LAS float* s = scr + (8 * c) * 33 + n;
        v4u o; o.x = pk2(s[0 * 33], s[1 * 33]); o.y = pk2(s[2 * 33], s[3 * 33]); o.z = pk2(s[4 * 33], s[5 * 33]); o.w = pk2(s[6 * 33], s[7 * 33]);
        *(v4u*)(WT + (size_t)dest_row(kind, FFd, n0 + n) * K + k0 + 8 * c) = o; }
    LDS_WAIT(); asm volatile("" ::: "memory");
}
__device__ __forceinline__ void norm_rows(Frame& F, const float* src, const float* gain, bf16* dst) {
    const int gw = blockIdx.x * NWAVES + F.wave, NGW = F.G * NWAVES;
    f32x4 g[4];
#pragma unroll
    for (int j = 0; j < 4; ++j) g[j] = ((const f32x4*)gain)[F.lane + 64 * j];
    for (int m = gw; m < T; m += NGW) {
        const f32x4* xr = (const f32x4*)(src + (size_t)m * D) + F.lane;
        f32x4 v[4]; float s = 0.f;
#pragma unroll
        for (int j = 0; j < 4; ++j) { v[j] = xr[64 * j]; s += dot4(v[j], v[j]); }
        const float rstd = 1.f / sqrtf(wave_sum(s) * (1.f / D) + EPS);
        unsigned long long* o8 = (unsigned long long*)(dst + (size_t)m * D) + F.lane;
#pragma unroll
        for (int j = 0; j < 4; ++j) { const f32x4 y = v[j] * rstd * g[j]; o8[64 * j] = (unsigned long long)pk2(y.x, y.y) | ((unsigned long long)pk2(y.z, y.w) << 32); }
    }
}
__device__ __forceinline__ void final_norm(Frame& F, const float* src, const float* gain, float* dst, float dbg_scale = 1.f) {
    const int gw = blockIdx.x * NWAVES + F.wave, NGW = F.G * NWAVES;
    f32x4 g[4];
#pragma unroll
    for (int j = 0; j < 4; ++j) g[j] = ((const f32x4*)gain)[F.lane + 64 * j];
    for (int m = gw; m < T; m += NGW) {
        const f32x4* xr = (const f32x4*)(src + (size_t)m * D) + F.lane;
        f32x4 v[4]; float s = 0.f;
#pragma unroll
        for (int j = 0; j < 4; ++j) { v[j] = xr[64 * j]; s += dot4(v[j], v[j]); }
        const float rstd = 1.f / sqrtf(wave_sum(s) * (1.f / D) + EPS);
        f32x4* o = (f32x4*)(dst + (size_t)m * D) + F.lane;
#pragma unroll
        for (int j = 0; j < 4; ++j) o[64 * j] = v[j] * rstd * g[j] * dbg_scale;
    }
}
__device__ __forceinline__ void p0_prologue(Frame& F) {
    LAS float* scr = (LAS float*)(F.lds + RING_OFF + F.wave * 16384);
    const int gw = blockIdx.x * NWAVES + F.wave, NGW = F.G * NWAVES;
    const int ntot = g_tt.total, nent = g_tt.n;
    for (int it = gw; it < ntot; it += NGW) {
        int ei = 0;
        while (ei + 1 < nent && it >= g_tt.e[ei + 1].item0) ++ei;
        const TEntry& te = g_tt.e[ei];
        p0_transpose_item(inp(te.in_idx) + te.src_off, te.K, te.N, wsp<bf16>(F, te.dst_off), te.kind, te.F, scr, it - te.item0, F.lane);
    }
    { const int gt = blockIdx.x * (NWAVES * 64) + F.tid, NGT = F.G * NWAVES * 64; const float* p = inp(I_P); bf16* pb = wsp<bf16>(F, WS_PB);
      for (int i = gt; i < 2 * T * PLE / 8; i += NGT) { const f32x4 a = *(const f32x4*)(p + (size_t)i * 8), b = *(const f32x4*)(p + (size_t)i * 8 + 4);
          v4u o; o.x = pk2(a.x, a.y); o.y = pk2(a.z, a.w); o.z = pk2(b.x, b.y); o.w = pk2(b.z, b.w); *(v4u*)(pb + (size_t)i * 8) = o; } }
    { const int gt = blockIdx.x * (NWAVES * 64) + F.tid, NGT = F.G * NWAVES * 64; float* rope = wsp<float>(F, WS_ROPE);
      for (int i = gt; i < SEQ * 32; i += NGT) { const int pos = i >> 5, f = i & 31;
          const float inv = exp2f(-(float)(2 * f) * (1.0f / 64.0f) * 13.287712379549449f); const float ang = (float)pos * inv;
          double rev = (double)ang * 0.15915494309189535; rev -= floor(rev); const float rv = (float)rev;
          rope[pos * 64 + f] = __builtin_amdgcn_cosf(rv); rope[pos * 64 + 32 + f] = __builtin_amdgcn_sinf(rv); } }
    if (blockIdx.x == 0 && F.wave == 0) {
        for (int l = 0; l < DEPTH; ++l) { const float* lf = inp(I_LAM) + l * 4 * HD;
            const float a = wave_sum(lf[F.lane] * lf[HD + F.lane]), b = wave_sum(lf[2 * HD + F.lane] * lf[3 * HD + F.lane]);
            const float lam_init = 0.8f - 0.6f * expf(-0.3f * (float)l);
            if (F.lane == 0) wsp<float>(F, WS_SCAL)[l] = expf(a) - expf(b) + lam_init; }
    }
#ifdef DBG_TWOPASS
    if (blockIdx.x == 0 && F.tid < 8) __hip_atomic_store((unsigned*)(F.ctl + CW_GCNT + 64 * F.tid), 0u, RLX_AGENT);
#endif
    norm_rows(F, inp(I_X), inp(I_GMIX), wsp<bf16>(F, WS_H));
}

__device__ __forceinline__ void route_phase(Frame& F, const float* src, const float* gain, bf16* dst) {
    LAS float* wrT = (LAS float*)(F.lds);
    LAS unsigned* lcnt = (LAS unsigned*)(F.lds + 32768);
    LAS unsigned* gbase = lcnt + 8;
    LAS int* rinfo = (LAS int*)(F.lds + 32768 + 64);
    const float* wr = inp(I_WR); const float* br = inp(I_BR);
    int* rti = wsp<int>(F, WS_RTI); float* rtw = wsp<float>(F, WS_RTW);
    for (int i = F.tid; i < NE * D; i += NWAVES * 64) wrT[(i & 7) * D + (i >> 3)] = wr[i];
    f32x4 g[4];
#pragma unroll
    for (int j = 0; j < 4; ++j) g[j] = ((const f32x4*)gain)[F.lane + 64 * j];
    __syncthreads();
    for (int item = blockIdx.x; item < T / 64; item += F.G) {
        if (F.tid < 8) lcnt[F.tid] = 0u;
        __syncthreads();
        for (int rr = 0; rr < 8; ++rr) {
            const int lr = F.wave * 8 + rr, m = item * 64 + lr;
            const f32x4* xr = (const f32x4*)(src + (size_t)m * D) + F.lane;
            f32x4 v[4]; float s = 0.f;
#pragma unroll
            for (int j = 0; j < 4; ++j) { v[j] = xr[64 * j]; s += dot4(v[j], v[j]); }
            const float rstd = 1.f / sqrtf(wave_sum(s) * (1.f / D) + EPS);
            unsigned long long* o8 = (unsigned long long*)(dst + (size_t)m * D) + F.lane;
#pragma unroll
            for (int j = 0; j < 4; ++j) { v[j] = v[j] * rstd * g[j]; o8[64 * j] = (unsigned long long)pk2(v[j].x, v[j].y) | ((unsigned long long)pk2(v[j].z, v[j].w) << 32); }
            float lg[8];
#pragma unroll
            for (int e = 0; e < 8; ++e) { float t = 0.f;
#pragma unroll
                for (int j = 0; j < 4; ++j) t += dot4(v[j], ((const LAS f32x4*)(wrT + e * D))[F.lane + 64 * j]);
                lg[e] = wave_sum(t) + br[e]; }
            int e1 = 0; float v1 = lg[0];
#pragma unroll
            for (int e = 1; e < 8; ++e) if (lg[e] > v1) { v1 = lg[e]; e1 = e; }
            int e2 = -1; float v2 = -INFINITY;
#pragma unroll
            for (int e = 0; e < 8; ++e) if (e != e1 && lg[e] > v2) { v2 = lg[e]; e2 = e; }
            if (e2 < 0) e2 = (e1 == 0) ? 1 : 0;
            const float ex = expf(v2 - v1), w1 = 1.f / (1.f + ex), w2 = ex / (1.f + ex);
            if (F.lane == 0) {
                const unsigned lp1 = __hip_atomic_fetch_add((unsigned*)&lcnt[e1], 1u, __ATOMIC_RELAXED, __HIP_MEMORY_SCOPE_WORKGROUP);
                const unsigned lp2 = __hip_atomic_fetch_add((unsigned*)&lcnt[e2], 1u, __ATOMIC_RELAXED, __HIP_MEMORY_SCOPE_WORKGROUP);
                rinfo[lr * 4 + 0] = e1; rinfo[lr * 4 + 1] = (int)lp1; rinfo[lr * 4 + 2] = e2; rinfo[lr * 4 + 3] = (int)lp2;
                rtw[(size_t)m * 2] = w1; rtw[(size_t)m * 2 + 1] = w2; }
        }
        __syncthreads();
        if (F.tid < 8) gbase[F.tid] = __hip_atomic_fetch_add((unsigned*)(F.ctl + CW_GCNT + 64 * F.tid), lcnt[F.tid], RLX_AGENT);
        __syncthreads();
        if (F.tid < 64) { const int m = item * 64 + F.tid; const int e1 = rinfo[F.tid * 4], lp1 = rinfo[F.tid * 4 + 1], e2 = rinfo[F.tid * 4 + 2], lp2 = rinfo[F.tid * 4 + 3];
            int* o = rti + (size_t)m * 4; o[0] = e1; o[1] = (int)gbase[e1] + lp1; o[2] = e2; o[3] = (int)gbase[e2] + lp2; }
        __syncthreads();
    }
}
__device__ __forceinline__ void load_counts(Frame& F, unsigned (&cnt)[8]) {
#pragma unroll
    for (int e = 0; e < 8; ++e) cnt[e] = (unsigned)__builtin_amdgcn_readfirstlane((int)__hip_atomic_load((unsigned*)(F.ctl + CW_GCNT + 64 * e), RLX_AGENT));
}
__device__ __forceinline__ void scatter_phase(Frame& F) {
    unsigned cnt[8]; load_counts(F, cnt);
    int coff[8]; { int s = 0;
#pragma unroll
        for (int e = 0; e < 8; ++e) { coff[e] = s; s += (int)((cnt[e] + 255u) & ~255u); } }
    const int gw = blockIdx.x * NWAVES + F.wave, NGW = F.G * NWAVES;
    const int* rti = wsp<int>(F, WS_RTI); int* rsel = wsp<int>(F, WS_RSEL); const bf16* H = wsp<bf16>(F, WS_H); bf16* HP = wsp<bf16>(F, WS_HP);
    for (int m = gw; m < T; m += NGW) {
        const int e1 = rti[(size_t)m * 4], p1 = rti[(size_t)m * 4 + 1], e2 = rti[(size_t)m * 4 + 2], p2 = rti[(size_t)m * 4 + 3];
        int c1 = 0, c2 = 0;
#pragma unroll
        for (int e = 0; e < 8; ++e) { c1 = (e1 == e) ? coff[e] : c1; c2 = (e2 == e) ? coff[e] : c2; }
        const int r1 = c1 + p1, r2 = c2 + p2;
        const v4u* s = (const v4u*)(H + (size_t)m * D); const v4u a = s[F.lane], b = s[F.lane + 64];
        v4u* d1 = (v4u*)(HP + (size_t)r1 * D); v4u* d2 = (v4u*)(HP + (size_t)r2 * D);
        d1[F.lane] = a; d1[F.lane + 64] = b; d2[F.lane] = a; d2[F.lane + 64] = b;
        if (F.lane == 0) { rsel[(size_t)m * 2] = r1; rsel[(size_t)m * 2 + 1] = r2; }
    }
}
__device__ __forceinline__ void combine_norm_phase(Frame& F, float* X, const float* gain, bf16* dst) {
    const int gw = blockIdx.x * NWAVES + F.wave, NGW = F.G * NWAVES;
    const int* rsel = wsp<int>(F, WS_RSEL); const float* rtw = wsp<float>(F, WS_RTW); const float* Y = wsp<float>(F, WS_Y);
    f32x4 g[4];
#pragma unroll
    for (int j = 0; j < 4; ++j) g[j] = ((const f32x4*)gain)[F.lane + 64 * j];
    for (int m = gw; m < T; m += NGW) {
        const int r1 = rsel[(size_t)m * 2], r2 = rsel[(size_t)m * 2 + 1]; const float w1 = rtw[(size_t)m * 2], w2 = rtw[(size_t)m * 2 + 1];
        f32x4* xr = (f32x4*)(X + (size_t)m * D) + F.lane; const f32x4* y1 = (const f32x4*)(Y + (size_t)r1 * D) + F.lane; const f32x4* y2 = (const f32x4*)(Y + (size_t)r2 * D) + F.lane;
        f32x4 v[4]; float s = 0.f;
#pragma unroll
        for (int j = 0; j < 4; ++j) { v[j] = xr[64 * j] + (y1[64 * j] * w1 + y2[64 * j] * w2); xr[64 * j] = v[j]; s += dot4(v[j], v[j]); }
        const float rstd = 1.f / sqrtf(wave_sum(s) * (1.f / D) + EPS);
        unsigned long long* o8 = (unsigned long long*)(dst + (size_t)m * D) + F.lane;
#pragma unroll
        for (int j = 0; j < 4; ++j) { const f32x4 y = v[j] * rstd * g[j]; o8[64 * j] = (unsigned long long)pk2(y.x, y.y) | ((unsigned long long)pk2(y.z, y.w) << 32); }
    }
}

__device__ __forceinline__ void conv_phase(Frame& F, int layer) {
    LAS bf16* zt = (LAS bf16*)(F.lds);
    LAS float* wl = (LAS float*)(F.lds + 65536);
    const float* cw = inp(I_CW) + (size_t)layer * CK * CCH; const float* cb = inp(I_CB) + layer * CCH;
    const float* lg = inp(I_CLG) + layer * CCH; const float* lb = inp(I_CLB) + layer * CCH;
    const bf16* Z = wsp<bf16>(F, WS_Z); bf16* ZC = wsp<bf16>(F, WS_ZC);
    for (int i = F.tid; i < CK * CCH; i += NWAVES * 64) { const int tap = i >> 9, ch = i & 511; wl[((tap * 2 + ((ch >> 2) & 1)) * 64 + (ch >> 3)) * 4 + (ch & 3)] = cw[i]; }
    const int c0 = 8 * F.lane;
    const f32x4 b_lo = *(const f32x4*)(cb + c0), b_hi = *(const f32x4*)(cb + c0 + 4), g_lo = *(const f32x4*)(lg + c0), g_hi = *(const f32x4*)(lg + c0 + 4), o_lo = *(const f32x4*)(lb + c0), o_hi = *(const f32x4*)(lb + c0 + 4);
    for (int unit = blockIdx.x; unit < BATCH * (SEQ / 32); unit += F.G) {
        const int b = unit / (SEQ / 32), t0 = (unit % (SEQ / 32)) * 32;
        __syncthreads();
        for (int i = F.tid; i < 62 * 64; i += NWAVES * 64) { const int r = i >> 6, c16 = i & 63, t = t0 - CPAD + r;
            v4u val = (v4u){0u, 0u, 0u, 0u}; if (t >= 0 && t < SEQ) val = *(const v4u*)(Z + ((size_t)(b * SEQ + t)) * CCH + c16 * 8);
            *(LAS v4u*)(zt + r * CCH + c16 * 8) = val; }
        __syncthreads();
        const int r0 = 4 * F.wave;
        f32x4 alo[4], ahi[4];
#pragma unroll
        for (int rr = 0; rr < 4; ++rr) { alo[rr] = b_lo; ahi[rr] = b_hi; }
        f32x4 zlo[4], zhi[4];
#define CONV_LDZ(slot, rowi) do { const v4u zz = *(const LAS v4u*)(zt + (r0 + (rowi)) * CCH + c0); \
        zlo[slot] = (f32x4){bf_lo(zz.x), bf_hi(zz.x), bf_lo(zz.y), bf_hi(zz.y)}; zhi[slot] = (f32x4){bf_lo(zz.z), bf_hi(zz.z), bf_lo(zz.w), bf_hi(zz.w)}; } while (0)
        CONV_LDZ(0, 0); CONV_LDZ(1, 1); CONV_LDZ(2, 2);
#pragma unroll
        for (int tap = 0; tap < CK; ++tap) {
            CONV_LDZ((tap + 3) & 3, tap + 3);
            const f32x4 wlo = *(const LAS f32x4*)(wl + ((tap * 2 + 0) * 64 + F.lane) * 4), whi = *(const LAS f32x4*)(wl + ((tap * 2 + 1) * 64 + F.lane) * 4);
#pragma unroll
            for (int rr = 0; rr < 4; ++rr) { alo[rr] += wlo * zlo[(tap + rr) & 3]; ahi[rr] += whi * zhi[(tap + rr) & 3]; }
        }
#undef CONV_LDZ
#pragma unroll
        for (int rr = 0; rr < 4; ++rr) {
            const float mean = wave_sum((alo[rr].x + alo[rr].y) + (alo[rr].z + alo[rr].w) + (ahi[rr].x + ahi[rr].y) + (ahi[rr].z + ahi[rr].w)) * (1.f / CCH);
            const f32x4 dl = alo[rr] - mean, dh = ahi[rr] - mean;
            const float rstd = 1.f / sqrtf(wave_sum(dot4(dl, dl) + dot4(dh, dh)) * (1.f / CCH) + EPS);
            f32x4 yl = dl * rstd * g_lo + o_lo, yh = dh * rstd * g_hi + o_hi;
            yl = yl * pg8::sigm4(yl); yh = yh * pg8::sigm4(yh);
            *(v4u*)(ZC + ((size_t)(b * SEQ + t0 + r0 + rr)) * CCH + c0) = pg8::pack8(yl, yh);
        }
    }
    __syncthreads();
}

__device__ __forceinline__ void conv_naive_phase(Frame& F, int layer) {
    const float* cw = inp(I_CW) + (size_t)layer * CK * CCH; const float* cb = inp(I_CB) + layer * CCH;
    const float* lg = inp(I_CLG) + layer * CCH; const float* lb = inp(I_CLB) + layer * CCH;
    const bf16* Z = wsp<bf16>(F, WS_Z); bf16* ZC = wsp<bf16>(F, WS_ZC);
    const int gw = blockIdx.x * NWAVES + F.wave, NGW = F.G * NWAVES, c0 = 8 * F.lane;
    for (int m = gw; m < T; m += NGW) {
        const int b = m / SEQ, t = m % SEQ;
        f32x4 alo = *(const f32x4*)(cb + c0), ahi = *(const f32x4*)(cb + c0 + 4);
        for (int tap = 0; tap < CK; ++tap) { const int tt = t + tap - CPAD; if (tt < 0 || tt >= SEQ) continue;
            const v4u zz = *(const v4u*)(Z + ((size_t)(b * SEQ + tt)) * CCH + c0);
            const f32x4 wlo = *(const f32x4*)(cw + tap * CCH + c0), whi = *(const f32x4*)(cw + tap * CCH + c0 + 4);
            alo += wlo * (f32x4){bf_lo(zz.x), bf_hi(zz.x), bf_lo(zz.y), bf_hi(zz.y)}; ahi += whi * (f32x4){bf_lo(zz.z), bf_hi(zz.z), bf_lo(zz.w), bf_hi(zz.w)}; }
        const float mean = wave_sum((alo.x + alo.y) + (alo.z + alo.w) + (ahi.x + ahi.y) + (ahi.z + ahi.w)) * (1.f / CCH);
        const f32x4 dl = alo - mean, dh = ahi - mean;
        const float rstd = 1.f / sqrtf(wave_sum(dot4(dl, dl) + dot4(dh, dh)) * (1.f / CCH) + EPS);
        f32x4 yl = dl * rstd * *(const f32x4*)(lg + c0) + *(const f32x4*)(lb + c0), yh = dh * rstd * *(const f32x4*)(lg + c0 + 4) + *(const f32x4*)(lb + c0 + 4);
        yl = yl * pg8::sigm4(yl); yh = yh * pg8::sigm4(yh);
        *(v4u*)(ZC + (size_t)m * CCH + c0) = pg8::pack8(yl, yh);
    }
}

#ifdef DBG_CHECK_INPROJ
__device__ __forceinline__ float chk_col(const float* w, const f32x4 (&hv)[4], int lane, int c) {
    float t = 0.f;
#pragma unroll
    for (int j = 0; j < 4; ++j) { const int k = 4 * (lane + 64 * j); t += hv[j].x * w[(size_t)(k + 0) * INC + c] + hv[j].y * w[(size_t)(k + 1) * INC + c] + hv[j].z * w[(size_t)(k + 2) * INC + c] + hv[j].w * w[(size_t)(k + 3) * INC + c]; }
    return wave_sum(t);
}
__device__ __forceinline__ bool chk_bad(float got, float exp_) { return !(fabsf(got - exp_) <= 0.02f + 0.02f * fabsf(exp_)); }
__device__ __forceinline__ void check_inproj(Frame& F, int layer) {
    const int gw = blockIdx.x * NWAVES + F.wave; const int m = (int)(dbg_hash((unsigned)gw, 5u) % (unsigned)T), pos = m % SEQ;
    const float* x = layer == 0 ? inp(I_X) : (const float*)wsp<float>(F, WS_X); const float* gain = inp(I_GMIX) + (size_t)layer * D; const float* w = inp(I_WIN) + (size_t)layer * D * INC; const float* rope = wsp<float>(F, WS_ROPE);
    const bf16* Q = wsp<bf16>(F, WS_Q); const bf16* K = wsp<bf16>(F, WS_K); const bf16* V = wsp<bf16>(F, WS_V); const bf16* Z = wsp<bf16>(F, WS_Z); const bf16* SG = wsp<bf16>(F, WS_SG);
    f32x4 hv[4]; float s = 0.f;
#pragma unroll
    for (int j = 0; j < 4; ++j) { hv[j] = ((const f32x4*)(x + (size_t)m * D))[F.lane + 64 * j]; s += dot4(hv[j], hv[j]); }
    const float rstd = 1.f / sqrtf(wave_sum(s) * (1.f / D) + EPS);
#pragma unroll
    for (int j = 0; j < 4; ++j) hv[j] = hv[j] * rstd * ((const f32x4*)gain)[F.lane + 64 * j];
    unsigned flags = 0u;
    { for (int i = 0; i < 2; ++i) { const int c0_ = (int)(dbg_hash((unsigned)gw, 100u + i) % 512u), c = (c0_ & ~63) | (c0_ & 31), f = c & 31; const float t1 = chk_col(w, hv, F.lane, c), t2 = chk_col(w, hv, F.lane, c + 32);
        const float cs = rope[pos * 64 + f], sn = rope[pos * 64 + 32 + f];
        if (chk_bad(bf_lo((unsigned)Q[(size_t)m * 512 + c]), (t1 * cs - t2 * sn) * QSCALE) || chk_bad(bf_lo((unsigned)Q[(size_t)m * 512 + c + 32]), (t2 * cs + t1 * sn) * QSCALE)) flags |= 1u; } }
    { const int c0_ = (int)(dbg_hash((unsigned)gw, 102u) % 512u), c = (c0_ & ~63) | (c0_ & 31), f = c & 31; const float t1 = chk_col(w, hv, F.lane, 512 + c), t2 = chk_col(w, hv, F.lane, 512 + c + 32);
        const float cs = rope[pos * 64 + f], sn = rope[pos * 64 + 32 + f];
        if (chk_bad(bf_lo((unsigned)K[(size_t)m * 512 + c]), t1 * cs - t2 * sn) || chk_bad(bf_lo((unsigned)K[(size_t)m * 512 + c + 32]), t2 * cs + t1 * sn)) flags |= 1u; }
    { const int cv = (int)(dbg_hash((unsigned)gw, 103u) % 512u); const float v = chk_col(w, hv, F.lane, 1024 + cv); if (chk_bad(bf_lo((unsigned)V[(size_t)m * 512 + cv]), v)) flags |= 2u; }
    { int cz[2]; cz[0] = (int)(dbg_hash((unsigned)gw, 104u) % 512u); cz[1] = (int)(dbg_hash((unsigned)gw, 105u) % 512u); for (int i = 0; i < 2; ++i) { const float a = chk_col(w, hv, F.lane, 1536 + cz[i]), g = chk_col(w, hv, F.lane, 2048 + cz[i]);
        if (chk_bad(bf_lo((unsigned)Z[(size_t)m * 512 + cz[i]]), a / (1.f + expf(-g)))) flags |= 2u; } }
    { const int ca = (int)(dbg_hash((unsigned)gw, 106u) % 1024u), cb = (int)(dbg_hash((unsigned)gw, 107u) % 1024u); const float a = chk_col(w, hv, F.lane, 2560 + ca), b = chk_col(w, hv, F.lane, 2560 + 1024 + cb);
#ifdef DBG_SG_DETAIL
        unsigned code = 0u;
        if (chk_bad(bf_lo((unsigned)SG[(size_t)m * 2048 + ca]), 1.f / (1.f + expf(-a)))) code = (unsigned)(DBG_SG_DETAIL == 1 ? 18 - (10 + ca / 256) : (DBG_SG_DETAIL == 2 ? 1 + ((m % 256) >> 4) : DBG_SG_DETAIL == 3 ? 16 - ((m % 256) >> 4) : 1 + ((m >> 8) & 15)));
        if (chk_bad(bf_lo((unsigned)SG[(size_t)m * 2048 + 1024 + cb]), 1.f / (1.f + expf(-b)))) { const unsigned c2 = (unsigned)(DBG_SG_DETAIL == 1 ? 18 - (14 + cb / 256) : (DBG_SG_DETAIL == 2 ? 1 + ((m % 256) >> 4) : DBG_SG_DETAIL == 3 ? 16 - ((m % 256) >> 4) : 1 + ((m >> 8) & 15))); code = code > c2 ? code : c2; }
#if DBG_SG_DETAIL == 5
        if (F.lane == 0 && code) __hip_atomic_fetch_add((unsigned*)(F.ctl + 17), 1u, RLX_AGENT);
#else
        if (F.lane == 0 && code) __hip_atomic_fetch_max((unsigned*)(F.ctl + 16), code, RLX_AGENT);
#endif
#else
        if (chk_bad(bf_lo((unsigned)SG[(size_t)m * 2048 + ca]), 1.f / (1.f + expf(-a))) || chk_bad(bf_lo((unsigned)SG[(size_t)m * 2048 + 1024 + cb]), 1.f / (1.f + expf(-b)))) flags |= 4u;
#endif
    }
    if (F.lane == 0 && flags) __hip_atomic_fetch_or((unsigned*)(F.ctl + 16), flags, RLX_AGENT);
}
#endif

#ifdef DBG_CHECK_ACT
__device__ __forceinline__ void check_act(Frame& F) {
    const int gw = blockIdx.x * NWAVES + F.wave; const int m = (int)(dbg_hash((unsigned)gw, 3u) % (unsigned)T);
    const float* x = wsp<float>(F, WS_X); const float* gain = inp(I_GFFN); const float* w = inp(I_WFGU); const bf16* ACT = wsp<bf16>(F, WS_ACT);
    f32x4 hv[4]; float s = 0.f;
#pragma unroll
    for (int j = 0; j < 4; ++j) { hv[j] = ((const f32x4*)(x + (size_t)m * D))[F.lane + 64 * j]; s += dot4(hv[j], hv[j]); }
    const float rstd = 1.f / sqrtf(wave_sum(s) * (1.f / D) + EPS);
#pragma unroll
    for (int j = 0; j < 4; ++j) hv[j] = hv[j] * rstd * ((const f32x4*)gain)[F.lane + 64 * j];
    unsigned flags = 0u; int cj[4]; for (int i = 0; i < 4; ++i) cj[i] = (int)(dbg_hash((unsigned)gw, 110u + i) % (unsigned)FF);
    for (int i = 0; i < 4; ++i) { float g = 0.f, u = 0.f;
#pragma unroll
        for (int j = 0; j < 4; ++j) { const int k = 4 * (F.lane + 64 * j);
            g += hv[j].x * w[(size_t)(k + 0) * (2 * FF) + cj[i]] + hv[j].y * w[(size_t)(k + 1) * (2 * FF) + cj[i]] + hv[j].z * w[(size_t)(k + 2) * (2 * FF) + cj[i]] + hv[j].w * w[(size_t)(k + 3) * (2 * FF) + cj[i]];
            u += hv[j].x * w[(size_t)(k + 0) * (2 * FF) + FF + cj[i]] + hv[j].y * w[(size_t)(k + 1) * (2 * FF) + FF + cj[i]] + hv[j].z * w[(size_t)(k + 2) * (2 * FF) + FF + cj[i]] + hv[j].w * w[(size_t)(k + 3) * (2 * FF) + FF + cj[i]]; }
        g = wave_sum(g); u = wave_sum(u);
        const float ex = g / (1.f + expf(-g)) * u, got = bf_lo((unsigned)ACT[(size_t)m * FF + cj[i]]);
        if (!(fabsf(got - ex) <= 0.03f + 0.03f * fabsf(ex))) flags |= 8u; }
    if (F.lane == 0 && flags) __hip_atomic_fetch_or((unsigned*)(F.ctl + 16), flags, RLX_AGENT);
}
#endif

#ifdef DBG_CHECK_MIX
__device__ __forceinline__ float chk_dot_bf(const bf16* a, int K, const float* w, int ldw, int c, int lane) {
    float t = 0.f; for (int k = lane; k < K; k += 64) t += bf_lo((unsigned)a[k]) * w[(size_t)k * ldw + c]; return wave_sum(t); }
__device__ __forceinline__ void check_mix(Frame& F, int layer) {
    const int gw = blockIdx.x * NWAVES + F.wave; const int m = (int)(dbg_hash((unsigned)gw, 1u) % (unsigned)T);
    const bf16* OB = wsp<bf16>(F, WS_OB); const bf16* ZC = wsp<bf16>(F, WS_ZC); const bf16* SG = wsp<bf16>(F, WS_SG); const bf16* MIX = wsp<bf16>(F, WS_MIX);
    unsigned flags = 0u; int cc[4]; for (int i = 0; i < 4; ++i) cc[i] = (int)(dbg_hash((unsigned)gw, 120u + i) % (unsigned)D);
    for (int i = 0; i < 4; ++i) { const int c = cc[i];
        const float ad = chk_dot_bf(OB + (size_t)m * AV, AV, inp(I_WAO) + (size_t)layer * AV * D, D, c, F.lane), cd = chk_dot_bf(ZC + (size_t)m * CCH, CCH, inp(I_WCO) + (size_t)layer * CCH * D, D, c, F.lane);
        const float ex = bf_lo((unsigned)SG[(size_t)m * 2048 + c]) * ad + bf_lo((unsigned)SG[(size_t)m * 2048 + 1024 + c]) * cd, got = bf_lo((unsigned)MIX[(size_t)m * D + c]);
        if (!(fabsf(got - ex) <= 0.02f + 0.02f * fabsf(ex))) flags |= 16u; }
    if (F.lane == 0 && flags) __hip_atomic_fetch_or((unsigned*)(F.ctl + 16), flags, RLX_AGENT);
}
__device__ __forceinline__ void snap_wo(Frame& F) { const int gw = blockIdx.x * NWAVES + F.wave; const int m = (int)(dbg_hash((unsigned)gw, 6u) % (unsigned)T);
    if (F.lane < 4) wsp<float>(F, 3 * MiB + 768 * 1024)[(size_t)gw * 4 + F.lane] = wsp<float>(F, WS_X)[(size_t)m * D + (int)(dbg_hash((unsigned)gw, 130u + F.lane) % (unsigned)D)]; }
__device__ __forceinline__ void check_wo(Frame& F, int layer) {
    const int gw = blockIdx.x * NWAVES + F.wave; const int m = (int)(dbg_hash((unsigned)gw, 6u) % (unsigned)T);
    const bf16* MIX = wsp<bf16>(F, WS_MIX); const float* X = wsp<float>(F, WS_X); const float* xin = inp(I_X);
    unsigned flags = 0u; int cc[4]; for (int i_ = 0; i_ < 4; ++i_) cc[i_] = (int)(dbg_hash((unsigned)gw, 130u + i_) % (unsigned)D);
    for (int i = 0; i < 4; ++i) { const int c = cc[i];
        const float ex = (layer == 0 ? xin[(size_t)m * D + c] : wsp<float>(F, 3 * MiB + 768 * 1024)[(size_t)gw * 4 + i]) + chk_dot_bf(MIX + (size_t)m * D, D, inp(I_WO) + (size_t)layer * D * D, D, c, F.lane), got = X[(size_t)m * D + c];
        if (!(fabsf(got - ex) <= 0.02f + 0.02f * fabsf(ex))) flags |= 32u; }
    if (F.lane == 0 && flags) __hip_atomic_fetch_or((unsigned*)(F.ctl + 16), flags, RLX_AGENT);
}
#endif

#ifdef DBG_CHECK_FFN
constexpr size_t WS_DBG = 3 * MiB;
__device__ __forceinline__ void snap_x(Frame& F, int slot, int samp) {
    const int gw = blockIdx.x * NWAVES + F.wave; const int m = (int)(dbg_hash((unsigned)gw, (unsigned)samp) % (unsigned)T);
    if (F.lane < 4) wsp<float>(F, WS_DBG)[(size_t)gw * 16 + slot * 4 + F.lane] = wsp<float>(F, WS_X)[(size_t)m * D + (int)(dbg_hash((unsigned)gw, 140u + F.lane) % (unsigned)D)];
}
__device__ __forceinline__ float chk_dot_f(const float* a, int K, const float* w, int ldw, int c, int lane) { float t = 0.f; for (int k = lane; k < K; k += 64) t += a[k] * w[(size_t)k * ldw + c]; return wave_sum(t); }
__device__ __forceinline__ void check_down(Frame& F) {
    const int gw = blockIdx.x * NWAVES + F.wave; const int m = (int)(dbg_hash((unsigned)gw, 2u) % (unsigned)T); int cc[4]; for (int i_ = 0; i_ < 4; ++i_) cc[i_] = (int)(dbg_hash((unsigned)gw, 140u + i_) % (unsigned)D); unsigned flags = 0u;
    for (int i = 0; i < 4; ++i) { const float d = chk_dot_bf(wsp<bf16>(F, WS_ACT) + (size_t)m * FF, FF, inp(I_WFDN), D, cc[i], F.lane);
        const float ex = wsp<float>(F, WS_DBG)[(size_t)gw * 16 + i] + d, got = wsp<float>(F, WS_X)[(size_t)m * D + cc[i]];
        if (!(fabsf(got - ex) <= 0.02f + 0.02f * fabsf(ex))) flags |= 64u; }
    if (F.lane == 0 && flags) __hip_atomic_fetch_or((unsigned*)(F.ctl + 16), flags, RLX_AGENT);
}
__device__ __forceinline__ void check_norm3(Frame& F, int layer) {
    const int gw = blockIdx.x * NWAVES + F.wave; const int m = (int)(dbg_hash((unsigned)gw, 4u) % (unsigned)T); const float* x = wsp<float>(F, WS_X) + (size_t)m * D; const float* g = inp(I_GPLE) + (size_t)layer * D;
    float s = 0.f; for (int k = F.lane; k < D; k += 64) s += x[k] * x[k];
    const float rstd = 1.f / sqrtf(wave_sum(s) * (1.f / D) + EPS); unsigned flags = 0u;
    for (int k = F.lane; k < D; k += 64) { const float ex = x[k] * rstd * g[k], got = bf_lo((unsigned)wsp<bf16>(F, WS_H)[(size_t)m * D + k]); if (!(fabsf(got - ex) <= 0.01f + 0.01f * fabsf(ex))) flags |= 256u; }
    if (flags) __hip_atomic_fetch_or((unsigned*)(F.ctl + 16), flags, RLX_AGENT);
}
__device__ __forceinline__ void check_ple(Frame& F, int layer) {
    const int gw = blockIdx.x * NWAVES + F.wave; const int m = (int)(dbg_hash((unsigned)gw, 4u) % (unsigned)T); int cc[4]; for (int i_ = 0; i_ < 4; ++i_) cc[i_] = (int)(dbg_hash((unsigned)gw, 140u + i_) % (unsigned)D); unsigned flags = 0u;
    for (int i = 0; i < 4; ++i) { const float gl = chk_dot_bf(wsp<bf16>(F, WS_H) + (size_t)m * D, D, inp(I_WPG) + (size_t)layer * D * D, D, cc[i], F.lane);
        const float pj = chk_dot_f(inp(I_P) + ((size_t)layer * T + m) * PLE, PLE, inp(I_WPP) + (size_t)layer * PLE * D, D, cc[i], F.lane);
        const float ex = wsp<float>(F, WS_DBG)[(size_t)gw * 16 + 4 + i] + pj / (1.f + expf(-gl)) + DBG_INJECT, got = wsp<float>(F, WS_X)[(size_t)m * D + cc[i]];
        if (!(fabsf(got - ex) <= 0.02f + 0.02f * fabsf(ex))) flags |= 128u; }
    if (F.lane == 0 && flags) __hip_atomic_fetch_or((unsigned*)(F.ctl + 16), flags, RLX_AGENT);
}
#endif

#ifdef DBG_CHECK_ATTN
__device__ __forceinline__ void check_attn(Frame& F, int layer) {
    const int gw = blockIdx.x * NWAVES + F.wave; const int m = (int)(dbg_hash((unsigned)gw, 7u) % (unsigned)T), h = gw & 3, b = m / SEQ;
    const float lam = wsp<float>(F, WS_SCAL)[layer]; const float lam_init = 0.8f - 0.6f * expf(-0.3f * (float)layer), post = 1.f - lam_init;
    const float* gsub = inp(I_GSUB) + layer * VD;
    const bf16* Q = wsp<bf16>(F, WS_Q); const bf16* Kb = wsp<bf16>(F, WS_K) + (size_t)b * SEQ * AQK; const bf16* Vb = wsp<bf16>(F, WS_V) + (size_t)b * SEQ * AV; const bf16* OB = wsp<bf16>(F, WS_OB);
    LAS float* S = (LAS float*)(F.lds) + F.wave * 2048; LAS float* O = (LAS float*)(F.lds + 65536) + F.wave * 256;
    for (int c = 0; c < 2; ++c) {
        float qf[64];
#pragma unroll
        for (int i = 0; i < 8; ++i) { const v4u t = *(const v4u*)(Q + (size_t)m * AQK + h * 128 + c * 64 + i * 8);
            qf[8 * i] = bf_lo(t.x); qf[8 * i + 1] = bf_hi(t.x); qf[8 * i + 2] = bf_lo(t.y); qf[8 * i + 3] = bf_hi(t.y); qf[8 * i + 4] = bf_lo(t.z); qf[8 * i + 5] = bf_hi(t.z); qf[8 * i + 6] = bf_lo(t.w); qf[8 * i + 7] = bf_hi(t.w); }
        float mx = -1e30f;
        for (int i = 0; i < 32; ++i) { const int j = F.lane + 64 * i; const bf16* kr = Kb + (size_t)j * AQK + h * 128 + c * 64; float sc = 0.f;
#pragma unroll
            for (int t8 = 0; t8 < 8; ++t8) { const v4u t = *(const v4u*)(kr + t8 * 8);
                sc += qf[8 * t8] * bf_lo(t.x) + qf[8 * t8 + 1] * bf_hi(t.x) + qf[8 * t8 + 2] * bf_lo(t.y) + qf[8 * t8 + 3] * bf_hi(t.y) + qf[8 * t8 + 4] * bf_lo(t.z) + qf[8 * t8 + 5] * bf_hi(t.z) + qf[8 * t8 + 6] * bf_lo(t.w) + qf[8 * t8 + 7] * bf_hi(t.w); }
            S[j] = sc; mx = fmaxf(mx, sc); }
#pragma unroll
        for (int o = 1; o < 64; o <<= 1) mx = fmaxf(mx, __shfl_xor(mx, o));
        float l = 0.f;
        for (int i = 0; i < 32; ++i) { const int j = F.lane + 64 * i; const float p = exp2f(S[j] - mx); S[j] = p; l += p; }
        l = wave_sum(l);
        for (int ch = 0; ch < 4; ++ch) { float a[32];
#pragma unroll
            for (int k = 0; k < 32; ++k) a[k] = 0.f;
            for (int i = 0; i < 32; ++i) { const int j = F.lane + 64 * i; const float p = S[j]; const bf16* vr = Vb + (size_t)j * AV + h * 128 + ch * 32;
#pragma unroll
                for (int t8 = 0; t8 < 4; ++t8) { const v4u t = *(const v4u*)(vr + t8 * 8);
                    a[8 * t8] += p * bf_lo(t.x); a[8 * t8 + 1] += p * bf_hi(t.x); a[8 * t8 + 2] += p * bf_lo(t.y); a[8 * t8 + 3] += p * bf_hi(t.y); a[8 * t8 + 4] += p * bf_lo(t.z); a[8 * t8 + 5] += p * bf_hi(t.z); a[8 * t8 + 6] += p * bf_lo(t.w); a[8 * t8 + 7] += p * bf_hi(t.w); } }
#pragma unroll
            for (int k = 0; k < 32; ++k) { const float r = wave_sum(a[k]); if (F.lane == 0) O[c * 128 + ch * 32 + k] = r / l; } }
    }
    LDS_WAIT();
    const float d0 = O[F.lane] - lam * O[128 + F.lane], d1 = O[64 + F.lane] - lam * O[128 + 64 + F.lane];
    const float rstd = post / sqrtf(wave_sum(d0 * d0 + d1 * d1) * (1.f / VD) + EPS);
    const float e0 = d0 * rstd * gsub[F.lane], e1 = d1 * rstd * gsub[64 + F.lane];
    const float g0 = bf_lo((unsigned)OB[(size_t)m * AV + h * 128 + F.lane]), g1 = bf_lo((unsigned)OB[(size_t)m * AV + h * 128 + 64 + F.lane]);
    if (!(fabsf(g0 - e0) <= 0.03f + 0.03f * fabsf(e0)) || !(fabsf(g1 - e1) <= 0.03f + 0.03f * fabsf(e1))) __hip_atomic_fetch_or((unsigned*)(F.ctl + 16), 512u, RLX_AGENT);
}
#endif

#ifdef DBG_CHECK_MOE
__device__ __forceinline__ void check_route(Frame& F) {
    const int gw = blockIdx.x * NWAVES + F.wave; const int m = (int)(dbg_hash((unsigned)gw, 6u) % (unsigned)T);
    const float* x = wsp<float>(F, WS_X) + (size_t)m * D; const float* g = inp(I_GFFN) + D; const float* wr = inp(I_WR); const float* br = inp(I_BR);
    float s = 0.f; for (int k = F.lane; k < D; k += 64) s += x[k] * x[k];
    const float rstd = 1.f / sqrtf(wave_sum(s) * (1.f / D) + EPS);
    float lg[8];
#pragma unroll
    for (int e = 0; e < 8; ++e) lg[e] = 0.f;
    for (int k = F.lane; k < D; k += 64) { const float hk = x[k] * rstd * g[k];
#pragma unroll
        for (int e = 0; e < 8; ++e) lg[e] += hk * wr[k * 8 + e]; }
#pragma unroll
    for (int e = 0; e < 8; ++e) lg[e] = wave_sum(lg[e]) + br[e];
    int e1 = 0; float v1 = lg[0];
#pragma unroll
    for (int e = 1; e < 8; ++e) if (lg[e] > v1) { v1 = lg[e]; e1 = e; }
    int e2 = -1; float v2 = -INFINITY;
#pragma unroll
    for (int e = 0; e < 8; ++e) if (e != e1 && lg[e] > v2) { v2 = lg[e]; e2 = e; }
    const float ex = expf(v2 - v1), w1 = 1.f / (1.f + ex), w2 = ex / (1.f + ex);
    const int* rti = wsp<int>(F, WS_RTI) + (size_t)m * 4; const float* rtw = wsp<float>(F, WS_RTW) + (size_t)m * 2;
    const bool tie = (v1 - v2) < 1e-3f;
    bool bad = !(fabsf(rtw[0] + rtw[1] - 1.f) < 1e-3f);
    if (!tie) bad = bad || rti[0] != e1 || rti[2] != e2 || !(fabsf(rtw[0] - w1) < 2e-3f) || !(fabsf(rtw[1] - w2) < 2e-3f);
    if (bad && F.lane == 0) __hip_atomic_fetch_or((unsigned*)(F.ctl + 16), 1024u, RLX_AGENT);
}
__device__ __forceinline__ void check_experts(Frame& F) {
    const int gw = blockIdx.x * NWAVES + F.wave; const int m = (int)(dbg_hash((unsigned)gw, 6u) % (unsigned)T);
    const int* rti = wsp<int>(F, WS_RTI) + (size_t)m * 4; const int* rsel = wsp<int>(F, WS_RSEL) + (size_t)m * 2;
    const bf16* H = wsp<bf16>(F, WS_H) + (size_t)m * D; unsigned flags = 0u;
    for (int t = 0; t < 2; ++t) { const int e = rti[2 * t], r = rsel[t];
        const bf16* hp = wsp<bf16>(F, WS_HP) + (size_t)r * D; const bf16* act = wsp<bf16>(F, WS_ACT) + (size_t)r * FE; const float* y = wsp<float>(F, WS_Y) + (size_t)r * D;
        for (int k = F.lane; k < D; k += 64) if (hp[k] != H[k]) flags |= 2048u;
        const float* wgu = inp(I_WEGU) + (size_t)e * D * 2 * FE; const float* wdn = inp(I_WEDN) + (size_t)e * FE * D;
        int cj[3]; for (int i_ = 0; i_ < 3; ++i_) cj[i_] = (int)(dbg_hash((unsigned)gw, 150u + i_ + 8 * t) % (unsigned)FE);
        for (int i = 0; i < 3; ++i) { float gg = 0.f, uu = 0.f;
            for (int k = F.lane; k < D; k += 64) { const float hk = bf_lo((unsigned)hp[k]); gg += hk * wgu[(size_t)k * (2 * FE) + cj[i]]; uu += hk * wgu[(size_t)k * (2 * FE) + FE + cj[i]]; }
            gg = wave_sum(gg); uu = wave_sum(uu);
            const float ex = gg / (1.f + expf(-gg)) * uu, got = bf_lo((unsigned)act[cj[i]]);
            if (!(fabsf(got - ex) <= 0.03f + 0.03f * fabsf(ex))) flags |= 4096u; }
        int cc[2]; for (int i_ = 0; i_ < 2; ++i_) cc[i_] = (int)(dbg_hash((unsigned)gw, 160u + i_) % (unsigned)D);
        for (int i = 0; i < 2; ++i) { float d = 0.f; for (int k = F.lane; k < FE; k += 64) d += bf_lo((unsigned)act[k]) * wdn[(size_t)k * D + cc[i]];
            d = wave_sum(d); if (!(fabsf(y[cc[i]] - d) <= 0.02f + 0.02f * fabsf(d))) flags |= 8192u; }
    }
    if (F.lane < 2) wsp<float>(F, 3 * MiB + 512 * 1024)[(size_t)gw * 2 + F.lane] = wsp<float>(F, WS_X)[(size_t)m * D + (int)(dbg_hash((unsigned)gw, 160u + F.lane) % (unsigned)D)];
    if (flags) __hip_atomic_fetch_or((unsigned*)(F.ctl + 16), flags, RLX_AGENT);
}
__device__ __forceinline__ void check_combine(Frame& F) {
    const int gw = blockIdx.x * NWAVES + F.wave; const int m = (int)(dbg_hash((unsigned)gw, 6u) % (unsigned)T);
    const int* rsel = wsp<int>(F, WS_RSEL) + (size_t)m * 2; const float* rtw = wsp<float>(F, WS_RTW) + (size_t)m * 2; const float* Y = wsp<float>(F, WS_Y);
    if (F.lane < 2) { const int c = (int)(dbg_hash((unsigned)gw, 160u + F.lane) % (unsigned)D);
        const float ex = wsp<float>(F, 3 * MiB + 512 * 1024)[(size_t)gw * 2 + F.lane] + rtw[0] * Y[(size_t)rsel[0] * D + c] + rtw[1] * Y[(size_t)rsel[1] * D + c], got = wsp<float>(F, WS_X)[(size_t)m * D + c];
        if (!(fabsf(got - ex) <= 1e-3f + 1e-3f * fabsf(ex))) __hip_atomic_fetch_or((unsigned*)(F.ctl + 16), 16384u, RLX_AGENT); }
}
#endif

__device__ __forceinline__ void attn_naive_phase(Frame& F, int layer) {
    const float lam = wsp<float>(F, WS_SCAL)[layer]; const float lam_init = 0.8f - 0.6f * expf(-0.3f * (float)layer), post = 1.f - lam_init;
    const float* gsub = inp(I_GSUB) + layer * VD;
    const bf16* Q = wsp<bf16>(F, WS_Q); const bf16* Kb = wsp<bf16>(F, WS_K); const bf16* Vb = wsp<bf16>(F, WS_V); bf16* OB = wsp<bf16>(F, WS_OB);
    for (int unit = blockIdx.x; unit < BATCH * NH * (SEQ / 256); unit += F.G) {
        const int b = unit >> 5, h = (unit >> 3) & 3, qb = unit & 7, q = qb * 256 + (F.tid >> 1), c = F.tid & 1;
        const bf16* qp = Q + ((size_t)(b * SEQ + q)) * AQK + h * 128 + c * 64;
        unsigned qv[32];
#pragma unroll
        for (int i = 0; i < 8; ++i) { const v4u t = *(const v4u*)(qp + i * 8); qv[4 * i] = t.x; qv[4 * i + 1] = t.y; qv[4 * i + 2] = t.z; qv[4 * i + 3] = t.w; }
        float o[128];
#pragma unroll
        for (int e = 0; e < 128; ++e) o[e] = 0.f;
        float mx = -1e30f, l = 0.f;
        const bf16* kp = Kb + (size_t)b * SEQ * AQK + h * 128 + c * 64; const bf16* vp = Vb + (size_t)b * SEQ * AV + h * 128;
        for (int key = 0; key < SEQ; ++key) {
            float s = 0.f;
#pragma unroll
            for (int i = 0; i < 8; ++i) { const v4u kk = *(const v4u*)(kp + (size_t)key * AQK + i * 8);
                s += bf_lo(qv[4 * i]) * bf_lo(kk.x) + bf_hi(qv[4 * i]) * bf_hi(kk.x) + bf_lo(qv[4 * i + 1]) * bf_lo(kk.y) + bf_hi(qv[4 * i + 1]) * bf_hi(kk.y)
                   + bf_lo(qv[4 * i + 2]) * bf_lo(kk.z) + bf_hi(qv[4 * i + 2]) * bf_hi(kk.z) + bf_lo(qv[4 * i + 3]) * bf_lo(kk.w) + bf_hi(qv[4 * i + 3]) * bf_hi(kk.w); }
            const float mn = fmaxf(mx, s), alpha = __builtin_amdgcn_exp2f(mx - mn), p = __builtin_amdgcn_exp2f(s - mn); mx = mn; l = l * alpha + p;
#pragma unroll
            for (int i = 0; i < 16; ++i) { const v4u vv = *(const v4u*)(vp + (size_t)key * AV + i * 8);
                o[8 * i + 0] = o[8 * i + 0] * alpha + p * bf_lo(vv.x); o[8 * i + 1] = o[8 * i + 1] * alpha + p * bf_hi(vv.x);
                o[8 * i + 2] = o[8 * i + 2] * alpha + p * bf_lo(vv.y); o[8 * i + 3] = o[8 * i + 3] * alpha + p * bf_hi(vv.y);
                o[8 * i + 4] = o[8 * i + 4] * alpha + p * bf_lo(vv.z); o[8 * i + 5] = o[8 * i + 5] * alpha + p * bf_hi(vv.z);
                o[8 * i + 6] = o[8 * i + 6] * alpha + p * bf_lo(vv.w); o[8 * i + 7] = o[8 * i + 7] * alpha + p * bf_hi(vv.w); }
        }
        const float inv = 1.f / l; float rs = 0.f;
#pragma unroll
        for (int e = 0; e < 128; ++e) { const float mine = o[e] * inv, other = __shfl_xor(mine, 1); const float d = (c == 0) ? (mine - lam * other) : (other - lam * mine); o[e] = d; rs += d * d; }
        const float rstd = 1.f / sqrtf(rs * (1.f / VD) + EPS) * post;
        bf16* op = OB + ((size_t)(b * SEQ + q)) * AV + h * 128 + c * 64;
#pragma unroll
        for (int i = 0; i < 8; ++i) { float y[8];
#pragma unroll
            for (int j = 0; j < 8; ++j) y[j] = (c ? o[64 + 8 * i + j] : o[8 * i + j]) * rstd * gsub[c * 64 + 8 * i + j];
            v4u w; w.x = pk2(y[0], y[1]); w.y = pk2(y[2], y[3]); w.z = pk2(y[4], y[5]); w.w = pk2(y[6], y[7]); *(v4u*)(op + 8 * i) = w; }
    }
}

namespace dattn {
using bf16x8 = __attribute__((ext_vector_type(8))) short;
using s16x4  = __attribute__((ext_vector_type(4))) short;
using f32x16 = __attribute__((ext_vector_type(16))) float;
using u32x4  = __attribute__((ext_vector_type(4))) unsigned;
constexpr int NW = 8, QBLK = 32, KVBLK = 64, LDK = 512;
constexpr float THRL = 11.5f;
constexpr size_t SHM_V = KVBLK * 128 * 2, SHM_K = KVBLK * 128 * 2, SHM_ATTN = 2 * SHM_V + 2 * SHM_K + NW * 64 * 4;
#define KSWZ(row, colB) ((row) * 256 + ((colB) ^ (((row) & 7) << 4)))
#define SBAR() __builtin_amdgcn_sched_barrier(0)
__device__ __forceinline__ int crow(int r, int hi) { return (r & 3) + 8 * (r >> 2) + 4 * hi; }
__device__ __forceinline__ unsigned cvtpk(float lo, float hi) { return pg8::cvt_pk_bf16(lo, hi); }
__device__ __forceinline__ void partialSM(f32x16& p0, f32x16& p1, float& m_reg, float& mn, float& alpha) {
  float pmax = p0[0]; for (int r = 1; r < 16; ++r) pmax = fmaxf(pmax, p0[r]); for (int r = 0; r < 16; ++r) pmax = fmaxf(pmax, p1[r]);
  { auto rr = __builtin_amdgcn_permlane32_swap(__float_as_uint(pmax), __float_as_uint(pmax), false, false);
    pmax = fmaxf(__uint_as_float(rr[0]), __uint_as_float(rr[1])); }
  if (__builtin_expect(__all(pmax - m_reg <= THRL), 1)) { mn = m_reg; alpha = 1.f; }
  else { mn = fmaxf(m_reg, pmax); alpha = __builtin_amdgcn_exp2f(m_reg - mn); m_reg = mn; }
  for (int r = 0; r < 16; ++r) p0[r] = p0[r] - mn; for (int r = 0; r < 16; ++r) p1[r] = p1[r] - mn;
  for (int r = 0; r < 16; ++r) p0[r] = __builtin_amdgcn_exp2f(p0[r]);
}
__device__ __forceinline__ void finishSM(f32x16& p0, f32x16& p1, float alpha, float& l_reg, bf16x8& pa0, bf16x8& pa1, bf16x8& pa2, bf16x8& pa3) {
  for (int r = 0; r < 16; ++r) p1[r] = __builtin_amdgcn_exp2f(p1[r]);
  float ps = 0; for (int r = 0; r < 16; ++r) ps += p0[r]; for (int r = 0; r < 16; ++r) ps += p1[r];
  { auto rr = __builtin_amdgcn_permlane32_swap(__float_as_uint(ps), __float_as_uint(ps), false, false);
    ps = __uint_as_float(rr[0]) + __uint_as_float(rr[1]); }
  l_reg = l_reg * alpha + ps;
#define PK4(P, BASE, OUT) do { unsigned a0 = cvtpk(P[BASE + 0], P[BASE + 1]), a1 = cvtpk(P[BASE + 2], P[BASE + 3]);   \
    unsigned b0 = cvtpk(P[BASE + 4], P[BASE + 5]), b1 = cvtpk(P[BASE + 6], P[BASE + 7]);                              \
    auto r0 = __builtin_amdgcn_permlane32_swap(a0, b0, false, false); auto r1 = __builtin_amdgcn_permlane32_swap(a1, b1, false, false); \
    u32x4 w = {r0[0], r1[0], r0[1], r1[1]}; OUT = *reinterpret_cast<bf16x8*>(&w); } while (0)
  PK4(p0, 0, pa0); PK4(p0, 8, pa1); PK4(p1, 0, pa2); PK4(p1, 8, pa3);
#undef PK4
}
__device__ __forceinline__ void qkt(f32x16& p0, f32x16& p1, const char* Ks, const bf16x8* qr, int r32, int hi, int c) {
  p0 = f32x16{}; p1 = f32x16{};
  for (int d0 = 0; d0 < 4; ++d0) { int cb = (c * 64 + d0 * 16 + hi * 8) * 2;
    bf16x8 b0 = *reinterpret_cast<const bf16x8*>(Ks + KSWZ(r32, cb));
    bf16x8 b1 = *reinterpret_cast<const bf16x8*>(Ks + KSWZ(32 + r32, cb));
    p0 = __builtin_amdgcn_mfma_f32_32x32x16_bf16(b0, qr[d0], p0, 0, 0, 0);
    p1 = __builtin_amdgcn_mfma_f32_32x32x16_bf16(b1, qr[d0], p1, 0, 0, 0); }
}
__device__ __forceinline__ int v_st(int k, int c) { const int kk = (k & ~0xC) | ((k & 4) << 1) | ((k & 8) >> 1); return ((kk >> 3) * 4 + (c >> 5)) * 512 + ((kk & 7) * 32 + (c & 31)) * 2; }
__device__ __forceinline__ int v_rd_base(int lane) { return ((lane & 3) << 3) | (((lane >> 2) & 3) << 6) | (((lane >> 4) & 1) << 5) | (((lane >> 5) & 1) << 8); }
constexpr int v_rd_off(int d0, int ks, int half) { return d0 * 512 + ks * 4096 + half * 2048; }
template <int OFF> __device__ __forceinline__ s16x4 tr_read(int vb) {
  s16x4 r; asm volatile("ds_read_b64_tr_b16 %0, %1 offset:%2" : "=&v"(r) : "v"(vb), "i"(OFF) : "memory"); return r;
}
template <int D0> __device__ __forceinline__ void pv_one(f32x16& od, int vb, bf16x8 pa0, bf16x8 pa1, bf16x8 pa2, bf16x8 pa3) {
  const s16x4 l0 = tr_read<v_rd_off(D0, 0, 0)>(vb), h0 = tr_read<v_rd_off(D0, 0, 1)>(vb), l1 = tr_read<v_rd_off(D0, 1, 0)>(vb), h1 = tr_read<v_rd_off(D0, 1, 1)>(vb);
  const s16x4 l2 = tr_read<v_rd_off(D0, 2, 0)>(vb), h2 = tr_read<v_rd_off(D0, 2, 1)>(vb), l3 = tr_read<v_rd_off(D0, 3, 0)>(vb), h3 = tr_read<v_rd_off(D0, 3, 1)>(vb);
  asm volatile("s_waitcnt lgkmcnt(0)" ::: "memory"); SBAR();
#define PK(L, H) (bf16x8){L[0], L[1], L[2], L[3], H[0], H[1], H[2], H[3]}
  od = __builtin_amdgcn_mfma_f32_32x32x16_bf16(pa0, PK(l0, h0), od, 0, 0, 0);
  od = __builtin_amdgcn_mfma_f32_32x32x16_bf16(pa1, PK(l1, h1), od, 0, 0, 0);
  od = __builtin_amdgcn_mfma_f32_32x32x16_bf16(pa2, PK(l2, h2), od, 0, 0, 0);
  od = __builtin_amdgcn_mfma_f32_32x32x16_bf16(pa3, PK(l3, h3), od, 0, 0, 0);
#undef PK
}
__device__ __forceinline__ void pv_d0(f32x16* o, int vb, bf16x8 pa0, bf16x8 pa1, bf16x8 pa2, bf16x8 pa3) {
  pv_one<0>(o[0], vb, pa0, pa1, pa2, pa3); pv_one<1>(o[1], vb, pa0, pa1, pa2, pa3); pv_one<2>(o[2], vb, pa0, pa1, pa2, pa3); pv_one<3>(o[3], vb, pa0, pa1, pa2, pa3);
}
__device__ __forceinline__ void unit(const unsigned short* Qb, const unsigned short* Kh, const unsigned short* Vh, unsigned short* Ob, int seq, char* lds, float lam, float post, const float* gsub) {
  int tid_ = threadIdx.x; asm volatile("" : "+v"(tid_));
  const int tid = tid_, wid = tid >> 6, lane = tid & 63, r32 = lane & 31, hi = lane >> 5, c = wid >> 2, wq = wid & 3;
  char* V_lds = lds; char* K_lds = lds + 2 * SHM_V;
  float* ws = (float*)(lds + 2 * SHM_V + 2 * SHM_K) + wid * 64; float* li_l = ws; float* al_l = ws + 32;
  float m_reg = -1e30f, l_reg = 0; f32x16 o[4] = {}; bf16x8 qr[4];
  const unsigned short* Qw = Qb + (long)(wq * QBLK + r32) * LDK + c * 64 + hi * 8;
#pragma unroll
  for (int d0 = 0; d0 < 4; ++d0) qr[d0] = *reinterpret_cast<const bf16x8*>(Qw + d0 * 16);
  const int sr = tid >> 4, sc = (tid & 15) * 8, vst0 = v_st(sr, sc), vst1 = v_st(32 + sr, sc);
  const int vb0 = (int)(uintptr_t)V_lds + v_rd_base(lane);
  struct { bf16x8 vs0, vs1, ks0, ks1; } sr_[2];
#define SLOAD(i, k0) do { sr_[i].vs0 = *reinterpret_cast<const bf16x8*>(&Vh[(long)((k0) + sr) * LDK + sc]); sr_[i].vs1 = *reinterpret_cast<const bf16x8*>(&Vh[(long)((k0) + 32 + sr) * LDK + sc]); \
    sr_[i].ks0 = *reinterpret_cast<const bf16x8*>(&Kh[(long)((k0) + sr) * LDK + sc]); sr_[i].ks1 = *reinterpret_cast<const bf16x8*>(&Kh[(long)((k0) + 32 + sr) * LDK + sc]); } while (0)
#define SWRITE(b, i) do { *(bf16x8*)(V_lds + (b) * SHM_V + vst0) = sr_[i].vs0; *(bf16x8*)(V_lds + (b) * SHM_V + vst1) = sr_[i].vs1; int kc = sc * 2; \
    *(bf16x8*)(K_lds + (b) * SHM_K + KSWZ(sr, kc)) = sr_[i].ks0; *(bf16x8*)(K_lds + (b) * SHM_K + KSWZ(32 + sr, kc)) = sr_[i].ks1; } while (0)
#define SWAIT() asm volatile("s_waitcnt vmcnt(4)" ::: "memory")
#define RESC(a) do { if (__any((a) < 1.f)) { if (hi == 0) al_l[r32] = (a); asm volatile("s_waitcnt lgkmcnt(0)" ::: "memory"); \
    for (int d = 0; d < 4; ++d) for (int r = 0; r < 16; ++r) o[d][r] *= al_l[crow(r, hi)]; } } while (0)
  f32x16 pA0, pA1, pB0, pB1; float mnA, mnB, alA, alB; bf16x8 pa0, pa1, pa2, pa3; const int NT = seq / KVBLK;
  constexpr int SE = 0, SO = 1;
  SLOAD(SE, 0); asm volatile("s_waitcnt vmcnt(0)" ::: "memory"); SWRITE(0, SE); __syncthreads();
  qkt(pA0, pA1, K_lds, qr, r32, hi, c); partialSM(pA0, pA1, m_reg, mnA, alA);
  SLOAD(SO, KVBLK); if (2 < NT) SLOAD(SE, 2 * KVBLK);
  SWAIT(); SWRITE(1, SO); __syncthreads();
  for (int j = 1; j + 1 < NT; j += 2) {
    SBAR(); qkt(pB0, pB1, K_lds + SHM_K, qr, r32, hi, c);
    finishSM(pA0, pA1, alA, l_reg, pa0, pa1, pa2, pa3); SBAR();
    SLOAD(SO, (j + 2) * KVBLK); SBAR();
    pv_d0(o, vb0, pa0, pa1, pa2, pa3); partialSM(pB0, pB1, m_reg, mnB, alB);
    __syncthreads(); SWAIT(); SWRITE(0, SE);
    RESC(alB); __syncthreads();
    SBAR(); qkt(pA0, pA1, K_lds, qr, r32, hi, c);
    finishSM(pB0, pB1, alB, l_reg, pa0, pa1, pa2, pa3); SBAR();
    if (j + 3 < NT) SLOAD(SE, (j + 3) * KVBLK); SBAR();
    pv_d0(o, vb0 + (int)SHM_V, pa0, pa1, pa2, pa3); partialSM(pA0, pA1, m_reg, mnA, alA);
    __syncthreads(); SWAIT(); SWRITE(1, SO);
    RESC(alA); __syncthreads();
  }
  SBAR(); qkt(pB0, pB1, K_lds + SHM_K, qr, r32, hi, c);
  finishSM(pA0, pA1, alA, l_reg, pa0, pa1, pa2, pa3); SBAR();
  pv_d0(o, vb0, pa0, pa1, pa2, pa3); partialSM(pB0, pB1, m_reg, mnB, alB);
  __syncthreads(); RESC(alB);
  finishSM(pB0, pB1, alB, l_reg, pa0, pa1, pa2, pa3); SBAR();
  pv_d0(o, vb0 + (int)SHM_V, pa0, pa1, pa2, pa3);
  if (hi == 0) li_l[r32] = l_reg; asm volatile("s_waitcnt vmcnt(0) lgkmcnt(0)" ::: "memory");
  float rli[16];
#pragma unroll
  for (int r = 0; r < 16; ++r) rli[r] = __builtin_amdgcn_rcpf(li_l[crow(r, hi)]);
  __syncthreads();
  float* xch = (float*)lds + (size_t)wq * 64 * 64 + lane;
  if (c == 1) {
#pragma unroll
    for (int d0 = 0; d0 < 4; ++d0)
#pragma unroll
      for (int r = 0; r < 16; ++r) xch[(d0 * 16 + r) * 64] = o[d0][r] * rli[r] * lam;
  }
  __syncthreads();
  if (c == 0) {
    float ss[16];
#pragma unroll
    for (int r = 0; r < 16; ++r) { float a = 0.f;
#pragma unroll
      for (int d0 = 0; d0 < 4; ++d0) { const float d = o[d0][r] * rli[r] - xch[(d0 * 16 + r) * 64]; o[d0][r] = d; a += d * d; }
      ss[r] = a; }
#pragma unroll
    for (int r = 0; r < 16; ++r) {
#pragma unroll
      for (int off = 1; off < 32; off <<= 1) ss[r] += __shfl_xor(ss[r], off);
      ss[r] = post / sqrtf(ss[r] * (1.f / 128.f) + 1e-6f); }
    float gs[4];
#pragma unroll
    for (int d0 = 0; d0 < 4; ++d0) gs[d0] = gsub[32 * d0 + r32];
    unsigned short* Ow = Ob + (long)(wq * QBLK) * LDK;
#pragma unroll
    for (int r = 0; r < 16; ++r) { const int orow = crow(r, hi);
#pragma unroll
      for (int d0 = 0; d0 < 4; ++d0) Ow[(long)orow * LDK + d0 * 32 + r32] = (unsigned short)f2bf(o[d0][r] * ss[r] * gs[d0]); }
  }
  __syncthreads();
#undef SLOAD
#undef SWRITE
#undef SWAIT
#undef RESC
}
#undef KSWZ
#undef SBAR
}

__device__ __forceinline__ void attn_mfma_phase(Frame& F, int layer) {
    const float lam = wsp<float>(F, WS_SCAL)[layer]; const float lam_init = 0.8f - 0.6f * expf(-0.3f * (float)layer), post = 1.f - lam_init;
    const float* gsub = inp(I_GSUB) + layer * VD;
    const bf16* Q = wsp<bf16>(F, WS_Q); const bf16* Kb = wsp<bf16>(F, WS_K); const bf16* Vb = wsp<bf16>(F, WS_V); bf16* OB = wsp<bf16>(F, WS_OB);
    for (int u = blockIdx.x; u < BATCH * NH * (SEQ / 128); u += F.G) {
        const int b = u >> 6, h = (u >> 4) & 3, qb = u & 15;
        const size_t rb = (size_t)b * SEQ;
        dattn::unit(Q + (rb + qb * 128) * AQK + h * 128, Kb + rb * AQK + h * 128, Vb + rb * AV + h * 128, OB + (rb + qb * 128) * AV + h * 128, SEQ, (char*)F.lds, lam, post, gsub);
    }
}

constexpr int NSTEP = 11, NPH = 1 + DEPTH * NSTEP;
struct Args { const float* in[N_IN]; float* out; unsigned char* ws; int ph_lo, ph_hi, pass, pad; };
#ifndef DBG_SITES
#define DBG_SITES 0xFF
#endif
#define GEMM_SITE(ID, EpiT, g, S, E) do { if (!((DBG_SITES >> (ID)) & 1)) {} else if ((MK_NAIVE_GEMM >> (ID)) & 1) pg8::gemm_phase_naive<EpiT, pg8::GroupOrder>(g, S, E); \
    else pg8::gemm_phase<EpiT, pg8::GroupOrder, MK_ALIGN, MK_SP2>(F.lds + RING_OFF, g, S, E); } while (0)

__global__ void __launch_bounds__(NWAVES * 64, 2) mk_fwd(Args args) {
    extern __shared__ __attribute__((aligned(16))) unsigned char lds[];
    Frame F;
    F.lds = (LAS unsigned char*)lds;
    F.MISC = (volatile LAS unsigned*)(F.lds + MISC_OFF);
    F.tid = threadIdx.x; F.lane = F.tid & 63; F.wave = __builtin_amdgcn_readfirstlane(F.tid >> 6);
    F.G = gridDim.x; F.ws = (GAS unsigned char*)args.ws; F.ctl = (gu32*)(F.ws + WS_CTL);
    for (int u = F.tid; u < (LDS_BYTES - LDSCTL_OFF) / 4; u += NWAVES * 64) ((LAS unsigned*)(F.lds + LDSCTL_OFF))[u] = 0u;
    __syncthreads();
    const int lo = args.ph_lo, hi = args.ph_hi;
#ifdef DBG_START_DELAY
    if (lo == 0) { const unsigned long long t0 = __builtin_amdgcn_s_memrealtime(); while (__builtin_amdgcn_s_memrealtime() - t0 < (unsigned long long)DBG_START_DELAY) __builtin_amdgcn_s_sleep(32); }
#endif
    XcdBarrier bar; bar.bar = (unsigned*)(F.ctl + CW_BAR); bar.x = 0; bar.st = nullptr;
    if (hi - lo > 1) bar = xcd_barrier_post((unsigned*)(F.ctl + CW_BAR), F.MISC + 8);
#define PHASE_BEGIN() do { const CAS unsigned char* k_ = (const CAS unsigned char*)__builtin_amdgcn_kernarg_segment_ptr(); asm volatile("" : "+s"(k_)); \
    F.ws = *(GAS unsigned char* const CAS*)(k_ + 8 * (N_IN + 1)); F.ctl = (gu32*)(F.ws + WS_CTL); int t_ = threadIdx.x; asm volatile("" : "+v"(t_)); \
    F.tid = t_; F.lane = t_ & 63; F.wave = __builtin_amdgcn_readfirstlane(t_ >> 6); F.G = gridDim.x; } while (0)
#define IN(k) (lo <= (k) && (k) < hi)
#define SEAM(k) do { if (IN(k) && IN((k) + 1)) xcd_barrier(bar); } while (0)
#define H wsp<bf16>(F, WS_H)
#define X wsp<float>(F, WS_X)

#ifdef DBG_STOP
    if (lo == 100) {
        PHASE_BEGIN();
        float* o = outp(); const size_t gt = (size_t)blockIdx.x * (NWAVES * 64) + F.tid, NGT = (size_t)F.G * NWAVES * 64;
        for (size_t i = gt; i < (size_t)T * D; i += NGT) { float v = 0.f;
#define DG_BF(off, len) v += bf_lo((unsigned)wsp<bf16>(F, off)[i % (size_t)(len)]);
#define DG_F32(off, len) v += wsp<float>(F, off)[i % (size_t)(len)];
            DBG_DIGEST
            o[i] = v; }
        return;
    }
#endif
#ifdef DBG_TWOPASS
#define CW_CK 2048
#define CK(slot, off, bytes) cksum(F, off, bytes, CW_CK + dbg_pass * 64 + (slot))
#define CKBAR() xcd_barrier(bar)
    const int dbg_pass = args.pass;
#else
#define CK(slot, off, bytes) do {} while (0)
#define CKBAR() do {} while (0)
#endif
    if (IN(0)) { PHASE_BEGIN(); p0_prologue(F); }
    SEAM(0);
#ifdef DBG_TWOPASS
    { PHASE_BEGIN(); CK(0, WS_WIN, WS_X - WS_WIN); CK(0, WS_H, (size_t)T * D * 2); CK(0, WS_PB, (size_t)2 * T * PLE * 2); CK(0, WS_ROPE, (size_t)SEQ * 64 * 4); CKBAR(); }
#endif

#pragma nounroll
    for (int layer = 0; layer < DEPTH; ++layer) {
        const int pb = 1 + layer * NSTEP;
#ifdef DBG_SKIP_MOE
        const bool moe = false; const bool skipffn = (layer & 1) != 0;
#elif defined(DBG_SKIP_DENSE)
        const bool moe = (layer & 1) != 0; const bool skipffn = (layer & 1) == 0;
#else
        const bool moe = (layer & 1) != 0; const bool skipffn = false;
#endif
        if (IN(pb + 0)) { PHASE_BEGIN();
            if (layer == 0) {
                pg8::Gemm g{wsp<bf16>(F, WS_PB), wsp<bf16>(F, WS_WPP), 2 * T, D, PLE}; pg8::GroupOrder S; S.init_equal(2, T, D, F.G, (int)blockIdx.x, (LAS int*)(F.lds + TP_OFF));
                pg8::EpiStore E{wsp<bf16>(F, WS_PROJ), D, D / 256};
                GEMM_SITE(0, pg8::EpiStore, g, S, E);
            }
            pg8::Gemm g{H, wsp<bf16>(F, WS_WIN) + (size_t)layer * INC * D, T, INC, D}; pg8::GroupOrder S; S.init_dense(T, INC, F.G, (int)blockIdx.x);
            pg8::EpiInProj E{wsp<bf16>(F, WS_Q), wsp<bf16>(F, WS_K), wsp<bf16>(F, WS_V), wsp<bf16>(F, WS_Z), wsp<bf16>(F, WS_SG), wsp<float>(F, WS_ROPE), QSCALE};
            GEMM_SITE(1, pg8::EpiInProj, g, S, E);
        }
        SEAM(pb + 0);
#ifdef DBG_TWOPASS
        { PHASE_BEGIN(); CK(pb + 0, WS_Q, 128 * MiB); if (layer == 0) CK(pb + 0, WS_PROJ, (size_t)2 * T * D * 2); if (layer == 1) { CK(32, WS_Q, 16 * MiB); CK(33, WS_K, 16 * MiB); CK(34, WS_V, 16 * MiB); CK(35, WS_Z, 16 * MiB); CK(36, WS_SG, 64 * MiB); } CKBAR(); }
#endif
        if (IN(pb + 1)) { PHASE_BEGIN();
#ifdef DBG_CHECK_INPROJ
            if (layer == DBG_LAYER) check_inproj(F, layer);
#endif
#if !defined(DBG_NO_ATTN) && MK_NAIVE_ATTN
            attn_naive_phase(F, layer);
#elif !defined(DBG_NO_ATTN)
            attn_mfma_phase(F, layer);
#else
            { bf16* ob = wsp<bf16>(F, WS_OB); const size_t gt = (size_t)blockIdx.x * (NWAVES * 64) + F.tid, NGT = (size_t)F.G * NWAVES * 64;
              for (size_t i = gt; i < (size_t)T * AV / 8; i += NGT) *(v4u*)(ob + i * 8) = (v4u){0u, 0u, 0u, 0u}; }
#endif
#if defined(DBG_NAIVE_CONV)
            conv_naive_phase(F, layer);
#elif !defined(DBG_NO_CONV)
            conv_phase(F, layer);
#else
            { bf16* ob = wsp<bf16>(F, WS_ZC); const size_t gt = (size_t)blockIdx.x * (NWAVES * 64) + F.tid, NGT = (size_t)F.G * NWAVES * 64;
              for (size_t i = gt; i < (size_t)T * CCH / 8; i += NGT) *(v4u*)(ob + i * 8) = (v4u){0u, 0u, 0u, 0u}; }
#endif
        }
        SEAM(pb + 1);
#ifdef DBG_CHECK_ATTN
        if (layer == DBG_CHECK_ATTN - 1) { PHASE_BEGIN(); check_attn(F, layer); xcd_barrier(bar); }
#endif
#ifdef DBG_TWOPASS
        { PHASE_BEGIN(); CK(pb + 1, WS_OB, 32 * MiB); CKBAR(); }
#endif
        if (IN(pb + 2)) { PHASE_BEGIN();
            { pg8::Gemm g{wsp<bf16>(F, WS_OB), wsp<bf16>(F, WS_WA) + (size_t)layer * D * AV, T, D, AV}; pg8::GroupOrder S; S.init_dense(T, D, F.G, (int)blockIdx.x);
              pg8::EpiGate<0> E{wsp<float>(F, WS_P), wsp<bf16>(F, WS_MIX), wsp<bf16>(F, WS_SG)};
              GEMM_SITE(2, pg8::EpiGate<0>, g, S, E); }
            { pg8::Gemm g{wsp<bf16>(F, WS_ZC), wsp<bf16>(F, WS_WC) + (size_t)layer * D * CCH, T, D, CCH}; pg8::GroupOrder S; S.init_dense(T, D, F.G, (int)blockIdx.x);
              pg8::EpiGate<1> E{wsp<float>(F, WS_P), wsp<bf16>(F, WS_MIX), wsp<bf16>(F, WS_SG)};
              GEMM_SITE(3, pg8::EpiGate<1>, g, S, E); }
        }
        SEAM(pb + 2);
#ifdef DBG_CHECK_MIX
        if (layer == DBG_LAYER) { PHASE_BEGIN(); check_mix(F, layer); snap_wo(F); xcd_barrier(bar); }
#endif
#ifdef DBG_TWOPASS
        { PHASE_BEGIN(); CK(pb + 2, WS_P, 96 * MiB); CKBAR(); }
#endif
        if (IN(pb + 3)) { PHASE_BEGIN();
            pg8::Gemm g{wsp<bf16>(F, WS_MIX), wsp<bf16>(F, WS_WO) + (size_t)layer * D * D, T, D, D}; pg8::GroupOrder S; S.init_dense(T, D, F.G, (int)blockIdx.x);
            pg8::EpiResid E{layer == 0 ? inp(I_X) : (const float*)X, X, D / 256};
            GEMM_SITE(4, pg8::EpiResid, g, S, E);
        }
        SEAM(pb + 3);
#ifdef DBG_CHECK_MIX
        if (layer == DBG_LAYER) { PHASE_BEGIN(); check_wo(F, layer); xcd_barrier(bar); }
#endif
#ifdef DBG_TWOPASS
        { PHASE_BEGIN(); CK(pb + 3, WS_X, (size_t)T * D * 4); CKBAR(); }
#endif
        if (IN(pb + 4)) { PHASE_BEGIN();
            if (moe) route_phase(F, X, inp(I_GFFN) + (size_t)layer * D, H);
            else norm_rows(F, X, inp(I_GFFN) + (size_t)layer * D, H);
        }
        SEAM(pb + 4);
#ifdef DBG_CHECK_MOE
        if (moe) { PHASE_BEGIN(); check_route(F); xcd_barrier(bar); }
#endif
#ifdef DBG_TWOPASS
        { PHASE_BEGIN(); CK(pb + 4, WS_H, (size_t)T * D * 2); if (moe) CK(pb + 4, WS_RTW, (size_t)T * 8); CKBAR(); }
#endif
        if (moe) {
            if (IN(pb + 5)) { PHASE_BEGIN(); scatter_phase(F); }
            SEAM(pb + 5);
        }
        if (IN(pb + 6) && !skipffn) { PHASE_BEGIN();
            pg8::Gemm g; pg8::GroupOrder S; pg8::EpiSwiGLU E;
            if (moe) { unsigned cnt[8]; load_counts(F, cnt); g = pg8::Gemm{wsp<bf16>(F, WS_HP), wsp<bf16>(F, WS_WEGU), MOE_ROWS, 2 * FE, D}; S.init_counts(cnt, 2 * FE, F.G, (int)blockIdx.x, (LAS int*)(F.lds + TP_OFF)); E = pg8::EpiSwiGLU{wsp<bf16>(F, WS_ACT), FE, 2 * FE / 256}; }
            else { g = pg8::Gemm{H, wsp<bf16>(F, WS_WFGU), T, 2 * FF, D}; S.init_dense(T, 2 * FF, F.G, (int)blockIdx.x); E = pg8::EpiSwiGLU{wsp<bf16>(F, WS_ACT), FF, 2 * FF / 256}; }
            GEMM_SITE(5, pg8::EpiSwiGLU, g, S, E);
        }
        SEAM(pb + 6);
#ifdef DBG_CHECK_FFN
        if (layer == 0) { PHASE_BEGIN(); snap_x(F, 0, 2); xcd_barrier(bar); }
#endif
#ifdef DBG_CHECK_ACT
        if (layer == 0) { PHASE_BEGIN(); check_act(F); xcd_barrier(bar); }
#endif
#ifdef DBG_TWOPASS
        { PHASE_BEGIN(); if (!moe) CK(pb + 6, WS_ACT, (size_t)T * FF * 2); CKBAR(); }
#endif
        if (IN(pb + 7) && !skipffn) { PHASE_BEGIN();
            pg8::Gemm g; pg8::GroupOrder S; pg8::EpiResid E;
            if (moe) { unsigned cnt[8]; load_counts(F, cnt); g = pg8::Gemm{wsp<bf16>(F, WS_ACT), wsp<bf16>(F, WS_WEDN), MOE_ROWS, D, FE}; S.init_counts(cnt, D, F.G, (int)blockIdx.x, (LAS int*)(F.lds + TP_OFF)); E = pg8::EpiResid{nullptr, wsp<float>(F, WS_Y), D / 256}; }
            else { g = pg8::Gemm{wsp<bf16>(F, WS_ACT), wsp<bf16>(F, WS_WFDN), T, D, FF}; S.init_dense(T, D, F.G, (int)blockIdx.x); E = pg8::EpiResid{X, X, D / 256}; }
            GEMM_SITE(6, pg8::EpiResid, g, S, E);
        }
        SEAM(pb + 7);
#ifdef DBG_CHECK_MOE
        if (moe) { PHASE_BEGIN(); check_experts(F); xcd_barrier(bar); }
#endif
#ifdef DBG_CHECK_FFN
        if (layer == 0) { PHASE_BEGIN(); check_down(F); xcd_barrier(bar); }
#endif
#ifdef DBG_TWOPASS
        { PHASE_BEGIN(); if (!moe) CK(pb + 7, WS_X, (size_t)T * D * 4); CKBAR(); }
#endif
        if (IN(pb + 8)) { PHASE_BEGIN();
            if (moe) combine_norm_phase(F, X, inp(I_GPLE) + (size_t)layer * D, H);
            else norm_rows(F, X, inp(I_GPLE) + (size_t)layer * D, H);
        }
        SEAM(pb + 8);
#ifdef DBG_CHECK_MOE
        if (moe) { PHASE_BEGIN(); check_combine(F); xcd_barrier(bar); }
#endif
#ifdef DBG_CHECK_FFN
        if (layer == DBG_LAYER) { PHASE_BEGIN(); check_norm3(F, layer); snap_x(F, 1, 4); xcd_barrier(bar); }
#endif
#ifdef DBG_TWOPASS
        { PHASE_BEGIN(); CK(pb + 8, WS_X, (size_t)T * D * 4); CK(pb + 8, WS_H, (size_t)T * D * 2); CKBAR(); }
#endif
#ifdef DBG_SKIP_PLE
        if (false) {
#else
        if (IN(pb + 9)) { PHASE_BEGIN();
#endif
            pg8::Gemm g{H, wsp<bf16>(F, WS_WPG) + (size_t)layer * D * D, T, D, D}; pg8::GroupOrder S; S.init_dense(T, D, F.G, (int)blockIdx.x);
            pg8::EpiPleGate E{X, wsp<bf16>(F, WS_PROJ) + (size_t)layer * T * D};
            GEMM_SITE(7, pg8::EpiPleGate, g, S, E);
        }
        SEAM(pb + 9);
#ifdef DBG_CHECK_FFN
        if (layer == DBG_LAYER) { PHASE_BEGIN(); check_ple(F, layer); xcd_barrier(bar); }
#endif
#ifdef DBG_TWOPASS
        { PHASE_BEGIN(); CK(pb + 9, WS_X, (size_t)T * D * 4); CKBAR(); }
#endif
        if (IN(pb + 10)) { PHASE_BEGIN();
            if (layer + 1 < DEPTH) norm_rows(F, X, inp(I_GMIX) + (size_t)(layer + 1) * D, H);
            else final_norm(F, X, inp(I_GFIN), outp());
        }
        if (layer + 1 < DEPTH) SEAM(pb + 10);
#ifdef DBG_TWOPASS
        if (layer + 1 < DEPTH) { PHASE_BEGIN(); CK(pb + 10, WS_H, (size_t)T * D * 2); CKBAR(); }
        else { xcd_barrier(bar); PHASE_BEGIN(); cksum_ptr(F, (const v4u*)outp(), (size_t)T * D * 4, CW_CK + dbg_pass * 64 + pb + 10); CKBAR(); }
#endif
    }
#ifdef DBG_TWOPASS
    if (dbg_pass == 1) { PHASE_BEGIN();
      if (blockIdx.x == 0 && F.tid == 0) { unsigned idx = 0u;
          for (int k = NPH - 1; k >= 0; --k) if (__hip_atomic_load((unsigned*)(F.ctl + CW_CK + k), RLX_AGENT) != __hip_atomic_load((unsigned*)(F.ctl + CW_CK + 64 + k), RLX_AGENT)) idx = (unsigned)(k + 1);
          unsigned idx2 = 0u; for (int k = 36; k >= 32; --k) if (__hip_atomic_load((unsigned*)(F.ctl + CW_CK + k), RLX_AGENT) != __hip_atomic_load((unsigned*)(F.ctl + CW_CK + 64 + k), RLX_AGENT)) idx2 = (unsigned)(k - 31);
          __hip_atomic_store((unsigned*)(F.ctl + 16), idx + 32u * idx2, RLX_AGENT); }
      xcd_barrier(bar); }
#endif
#ifdef DBG_CODE_OUT
    if (args.pass == 1 || !DBG_TWOPASS_ON) { xcd_barrier(bar); PHASE_BEGIN(); final_norm(F, inp(I_X), inp(I_GFIN), outp(), 1.f + (float)__hip_atomic_load((unsigned*)(F.ctl + 16), RLX_AGENT) + (float)((__hip_atomic_load((unsigned*)(F.ctl + 17), RLX_AGENT) + 63u) / 64u)); }
#endif
#undef IN
#undef SEAM
#undef H
#undef X
}

extern "C" void kernel_launch(void* const* d_in, const int* in_sizes, int n_in, void* d_out, int out_size, void* d_ws, size_t ws_size, hipStream_t stream) {
    static int grid = 0;
    if (grid == 0) {
        if (n_in != N_IN || in_sizes[0] != T * D || out_size != T * D || ws_size < WS_END) {
            fprintf(stderr, "kernel_launch: built for %d inputs, x/out of %d floats, >= %zu bytes of workspace; got n_in %d, in0 %d, out %d, ws %zu; nothing launched\n", N_IN, T * D, (size_t)WS_END, n_in, n_in > 0 ? in_sizes[0] : -1, out_size, ws_size);
            grid = -1; return; }
        int dev = 0, cus = 0, per_cu = 0;
        if (hipGetDevice(&dev) != hipSuccess || hipDeviceGetAttribute(&cus, hipDeviceAttributeMultiprocessorCount, dev) != hipSuccess) { fprintf(stderr, "kernel_launch: device query failed\n"); grid = -1; return; }
        if (hipFuncSetAttribute((const void*)mk_fwd, hipFuncAttributeMaxDynamicSharedMemorySize, LDS_BYTES) != hipSuccess) { fprintf(stderr, "kernel_launch: hipFuncSetAttribute failed\n"); grid = -1; return; }
        if (hipOccupancyMaxActiveBlocksPerMultiprocessor(&per_cu, (const void*)mk_fwd, NWAVES * 64, LDS_BYTES) != hipSuccess || per_cu < 1) { fprintf(stderr, "kernel_launch: occupancy query reports %d workgroups per CU\n", per_cu); }
        (void)hipGetLastError();
        grid = cus;
    }
    if (grid < 0) return;
    if (hipMemsetAsync((char*)d_ws + WS_CTL, 0, CTL_ZERO_BYTES, stream) != hipSuccess) { fprintf(stderr, "kernel_launch: hipMemsetAsync failed\n"); return; }
    Args a{};
    for (int i = 0; i < N_IN; ++i) a.in[i] = (const float*)d_in[i];
    a.out = (float*)d_out; a.ws = (unsigned char*)d_ws;
#if MK_PER_PHASE
#ifdef DBG_STOP
    for (int ph = 0; ph <= DBG_STOP; ++ph) { a.ph_lo = ph; a.ph_hi = ph + 1; hipLaunchKernelGGL(mk_fwd, dim3(grid), dim3(NWAVES * 64), LDS_BYTES, stream, a); }
    a.ph_lo = 100; a.ph_hi = 101; hipLaunchKernelGGL(mk_fwd, dim3(grid), dim3(NWAVES * 64), LDS_BYTES, stream, a);
#else
    for (int ph = 0; ph < NPH; ++ph) { a.ph_lo = ph; a.ph_hi = ph + 1; hipLaunchKernelGGL(mk_fwd, dim3(grid), dim3(NWAVES * 64), LDS_BYTES, stream, a); }
#endif
#else
#ifdef DBG_TWOPASS
    a.ph_lo = 0; a.ph_hi = NPH; a.pass = 0; hipLaunchKernelGGL(mk_fwd, dim3(grid), dim3(NWAVES * 64), LDS_BYTES, stream, a);
    (void)hipMemsetAsync((char*)d_ws + WS_CTL + CW_BAR * 4, 0, XCD_BAR_WORDS * 4, stream); (void)hipMemsetAsync((char*)d_ws + WS_CTL + CW_GCNT * 4, 0, 2048, stream);
    a.pass = 1; hipLaunchKernelGGL(mk_fwd, dim3(grid), dim3(NWAVES * 64), LDS_BYTES, stream, a);
#else
    a.ph_lo = 0; a.ph_hi = NPH; hipLaunchKernelGGL(mk_fwd, dim3(grid), dim3(NWAVES * 64), LDS_BYTES, stream, a);
#endif
#endif
    const hipError_t le = hipPeekAtLastError();
    if (le != hipSuccess) fprintf(stderr, "kernel_launch: launch failed: %s\n", hipGetErrorName(le));
}
```

```cpp
#include <hip/hip_runtime.h>
#include <cstdio>
#include <cstdint>
#define MK_SP2 true
#define MK_ALIGN true
#define MK_NAIVE_ATTN 0
namespace pg8 {
#define PG8_LAS __attribute__((address_space(3)))
typedef unsigned short bf16_t;
typedef short bf16x8 __attribute__((ext_vector_type(8)));
typedef float f32x4 __attribute__((ext_vector_type(4)));
typedef unsigned u32x4 __attribute__((ext_vector_type(4)));
constexpr int BM = 256, BK = 64, HALF = 128, HTB = HALF * BK * 2  , STAGE_BYTES = 8 * HTB, NXCD = 8, WGM = 8;

__host__ __device__ __forceinline__ int lds_byte(int r, int c) { const int st = (r >> 4) * 2 + (c >> 5), rr = r & 15, cc = c & 31, ob = rr * 64 + cc * 2; return st * 1024 + (ob ^ (((ob >> 9) & 1) << 5)); }
__host__ __device__ __forceinline__ void stage_rc(int b, int& R, int& C) { const int st = b / 1024, sb = b % 1024, swz = sb ^ (((sb >> 9) & 1) << 5); R = (st >> 1) * 16 + swz / 64; C = (st & 1) * 32 + (swz % 64) / 2; }
__host__ __device__ __forceinline__ int perm32(int rho) { const int n = rho >> 4, i = rho & 15; return 8 * (i >> 2) + 4 * n + (i & 3); }

struct Unit { int pm, pn; };
struct Gemm { const bf16_t* A; const bf16_t* Bt; int M, N, K; };

typedef float cvt_f32x2_t __attribute__((ext_vector_type(2))); typedef __bf16 cvt_bf16x2_t __attribute__((ext_vector_type(2)));
__device__ __forceinline__ unsigned cvt_pk_bf16(float lo, float hi) { cvt_f32x2_t v = {lo, hi}; cvt_bf16x2_t b = __builtin_convertvector(v, cvt_bf16x2_t); return __builtin_bit_cast(unsigned, b); }
typedef float f32x2 __attribute__((ext_vector_type(2)));
typedef unsigned u32x2 __attribute__((ext_vector_type(2)));
__device__ __forceinline__ float sigm(float x) { return __builtin_amdgcn_rcpf(1.0f + __builtin_amdgcn_exp2f(-1.4426950408889634f * x)); }
__device__ __forceinline__ float bf_lo(unsigned w) { return __uint_as_float(w << 16); }
__device__ __forceinline__ float bf_hi(unsigned w) { return __uint_as_float(w & 0xffff0000u); }

struct GroupOrder {
    int ng, nN, nwg, G, c, TM; PG8_LAS int* tp;
    __device__ __forceinline__ void init_equal(int ngroups, int rows_per_group, int N, int G_, int c_, PG8_LAS int* tp_) {
        ng = ngroups; nN = N / BM; const int t = rows_per_group / BM; TM = t * ngroups; nwg = TM * nN; G = G_; c = c_; tp = tp_;
        if (ngroups > 1) { int tx = threadIdx.x; asm volatile("" : "+v"(tx)); if (tx < 9) tp[tx] = (tx < ngroups ? tx : ngroups) * t; __syncthreads(); }
    }
    __device__ __forceinline__ void init_dense(int M, int N, int G_, int c_) { init_equal(1, M, N, G_, c_, nullptr); }
    __device__ __forceinline__ void init_counts(const unsigned (&cnt)[8], int N, int G_, int c_, PG8_LAS int* tp_) {
        ng = 8; nN = N / BM; G = G_; c = c_; tp = tp_; int s = 0; int tx = threadIdx.x; asm volatile("" : "+v"(tx));
        if (tx == 0) tp[0] = 0;
#pragma unroll
        for (int e = 0; e < 8; ++e) { s += (int)((cnt[e] + 255u) >> 8); if (tx == 0) tp[e + 1] = s; }
        TM = s; nwg = TM * nN; __syncthreads();
    }
    __device__ __forceinline__ bool next(int i, Unit& u) const {
        const long L = (long)i * G + c; if (L >= nwg) return false;
        int wgid = (int)L; { const int q = nwg / NXCD, r = nwg % NXCD, xcd = wgid % NXCD, off = wgid / NXCD; wgid = (xcd < r ? xcd * (q + 1) : r * (q + 1) + (xcd - r) * q) + off; }
        const int nig = WGM * nN, gid = wgid / nig, fm = gid * WGM, gsz = (TM - fm) < WGM ? (TM - fm) : WGM;
        const int rt = fm + ((wgid % nig) % gsz), pl = (wgid % nig) / gsz;
        int e = 0;
        if (ng > 1) {
#pragma unroll
            for (int j = 1; j < 8; ++j) e += (j < ng && rt >= __builtin_amdgcn_readfirstlane(tp[j])) ? 1 : 0; }
        u.pm = rt; u.pn = e * nN + pl; return true;
    }
    __device__ __forceinline__ void a_ready(const Unit&) const {}
    __device__ __forceinline__ void done(const Unit&) const {}
};

#define EPI_ROWS(row0) _Pragma("unroll") for (int ai = 0; ai < 2; ++ai) _Pragma("unroll") for (int m = 0; m < 4; ++m)
__device__ __forceinline__ u32x4 pack8(const f32x4 a, const f32x4 b) { u32x4 w; w.x = cvt_pk_bf16(a[0], a[1]); w.y = cvt_pk_bf16(a[2], a[3]); w.z = cvt_pk_bf16(b[0], b[1]); w.w = cvt_pk_bf16(b[2], b[3]); return w; }
__device__ __forceinline__ f32x4 sigm4(const f32x4 v) { return (f32x4){sigm(v[0]), sigm(v[1]), sigm(v[2]), sigm(v[3])}; }

struct EpiInProj {
    static constexpr bool PERM = true, AFTER_DRAIN = false;
    bf16_t *Q, *K, *V, *Z, *SG; const float* rope; float qscale;
    __device__ __forceinline__ void operator()(const f32x4 (&acc)[2][2][4][2], const Unit& u, int wr, int wc, int fr, int fq) const {
        const int pn = u.pn, row0 = u.pm * BM + wr * 64 + fr, cl = wc * 32 + 8 * fq;
        if (pn < 4) {
            bf16_t* base = (pn < 2) ? Q : K; const float sc = (pn < 2) ? qscale : 1.0f; const int colt = (pn & 1) * 256, g4 = 4 * (4 * (wc & 1) + fq);
            EPI_ROWS(row0) { const int row = row0 + ai * HALF + m * 16; const float* rp = rope + (size_t)(row & 2047) * 64 + g4;
                const f32x4 cs = *(const f32x4*)rp, sn = *(const f32x4*)(rp + 32);
#pragma unroll
                for (int bj = 0; bj < 2; ++bj) { const f32x4 v0 = acc[ai][bj][m][0], v1 = acc[ai][bj][m][1];
                    const f32x4 lo = (v0 * cs - v1 * sn) * sc, hi = (v1 * cs + v0 * sn) * sc;
                    bf16_t* p = base + (size_t)row * 512 + colt + (2 * bj + (wc >> 1)) * 64 + g4;
                    u32x2 a; a.x = cvt_pk_bf16(lo[0], lo[1]); a.y = cvt_pk_bf16(lo[2], lo[3]); *(u32x2*)p = a;
                    u32x2 b; b.x = cvt_pk_bf16(hi[0], hi[1]); b.y = cvt_pk_bf16(hi[2], hi[3]); *(u32x2*)(p + 32) = b; } }
        } else if (pn < 6) {
            EPI_ROWS(row0) { bf16_t* p = V + (size_t)(row0 + ai * HALF + m * 16) * 512 + (pn - 4) * 256 + cl;
#pragma unroll
                for (int bj = 0; bj < 2; ++bj) *(u32x4*)(p + bj * HALF) = pack8(acc[ai][bj][m][0], acc[ai][bj][m][1]); }
        } else if (pn < 10) {
            EPI_ROWS(row0) { bf16_t* p = Z + (size_t)(row0 + ai * HALF + m * 16) * 512 + (pn - 6) * 128 + cl;
                *(u32x4*)p = pack8(acc[ai][0][m][0] * sigm4(acc[ai][1][m][0]), acc[ai][0][m][1] * sigm4(acc[ai][1][m][1])); }
        } else {
            EPI_ROWS(row0) { bf16_t* p = SG + (size_t)(row0 + ai * HALF + m * 16) * 2048 + (pn - 10) * 256 + cl;
#pragma unroll
                for (int bj = 0; bj < 2; ++bj) *(u32x4*)(p + bj * HALF) = pack8(sigm4(acc[ai][bj][m][0]), sigm4(acc[ai][bj][m][1])); }
        }
    }
};
template <int MODE> struct EpiGate {
    static constexpr bool PERM = false, AFTER_DRAIN = false;
    float* P; bf16_t* MIX; const bf16_t* SG;
    __device__ __forceinline__ void operator()(const f32x4 (&acc)[2][2][4][2], const Unit& u, int wr, int wc, int fr, int fq) const {
        const int row0 = u.pm * BM + wr * 64 + fr, col0 = u.pn * BM + wc * 32 + 4 * fq;
        EPI_ROWS(row0) { const size_t row = (size_t)(row0 + ai * HALF + m * 16);
#pragma unroll
            for (int bj = 0; bj < 2; ++bj)
#pragma unroll
                for (int n = 0; n < 2; ++n) { const int col = col0 + bj * HALF + n * 16;
                    const u32x2 gw = *(const u32x2*)(SG + row * 2048 + MODE * 1024 + col);
                    const f32x4 gt = (f32x4){bf_lo(gw.x), bf_hi(gw.x), bf_lo(gw.y), bf_hi(gw.y)};
                    if (MODE == 0) *(f32x4*)(P + row * 1024 + col) = gt * acc[ai][bj][m][n];
                    else { const f32x4 r = *(const f32x4*)(P + row * 1024 + col) + gt * acc[ai][bj][m][n];
                        u32x2 w; w.x = cvt_pk_bf16(r[0], r[1]); w.y = cvt_pk_bf16(r[2], r[3]); *(u32x2*)(MIX + row * 1024 + col) = w; } } }
    }
};
struct EpiResid {
    static constexpr bool PERM = false, AFTER_DRAIN = false;
    const float* base; float* out; int nN;
    __device__ __forceinline__ void operator()(const f32x4 (&acc)[2][2][4][2], const Unit& u, int wr, int wc, int fr, int fq) const {
        const int row0 = u.pm * BM + wr * 64 + fr, col0 = (u.pn % nN) * BM + wc * 32 + 4 * fq;
        EPI_ROWS(row0) { const size_t off = (size_t)(row0 + ai * HALF + m * 16) * 1024 + col0;
#pragma unroll
            for (int bj = 0; bj < 2; ++bj)
#pragma unroll
                for (int n = 0; n < 2; ++n) { f32x4 r = acc[ai][bj][m][n]; if (base) r += *(const f32x4*)(base + off + bj * HALF + n * 16); *(f32x4*)(out + off + bj * HALF + n * 16) = r; } }
    }
};
struct EpiSwiGLU {
    static constexpr bool PERM = true, AFTER_DRAIN = false;
    bf16_t* ACT; int ldc, nN;
    __device__ __forceinline__ void operator()(const f32x4 (&acc)[2][2][4][2], const Unit& u, int wr, int wc, int fr, int fq) const {
        const int row0 = u.pm * BM + wr * 64 + fr, cl = (u.pn % nN) * 128 + wc * 32 + 8 * fq;
        EPI_ROWS(row0) { bf16_t* p = ACT + (size_t)(row0 + ai * HALF + m * 16) * ldc + cl;
            const f32x4 g0 = acc[ai][0][m][0], g1 = acc[ai][0][m][1];
            *(u32x4*)p = pack8(g0 * sigm4(g0) * acc[ai][1][m][0], g1 * sigm4(g1) * acc[ai][1][m][1]); }
    }
};
struct EpiStore {
    static constexpr bool PERM = true, AFTER_DRAIN = false;
    bf16_t* O; int ldc, nN;
    __device__ __forceinline__ void operator()(const f32x4 (&acc)[2][2][4][2], const Unit& u, int wr, int wc, int fr, int fq) const {
        const int row0 = u.pm * BM + wr * 64 + fr, cl = (u.pn % nN) * BM + wc * 32 + 8 * fq;
        EPI_ROWS(row0) { bf16_t* p = O + (size_t)(row0 + ai * HALF + m * 16) * ldc + cl;
#pragma unroll
            for (int bj = 0; bj < 2; ++bj) *(u32x4*)(p + bj * HALF) = pack8(acc[ai][bj][m][0], acc[ai][bj][m][1]); }
    }
};
struct EpiPleGate {
    static constexpr bool PERM = false, AFTER_DRAIN = false;
    float* X; const bf16_t* PROJ;
    __device__ __forceinline__ void operator()(const f32x4 (&acc)[2][2][4][2], const Unit& u, int wr, int wc, int fr, int fq) const {
        const int row0 = u.pm * BM + wr * 64 + fr, col0 = u.pn * BM + wc * 32 + 4 * fq;
        EPI_ROWS(row0) { const size_t off = (size_t)(row0 + ai * HALF + m * 16) * 1024 + col0;
#pragma unroll
            for (int bj = 0; bj < 2; ++bj)
#pragma unroll
                for (int n = 0; n < 2; ++n) { const size_t o = off + bj * HALF + n * 16; const u32x2 pw = *(const u32x2*)(PROJ + o);
                    const f32x4 pr = (f32x4){bf_lo(pw.x), bf_hi(pw.x), bf_lo(pw.y), bf_hi(pw.y)};
                    *(f32x4*)(X + o) = *(const f32x4*)(X + o) + sigm4(acc[ai][bj][m][n]) * pr; } }
    }
};

template <class Epi, class Sched>
__device__ __forceinline__ void gemm_phase_naive(const Gemm g, const Sched& S, const Epi& E) {
    int tid_ = threadIdx.x; asm volatile("" : "+v"(tid_));
    const int tid = tid_, wid = __builtin_amdgcn_readfirstlane(tid >> 6), lane = tid & 63, wr = wid >> 2, wc = wid & 3, fr = lane & 15, fq = lane >> 4;
    const int K = g.K; Unit u;
    for (int ui = 0; S.next(ui, u); ++ui) {
        f32x4 acc[2][2][4][2];
#pragma unroll
        for (int ai = 0; ai < 2; ++ai)
#pragma unroll
            for (int m = 0; m < 4; ++m) {
                const bf16_t* ap = g.A + (size_t)(u.pm * BM + ai * HALF + wr * 64 + m * 16 + fr) * K;
#pragma unroll
                for (int bj = 0; bj < 2; ++bj)
#pragma unroll
                    for (int n = 0; n < 2; ++n) { f32x4 r = (f32x4){0.f, 0.f, 0.f, 0.f};
#pragma unroll
                        for (int j = 0; j < 4; ++j) { const int col = u.pn * BM + bj * HALF + wc * 32 + (Epi::PERM ? (8 * fq + 4 * n + j) : (16 * n + 4 * fq + j));
                            const bf16_t* bp = g.Bt + (size_t)col * K; float s = 0.f;
                            for (int k = 0; k < K; k += 8) { const u32x4 a = *(const u32x4*)(ap + k), b = *(const u32x4*)(bp + k);
                                s += bf_lo(a.x) * bf_lo(b.x) + bf_hi(a.x) * bf_hi(b.x) + bf_lo(a.y) * bf_lo(b.y) + bf_hi(a.y) * bf_hi(b.y)
                                   + bf_lo(a.z) * bf_lo(b.z) + bf_hi(a.z) * bf_hi(b.z) + bf_lo(a.w) * bf_lo(b.w) + bf_hi(a.w) * bf_hi(b.w); }
                            r[j] = s; }
                        acc[ai][bj][m][n] = r; } }
        E(acc, u, wr, wc, fr, fq);
    }
}
template <class Epi, class Sched, bool ALIGN_EPI = false, bool SP2 = false>
__device__ __forceinline__ void gemm_phase(PG8_LAS unsigned char* lds, const Gemm g, const Sched& S, const Epi& E) {
    int tid_ = threadIdx.x; asm volatile("" : "+v"(tid_));
    const int tid = tid_, wid = __builtin_amdgcn_readfirstlane(tid >> 6), lane = tid & 63, wr = wid >> 2, wc = wid & 3, fr = lane & 15, fq = lane >> 4;
    int K_ = g.K; asm volatile("" : "+s"(K_));
    const int K = K_, nt = K / BK;
    unsigned voffA[2], voffB[2];
#pragma unroll
    for (int i = 0; i < 2; ++i) { int R, C; stage_rc(tid * 16 + i * 8192, R, C); const int Rb = Epi::PERM ? ((R & ~31) + perm32(R & 31)) : R;
        voffA[i] = (unsigned)(R * K + C) * 2u; voffB[i] = (unsigned)(Rb * K + C) * 2u; }
    const size_t kstep = (size_t)(BK * 2);
    const size_t hstep = (size_t)HALF * K * 2;
    const size_t tstep = 2 * hstep;
    const unsigned ldsw = (unsigned)wid * 1024u;
    const int aoff = lds_byte(wr * 64 + fr, fq * 8), boff = lds_byte(wc * 32 + fr, fq * 8);
#define PG8_SA(b, h) (((b) * 2 + (h)) * HTB)
#define PG8_SB(b, h) ((4 + (b) * 2 + (h)) * HTB)
#define PG8_STAGE(bufoff, gbase, voff) do { _Pragma("unroll") for (int _i = 0; _i < 2; ++_i) \
        __builtin_amdgcn_global_load_lds((const unsigned*)((const char*)(gbase) + (voff)[_i]), (PG8_LAS unsigned*)(lds + (bufoff) + ldsw + _i * 8192), 16, 0, 0); } while (0)
#define PG8_LDA(dst, b, h) do { _Pragma("unroll") for (int m = 0; m < 4; ++m) _Pragma("unroll") for (int k = 0; k < 2; ++k) dst[m][k] = *(const PG8_LAS bf16x8*)(lds + PG8_SA(b, h) + aoff + m * 2048 + k * 1024); } while (0)
#define PG8_LDB(dst, b, h) do { _Pragma("unroll") for (int n = 0; n < 2; ++n) _Pragma("unroll") for (int k = 0; k < 2; ++k) dst[n][k] = *(const PG8_LAS bf16x8*)(lds + PG8_SB(b, h) + boff + n * 2048 + k * 1024); } while (0)
#define PG8_MMA(ai, bj, At, Bt) do { __builtin_amdgcn_s_setprio(1); _Pragma("unroll") for (int m = 0; m < 4; ++m) _Pragma("unroll") for (int n = 0; n < 2; ++n) _Pragma("unroll") for (int k = 0; k < 2; ++k) \
        acc[ai][bj][m][n] = __builtin_amdgcn_mfma_f32_16x16x32_bf16(Bt[n][k], At[m][k], acc[ai][bj][m][n], 0, 0, 0); __builtin_amdgcn_s_setprio(0); } while (0)
#define PG8_WAIT_V(n) asm volatile("s_waitcnt vmcnt(" #n ")" ::: "memory")
#define PG8_WAIT_L(n) asm volatile("s_waitcnt lgkmcnt(" #n ")" ::: "memory")
#define PG8_BAR __builtin_amdgcn_s_barrier()
#define PG8_SCHED __builtin_amdgcn_sched_barrier(0)
    Unit cur, nxt; int ui = 0;
    if (!S.next(0, cur)) return;
    f32x4 acc[2][2][4][2];
#pragma unroll
    for (int a = 0; a < 2; ++a)
#pragma unroll
        for (int b = 0; b < 2; ++b)
#pragma unroll
            for (int m = 0; m < 4; ++m)
#pragma unroll
                for (int n = 0; n < 2; ++n) acc[a][b][m][n] = (f32x4){0.f, 0.f, 0.f, 0.f};
    bf16x8 At[4][2], B0[2][2], B1[2][2];
    const char* cA = (const char*)g.A + (size_t)cur.pm * tstep; const char* cB = (const char*)g.Bt + (size_t)cur.pn * tstep;
    S.a_ready(cur);
    if constexpr (SP2) {
        PG8_STAGE(PG8_SB(0, 0), cB, voffB); PG8_STAGE(PG8_SB(0, 1), cB + hstep, voffB); PG8_STAGE(PG8_SA(0, 0), cA, voffA); PG8_STAGE(PG8_SA(0, 1), cA + hstep, voffA);
        if (wr == 1) PG8_BAR;
        PG8_WAIT_V(2); PG8_BAR;
        PG8_STAGE(PG8_SB(1, 0), cB + kstep, voffB); PG8_STAGE(PG8_SA(1, 0), cA + kstep, voffA); PG8_STAGE(PG8_SB(1, 1), cB + hstep + kstep, voffB);
        PG8_WAIT_V(6); PG8_BAR;
    } else {
        PG8_STAGE(PG8_SB(0, 0), cB, voffB); PG8_STAGE(PG8_SA(0, 0), cA, voffA); PG8_STAGE(PG8_SB(0, 1), cB + hstep, voffB); PG8_STAGE(PG8_SA(0, 1), cA + hstep, voffA);
        if (wr == 1) PG8_BAR;
        PG8_WAIT_V(4); PG8_BAR;
        PG8_STAGE(PG8_SB(1, 0), cB + kstep, voffB); PG8_STAGE(PG8_SA(1, 0), cA + kstep, voffA); PG8_STAGE(PG8_SB(1, 1), cB + hstep + kstep, voffB);
        PG8_WAIT_V(6); PG8_BAR;
    }
    for (;;) {
        const bool has_next = S.next(ui + 1, nxt);
        const char* nA = has_next ? (const char*)g.A + (size_t)nxt.pm * tstep : cA; const char* nB = has_next ? (const char*)g.Bt + (size_t)nxt.pn * tstep : cB;
#pragma nounroll
        for (int t = 0; t < nt; t += 2) {
            const bool last = (t == nt - 2);
            const char* a1 = cA + (size_t)(t + 1) * kstep;
            const char* a2 = last ? nA : cA + (size_t)(t + 2) * kstep; const char* b2 = last ? nB : cB + (size_t)(t + 2) * kstep;
            const char* a3 = a2 + kstep; const char* b3 = b2 + kstep;
            if (last && has_next) S.a_ready(nxt);
            if constexpr (SP2) {
            PG8_LDB(B0, 0, 0); PG8_LDB(B1, 0, 1); PG8_SCHED; PG8_LDA(At, 0, 0); PG8_STAGE(PG8_SA(1, 1), a1 + hstep, voffA);
            PG8_WAIT_V(8); PG8_WAIT_L(0); PG8_BAR; PG8_MMA(0, 0, At, B0); PG8_MMA(0, 1, At, B1); PG8_BAR; PG8_SCHED;
            PG8_LDA(At, 0, 1); PG8_STAGE(PG8_SB(0, 0), b2, voffB); PG8_STAGE(PG8_SB(0, 1), b2 + hstep, voffB); PG8_STAGE(PG8_SA(0, 0), a2, voffA);
            PG8_WAIT_V(8); PG8_WAIT_L(0); PG8_BAR; PG8_MMA(1, 0, At, B0); PG8_MMA(1, 1, At, B1); PG8_BAR; PG8_SCHED;
            PG8_LDB(B0, 1, 0); PG8_LDB(B1, 1, 1); PG8_SCHED; PG8_LDA(At, 1, 0); PG8_STAGE(PG8_SA(0, 1), a2 + hstep, voffA);
            PG8_WAIT_V(8); PG8_WAIT_L(0); PG8_BAR; PG8_MMA(0, 0, At, B0); PG8_MMA(0, 1, At, B1); PG8_BAR; PG8_SCHED;
            PG8_LDA(At, 1, 1); PG8_STAGE(PG8_SB(1, 0), b3, voffB); PG8_STAGE(PG8_SB(1, 1), b3 + hstep, voffB); PG8_STAGE(PG8_SA(1, 0), a3, voffA);
            PG8_WAIT_V(8); PG8_WAIT_L(0); PG8_BAR; PG8_MMA(1, 0, At, B0); PG8_MMA(1, 1, At, B1); PG8_BAR; PG8_SCHED;
            } else {
            PG8_LDB(B0, 0, 0); PG8_SCHED; PG8_LDA(At, 0, 0); PG8_STAGE(PG8_SA(1, 1), a1 + hstep, voffA);
            PG8_WAIT_L(8); PG8_BAR; PG8_WAIT_L(0); PG8_MMA(0, 0, At, B0); PG8_BAR; PG8_SCHED;
            PG8_LDB(B1, 0, 1); PG8_STAGE(PG8_SB(0, 0), b2, voffB);
            PG8_BAR; PG8_WAIT_L(0); PG8_MMA(0, 1, At, B1); PG8_BAR;
            PG8_LDA(At, 0, 1); PG8_STAGE(PG8_SA(0, 0), a2, voffA);
            PG8_BAR; PG8_WAIT_L(0); PG8_MMA(1, 0, At, B0); PG8_BAR; PG8_SCHED;
            PG8_STAGE(PG8_SB(0, 1), b2 + hstep, voffB);
            PG8_WAIT_V(6); PG8_BAR; PG8_MMA(1, 1, At, B1); PG8_BAR;
            PG8_LDB(B0, 1, 0); PG8_SCHED; PG8_LDA(At, 1, 0); PG8_STAGE(PG8_SA(0, 1), a2 + hstep, voffA);
            PG8_WAIT_L(8); PG8_BAR; PG8_WAIT_L(0); PG8_MMA(0, 0, At, B0); PG8_BAR; PG8_SCHED;
            PG8_LDB(B1, 1, 1); PG8_STAGE(PG8_SB(1, 0), b3, voffB);
            PG8_BAR; PG8_WAIT_L(0); PG8_MMA(0, 1, At, B1); PG8_BAR;
            PG8_LDA(At, 1, 1); PG8_STAGE(PG8_SA(1, 0), a3, voffA);
            PG8_BAR; PG8_WAIT_L(0); PG8_MMA(1, 0, At, B0); PG8_BAR; PG8_SCHED;
            PG8_STAGE(PG8_SB(1, 1), b3 + hstep, voffB);
            PG8_WAIT_V(6); PG8_BAR; PG8_MMA(1, 1, At, B1); PG8_BAR;
            }
        }
        if constexpr (ALIGN_EPI) { if (wr == 0) PG8_BAR; }
        if constexpr (!Epi::AFTER_DRAIN) { E(acc, cur, wr, wc, fr, fq); S.done(cur); }
        if (!has_next) break;
#pragma unroll
        for (int a = 0; a < 2; ++a)
#pragma unroll
            for (int b = 0; b < 2; ++b)
#pragma unroll
                for (int m = 0; m < 4; ++m)
#pragma unroll
                    for (int n = 0; n < 2; ++n) acc[a][b][m][n] = (f32x4){0.f, 0.f, 0.f, 0.f};
        cur = nxt; cA = nA; cB = nB; ++ui;
        if constexpr (ALIGN_EPI) { if (wr == 1) PG8_BAR; }
    }
    PG8_WAIT_V(0);
    if constexpr (!ALIGN_EPI) { if (wr == 0) PG8_BAR; }
    PG8_BAR;
    if constexpr (Epi::AFTER_DRAIN) { E.fused(acc, cur, wr, wc, fr, fq, lds, wid, lane); S.done(cur); }
#undef PG8_SA
#undef PG8_SB
#undef PG8_STAGE
#undef PG8_LDA
#undef PG8_LDB
#undef PG8_MMA
#undef PG8_WAIT_V
#undef PG8_WAIT_L
#undef PG8_BAR
#undef PG8_SCHED
}
}

constexpr int NWAVES = 8;
#ifndef MK_PER_PHASE
#define MK_PER_PHASE 0
#endif
#ifndef MK_NAIVE_GEMM
#define MK_NAIVE_GEMM 0
#endif
#ifndef MK_SP2
#define MK_SP2 true
#endif
#ifndef MK_ALIGN
#define MK_ALIGN true
#endif
#ifdef DBG_TWOPASS
#define DBG_TWOPASS_ON 1
#else
#define DBG_TWOPASS_ON 0
#endif
#ifndef DBG_LAYER
#define DBG_LAYER 0
#endif
#ifndef DBG_INJECT
#define DBG_INJECT 0.f
#endif
#ifndef MK_NAIVE_ATTN
#define MK_NAIVE_ATTN 1
#endif

constexpr int BATCH = 8, SEQ = 2048, D = 1024, T = BATCH * SEQ, DEPTH = 2;
constexpr int NH = 4, HD = 64, VD = 128, AQK = 512, AV = 512, CCH = 512, CK = 31, CPAD = 15;
constexpr int INC = 2 * AQK + AV + 2 * CCH + 2 * D;
constexpr int FF = 2816, NE = 8, FE = 3584, PLE = 256;
constexpr float EPS = 1e-6f;
constexpr float QSCALE = 0.125f * 1.4426950408889634f;
constexpr int MOE_ROWS = 2 * T + NE * 256;
enum { I_X = 0, I_P, I_GMIX, I_WIN, I_LAM, I_GSUB, I_WAO, I_CW, I_CB, I_CLG, I_CLB, I_WCO, I_WO, I_GFFN, I_WFGU, I_WFDN, I_WR, I_BR, I_WEGU, I_WEDN, I_GPLE, I_WPG, I_WPP, I_GFIN, N_IN };

constexpr size_t MiB = 1u << 20;
constexpr size_t WS_CTL = 0, CTL_ZERO_BYTES = 1 * MiB;
constexpr size_t WS_ROPE = 1 * MiB;
constexpr size_t WS_SCAL = 1 * MiB + 512 * 1024;
constexpr size_t WS_RTI = WS_SCAL + 4096;
constexpr size_t WS_RTW = WS_RTI + (size_t)T * 16;
constexpr size_t WS_RSEL = WS_RTW + (size_t)T * 8;
static_assert(WS_RSEL + (size_t)T * 8 <= 4 * MiB, "misc region");
constexpr size_t WS_WIN = 4 * MiB, WS_WA = 22 * MiB, WS_WC = 24 * MiB, WS_WO = 26 * MiB, WS_WFGU = 30 * MiB, WS_WFDN = 41 * MiB, WS_WPG = 47 * MiB, WS_WPP = 51 * MiB;
constexpr size_t WS_WEGU = 52 * MiB, WS_WEDN = 164 * MiB;
constexpr size_t WS_X = 220 * MiB, WS_H = 284 * MiB, WS_PROJ = 316 * MiB, WS_PB = 380 * MiB, WS_R = 396 * MiB;
constexpr size_t WS_Q = WS_R, WS_K = WS_R + 16 * MiB, WS_V = WS_R + 32 * MiB, WS_Z = WS_R + 48 * MiB, WS_SG = WS_R + 64 * MiB, WS_OB = WS_R + 128 * MiB, WS_ZC = WS_R + 144 * MiB,
                 WS_P = WS_R + 160 * MiB, WS_MIX = WS_R + 224 * MiB;
constexpr size_t WS_ACT = WS_R, WS_HP = WS_R + 240 * MiB, WS_Y = WS_R + 308 * MiB, WS_END = WS_R + 444 * MiB;
static_assert((size_t)MOE_ROWS * FE * 2 <= 240 * MiB && (size_t)MOE_ROWS * D * 2 <= 68 * MiB && (size_t)MOE_ROWS * D * 4 <= 136 * MiB && (size_t)T * FF * 2 <= 240 * MiB, "region R");
constexpr int CW_TMO = 0, CW_CODE = 1, CW_BAR = 4096, CW_GCNT = 8192;

constexpr int RING_OFF = 0, RING_BYTES = 131072;
constexpr int LDSCTL_OFF = RING_BYTES, MISC_OFF = LDSCTL_OFF + 320;
constexpr int TP_OFF = MISC_OFF + 64;
constexpr int LDS_BYTES = 147456;

#define GAS __attribute__((address_space(1)))
#define LAS __attribute__((address_space(3)))
typedef unsigned short bf16;
typedef unsigned v4u __attribute__((ext_vector_type(4)));
typedef unsigned v2u __attribute__((ext_vector_type(2)));
typedef float f32x4 __attribute__((ext_vector_type(4)));
typedef GAS unsigned gu32;
#define RLX_AGENT __ATOMIC_RELAXED, __HIP_MEMORY_SCOPE_AGENT
#define LDS_WAIT() asm volatile("s_waitcnt lgkmcnt(0)" ::: "memory")
#define VM_WAIT() asm volatile("s_waitcnt vmcnt(0)" ::: "memory")
__device__ __forceinline__ unsigned f2bf(float f) { unsigned u = __builtin_bit_cast(unsigned, f); return (u + 0x7fffu + ((u >> 16) & 1u)) >> 16; }
__device__ __forceinline__ unsigned pk2(float lo, float hi) { return f2bf(lo) | (f2bf(hi) << 16); }
using pg8::bf_lo; using pg8::bf_hi; using pg8::sigm;

#define XB_TMO      128
#define XB_XCNT(j)  (256  + 64 * (j))
#define XB_XSUB(j)  (1280 + 64 * (j))
#define XB_XGEN(j)  (2304 + 64 * (j))
#define XB_TOP      3328
#define XB_TOPGEN   3392
#define XCD_BAR_WORDS 3456
#define XB_SPIN_CAP (1u << 18)

__device__ __forceinline__ unsigned xb_ld(unsigned* p)              { return __hip_atomic_load(p, __ATOMIC_RELAXED, __HIP_MEMORY_SCOPE_AGENT); }
__device__ __forceinline__ unsigned xb_add(unsigned* p, unsigned v) { return __hip_atomic_fetch_add(p, v, __ATOMIC_RELAXED, __HIP_MEMORY_SCOPE_AGENT); }
__device__ __forceinline__ unsigned xb_xcc_id() { return (unsigned)__builtin_amdgcn_s_getreg((3 << 11) | 20) & 0xFu; }
#define XB_SPIN(cond, bar) do { unsigned _sp = 0; while (cond) { __builtin_amdgcn_s_sleep(1); \
    if ((++_sp & 255u) == 0u) { if (xb_ld(&(bar)[XB_TMO])) break; if (_sp > XB_SPIN_CAP) { atomicAdd(&(bar)[XB_TMO], 1u); break; } } } } while (0)

struct XcdBarrier {
    unsigned* bar; unsigned x;
    volatile LAS unsigned* st;
};

__device__ __forceinline__ XcdBarrier xcd_barrier_post(unsigned* bar, volatile LAS unsigned* st) {
    XcdBarrier b; b.bar = bar; b.x = xb_xcc_id(); b.st = st;
    if (threadIdx.x == 0) (void)xb_add(&bar[XB_XCNT(b.x)], 1u);
    return b;
}
__device__ __forceinline__ void xcd_barrier_complete(unsigned* bar, unsigned x, unsigned& nloc, unsigned& nx) {
    const unsigned G = gridDim.x * gridDim.y * gridDim.z;
    unsigned sum, cnt, mine, sp = 0u;
    for (;;) {
        sum = 0u; cnt = 0u; mine = 0u;
#pragma unroll
        for (unsigned j = 0; j < 16; ++j) { const unsigned c = xb_ld(&bar[XB_XCNT(j)]); sum += c; cnt += (c > 0u) ? 1u : 0u; mine = (j == x) ? c : mine; }
        if (sum == G) break;
        __builtin_amdgcn_s_sleep(1);
        if ((++sp & 255u) == 0u) { if (xb_ld(&bar[XB_TMO])) break; if (sp > XB_SPIN_CAP) { atomicAdd(&bar[XB_TMO], 1u); break; } }
    }
    nloc = mine > 0u ? mine : 1u; nx = cnt > 0u ? cnt : 1u;
}

__device__ __forceinline__ void xcd_barrier(const XcdBarrier& b) {
    asm volatile("s_waitcnt vmcnt(0)" ::: "memory");
    __syncthreads();
    if (threadIdx.x == 0) {
        GAS unsigned* gbar_ = (GAS unsigned*)b.bar; unsigned bx = b.x; asm volatile("" : "+s"(gbar_), "+s"(bx)); unsigned* bar = (unsigned*)gbar_;
        __builtin_amdgcn_s_waitcnt(0);
        unsigned nloc = b.st[0], nx = b.st[1];
        if (nloc == 0u) { xcd_barrier_complete(bar, bx, nloc, nx); b.st[0] = nloc; b.st[1] = nx; }
        const unsigned old = xb_add(&bar[XB_XSUB(bx)], 1u);
        const unsigned gen = old / nloc;
        if (old + 1u == (gen + 1u) * nloc) {
            __builtin_amdgcn_fence(__ATOMIC_RELEASE, "agent");
            asm volatile("s_waitcnt vmcnt(0)" ::: "memory");
            const unsigned og = xb_add(&bar[XB_TOP], 1u);
            const unsigned tg = og / nx;
            if (og + 1u == (tg + 1u) * nx) xb_add(&bar[XB_TOPGEN], 1u);
            else XB_SPIN(xb_ld(&bar[XB_TOPGEN]) == tg, bar);
            __builtin_amdgcn_fence(__ATOMIC_ACQUIRE, "agent");
            xb_add(&bar[XB_XGEN(bx)], 1u);
            asm volatile("s_waitcnt vmcnt(0)" ::: "memory");
        } else {
            XB_SPIN(xb_ld(&bar[XB_XGEN(bx)]) == gen, bar);
            __builtin_amdgcn_fence(__ATOMIC_ACQUIRE, "agent");
            asm volatile("s_waitcnt vmcnt(0)" ::: "memory");
        }
    }
    __syncthreads();
}

struct Frame {
    LAS unsigned char* lds;
    volatile LAS unsigned* MISC;
    gu32* ctl;
    GAS unsigned char* ws;
    int tid, lane, wave, G;
};
#define CAS __attribute__((address_space(4)))
__device__ __forceinline__ const float* inp(int i) {
    const CAS unsigned char* k = (const CAS unsigned char*)__builtin_amdgcn_kernarg_segment_ptr();
    asm volatile("" : "+s"(k));
    return (const float*)*(GAS const float* const CAS*)(k + 8 * i);
}
__device__ __forceinline__ float* outp() {
    const CAS unsigned char* k = (const CAS unsigned char*)__builtin_amdgcn_kernarg_segment_ptr();
    asm volatile("" : "+s"(k));
    return (float*)*(GAS float* const CAS*)(k + 8 * N_IN);
}
template <class TP> __device__ __forceinline__ TP* wsp(Frame& F, size_t off) { GAS unsigned char* w = F.ws; asm volatile("" : "+s"(w)); return (TP*)(w + off); }

__device__ __forceinline__ float wave_sum(float v) {
#pragma unroll
    for (int o = 1; o < 64; o <<= 1) v += __shfl_xor(v, o);
    return v;
}
__device__ __forceinline__ float dot4(const f32x4 a, const f32x4 b) { return (a.x * b.x + a.y * b.y) + (a.z * b.z + a.w * b.w); }

__device__ __forceinline__ unsigned dbg_hash(unsigned a, unsigned b) { unsigned x = a * 2654435761u + b * 40503u + 0x9e3779b9u; x ^= x >> 15; x *= 2246822519u; x ^= x >> 13; x *= 3266489917u; x ^= x >> 16; return x; }
__device__ __forceinline__ void cksum_ptr(Frame& F, const v4u* p, size_t bytes, int slot) {
    const size_t n = bytes / 16, gt = (size_t)blockIdx.x * (NWAVES * 64) + F.tid, NGT = (size_t)F.G * NWAVES * 64; unsigned s = 0u;
    for (size_t i = gt; i < n; i += NGT) { const v4u v = p[i]; s += (v.x + v.y) + (v.z + v.w); }
#pragma unroll
    for (int o = 1; o < 64; o <<= 1) s += (unsigned)__shfl_xor((int)s, o);
    if (F.lane == 0) __hip_atomic_fetch_add((unsigned*)(F.ctl + slot), s, RLX_AGENT);
}
__device__ __forceinline__ void cksum(Frame& F, size_t off, size_t bytes, int slot) { cksum_ptr(F, wsp<v4u>(F, off), bytes, slot); }

enum { PK_ID = 0, PK_INPROJ = 1, PK_SWIGLU = 2 };
struct TEntry { int in_idx, K, N, kind, F, item0; unsigned src_off; unsigned pad; unsigned long long dst_off; };
struct TTable { TEntry e[32]; int n, total; };
constexpr TTable make_table() {
    TTable t{}; int n = 0, it = 0;
    auto add = [&](int in_idx, size_t src_off, int K, int N, int kind, int F, size_t dst) {
        t.e[n].in_idx = in_idx; t.e[n].K = K; t.e[n].N = N; t.e[n].kind = kind; t.e[n].F = F; t.e[n].item0 = it; t.e[n].src_off = (unsigned)src_off; t.e[n].pad = 0; t.e[n].dst_off = dst;
        it += (K / 64) * (N / 32); ++n; };
    for (int l = 0; l < 2; ++l) add(I_WIN, (size_t)l * D * INC, D, INC, PK_INPROJ, 0, WS_WIN + (size_t)l * INC * D * 2);
    for (int l = 0; l < 2; ++l) add(I_WAO, (size_t)l * AV * D, AV, D, PK_ID, 0, WS_WA + (size_t)l * D * AV * 2);
    for (int l = 0; l < 2; ++l) add(I_WCO, (size_t)l * CCH * D, CCH, D, PK_ID, 0, WS_WC + (size_t)l * D * CCH * 2);
    for (int l = 0; l < 2; ++l) add(I_WO, (size_t)l * D * D, D, D, PK_ID, 0, WS_WO + (size_t)l * D * D * 2);
    add(I_WFGU, 0, D, 2 * FF, PK_SWIGLU, FF, WS_WFGU);
    add(I_WFDN, 0, FF, D, PK_ID, 0, WS_WFDN);
    for (int l = 0; l < 2; ++l) add(I_WPG, (size_t)l * D * D, D, D, PK_ID, 0, WS_WPG + (size_t)l * D * D * 2);
    for (int l = 0; l < 2; ++l) add(I_WPP, (size_t)l * PLE * D, PLE, D, PK_ID, 0, WS_WPP + (size_t)l * D * PLE * 2);
    for (int e = 0; e < NE; ++e) add(I_WEGU, (size_t)e * D * 2 * FE, D, 2 * FE, PK_SWIGLU, FE, WS_WEGU + (size_t)e * 2 * FE * D * 2);
    for (int e = 0; e < NE; ++e) add(I_WEDN, (size_t)e * FE * D, FE, D, PK_ID, 0, WS_WEDN + (size_t)e * D * FE * 2);
    t.n = n; t.total = it; return t;
}
__constant__ TTable g_tt = make_table();
static_assert(make_table().n == 30, "transpose table");

__device__ __forceinline__ int dest_row(int kind, int F, int c) {
    if (kind == PK_INPROJ) {
        if (c < 1024) { const int d = c & 63, dd = d & 31; return (c & ~63) + ((dd >> 2) << 3) + ((d >> 5) << 2) + (dd & 3); }
        if (c >= 1536 && c < 2560) { const int cc = c - 1536, h = cc >= 512 ? 1 : 0, r = cc - h * 512; return 1536 + ((r >> 7) << 8) + (h << 7) + (r & 127); }
        return c;
    }
    if (kind == PK_SWIGLU) { const int h = c >= F ? 1 : 0, r = c - h * F; return ((r >> 7) << 8) + (h << 7) + (r & 127); }
    return c;
}
__device__ __forceinline__ void p0_transpose_item(const float* W, int K, int N, bf16* WT, int kind, int FFd, LAS float* scr, int item, int lane) {
    const int nblk = N / 32, kb = item / nblk, nb = item % nblk, k0 = 64 * kb, n0 = 32 * nb;
#pragma unroll 8
    for (int i = 0; i < 32; ++i) { const int kk = 2 * i + (lane >> 5); scr[kk * 33 + (lane & 31)] = W[(size_t)(k0 + kk) * N + n0 + (lane & 31)]; }
    LDS_WAIT(); asm volatile("" ::: "memory");
    const int c = lane & 7;
#pragma unroll
    for (int j = 0; j < 4; ++j) { const int n = (lane >> 3) + 8 * j; const LAS float* s = scr + (8 * c) * 33 + n;
        v4u o; o.x = pk2(s[0 * 33], s[1 * 33]); o.y = pk2(s[2 * 33], s[3 * 33]); o.z = pk2(s[4 * 33], s[5 * 33]); o.w = pk2(s[6 * 33], s[7 * 33]);
        *(v4u*)(WT + (size_t)dest_row(kind, FFd, n0 + n) * K + k0 + 8 * c) = o; }
    LDS_WAIT(); asm volatile("" ::: "memory");
}
__device__ __forceinline__ void norm_rows(Frame& F, const float* src, const float* gain, bf16* dst) {
    const int gw = blockIdx.x * NWAVES + F.wave, NGW = F.G * NWAVES;
    f32x4 g[4];
#pragma unroll
    for (int j = 0; j < 4; ++j) g[j] = ((const f32x4*)gain)[F.lane + 64 * j];
    for (int m = gw; m < T; m += NGW) {
        const f32x4* xr = (const f32x4*)(src + (size_t)m * D) + F.lane;
        f32x4 v[4]; float s = 0.f;
#pragma unroll
        for (int j = 0; j < 4; ++j) { v[j] = xr[64 * j]; s += dot4(v[j], v[j]); }
        const float rstd = 1.f / sqrtf(wave_sum(s) * (1.f / D) + EPS);
        unsigned long long* o8 = (unsigned long long*)(dst + (size_t)m * D) + F.lane;
#pragma unroll
        for (int j = 0; j < 4; ++j) { const f32x4 y = v[j] * rstd * g[j]; o8[64 * j] = (unsigned long long)pk2(y.x, y.y) | ((unsigned long long)pk2(y.z, y.w) << 32); }
    }
}
__device__ __forceinline__ void final_norm(Frame& F, const float* src, const float* gain, float* dst, float dbg_scale = 1.f) {
    const int gw = blockIdx.x * NWAVES + F.wave, NGW = F.G * NWAVES;
    f32x4 g[4];
#pragma unroll
    for (int j = 0; j < 4; ++j) g[j] = ((const f32x4*)gain)[F.lane + 64 * j];
    for (int m = gw; m < T; m += NGW) {
        const f32x4* xr = (const f32x4*)(src + (size_t)m * D) + F.lane;
        f32x4 v[4]; float s = 0.f;
#pragma unroll
        for (int j = 0; j < 4; ++j) { v[j] = xr[64 * j]; s += dot4(v[j], v[j]); }
        const float rstd = 1.f / sqrtf(wave_sum(s) * (1.f / D) + EPS);
        f32x4* o = (f32x4*)(dst + (size_t)m * D) + F.lane;
#pragma unroll
        for (int j = 0; j < 4; ++j) o[64 * j] = v[j] * rstd * g[j] * dbg_scale;
    }
}
__device__ __forceinline__ void p0_prologue(Frame& F) {
    LAS float* scr = (LAS float*)(F.lds + RING_OFF + F.wave * 16384);
    const int gw = blockIdx.x * NWAVES + F.wave, NGW = F.G * NWAVES;
    const int ntot = g_tt.total, nent = g_tt.n;
    for (int it = gw; it < ntot; it += NGW) {
        int ei = 0;
        while (ei + 1 < nent && it >= g_tt.e[ei + 1].item0) ++ei;
        const TEntry& te = g_tt.e[ei];
        p0_transpose_item(inp(te.in_idx) + te.src_off, te.K, te.N, wsp<bf16>(F, te.dst_off), te.kind, te.F, scr, it - te.item0, F.lane);
    }
    { const int gt = blockIdx.x * (NWAVES * 64) + F.tid, NGT = F.G * NWAVES * 64; const float* p = inp(I_P); bf16* pb = wsp<bf16>(F, WS_PB);
      for (int i = gt; i < 2 * T * PLE / 8; i += NGT) { const f32x4 a = *(const f32x4*)(p + (size_t)i * 8), b = *(const f32x4*)(p + (size_t)i * 8 + 4);
          v4u o; o.x = pk2(a.x, a.y); o.y = pk2(a.z, a.w); o.z = pk2(b.x, b.y); o.w = pk2(b.z, b.w); *(v4u*)(pb + (size_t)i * 8) = o; } }
    { const int gt = blockIdx.x * (NWAVES * 64) + F.tid, NGT = F.G * NWAVES * 64; float* rope = wsp<float>(F, WS_ROPE);
      for (int i = gt; i < SEQ * 32; i += NGT) { const int pos = i >> 5, f = i & 31;
          const float inv = exp2f(-(float)(2 * f) * (1.0f / 64.0f) * 13.287712379549449f); const float ang = (float)pos * inv;
          double rev = (double)ang * 0.15915494309189535; rev -= floor(rev); const float rv = (float)rev;
          rope[pos * 64 + f] = __builtin_amdgcn_cosf(rv); rope[pos * 64 + 32 + f] = __builtin_amdgcn_sinf(rv); } }
    if (blockIdx.x == 0 && F.wave == 0) {
        for (int l = 0; l < DEPTH; ++l) { const float* lf = inp(I_LAM) + l * 4 * HD;
            const float a = wave_sum(lf[F.lane] * lf[HD + F.lane]), b = wave_sum(lf[2 * HD + F.lane] * lf[3 * HD + F.lane]);
            const float lam_init = 0.8f - 0.6f * expf(-0.3f * (float)l);
            if (F.lane == 0) wsp<float>(F, WS_SCAL)[l] = expf(a) - expf(b) + lam_init; }
    }
#ifdef DBG_TWOPASS
    if (blockIdx.x == 0 && F.tid < 8) __hip_atomic_store((unsigned*)(F.ctl + CW_GCNT + 64 * F.tid), 0u, RLX_AGENT);
#endif
    norm_rows(F, inp(I_X), inp(I_GMIX), wsp<bf16>(F, WS_H));
}

__device__ __forceinline__ void route_phase(Frame& F, const float* src, const float* gain, bf16* dst) {
    LAS float* wrT = (LAS float*)(F.lds);
    LAS unsigned* lcnt = (LAS unsigned*)(F.lds + 32768);
    LAS unsigned* gbase = lcnt + 8;
    LAS int* rinfo = (LAS int*)(F.lds + 32768 + 64);
    const float* wr = inp(I_WR); const float* br = inp(I_BR);
    int* rti = wsp<int>(F, WS_RTI); float* rtw = wsp<float>(F, WS_RTW);
    for (int i = F.tid; i < NE * D; i += NWAVES * 64) wrT[(i & 7) * D + (i >> 3)] = wr[i];
    f32x4 g[4];
#pragma unroll
    for (int j = 0; j < 4; ++j) g[j] = ((const f32x4*)gain)[F.lane + 64 * j];
    __syncthreads();
    for (int item = blockIdx.x; item < T / 64; item += F.G) {
        if (F.tid < 8) lcnt[F.tid] = 0u;
        __syncthreads();
        for (int rr = 0; rr < 8; ++rr) {
            const int lr = F.wave * 8 + rr, m = item * 64 + lr;
            const f32x4* xr = (const f32x4*)(src + (size_t)m * D) + F.lane;
            f32x4 v[4]; float s = 0.f;
#pragma unroll
            for (int j = 0; j < 4; ++j) { v[j] = xr[64 * j]; s += dot4(v[j], v[j]); }
            const float rstd = 1.f / sqrtf(wave_sum(s) * (1.f / D) + EPS);
            unsigned long long* o8 = (unsigned long long*)(dst + (size_t)m * D) + F.lane;
#pragma unroll
            for (int j = 0; j < 4; ++j) { v[j] = v[j] * rstd * g[j]; o8[64 * j] = (unsigned long long)pk2(v[j].x, v[j].y) | ((unsigned long long)pk2(v[j].z, v[j].w) << 32); }
            float lg[8];
#pragma unroll
            for (int e = 0; e < 8; ++e) { float t = 0.f;
#pragma unroll
                for (int j = 0; j < 4; ++j) t += dot4(v[j], ((const LAS f32x4*)(wrT + e * D))[F.lane + 64 * j]);
                lg[e] = wave_sum(t) + br[e]; }
            int e1 = 0; float v1 = lg[0];
#pragma unroll
            for (int e = 1; e < 8; ++e) if (lg[e] > v1) { v1 = lg[e]; e1 = e; }
            int e2 = -1; float v2 = -INFINITY;
#pragma unroll
            for (int e = 0; e < 8; ++e) if (e != e1 && lg[e] > v2) { v2 = lg[e]; e2 = e; }
            if (e2 < 0) e2 = (e1 == 0) ? 1 : 0;
            const float ex = expf(v2 - v1), w1 = 1.f / (1.f + ex), w2 = ex / (1.f + ex);
            if (F.lane == 0) {
                const unsigned lp1 = __hip_atomic_fetch_add((unsigned*)&lcnt[e1], 1u, __ATOMIC_RELAXED, __HIP_MEMORY_SCOPE_WORKGROUP);
                const unsigned lp2 = __hip_atomic_fetch_add((unsigned*)&lcnt[e2], 1u, __ATOMIC_RELAXED, __HIP_MEMORY_SCOPE_WORKGROUP);
                rinfo[lr * 4 + 0] = e1; rinfo[lr * 4 + 1] = (int)lp1; rinfo[lr * 4 + 2] = e2; rinfo[lr * 4 + 3] = (int)lp2;
                rtw[(size_t)m * 2] = w1; rtw[(size_t)m * 2 + 1] = w2; }
        }
        __syncthreads();
        if (F.tid < 8) gbase[F.tid] = __hip_atomic_fetch_add((unsigned*)(F.ctl + CW_GCNT + 64 * F.tid), lcnt[F.tid], RLX_AGENT);
        __syncthreads();
        if (F.tid < 64) { const int m = item * 64 + F.tid; const int e1 = rinfo[F.tid * 4], lp1 = rinfo[F.tid * 4 + 1], e2 = rinfo[F.tid * 4 + 2], lp2 = rinfo[F.tid * 4 + 3];
            int* o = rti + (size_t)m * 4; o[0] = e1; o[1] = (int)gbase[e1] + lp1; o[2] = e2; o[3] = (int)gbase[e2] + lp2; }
        __syncthreads();
    }
}
__device__ __forceinline__ void load_counts(Frame& F, unsigned (&cnt)[8]) {
#pragma unroll
    for (int e = 0; e < 8; ++e) cnt[e] = (unsigned)__builtin_amdgcn_readfirstlane((int)__hip_atomic_load((unsigned*)(F.ctl + CW_GCNT + 64 * e), RLX_AGENT));
}
__device__ __forceinline__ void scatter_phase(Frame& F) {
    unsigned cnt[8]; load_counts(F, cnt);
    int coff[8]; { int s = 0;
#pragma unroll
        for (int e = 0; e < 8; ++e) { coff[e] = s; s += (int)((cnt[e] + 255u) & ~255u); } }
    const int gw = blockIdx.x * NWAVES + F.wave, NGW = F.G * NWAVES;
    const int* rti = wsp<int>(F, WS_RTI); int* rsel = wsp<int>(F, WS_RSEL); const bf16* H = wsp<bf16>(F, WS_H); bf16* HP = wsp<bf16>(F, WS_HP);
    for (int m = gw; m < T; m += NGW) {
        const int e1 = rti[(size_t)m * 4], p1 = rti[(size_t)m * 4 + 1], e2 = rti[(size_t)m * 4 + 2], p2 = rti[(size_t)m * 4 + 3];
        int c1 = 0, c2 = 0;
#pragma unroll
        for (int e = 0; e < 8; ++e) { c1 = (e1 == e) ? coff[e] : c1; c2 = (e2 == e) ? coff[e] : c2; }
        const int r1 = c1 + p1, r2 = c2 + p2;
        const v4u* s = (const v4u*)(H + (size_t)m * D); const v4u a = s[F.lane], b = s[F.lane + 64];
        v4u* d1 = (v4u*)(HP + (size_t)r1 * D); v4u* d2 = (v4u*)(HP + (size_t)r2 * D);
        d1[F.lane] = a; d1[F.lane + 64] = b; d2[F.lane] = a; d2[F.lane + 64] = b;
        if (F.lane == 0) { rsel[(size_t)m * 2] = r1; rsel[(size_t)m * 2 + 1] = r2; }
    }
}
__device__ __forceinline__ void combine_norm_phase(Frame& F, float* X, const float* gain, bf16* dst) {
    const int gw = blockIdx.x * NWAVES + F.wave, NGW = F.G * NWAVES;
    const int* rsel = wsp<int>(F, WS_RSEL); const float* rtw = wsp<float>(F, WS_RTW); const float* Y = wsp<float>(F, WS_Y);
    f32x4 g[4];
#pragma unroll
    for (int j = 0; j < 4; ++j) g[j] = ((const f32x4*)gain)[F.lane + 64 * j];
    for (int m = gw; m < T; m += NGW) {
        const int r1 = rsel[(size_t)m * 2], r2 = rsel[(size_t)m * 2 + 1]; const float w1 = rtw[(size_t)m * 2], w2 = rtw[(size_t)m * 2 + 1];
        f32x4* xr = (f32x4*)(X + (size_t)m * D) + F.lane; const f32x4* y1 = (const f32x4*)(Y + (size_t)r1 * D) + F.lane; const f32x4* y2 = (const f32x4*)(Y + (size_t)r2 * D) + F.lane;
        f32x4 v[4]; float s = 0.f;
#pragma unroll
        for (int j = 0; j < 4; ++j) { v[j] = xr[64 * j] + (y1[64 * j] * w1 + y2[64 * j] * w2); xr[64 * j] = v[j]; s += dot4(v[j], v[j]); }
        const float rstd = 1.f / sqrtf(wave_sum(s) * (1.f / D) + EPS);
        unsigned long long* o8 = (unsigned long long*)(dst + (size_t)m * D) + F.lane;
#pragma unroll
        for (int j = 0; j < 4; ++j) { const f32x4 y = v[j] * rstd * g[j]; o8[64 * j] = (unsigned long long)pk2(y.x, y.y) | ((unsigned long long)pk2(y.z, y.w) << 32); }
    }
}

__device__ __forceinline__ void conv_phase(Frame& F, int layer) {
    LAS bf16* zt = (LAS bf16*)(F.lds);
    LAS float* wl = (LAS float*)(F.lds + 65536);
    const float* cw = inp(I_CW) + (size_t)layer * CK * CCH; const float* cb = inp(I_CB) + layer * CCH;
    const float* lg = inp(I_CLG) + layer * CCH; const float* lb = inp(I_CLB) + layer * CCH;
    const bf16* Z = wsp<bf16>(F, WS_Z); bf16* ZC = wsp<bf16>(F, WS_ZC);
    for (int i = F.tid; i < CK * CCH; i += NWAVES * 64) { const int tap = i >> 9, ch = i & 511; wl[((tap * 2 + ((ch >> 2) & 1)) * 64 + (ch >> 3)) * 4 + (ch & 3)] = cw[i]; }
    const int c0 = 8 * F.lane;
    const f32x4 b_lo = *(const f32x4*)(cb + c0), b_hi = *(const f32x4*)(cb + c0 + 4), g_lo = *(const f32x4*)(lg + c0), g_hi = *(const f32x4*)(lg + c0 + 4), o_lo = *(const f32x4*)(lb + c0), o_hi = *(const f32x4*)(lb + c0 + 4);
    for (int unit = blockIdx.x; unit < BATCH * (SEQ / 32); unit += F.G) {
        const int b = unit / (SEQ / 32), t0 = (unit % (SEQ / 32)) * 32;
        __syncthreads();
        for (int i = F.tid; i < 62 * 64; i += NWAVES * 64) { const int r = i >> 6, c16 = i & 63, t = t0 - CPAD + r;
            v4u val = (v4u){0u, 0u, 0u, 0u}; if (t >= 0 && t < SEQ) val = *(const v4u*)(Z + ((size_t)(b * SEQ + t)) * CCH + c16 * 8);
            *(LAS v4u*)(zt + r * CCH + c16 * 8) = val; }
        __syncthreads();
        const int r0 = 4 * F.wave;
        f32x4 alo[4], ahi[4];
#pragma unroll
        for (int rr = 0; rr < 4; ++rr) { alo[rr] = b_lo; ahi[rr] = b_hi; }
        f32x4 zlo[4], zhi[4];
#define CONV_LDZ(slot, rowi) do { const v4u zz = *(const LAS v4u*)(zt + (r0 + (rowi)) * CCH + c0); \
        zlo[slot] = (f32x4){bf_lo(zz.x), bf_hi(zz.x), bf_lo(zz.y), bf_hi(zz.y)}; zhi[slot] = (f32x4){bf_lo(zz.z), bf_hi(zz.z), bf_lo(zz.w), bf_hi(zz.w)}; } while (0)
        CONV_LDZ(0, 0); CONV_LDZ(1, 1); CONV_LDZ(2, 2);
#pragma unroll
        for (int tap = 0; tap < CK; ++tap) {
            CONV_LDZ((tap + 3) & 3, tap + 3);
            const f32x4 wlo = *(const LAS f32x4*)(wl + ((tap * 2 + 0) * 64 + F.lane) * 4), whi = *(const LAS f32x4*)(wl + ((tap * 2 + 1) * 64 + F.lane) * 4);
#pragma unroll
            for (int rr = 0; rr < 4; ++rr) { alo[rr] += wlo * zlo[(tap + rr) & 3]; ahi[rr] += whi * zhi[(tap + rr) & 3]; }
        }
#undef CONV_LDZ
#pragma unroll
        for (int rr = 0; rr < 4; ++rr) {
            const float mean = wave_sum((alo[rr].x + alo[rr].y) + (alo[rr].z + alo[rr].w) + (ahi[rr].x + ahi[rr].y) + (ahi[rr].z + ahi[rr].w)) * (1.f / CCH);
            const f32x4 dl = alo[rr] - mean, dh = ahi[rr] - mean;
            const float rstd = 1.f / sqrtf(wave_sum(dot4(dl, dl) + dot4(dh, dh)) * (1.f / CCH) + EPS);
            f32x4 yl = dl * rstd * g_lo + o_lo, yh = dh * rstd * g_hi + o_hi;
            yl = yl * pg8::sigm4(yl); yh = yh * pg8::sigm4(yh);
            *(v4u*)(ZC + ((size_t)(b * SEQ + t0 + r0 + rr)) * CCH + c0) = pg8::pack8(yl, yh);
        }
    }
    __syncthreads();
}

__device__ __forceinline__ void conv_naive_phase(Frame& F, int layer) {
    const float* cw = inp(I_CW) + (size_t)layer * CK * CCH; const float* cb = inp(I_CB) + layer * CCH;
    const float* lg = inp(I_CLG) + layer * CCH; const float* lb = inp(I_CLB) + layer * CCH;
    const bf16* Z = wsp<bf16>(F, WS_Z); bf16* ZC = wsp<bf16>(F, WS_ZC);
    const int gw = blockIdx.x * NWAVES + F.wave, NGW = F.G * NWAVES, c0 = 8 * F.lane;
    for (int m = gw; m < T; m += NGW) {
        const int b = m / SEQ, t = m % SEQ;
        f32x4 alo = *(const f32x4*)(cb + c0), ahi = *(const f32x4*)(cb + c0 + 4);
        for (int tap = 0; tap < CK; ++tap) { const int tt = t + tap - CPAD; if (tt < 0 || tt >= SEQ) continue;
            const v4u zz = *(const v4u*)(Z + ((size_t)(b * SEQ + tt)) * CCH + c0);
            const f32x4 wlo = *(const f32x4*)(cw + tap * CCH + c0), whi = *(const f32x4*)(cw + tap * CCH + c0 + 4);
            alo += wlo * (f32x4){bf_lo(zz.x), bf_hi(zz.x), bf_lo(zz.y), bf_hi(zz.y)}; ahi += whi * (f32x4){bf_lo(zz.z), bf_hi(zz.z), bf_lo(zz.w), bf_hi(zz.w)}; }
        const float mean = wave_sum((alo.x + alo.y) + (alo.z + alo.w) + (ahi.x + ahi.y) + (ahi.z + ahi.w)) * (1.f / CCH);
        const f32x4 dl = alo - mean, dh = ahi - mean;
        const float rstd = 1.f / sqrtf(wave_sum(dot4(dl, dl) + dot4(dh, dh)) * (1.f / CCH) + EPS);
        f32x4 yl = dl * rstd * *(const f32x4*)(lg + c0) + *(const f32x4*)(lb + c0), yh = dh * rstd * *(const f32x4*)(lg + c0 + 4) + *(const f32x4*)(lb + c0 + 4);
        yl = yl * pg8::sigm4(yl); yh = yh * pg8::sigm4(yh);
        *(v4u*)(ZC + (size_t)m * CCH + c0) = pg8::pack8(yl, yh);
    }
}

#ifdef DBG_CHECK_INPROJ
__device__ __forceinline__ float chk_col(const float* w, const f32x4 (&hv)[4], int lane, int c) {
    float t = 0.f;
#pragma unroll
    for (int j = 0; j < 4; ++j) { const int k = 4 * (lane + 64 * j); t += hv[j].x * w[(size_t)(k + 0) * INC + c] + hv[j].y * w[(size_t)(k + 1) * INC + c] + hv[j].z * w[(size_t)(k + 2) * INC + c] + hv[j].w * w[(size_t)(k + 3) * INC + c]; }
    return wave_sum(t);
}
__device__ __forceinline__ bool chk_bad(float got, float exp_) { return !(fabsf(got - exp_) <= 0.02f + 0.02f * fabsf(exp_)); }
__device__ __forceinline__ void check_inproj(Frame& F, int layer) {
    const int gw = blockIdx.x * NWAVES + F.wave; const int m = (int)(dbg_hash((unsigned)gw, 5u) % (unsigned)T), pos = m % SEQ;
    const float* x = layer == 0 ? inp(I_X) : (const float*)wsp<float>(F, WS_X); const float* gain = inp(I_GMIX) + (size_t)layer * D; const float* w = inp(I_WIN) + (size_t)layer * D * INC; const float* rope = wsp<float>(F, WS_ROPE);
    const bf16* Q = wsp<bf16>(F, WS_Q); const bf16* K = wsp<bf16>(F, WS_K); const bf16* V = wsp<bf16>(F, WS_V); const bf16* Z = wsp<bf16>(F, WS_Z); const bf16* SG = wsp<bf16>(F, WS_SG);
    f32x4 hv[4]; float s = 0.f;
#pragma unroll
    for (int j = 0; j < 4; ++j) { hv[j] = ((const f32x4*)(x + (size_t)m * D))[F.lane + 64 * j]; s += dot4(hv[j], hv[j]); }
    const float rstd = 1.f / sqrtf(wave_sum(s) * (1.f / D) + EPS);
#pragma unroll
    for (int j = 0; j < 4; ++j) hv[j] = hv[j] * rstd * ((const f32x4*)gain)[F.lane + 64 * j];
    unsigned flags = 0u;
    { for (int i = 0; i < 2; ++i) { const int c0_ = (int)(dbg_hash((unsigned)gw, 100u + i) % 512u), c = (c0_ & ~63) | (c0_ & 31), f = c & 31; const float t1 = chk_col(w, hv, F.lane, c), t2 = chk_col(w, hv, F.lane, c + 32);
        const float cs = rope[pos * 64 + f], sn = rope[pos * 64 + 32 + f];
        if (chk_bad(bf_lo((unsigned)Q[(size_t)m * 512 + c]), (t1 * cs - t2 * sn) * QSCALE) || chk_bad(bf_lo((unsigned)Q[(size_t)m * 512 + c + 32]), (t2 * cs + t1 * sn) * QSCALE)) flags |= 1u; } }
    { const int c0_ = (int)(dbg_hash((unsigned)gw, 102u) % 512u), c = (c0_ & ~63) | (c0_ & 31), f = c & 31; const float t1 = chk_col(w, hv, F.lane, 512 + c), t2 = chk_col(w, hv, F.lane, 512 + c + 32);
        const float cs = rope[pos * 64 + f], sn = rope[pos * 64 + 32 + f];
        if (chk_bad(bf_lo((unsigned)K[(size_t)m * 512 + c]), t1 * cs - t2 * sn) || chk_bad(bf_lo((unsigned)K[(size_t)m * 512 + c + 32]), t2 * cs + t1 * sn)) flags |= 1u; }
    { const int cv = (int)(dbg_hash((unsigned)gw, 103u) % 512u); const float v = chk_col(w, hv, F.lane, 1024 + cv); if (chk_bad(bf_lo((unsigned)V[(size_t)m * 512 + cv]), v)) flags |= 2u; }
    { int cz[2]; cz[0] = (int)(dbg_hash((unsigned)gw, 104u) % 512u); cz[1] = (int)(dbg_hash((unsigned)gw, 105u) % 512u); for (int i = 0; i < 2; ++i) { const float a = chk_col(w, hv, F.lane, 1536 + cz[i]), g = chk_col(w, hv, F.lane, 2048 + cz[i]);
        if (chk_bad(bf_lo((unsigned)Z[(size_t)m * 512 + cz[i]]), a / (1.f + expf(-g)))) flags |= 2u; } }
    { const int ca = (int)(dbg_hash((unsigned)gw, 106u) % 1024u), cb = (int)(dbg_hash((unsigned)gw, 107u) % 1024u); const float a = chk_col(w, hv, F.lane, 2560 + ca), b = chk_col(w, hv, F.lane, 2560 + 1024 + cb);
#ifdef DBG_SG_DETAIL
        unsigned code = 0u;
        if (chk_bad(bf_lo((unsigned)SG[(size_t)m * 2048 + ca]), 1.f / (1.f + expf(-a)))) code = (unsigned)(DBG_SG_DETAIL == 1 ? 18 - (10 + ca / 256) : (DBG_SG_DETAIL == 2 ? 1 + ((m % 256) >> 4) : DBG_SG_DETAIL == 3 ? 16 - ((m % 256) >> 4) : 1 + ((m >> 8) & 15)));
        if (chk_bad(bf_lo((unsigned)SG[(size_t)m * 2048 + 1024 + cb]), 1.f / (1.f + expf(-b)))) { const unsigned c2 = (unsigned)(DBG_SG_DETAIL == 1 ? 18 - (14 + cb / 256) : (DBG_SG_DETAIL == 2 ? 1 + ((m % 256) >> 4) : DBG_SG_DETAIL == 3 ? 16 - ((m % 256) >> 4) : 1 + ((m >> 8) & 15))); code = code > c2 ? code : c2; }
#if DBG_SG_DETAIL == 5
        if (F.lane == 0 && code) __hip_atomic_fetch_add((unsigned*)(F.ctl + 17), 1u, RLX_AGENT);
#else
        if (F.lane == 0 && code) __hip_atomic_fetch_max((unsigned*)(F.ctl + 16), code, RLX_AGENT);
#endif
#else
        if (chk_bad(bf_lo((unsigned)SG[(size_t)m * 2048 + ca]), 1.f / (1.f + expf(-a))) || chk_bad(bf_lo((unsigned)SG[(size_t)m * 2048 + 1024 + cb]), 1.f / (1.f + expf(-b)))) flags |= 4u;
#endif
    }
    if (F.lane == 0 && flags) __hip_atomic_fetch_or((unsigned*)(F.ctl + 16), flags, RLX_AGENT);
}
#endif

#ifdef DBG_CHECK_ACT
__device__ __forceinline__ void check_act(Frame& F) {
    const int gw = blockIdx.x * NWAVES + F.wave; const int m = (int)(dbg_hash((unsigned)gw, 3u) % (unsigned)T);
    const float* x = wsp<float>(F, WS_X); const float* gain = inp(I_GFFN); const float* w = inp(I_WFGU); const bf16* ACT = wsp<bf16>(F, WS_ACT);
    f32x4 hv[4]; float s = 0.f;
#pragma unroll
    for (int j = 0; j < 4; ++j) { hv[j] = ((const f32x4*)(x + (size_t)m * D))[F.lane + 64 * j]; s += dot4(hv[j], hv[j]); }
    const float rstd = 1.f / sqrtf(wave_sum(s) * (1.f / D) + EPS);
#pragma unroll
    for (int j = 0; j < 4; ++j) hv[j] = hv[j] * rstd * ((const f32x4*)gain)[F.lane + 64 * j];
    unsigned flags = 0u; int cj[4]; for (int i = 0; i < 4; ++i) cj[i] = (int)(dbg_hash((unsigned)gw, 110u + i) % (unsigned)FF);
    for (int i = 0; i < 4; ++i) { float g = 0.f, u = 0.f;
#pragma unroll
        for (int j = 0; j < 4; ++j) { const int k = 4 * (F.lane + 64 * j);
            g += hv[j].x * w[(size_t)(k + 0) * (2 * FF) + cj[i]] + hv[j].y * w[(size_t)(k + 1) * (2 * FF) + cj[i]] + hv[j].z * w[(size_t)(k + 2) * (2 * FF) + cj[i]] + hv[j].w * w[(size_t)(k + 3) * (2 * FF) + cj[i]];
            u += hv[j].x * w[(size_t)(k + 0) * (2 * FF) + FF + cj[i]] + hv[j].y * w[(size_t)(k + 1) * (2 * FF) + FF + cj[i]] + hv[j].z * w[(size_t)(k + 2) * (2 * FF) + FF + cj[i]] + hv[j].w * w[(size_t)(k + 3) * (2 * FF) + FF + cj[i]]; }
        g = wave_sum(g); u = wave_sum(u);
        const float ex = g / (1.f + expf(-g)) * u, got = bf_lo((unsigned)ACT[(size_t)m * FF + cj[i]]);
        if (!(fabsf(got - ex) <= 0.03f + 0.03f * fabsf(ex))) flags |= 8u; }
    if (F.lane == 0 && flags) __hip_atomic_fetch_or((unsigned*)(F.ctl + 16), flags, RLX_AGENT);
}
#endif

#ifdef DBG_CHECK_MIX
__device__ __forceinline__ float chk_dot_bf(const bf16* a, int K, const float* w, int ldw, int c, int lane) {
    float t = 0.f; for (int k = lane; k < K; k += 64) t += bf_lo((unsigned)a[k]) * w[(size_t)k * ldw + c]; return wave_sum(t); }
__device__ __forceinline__ void check_mix(Frame& F, int layer) {
    const int gw = blockIdx.x * NWAVES + F.wave; const int m = (int)(dbg_hash((unsigned)gw, 1u) % (unsigned)T);
    const bf16* OB = wsp<bf16>(F, WS_OB); const bf16* ZC = wsp<bf16>(F, WS_ZC); const bf16* SG = wsp<bf16>(F, WS_SG); const bf16* MIX = wsp<bf16>(F, WS_MIX);
    unsigned flags = 0u; int cc[4]; for (int i = 0; i < 4; ++i) cc[i] = (int)(dbg_hash((unsigned)gw, 120u + i) % (unsigned)D);
    for (int i = 0; i < 4; ++i) { const int c = cc[i];
        const float ad = chk_dot_bf(OB + (size_t)m * AV, AV, inp(I_WAO) + (size_t)layer * AV * D, D, c, F.lane), cd = chk_dot_bf(ZC + (size_t)m * CCH, CCH, inp(I_WCO) + (size_t)layer * CCH * D, D, c, F.lane);
        const float ex = bf_lo((unsigned)SG[(size_t)m * 2048 + c]) * ad + bf_lo((unsigned)SG[(size_t)m * 2048 + 1024 + c]) * cd, got = bf_lo((unsigned)MIX[(size_t)m * D + c]);
        if (!(fabsf(got - ex) <= 0.02f + 0.02f * fabsf(ex))) flags |= 16u; }
    if (F.lane == 0 && flags) __hip_atomic_fetch_or((unsigned*)(F.ctl + 16), flags, RLX_AGENT);
}
__device__ __forceinline__ void snap_wo(Frame& F) { const int gw = blockIdx.x * NWAVES + F.wave; const int m = (int)(dbg_hash((unsigned)gw, 6u) % (unsigned)T);
    if (F.lane < 4) wsp<float>(F, 3 * MiB + 768 * 1024)[(size_t)gw * 4 + F.lane] = wsp<float>(F, WS_X)[(size_t)m * D + (int)(dbg_hash((unsigned)gw, 130u + F.lane) % (unsigned)D)]; }
__device__ __forceinline__ void check_wo(Frame& F, int layer) {
    const int gw = blockIdx.x * NWAVES + F.wave; const int m = (int)(dbg_hash((unsigned)gw, 6u) % (unsigned)T);
    const bf16* MIX = wsp<bf16>(F, WS_MIX); const float* X = wsp<float>(F, WS_X); const float* xin = inp(I_X);
    unsigned flags = 0u; int cc[4]; for (int i_ = 0; i_ < 4; ++i_) cc[i_] = (int)(dbg_hash((unsigned)gw, 130u + i_) % (unsigned)D);
    for (int i = 0; i < 4; ++i) { const int c = cc[i];
        const float ex = (layer == 0 ? xin[(size_t)m * D + c] : wsp<float>(F, 3 * MiB + 768 * 1024)[(size_t)gw * 4 + i]) + chk_dot_bf(MIX + (size_t)m * D, D, inp(I_WO) + (size_t)layer * D * D, D, c, F.lane), got = X[(size_t)m * D + c];
        if (!(fabsf(got - ex) <= 0.02f + 0.02f * fabsf(ex))) flags |= 32u; }
    if (F.lane == 0 && flags) __hip_atomic_fetch_or((unsigned*)(F.ctl + 16), flags, RLX_AGENT);
}
#endif

#ifdef DBG_CHECK_FFN
constexpr size_t WS_DBG = 3 * MiB;
__device__ __forceinline__ void snap_x(Frame& F, int slot, int samp) {
    const int gw = blockIdx.x * NWAVES + F.wave; const int m = (int)(dbg_hash((unsigned)gw, (unsigned)samp) % (unsigned)T);
    if (F.lane < 4) wsp<float>(F, WS_DBG)[(size_t)gw * 16 + slot * 4 + F.lane] = wsp<float>(F, WS_X)[(size_t)m * D + (int)(dbg_hash((unsigned)gw, 140u + F.lane) % (unsigned)D)];
}
__device__ __forceinline__ float chk_dot_f(const float* a, int K, const float* w, int ldw, int c, int lane) { float t = 0.f; for (int k = lane; k < K; k += 64) t += a[k] * w[(size_t)k * ldw + c]; return wave_sum(t); }
__device__ __forceinline__ void check_down(Frame& F) {
    const int gw = blockIdx.x * NWAVES + F.wave; const int m = (int)(dbg_hash((unsigned)gw, 2u) % (unsigned)T); int cc[4]; for (int i_ = 0; i_ < 4; ++i_) cc[i_] = (int)(dbg_hash((unsigned)gw, 140u + i_) % (unsigned)D); unsigned flags = 0u;
    for (int i = 0; i < 4; ++i) { const float d = chk_dot_bf(wsp<bf16>(F, WS_ACT) + (size_t)m * FF, FF, inp(I_WFDN), D, cc[i], F.lane);
        const float ex = wsp<float>(F, WS_DBG)[(size_t)gw * 16 + i] + d, got = wsp<float>(F, WS_X)[(size_t)m * D + cc[i]];
        if (!(fabsf(got - ex) <= 0.02f + 0.02f * fabsf(ex))) flags |= 64u; }
    if (F.lane == 0 && flags) __hip_atomic_fetch_or((unsigned*)(F.ctl + 16), flags, RLX_AGENT);
}
__device__ __forceinline__ void check_norm3(Frame& F, int layer) {
    const int gw = blockIdx.x * NWAVES + F.wave; const int m = (int)(dbg_hash((unsigned)gw, 4u) % (unsigned)T); const float* x = wsp<float>(F, WS_X) + (size_t)m * D; const float* g = inp(I_GPLE) + (size_t)layer * D;
    float s = 0.f; for (int k = F.lane; k < D; k += 64) s += x[k] * x[k];
    const float rstd = 1.f / sqrtf(wave_sum(s) * (1.f / D) + EPS); unsigned flags = 0u;
    for (int k = F.lane; k < D; k += 64) { const float ex = x[k] * rstd * g[k], got = bf_lo((unsigned)wsp<bf16>(F, WS_H)[(size_t)m * D + k]); if (!(fabsf(got - ex) <= 0.01f + 0.01f * fabsf(ex))) flags |= 256u; }
    if (flags) __hip_atomic_fetch_or((unsigned*)(F.ctl + 16), flags, RLX_AGENT);
}
__device__ __forceinline__ void check_ple(Frame& F, int layer) {
    const int gw = blockIdx.x * NWAVES + F.wave; const int m = (int)(dbg_hash((unsigned)gw, 4u) % (unsigned)T); int cc[4]; for (int i_ = 0; i_ < 4; ++i_) cc[i_] = (int)(dbg_hash((unsigned)gw, 140u + i_) % (unsigned)D); unsigned flags = 0u;
    for (int i = 0; i < 4; ++i) { const float gl = chk_dot_bf(wsp<bf16>(F, WS_H) + (size_t)m * D, D, inp(I_WPG) + (size_t)layer * D * D, D, cc[i], F.lane);
        const float pj = chk_dot_f(inp(I_P) + ((size_t)layer * T + m) * PLE, PLE, inp(I_WPP) + (size_t)layer * PLE * D, D, cc[i], F.lane);
        const float ex = wsp<float>(F, WS_DBG)[(size_t)gw * 16 + 4 + i] + pj / (1.f + expf(-gl)) + DBG_INJECT, got = wsp<float>(F, WS_X)[(size_t)m * D + cc[i]];
        if (!(fabsf(got - ex) <= 0.02f + 0.02f * fabsf(ex))) flags |= 128u; }
    if (F.lane == 0 && flags) __hip_atomic_fetch_or((unsigned*)(F.ctl + 16), flags, RLX_AGENT);
}
#endif

#ifdef DBG_CHECK_ATTN
__device__ __forceinline__ void check_attn(Frame& F, int layer) {
    const int gw = blockIdx.x * NWAVES + F.wave; const int m = (int)(dbg_hash((unsigned)gw, 7u) % (unsigned)T), h = gw & 3, b = m / SEQ;
    const float lam = wsp<float>(F, WS_SCAL)[layer]; const float lam_init = 0.8f - 0.6f * expf(-0.3f * (float)layer), post = 1.f - lam_init;
    const float* gsub = inp(I_GSUB) + layer * VD;
    const bf16* Q = wsp<bf16>(F, WS_Q); const bf16* Kb = wsp<bf16>(F, WS_K) + (size_t)b * SEQ * AQK; const bf16* Vb = wsp<bf16>(F, WS_V) + (size_t)b * SEQ * AV; const bf16* OB = wsp<bf16>(F, WS_OB);
    LAS float* S = (LAS float*)(F.lds) + F.wave * 2048; LAS float* O = (LAS float*)(F.lds + 65536) + F.wave * 256;
    for (int c = 0; c < 2; ++c) {
        float qf[64];
#pragma unroll
        for (int i = 0; i < 8; ++i) { const v4u t = *(const v4u*)(Q + (size_t)m * AQK + h * 128 + c * 64 + i * 8);
            qf[8 * i] = bf_lo(t.x); qf[8 * i + 1] = bf_hi(t.x); qf[8 * i + 2] = bf_lo(t.y); qf[8 * i + 3] = bf_hi(t.y); qf[8 * i + 4] = bf_lo(t.z); qf[8 * i + 5] = bf_hi(t.z); qf[8 * i + 6] = bf_lo(t.w); qf[8 * i + 7] = bf_hi(t.w); }
        float mx = -1e30f;
        for (int i = 0; i < 32; ++i) { const int j = F.lane + 64 * i; const bf16* kr = Kb + (size_t)j * AQK + h * 128 + c * 64; float sc = 0.f;
#pragma unroll
            for (int t8 = 0; t8 < 8; ++t8) { const v4u t = *(const v4u*)(kr + t8 * 8);
                sc += qf[8 * t8] * bf_lo(t.x) + qf[8 * t8 + 1] * bf_hi(t.x) + qf[8 * t8 + 2] * bf_lo(t.y) + qf[8 * t8 + 3] * bf_hi(t.y) + qf[8 * t8 + 4] * bf_lo(t.z) + qf[8 * t8 + 5] * bf_hi(t.z) + qf[8 * t8 + 6] * bf_lo(t.w) + qf[8 * t8 + 7] * bf_hi(t.w); }
            S[j] = sc; mx = fmaxf(mx, sc); }
#pragma unroll
        for (int o = 1; o < 64; o <<= 1) mx = fmaxf(mx, __shfl_xor(mx, o));
        float l = 0.f;
        for (int i = 0; i < 32; ++i) { const int j = F.lane + 64 * i; const float p = exp2f(S[j] - mx); S[j] = p; l += p; }
        l = wave_sum(l);
        for (int ch = 0; ch < 4; ++ch) { float a[32];
#pragma unroll
            for (int k = 0; k < 32; ++k) a[k] = 0.f;
            for (int i = 0; i < 32; ++i) { const int j = F.lane + 64 * i; const float p = S[j]; const bf16* vr = Vb + (size_t)j * AV + h * 128 + ch * 32;
#pragma unroll
                for (int t8 = 0; t8 < 4; ++t8) { const v4u t = *(const v4u*)(vr + t8 * 8);
                    a[8 * t8] += p * bf_lo(t.x); a[8 * t8 + 1] += p * bf_hi(t.x); a[8 * t8 + 2] += p * bf_lo(t.y); a[8 * t8 + 3] += p * bf_hi(t.y); a[8 * t8 + 4] += p * bf_lo(t.z); a[8 * t8 + 5] += p * bf_hi(t.z); a[8 * t8 + 6] += p * bf_lo(t.w); a[8 * t8 + 7] += p * bf_hi(t.w); } }
#pragma unroll
            for (int k = 0; k < 32; ++k) { const float r = wave_sum(a[k]); if (F.lane == 0) O[c * 128 + ch * 32 + k] = r / l; } }
    }
    LDS_WAIT();
    const float d0 = O[F.lane] - lam * O[128 + F.lane], d1 = O[64 + F.lane] - lam * O[128 + 64 + F.lane];
    const float rstd = post / sqrtf(wave_sum(d0 * d0 + d1 * d1) * (1.f / VD) + EPS);
    const float e0 = d0 * rstd * gsub[F.lane], e1 = d1 * rstd * gsub[64 + F.lane];
    const float g0 = bf_lo((unsigned)OB[(size_t)m * AV + h * 128 + F.lane]), g1 = bf_lo((unsigned)OB[(size_t)m * AV + h * 128 + 64 + F.lane]);
    if (!(fabsf(g0 - e0) <= 0.03f + 0.03f * fabsf(e0)) || !(fabsf(g1 - e1) <= 0.03f + 0.03f * fabsf(e1))) __hip_atomic_fetch_or((unsigned*)(F.ctl + 16), 512u, RLX_AGENT);
}
#endif

#ifdef DBG_CHECK_MOE
__device__ __forceinline__ void check_route(Frame& F) {
    const int gw = blockIdx.x * NWAVES + F.wave; const int m = (int)(dbg_hash((unsigned)gw, 6u) % (unsigned)T);
    const float* x = wsp<float>(F, WS_X) + (size_t)m * D; const float* g = inp(I_GFFN) + D; const float* wr = inp(I_WR); const float* br = inp(I_BR);
    float s = 0.f; for (int k = F.lane; k < D; k += 64) s += x[k] * x[k];
    const float rstd = 1.f / sqrtf(wave_sum(s) * (1.f / D) + EPS);
    float lg[8];
#pragma unroll
    for (int e = 0; e < 8; ++e) lg[e] = 0.f;
    for (int k = F.lane; k < D; k += 64) { const float hk = x[k] * rstd * g[k];
#pragma unroll
        for (int e = 0; e < 8; ++e) lg[e] += hk * wr[k * 8 + e]; }
#pragma unroll
    for (int e = 0; e < 8; ++e) lg[e] = wave_sum(lg[e]) + br[e];
    int e1 = 0; float v1 = lg[0];
#pragma unroll
    for (int e = 1; e < 8; ++e) if (lg[e] > v1) { v1 = lg[e]; e1 = e; }
    int e2 = -1; float v2 = -INFINITY;
#pragma unroll
    for (int e = 0; e < 8; ++e) if (e != e1 && lg[e] > v2) { v2 = lg[e]; e2 = e; }
    const float ex = expf(v2 - v1), w1 = 1.f / (1.f + ex), w2 = ex / (1.f + ex);
    const int* rti = wsp<int>(F, WS_RTI) + (size_t)m * 4; const float* rtw = wsp<float>(F, WS_RTW) + (size_t)m * 2;
    const bool tie = (v1 - v2) < 1e-3f;
    bool bad = !(fabsf(rtw[0] + rtw[1] - 1.f) < 1e-3f);
    if (!tie) bad = bad || rti[0] != e1 || rti[2] != e2 || !(fabsf(rtw[0] - w1) < 2e-3f) || !(fabsf(rtw[1] - w2) < 2e-3f);
    if (bad && F.lane == 0) __hip_atomic_fetch_or((unsigned*)(F.ctl + 16), 1024u, RLX_AGENT);
}
__device__ __forceinline__ void check_experts(Frame& F) {
    const int gw = blockIdx.x * NWAVES + F.wave; const int m = (int)(dbg_hash((unsigned)gw, 6u) % (unsigned)T);
    const int* rti = wsp<int>(F, WS_RTI) + (size_t)m * 4; const int* rsel = wsp<int>(F, WS_RSEL) + (size_t)m * 2;
    const bf16* H = wsp<bf16>(F, WS_H) + (size_t)m * D; unsigned flags = 0u;
    for (int t = 0; t < 2; ++t) { const int e = rti[2 * t], r = rsel[t];
        const bf16* hp = wsp<bf16>(F, WS_HP) + (size_t)r * D; const bf16* act = wsp<bf16>(F, WS_ACT) + (size_t)r * FE; const float* y = wsp<float>(F, WS_Y) + (size_t)r * D;
        for (int k = F.lane; k < D; k += 64) if (hp[k] != H[k]) flags |= 2048u;
        const float* wgu = inp(I_WEGU) + (size_t)e * D * 2 * FE; const float* wdn = inp(I_WEDN) + (size_t)e * FE * D;
        int cj[3]; for (int i_ = 0; i_ < 3; ++i_) cj[i_] = (int)(dbg_hash((unsigned)gw, 150u + i_ + 8 * t) % (unsigned)FE);
        for (int i = 0; i < 3; ++i) { float gg = 0.f, uu = 0.f;
            for (int k = F.lane; k < D; k += 64) { const float hk = bf_lo((unsigned)hp[k]); gg += hk * wgu[(size_t)k * (2 * FE) + cj[i]]; uu += hk * wgu[(size_t)k * (2 * FE) + FE + cj[i]]; }
            gg = wave_sum(gg); uu = wave_sum(uu);
            const float ex = gg / (1.f + expf(-gg)) * uu, got = bf_lo((unsigned)act[cj[i]]);
            if (!(fabsf(got - ex) <= 0.03f + 0.03f * fabsf(ex))) flags |= 4096u; }
        int cc[2]; for (int i_ = 0; i_ < 2; ++i_) cc[i_] = (int)(dbg_hash((unsigned)gw, 160u + i_) % (unsigned)D);
        for (int i = 0; i < 2; ++i) { float d = 0.f; for (int k = F.lane; k < FE; k += 64) d += bf_lo((unsigned)act[k]) * wdn[(size_t)k * D + cc[i]];
            d = wave_sum(d); if (!(fabsf(y[cc[i]] - d) <= 0.02f + 0.02f * fabsf(d))) flags |= 8192u; }
    }
    if (F.lane < 2) wsp<float>(F, 3 * MiB + 512 * 1024)[(size_t)gw * 2 + F.lane] = wsp<float>(F, WS_X)[(size_t)m * D + (int)(dbg_hash((unsigned)gw, 160u + F.lane) % (unsigned)D)];
    if (flags) __hip_atomic_fetch_or((unsigned*)(F.ctl + 16), flags, RLX_AGENT);
}
__device__ __forceinline__ void check_combine(Frame& F) {
    const int gw = blockIdx.x * NWAVES + F.wave; const int m = (int)(dbg_hash((unsigned)gw, 6u) % (unsigned)T);
    const int* rsel = wsp<int>(F, WS_RSEL) + (size_t)m * 2; const float* rtw = wsp<float>(F, WS_RTW) + (size_t)m * 2; const float* Y = wsp<float>(F, WS_Y);
    if (F.lane < 2) { const int c = (int)(dbg_hash((unsigned)gw, 160u + F.lane) % (unsigned)D);
        const float ex = wsp<float>(F, 3 * MiB + 512 * 1024)[(size_t)gw * 2 + F.lane] + rtw[0] * Y[(size_t)rsel[0] * D + c] + rtw[1] * Y[(size_t)rsel[1] * D + c], got = wsp<float>(F, WS_X)[(size_t)m * D + c];
        if (!(fabsf(got - ex) <= 1e-3f + 1e-3f * fabsf(ex))) __hip_atomic_fetch_or((unsigned*)(F.ctl + 16), 16384u, RLX_AGENT); }
}
#endif

__device__ __forceinline__ void attn_naive_phase(Frame& F, int layer) {
    const float lam = wsp<float>(F, WS_SCAL)[layer]; const float lam_init = 0.8f - 0.6f * expf(-0.3f * (float)layer), post = 1.f - lam_init;
    const float* gsub = inp(I_GSUB) + layer * VD;
    const bf16* Q = wsp<bf16>(F, WS_Q); const bf16* Kb = wsp<bf16>(F, WS_K); const bf16* Vb = wsp<bf16>(F, WS_V); bf16* OB = wsp<bf16>(F, WS_OB);
    for (int unit = blockIdx.x; unit < BATCH * NH * (SEQ / 256); unit += F.G) {
        const int b = unit >> 5, h = (unit >> 3) & 3, qb = unit & 7, q = qb * 256 + (F.tid >> 1), c = F.tid & 1;
        const bf16* qp = Q + ((size_t)(b * SEQ + q)) * AQK + h * 128 + c * 64;
        unsigned qv[32];
#pragma unroll
        for (int i = 0; i < 8; ++i) { const v4u t = *(const v4u*)(qp + i * 8); qv[4 * i] = t.x; qv[4 * i + 1] = t.y; qv[4 * i + 2] = t.z; qv[4 * i + 3] = t.w; }
        float o[128];
#pragma unroll
        for (int e = 0; e < 128; ++e) o[e] = 0.f;
        float mx = -1e30f, l = 0.f;
        const bf16* kp = Kb + (size_t)b * SEQ * AQK + h * 128 + c * 64; const bf16* vp = Vb + (size_t)b * SEQ * AV + h * 128;
        for (int key = 0; key < SEQ; ++key) {
            float s = 0.f;
#pragma unroll
            for (int i = 0; i < 8; ++i) { const v4u kk = *(const v4u*)(kp + (size_t)key * AQK + i * 8);
                s += bf_lo(qv[4 * i]) * bf_lo(kk.x) + bf_hi(qv[4 * i]) * bf_hi(kk.x) + bf_lo(qv[4 * i + 1]) * bf_lo(kk.y) + bf_hi(qv[4 * i + 1]) * bf_hi(kk.y)
                   + bf_lo(qv[4 * i + 2]) * bf_lo(kk.z) + bf_hi(qv[4 * i + 2]) * bf_hi(kk.z) + bf_lo(qv[4 * i + 3]) * bf_lo(kk.w) + bf_hi(qv[4 * i + 3]) * bf_hi(kk.w); }
            const float mn = fmaxf(mx, s), alpha = __builtin_amdgcn_exp2f(mx - mn), p = __builtin_amdgcn_exp2f(s - mn); mx = mn; l = l * alpha + p;
#pragma unroll
            for (int i = 0; i < 16; ++i) { const v4u vv = *(const v4u*)(vp + (size_t)key * AV + i * 8);
                o[8 * i + 0] = o[8 * i + 0] * alpha + p * bf_lo(vv.x); o[8 * i + 1] = o[8 * i + 1] * alpha + p * bf_hi(vv.x);
                o[8 * i + 2] = o[8 * i + 2] * alpha + p * bf_lo(vv.y); o[8 * i + 3] = o[8 * i + 3] * alpha + p * bf_hi(vv.y);
                o[8 * i + 4] = o[8 * i + 4] * alpha + p * bf_lo(vv.z); o[8 * i + 5] = o[8 * i + 5] * alpha + p * bf_hi(vv.z);
                o[8 * i + 6] = o[8 * i + 6] * alpha + p * bf_lo(vv.w); o[8 * i + 7] = o[8 * i + 7] * alpha + p * bf_hi(vv.w); }
        }
        const float inv = 1.f / l; float rs = 0.f;
#pragma unroll
        for (int e = 0; e < 128; ++e) { const float mine = o[e] * inv, other = __shfl_xor(mine, 1); const float d = (c == 0) ? (mine - lam * other) : (other - lam * mine); o[e] = d; rs += d * d; }
        const float rstd = 1.f / sqrtf(rs * (1.f / VD) + EPS) * post;
        bf16* op = OB + ((size_t)(b * SEQ + q)) * AV + h * 128 + c * 64;
#pragma unroll
        for (int i = 0; i < 8; ++i) { float y[8];
#pragma unroll
            for (int j = 0; j < 8; ++j) y[j] = (c ? o[64 + 8 * i + j] : o[8 * i + j]) * rstd * gsub[c * 64 + 8 * i + j];
            v4u w; w.x = pk2(y[0], y[1]); w.y = pk2(y[2], y[3]); w.z = pk2(y[4], y[5]); w.w = pk2(y[6], y[7]); *(v4u*)(op + 8 * i) = w; }
    }
}

namespace dattn {
using bf16x8 = __attribute__((ext_vector_type(8))) short;
using s16x4  = __attribute__((ext_vector_type(4))) short;
using f32x16 = __attribute__((ext_vector_type(16))) float;
using u32x4  = __attribute__((ext_vector_type(4))) unsigned;
constexpr int NW = 8, QBLK = 32, KVBLK = 64, LDK = 512;
constexpr float THRL = 11.5f;
constexpr size_t SHM_V = KVBLK * 128 * 2, SHM_K = KVBLK * 128 * 2, SHM_ATTN = 2 * SHM_V + 2 * SHM_K + NW * 64 * 4;
#define KSWZ(row, colB) ((row) * 256 + ((colB) ^ (((row) & 7) << 4)))
#define SBAR() __builtin_amdgcn_sched_barrier(0)
__device__ __forceinline__ int crow(int r, int hi) { return (r & 3) + 8 * (r >> 2) + 4 * hi; }
__device__ __forceinline__ unsigned cvtpk(float lo, float hi) { return pg8::cvt_pk_bf16(lo, hi); }
__device__ __forceinline__ void partialSM(f32x16& p0, f32x16& p1, float& m_reg, float& mn, float& alpha) {
  float pmax = p0[0]; for (int r = 1; r < 16; ++r) pmax = fmaxf(pmax, p0[r]); for (int r = 0; r < 16; ++r) pmax = fmaxf(pmax, p1[r]);
  { auto rr = __builtin_amdgcn_permlane32_swap(__float_as_uint(pmax), __float_as_uint(pmax), false, false);
    pmax = fmaxf(__uint_as_float(rr[0]), __uint_as_float(rr[1])); }
  if (__builtin_expect(__all(pmax - m_reg <= THRL), 1)) { mn = m_reg; alpha = 1.f; }
  else { mn = fmaxf(m_reg, pmax); alpha = __builtin_amdgcn_exp2f(m_reg - mn); m_reg = mn; }
  for (int r = 0; r < 16; ++r) p0[r] = p0[r] - mn; for (int r = 0; r < 16; ++r) p1[r] = p1[r] - mn;
  for (int r = 0; r < 16; ++r) p0[r] = __builtin_amdgcn_exp2f(p0[r]);
}
__device__ __forceinline__ void finishSM(f32x16& p0, f32x16& p1, float alpha, float& l_reg, bf16x8& pa0, bf16x8& pa1, bf16x8& pa2, bf16x8& pa3) {
  for (int r = 0; r < 16; ++r) p1[r] = __builtin_amdgcn_exp2f(p1[r]);
  float ps = 0; for (int r = 0; r < 16; ++r) ps += p0[r]; for (int r = 0; r < 16; ++r) ps += p1[r];
  { auto rr = __builtin_amdgcn_permlane32_swap(__float_as_uint(ps), __float_as_uint(ps), false, false);
    ps = __uint_as_float(rr[0]) + __uint_as_float(rr[1]); }
  l_reg = l_reg * alpha + ps;
#define PK4(P, BASE, OUT) do { unsigned a0 = cvtpk(P[BASE + 0], P[BASE + 1]), a1 = cvtpk(P[BASE + 2], P[BASE + 3]);   \
    unsigned b0 = cvtpk(P[BASE + 4], P[BASE + 5]), b1 = cvtpk(P[BASE + 6], P[BASE + 7]);                              \
    auto r0 = __builtin_amdgcn_permlane32_swap(a0, b0, false, false); auto r1 = __builtin_amdgcn_permlane32_swap(a1, b1, false, false); \
    u32x4 w = {r0[0], r1[0], r0[1], r1[1]}; OUT = *reinterpret_cast<bf16x8*>(&w); } while (0)
  PK4(p0, 0, pa0); PK4(p0, 8, pa1); PK4(p1, 0, pa2); PK4(p1, 8, pa3);
#undef PK4
}
__device__ __forceinline__ void qkt(f32x16& p0, f32x16& p1, const char* Ks, const bf16x8* qr, int r32, int hi, int c) {
  p0 = f32x16{}; p1 = f32x16{};
  for (int d0 = 0; d0 < 4; ++d0) { int cb = (c * 64 + d0 * 16 + hi * 8) * 2;
    bf16x8 b0 = *reinterpret_cast<const bf16x8*>(Ks + KSWZ(r32, cb));
    bf16x8 b1 = *reinterpret_cast<const bf16x8*>(Ks + KSWZ(32 + r32, cb));
    p0 = __builtin_amdgcn_mfma_f32_32x32x16_bf16(b0, qr[d0], p0, 0, 0, 0);
    p1 = __builtin_amdgcn_mfma_f32_32x32x16_bf16(b1, qr[d0], p1, 0, 0, 0); }
}
__device__ __forceinline__ int v_st(int k, int c) { const int kk = (k & ~0xC) | ((k & 4) << 1) | ((k & 8) >> 1); return ((kk >> 3) * 4 + (c >> 5)) * 512 + ((kk & 7) * 32 + (c & 31)) * 2; }
__device__ __forceinline__ int v_rd_base(int lane) { return ((lane & 3) << 3) | (((lane >> 2) & 3) << 6) | (((lane >> 4) & 1) << 5) | (((lane >> 5) & 1) << 8); }
constexpr int v_rd_off(int d0, int ks, int half) { return d0 * 512 + ks * 4096 + half * 2048; }
template <int OFF> __device__ __forceinline__ s16x4 tr_read(int vb) {
  s16x4 r; asm volatile("ds_read_b64_tr_b16 %0, %1 offset:%2" : "=&v"(r) : "v"(vb), "i"(OFF) : "memory"); return r;
}
template <int D0> __device__ __forceinline__ void pv_one(f32x16& od, int vb, bf16x8 pa0, bf16x8 pa1, bf16x8 pa2, bf16x8 pa3) {
  const s16x4 l0 = tr_read<v_rd_off(D0, 0, 0)>(vb), h0 = tr_read<v_rd_off(D0, 0, 1)>(vb), l1 = tr_read<v_rd_off(D0, 1, 0)>(vb), h1 = tr_read<v_rd_off(D0, 1, 1)>(vb);
  const s16x4 l2 = tr_read<v_rd_off(D0, 2, 0)>(vb), h2 = tr_read<v_rd_off(D0, 2, 1)>(vb), l3 = tr_read<v_rd_off(D0, 3, 0)>(vb), h3 = tr_read<v_rd_off(D0, 3, 1)>(vb);
  asm volatile("s_waitcnt lgkmcnt(0)" ::: "memory"); SBAR();
#define PK(L, H) (bf16x8){L[0], L[1], L[2], L[3], H[0], H[1], H[2], H[3]}
  od = __builtin_amdgcn_mfma_f32_32x32x16_bf16(pa0, PK(l0, h0), od, 0, 0, 0);
  od = __builtin_amdgcn_mfma_f32_32x32x16_bf16(pa1, PK(l1, h1), od, 0, 0, 0);
  od = __builtin_amdgcn_mfma_f32_32x32x16_bf16(pa2, PK(l2, h2), od, 0, 0, 0);
  od = __builtin_amdgcn_mfma_f32_32x32x16_bf16(pa3, PK(l3, h3), od, 0, 0, 0);
#undef PK
}
__device__ __forceinline__ void pv_d0(f32x16* o, int vb, bf16x8 pa0, bf16x8 pa1, bf16x8 pa2, bf16x8 pa3) {
  pv_one<0>(o[0], vb, pa0, pa1, pa2, pa3); pv_one<1>(o[1], vb, pa0, pa1, pa2, pa3); pv_one<2>(o[2], vb, pa0, pa1, pa2, pa3); pv_one<3>(o[3], vb, pa0, pa1, pa2, pa3);
}
__device__ __forceinline__ void unit(const unsigned short* Qb, const unsigned short* Kh, const unsigned short* Vh, unsigned short* Ob, int seq, char* lds, float lam, float post, const float* gsub) {
  int tid_ = threadIdx.x; asm volatile("" : "+v"(tid_));
  const int tid = tid_, wid = tid >> 6, lane = tid & 63, r32 = lane & 31, hi = lane >> 5, c = wid >> 2, wq = wid & 3;
  char* V_lds = lds; char* K_lds = lds + 2 * SHM_V;
  float* ws = (float*)(lds + 2 * SHM_V + 2 * SHM_K) + wid * 64; float* li_l = ws; float* al_l = ws + 32;
  float m_reg = -1e30f, l_reg = 0; f32x16 o[4] = {}; bf16x8 qr[4];
  const unsigned short* Qw = Qb + (long)(wq * QBLK + r32) * LDK + c * 64 + hi * 8;
#pragma unroll
  for (int d0 = 0; d0 < 4; ++d0) qr[d0] = *reinterpret_cast<const bf16x8*>(Qw + d0 * 16);
  const int sr = tid >> 4, sc = (tid & 15) * 8, vst0 = v_st(sr, sc), vst1 = v_st(32 + sr, sc);
  const int vb0 = (int)(uintptr_t)V_lds + v_rd_base(lane);
  struct { bf16x8 vs0, vs1, ks0, ks1; } sr_[2];
#define SLOAD(i, k0) do { sr_[i].vs0 = *reinterpret_cast<const bf16x8*>(&Vh[(long)((k0) + sr) * LDK + sc]); sr_[i].vs1 = *reinterpret_cast<const bf16x8*>(&Vh[(long)((k0) + 32 + sr) * LDK + sc]); \
    sr_[i].ks0 = *reinterpret_cast<const bf16x8*>(&Kh[(long)((k0) + sr) * LDK + sc]); sr_[i].ks1 = *reinterpret_cast<const bf16x8*>(&Kh[(long)((k0) + 32 + sr) * LDK + sc]); } while (0)
#define SWRITE(b, i) do { *(bf16x8*)(V_lds + (b) * SHM_V + vst0) = sr_[i].vs0; *(bf16x8*)(V_lds + (b) * SHM_V + vst1) = sr_[i].vs1; int kc = sc * 2; \
    *(bf16x8*)(K_lds + (b) * SHM_K + KSWZ(sr, kc)) = sr_[i].ks0; *(bf16x8*)(K_lds + (b) * SHM_K + KSWZ(32 + sr, kc)) = sr_[i].ks1; } while (0)
#define SWAIT() asm volatile("s_waitcnt vmcnt(4)" ::: "memory")
#define RESC(a) do { if (__any((a) < 1.f)) { if (hi == 0) al_l[r32] = (a); asm volatile("s_waitcnt lgkmcnt(0)" ::: "memory"); \
    for (int d = 0; d < 4; ++d) for (int r = 0; r < 16; ++r) o[d][r] *= al_l[crow(r, hi)]; } } while (0)
  f32x16 pA0, pA1, pB0, pB1; float mnA, mnB, alA, alB; bf16x8 pa0, pa1, pa2, pa3; const int NT = seq / KVBLK;
  constexpr int SE = 0, SO = 1;
  SLOAD(SE, 0); asm volatile("s_waitcnt vmcnt(0)" ::: "memory"); SWRITE(0, SE); __syncthreads();
  qkt(pA0, pA1, K_lds, qr, r32, hi, c); partialSM(pA0, pA1, m_reg, mnA, alA);
  SLOAD(SO, KVBLK); if (2 < NT) SLOAD(SE, 2 * KVBLK);
  SWAIT(); SWRITE(1, SO); __syncthreads();
  for (int j = 1; j + 1 < NT; j += 2) {
    SBAR(); qkt(pB0, pB1, K_lds + SHM_K, qr, r32, hi, c);
    finishSM(pA0, pA1, alA, l_reg, pa0, pa1, pa2, pa3); SBAR();
    SLOAD(SO, (j + 2) * KVBLK); SBAR();
    pv_d0(o, vb0, pa0, pa1, pa2, pa3); partialSM(pB0, pB1, m_reg, mnB, alB);
    __syncthreads(); SWAIT(); SWRITE(0, SE);
    RESC(alB); __syncthreads();
    SBAR(); qkt(pA0, pA1, K_lds, qr, r32, hi, c);
    finishSM(pB0, pB1, alB, l_reg, pa0, pa1, pa2, pa3); SBAR();
    if (j + 3 < NT) SLOAD(SE, (j + 3) * KVBLK); SBAR();
    pv_d0(o, vb0 + (int)SHM_V, pa0, pa1, pa2, pa3); partialSM(pA0, pA1, m_reg, mnA, alA);
    __syncthreads(); SWAIT(); SWRITE(1, SO);
    RESC(alA); __syncthreads();
  }
  SBAR(); qkt(pB0, pB1, K_lds + SHM_K, qr, r32, hi, c);
  finishSM(pA0, pA1, alA, l_reg, pa0, pa1, pa2, pa3); SBAR();
  pv_d0(o, vb0, pa0, pa1, pa2, pa3); partialSM(pB0, pB1, m_reg, mnB, alB);
  __syncthreads(); RESC(alB);
  finishSM(pB0, pB1, alB, l_reg, pa0, pa1, pa2, pa3); SBAR();
  pv_d0(o, vb0 + (int)SHM_V, pa0, pa1, pa2, pa3);
  if (hi == 0) li_l[r32] = l_reg; asm volatile("s_waitcnt vmcnt(0) lgkmcnt(0)" ::: "memory");
  float rli[16];
#pragma unroll
  for (int r = 0; r < 16; ++r) rli[r] = __builtin_amdgcn_rcpf(li_l[crow(r, hi)]);
  __syncthreads();
  float* xch = (float*)lds + (size_t)wq * 64 * 64 + lane;
  if (c == 1) {
#pragma unroll
    for (int d0 = 0; d0 < 4; ++d0)
#pragma unroll
      for (int r = 0; r < 16; ++r) xch[(d0 * 16 + r) * 64] = o[d0][r] * rli[r] * lam;
  }
  __syncthreads();
  if (c == 0) {
    float ss[16];
#pragma unroll
    for (int r = 0; r < 16; ++r) { float a = 0.f;
#pragma unroll
      for (int d0 = 0; d0 < 4; ++d0) { const float d = o[d0][r] * rli[r] - xch[(d0 * 16 + r) * 64]; o[d0][r] = d; a += d * d; }
      ss[r] = a; }
#pragma unroll
    for (int r = 0; r < 16; ++r) {
#pragma unroll
      for (int off = 1; off < 32; off <<= 1) ss[r] += __shfl_xor(ss[r], off);
      ss[r] = post / sqrtf(ss[r] * (1.f / 128.f) + 1e-6f); }
    float gs[4];
#pragma unroll
    for (int d0 = 0; d0 < 4; ++d0) gs[d0] = gsub[32 * d0 + r32];
    unsigned short* Ow = Ob + (long)(wq * QBLK) * LDK;
#pragma unroll
    for (int r = 0; r < 16; ++r) { const int orow = crow(r, hi);
#pragma unroll
      for (int d0 = 0; d0 < 4; ++d0) Ow[(long)orow * LDK + d0 * 32 + r32] = (unsigned short)f2bf(o[d0][r] * ss[r] * gs[d0]); }
  }
  __syncthreads();
#undef SLOAD
#undef SWRITE
#undef SWAIT
#undef RESC
}
#undef KSWZ
#undef SBAR
}

__device__ __forceinline__ void attn_mfma_phase(Frame& F, int layer) {
    const float lam = wsp<float>(F, WS_SCAL)[layer]; const float lam_init = 0.8f - 0.6f * expf(-0.3f * (float)layer), post = 1.f - lam_init;
    const float* gsub = inp(I_GSUB) + layer * VD;
    const bf16* Q = wsp<bf16>(F, WS_Q); const bf16* Kb = wsp<bf16>(F, WS_K); const bf16* Vb = wsp<bf16>(F, WS_V); bf16* OB = wsp<bf16>(F, WS_OB);
    for (int u = blockIdx.x; u < BATCH * NH * (SEQ / 128); u += F.G) {
        const int b = u >> 6, h = (u >> 4) & 3, qb = u & 15;
        const size_t rb = (size_t)b * SEQ;
        dattn::unit(Q + (rb + qb * 128) * AQK + h * 128, Kb + rb * AQK + h * 128, Vb + rb * AV + h * 128, OB + (rb + qb * 128) * AV + h * 128, SEQ, (char*)F.lds, lam, post, gsub);
    }
}

constexpr int NSTEP = 11, NPH = 1 + DEPTH * NSTEP;
struct Args { const float* in[N_IN]; float* out; unsigned char* ws; int ph_lo, ph_hi, pass, pad; };
#ifndef DBG_SITES
#define DBG_SITES 0xFF
#endif
#define GEMM_SITE(ID, EpiT, g, S, E) do { if (!((DBG_SITES >> (ID)) & 1)) {} else if ((MK_NAIVE_GEMM >> (ID)) & 1) pg8::gemm_phase_naive<EpiT, pg8::GroupOrder>(g, S, E); \
    else pg8::gemm_phase<EpiT, pg8::GroupOrder, MK_ALIGN, MK_SP2>(F.lds + RING_OFF, g, S, E); } while (0)

__global__ void __launch_bounds__(NWAVES * 64, 2) mk_fwd(Args args) {
    extern __shared__ __attribute__((aligned(16))) unsigned char lds[];
    Frame F;
    F.lds = (LAS unsigned char*)lds;
    F.MISC = (volatile LAS unsigned*)(F.lds + MISC_OFF);
    F.tid = threadIdx.x; F.lane = F.tid & 63; F.wave = __builtin_amdgcn_readfirstlane(F.tid >> 6);
    F.G = gridDim.x; F.ws = (GAS unsigned char*)args.ws; F.ctl = (gu32*)(F.ws + WS_CTL);
    for (int u = F.tid; u < (LDS_BYTES - LDSCTL_OFF) / 4; u += NWAVES * 64) ((LAS unsigned*)(F.lds + LDSCTL_OFF))[u] = 0u;
    __syncthreads();
    const int lo = args.ph_lo, hi = args.ph_hi;
#ifdef DBG_START_DELAY
    if (lo == 0) { const unsigned long long t0 = __builtin_amdgcn_s_memrealtime(); while (__builtin_amdgcn_s_memrealtime() - t0 < (unsigned long long)DBG_START_DELAY) __builtin_amdgcn_s_sleep(32); }
#endif
    XcdBarrier bar; bar.bar = (unsigned*)(F.ctl + CW_BAR); bar.x = 0; bar.st = nullptr;
    if (hi - lo > 1) bar = xcd_barrier_post((unsigned*)(F.ctl + CW_BAR), F.MISC + 8);
#define PHASE_BEGIN() do { const CAS unsigned char* k_ = (const CAS unsigned char*)__builtin_amdgcn_kernarg_segment_ptr(); asm volatile("" : "+s"(k_)); \
    F.ws = *(GAS unsigned char* const CAS*)(k_ + 8 * (N_IN + 1)); F.ctl = (gu32*)(F.ws + WS_CTL); int t_ = threadIdx.x; asm volatile("" : "+v"(t_)); \
    F.tid = t_; F.lane = t_ & 63; F.wave = __builtin_amdgcn_readfirstlane(t_ >> 6); F.G = gridDim.x; } while (0)
#define IN(k) (lo <= (k) && (k) < hi)
#define SEAM(k) do { if (IN(k) && IN((k) + 1)) xcd_barrier(bar); } while (0)
#define H wsp<bf16>(F, WS_H)
#define X wsp<float>(F, WS_X)

#ifdef DBG_STOP
    if (lo == 100) {
        PHASE_BEGIN();
        float* o = outp(); const size_t gt = (size_t)blockIdx.x * (NWAVES * 64) + F.tid, NGT = (size_t)F.G * NWAVES * 64;
        for (size_t i = gt; i < (size_t)T * D; i += NGT) { float v = 0.f;
#define DG_BF(off, len) v += bf_lo((unsigned)wsp<bf16>(F, off)[i % (size_t)(len)]);
#define DG_F32(off, len) v += wsp<float>(F, off)[i % (size_t)(len)];
            DBG_DIGEST
            o[i] = v; }
        return;
    }
#endif
#ifdef DBG_TWOPASS
#define CW_CK 2048
#define CK(slot, off, bytes) cksum(F, off, bytes, CW_CK + dbg_pass * 64 + (slot))
#define CKBAR() xcd_barrier(bar)
    const int dbg_pass = args.pass;
#else
#define CK(slot, off, bytes) do {} while (0)
#define CKBAR() do {} while (0)
#endif
    if (IN(0)) { PHASE_BEGIN(); p0_prologue(F); }
    SEAM(0);
#ifdef DBG_TWOPASS
    { PHASE_BEGIN(); CK(0, WS_WIN, WS_X - WS_WIN); CK(0, WS_H, (size_t)T * D * 2); CK(0, WS_PB, (size_t)2 * T * PLE * 2); CK(0, WS_ROPE, (size_t)SEQ * 64 * 4); CKBAR(); }
#endif

#pragma nounroll
    for (int layer = 0; layer < DEPTH; ++layer) {
        const int pb = 1 + layer * NSTEP;
#ifdef DBG_SKIP_MOE
        const bool moe = false; const bool skipffn = (layer & 1) != 0;
#elif defined(DBG_SKIP_DENSE)
        const bool moe = (layer & 1) != 0; const bool skipffn = (layer & 1) == 0;
#else
        const bool moe = (layer & 1) != 0; const bool skipffn = false;
#endif
        if (IN(pb + 0)) { PHASE_BEGIN();
            if (layer == 0) {
                pg8::Gemm g{wsp<bf16>(F, WS_PB), wsp<bf16>(F, WS_WPP), 2 * T, D, PLE}; pg8::GroupOrder S; S.init_equal(2, T, D, F.G, (int)blockIdx.x, (LAS int*)(F.lds + TP_OFF));
                pg8::EpiStore E{wsp<bf16>(F, WS_PROJ), D, D / 256};
                GEMM_SITE(0, pg8::EpiStore, g, S, E);
            }
            pg8::Gemm g{H, wsp<bf16>(F, WS_WIN) + (size_t)layer * INC * D, T, INC, D}; pg8::GroupOrder S; S.init_dense(T, INC, F.G, (int)blockIdx.x);
            pg8::EpiInProj E{wsp<bf16>(F, WS_Q), wsp<bf16>(F, WS_K), wsp<bf16>(F, WS_V), wsp<bf16>(F, WS_Z), wsp<bf16>(F, WS_SG), wsp<float>(F, WS_ROPE), QSCALE};
            GEMM_SITE(1, pg8::EpiInProj, g, S, E);
        }
        SEAM(pb + 0);
#ifdef DBG_TWOPASS
        { PHASE_BEGIN(); CK(pb + 0, WS_Q, 128 * MiB); if (layer == 0) CK(pb + 0, WS_PROJ, (size_t)2 * T * D * 2); if (layer == 1) { CK(32, WS_Q, 16 * MiB); CK(33, WS_K, 16 * MiB); CK(34, WS_V, 16 * MiB); CK(35, WS_Z, 16 * MiB); CK(36, WS_SG, 64 * MiB); } CKBAR(); }
#endif
        if (IN(pb + 1)) { PHASE_BEGIN();
#ifdef DBG_CHECK_INPROJ
            if (layer == DBG_LAYER) check_inproj(F, layer);
#endif
#if !defined(DBG_NO_ATTN) && MK_NAIVE_ATTN
            attn_naive_phase(F, layer);
#elif !defined(DBG_NO_ATTN)
            attn_mfma_phase(F, layer);
#else
            { bf16* ob = wsp<bf16>(F, WS_OB); const size_t gt = (size_t)blockIdx.x * (NWAVES * 64) + F.tid, NGT = (size_t)F.G * NWAVES * 64;
              for (size_t i = gt; i < (size_t)T * AV / 8; i += NGT) *(v4u*)(ob + i * 8) = (v4u){0u, 0u, 0u, 0u}; }
#endif
#if defined(DBG_NAIVE_CONV)
            conv_naive_phase(F, layer);
#elif !defined(DBG_NO_CONV)
            conv_phase(F, layer);
#else
            { bf16* ob = wsp<bf16>(F, WS_ZC); const size_t gt = (size_t)blockIdx.x * (NWAVES * 64) + F.tid, NGT = (size_t)F.G * NWAVES * 64;
              for (size_t i = gt; i < (size_t)T * CCH / 8; i += NGT) *(v4u*)(ob + i * 8) = (v4u){0u, 0u, 0u, 0u}; }
#endif
        }
        SEAM(pb + 1);
#ifdef DBG_CHECK_ATTN
        if (layer == DBG_CHECK_ATTN - 1) { PHASE_BEGIN(); check_attn(F, layer); xcd_barrier(bar); }
#endif
#ifdef DBG_TWOPASS
        { PHASE_BEGIN(); CK(pb + 1, WS_OB, 32 * MiB); CKBAR(); }
#endif
        if (IN(pb + 2)) { PHASE_BEGIN();
            { pg8::Gemm g{wsp<bf16>(F, WS_OB), wsp<bf16>(F, WS_WA) + (size_t)layer * D * AV, T, D, AV}; pg8::GroupOrder S; S.init_dense(T, D, F.G, (int)blockIdx.x);
              pg8::EpiGate<0> E{wsp<float>(F, WS_P), wsp<bf16>(F, WS_MIX), wsp<bf16>(F, WS_SG)};
              GEMM_SITE(2, pg8::EpiGate<0>, g, S, E); }
            { pg8::Gemm g{wsp<bf16>(F, WS_ZC), wsp<bf16>(F, WS_WC) + (size_t)layer * D * CCH, T, D, CCH}; pg8::GroupOrder S; S.init_dense(T, D, F.G, (int)blockIdx.x);
              pg8::EpiGate<1> E{wsp<float>(F, WS_P), wsp<bf16>(F, WS_MIX), wsp<bf16>(F, WS_SG)};
              GEMM_SITE(3, pg8::EpiGate<1>, g, S, E); }
        }
        SEAM(pb + 2);
#ifdef DBG_CHECK_MIX
        if (layer == DBG_LAYER) { PHASE_BEGIN(); check_mix(F, layer); snap_wo(F); xcd_barrier(bar); }
#endif
#ifdef DBG_TWOPASS
        { PHASE_BEGIN(); CK(pb + 2, WS_P, 96 * MiB); CKBAR(); }
#endif
        if (IN(pb + 3)) { PHASE_BEGIN();
            pg8::Gemm g{wsp<bf16>(F, WS_MIX), wsp<bf16>(F, WS_WO) + (size_t)layer * D * D, T, D, D}; pg8::GroupOrder S; S.init_dense(T, D, F.G, (int)blockIdx.x);
            pg8::EpiResid E{layer == 0 ? inp(I_X) : (const float*)X, X, D / 256};
            GEMM_SITE(4, pg8::EpiResid, g, S, E);
        }
        SEAM(pb + 3);
#ifdef DBG_CHECK_MIX
        if (layer == DBG_LAYER) { PHASE_BEGIN(); check_wo(F, layer); xcd_barrier(bar); }
#endif
#ifdef DBG_TWOPASS
        { PHASE_BEGIN(); CK(pb + 3, WS_X, (size_t)T * D * 4); CKBAR(); }
#endif
        if (IN(pb + 4)) { PHASE_BEGIN();
            if (moe) route_phase(F, X, inp(I_GFFN) + (size_t)layer * D, H);
            else norm_rows(F, X, inp(I_GFFN) + (size_t)layer * D, H);
        }
        SEAM(pb + 4);
#ifdef DBG_CHECK_MOE
        if (moe) { PHASE_BEGIN(); check_route(F); xcd_barrier(bar); }
#endif
#ifdef DBG_TWOPASS
        { PHASE_BEGIN(); CK(pb + 4, WS_H, (size_t)T * D * 2); if (moe) CK(pb + 4, WS_RTW, (size_t)T * 8); CKBAR(); }
#endif
        if (moe) {
            if (IN(pb + 5)) { PHASE_BEGIN(); scatter_phase(F); }
            SEAM(pb + 5);
        }
        if (IN(pb + 6) && !skipffn) { PHASE_BEGIN();
            pg8::Gemm g; pg8::GroupOrder S; pg8::EpiSwiGLU E;
            if (moe) { unsigned cnt[8]; load_counts(F, cnt); g = pg8::Gemm{wsp<bf16>(F, WS_HP), wsp<bf16>(F, WS_WEGU), MOE_ROWS, 2 * FE, D}; S.init_counts(cnt, 2 * FE, F.G, (int)blockIdx.x, (LAS int*)(F.lds + TP_OFF)); E = pg8::EpiSwiGLU{wsp<bf16>(F, WS_ACT), FE, 2 * FE / 256}; }
            else { g = pg8::Gemm{H, wsp<bf16>(F, WS_WFGU), T, 2 * FF, D}; S.init_dense(T, 2 * FF, F.G, (int)blockIdx.x); E = pg8::EpiSwiGLU{wsp<bf16>(F, WS_ACT), FF, 2 * FF / 256}; }
            GEMM_SITE(5, pg8::EpiSwiGLU, g, S, E);
        }
        SEAM(pb + 6);
#ifdef DBG_CHECK_FFN
        if (layer == 0) { PHASE_BEGIN(); snap_x(F, 0, 2); xcd_barrier(bar); }
#endif
#ifdef DBG_CHECK_ACT
        if (layer == 0) { PHASE_BEGIN(); check_act(F); xcd_barrier(bar); }
#endif
#ifdef DBG_TWOPASS
        { PHASE_BEGIN(); if (!moe) CK(pb + 6, WS_ACT, (size_t)T * FF * 2); CKBAR(); }
#endif
        if (IN(pb + 7) && !skipffn) { PHASE_BEGIN();
            pg8::Gemm g; pg8::GroupOrder S; pg8::EpiResid E;
            if (moe) { unsigned cnt[8]; load_counts(F, cnt); g = pg8::Gemm{wsp<bf16>(F, WS_ACT), wsp<bf16>(F, WS_WEDN), MOE_ROWS, D, FE}; S.init_counts(cnt, D, F.G, (int)blockIdx.x, (LAS int*)(F.lds + TP_OFF)); E = pg8::EpiResid{nullptr, wsp<float>(F, WS_Y), D / 256}; }
            else { g = pg8::Gemm{wsp<bf16>(F, WS_ACT), wsp<bf16>(F, WS_WFDN), T, D, FF}; S.init_dense(T, D, F.G, (int)blockIdx.x); E = pg8::EpiResid{X, X, D / 256}; }
            GEMM_SITE(6, pg8::EpiResid, g, S, E);
        }
        SEAM(pb + 7);
#ifdef DBG_CHECK_MOE
        if (moe) { PHASE_BEGIN(); check_experts(F); xcd_barrier(bar); }
#endif
#ifdef DBG_CHECK_FFN
        if (layer == 0) { PHASE_BEGIN(); check_down(F); xcd_barrier(bar); }
#endif
#ifdef DBG_TWOPASS
        { PHASE_BEGIN(); if (!moe) CK(pb + 7, WS_X, (size_t)T * D * 4); CKBAR(); }
#endif
        if (IN(pb + 8)) { PHASE_BEGIN();
            if (moe) combine_norm_phase(F, X, inp(I_GPLE) + (size_t)layer * D, H);
            else norm_rows(F, X, inp(I_GPLE) + (size_t)layer * D, H);
        }
        SEAM(pb + 8);
#ifdef DBG_CHECK_MOE
        if (moe) { PHASE_BEGIN(); check_combine(F); xcd_barrier(bar); }
#endif
#ifdef DBG_CHECK_FFN
        if (layer == DBG_LAYER) { PHASE_BEGIN(); check_norm3(F, layer); snap_x(F, 1, 4); xcd_barrier(bar); }
#endif
#ifdef DBG_TWOPASS
        { PHASE_BEGIN(); CK(pb + 8, WS_X, (size_t)T * D * 4); CK(pb + 8, WS_H, (size_t)T * D * 2); CKBAR(); }
#endif
#ifdef DBG_SKIP_PLE
        if (false) {
#else
        if (IN(pb + 9)) { PHASE_BEGIN();
#endif
            pg8::Gemm g{H, wsp<bf16>(F, WS_WPG) + (size_t)layer * D * D, T, D, D}; pg8::GroupOrder S; S.init_dense(T, D, F.G, (int)blockIdx.x);
            pg8::EpiPleGate E{X, wsp<bf16>(F, WS_PROJ) + (size_t)layer * T * D};
            GEMM_SITE(7, pg8::EpiPleGate, g, S, E);
        }
        SEAM(pb + 9);
#ifdef DBG_CHECK_FFN
        if (layer == DBG_LAYER) { PHASE_BEGIN(); check_ple(F, layer); xcd_barrier(bar); }
#endif
#ifdef DBG_TWOPASS
        { PHASE_BEGIN(); CK(pb + 9, WS_X, (size_t)T * D * 4); CKBAR(); }
#endif
        if (IN(pb + 10)) { PHASE_BEGIN();
            if (layer + 1 < DEPTH) norm_rows(F, X, inp(I_GMIX) + (size_t)(layer + 1) * D, H);
            else final_norm(F, X, inp(I_GFIN), outp());
        }
        if (layer + 1 < DEPTH) SEAM(pb + 10);
#ifdef DBG_TWOPASS
        if (layer + 1 < DEPTH) { PHASE_BEGIN(); CK(pb + 10, WS_H, (size_t)T * D * 2); CKBAR(); }
        else { xcd_barrier(bar); PHASE_BEGIN(); cksum_ptr(F, (const v4u*)outp(), (size_t)T * D * 4, CW_CK + dbg_pass * 64 + pb + 10); CKBAR(); }
#endif
    }
#ifdef DBG_TWOPASS
    if (dbg_pass == 1) { PHASE_BEGIN();
      if (blockIdx.x == 0 && F.tid == 0) { unsigned idx = 0u;
          for (int k = NPH - 1; k >= 0; --k) if (__hip_atomic_load((unsigned*)(F.ctl + CW_CK + k), RLX_AGENT) != __hip_atomic_load((unsigned*)(F.ctl + CW_CK + 64 + k), RLX_AGENT)) idx = (unsigned)(k + 1);
          unsigned idx2 = 0u; for (int k = 36; k >= 32; --k) if (__hip_atomic_load((unsigned*)(F.ctl + CW_CK + k), RLX_AGENT) != __hip_atomic_load((unsigned*)(F.ctl + CW_CK + 64 + k), RLX_AGENT)) idx2 = (unsigned)(k - 31);
          __hip_atomic_store((unsigned*)(F.ctl + 16), idx + 32u * idx2, RLX_AGENT); }
      xcd_barrier(bar); }
#endif
#ifdef DBG_CODE_OUT
    if (args.pass == 1 || !DBG_TWOPASS_ON) { xcd_barrier(bar); PHASE_BEGIN(); final_norm(F, inp(I_X), inp(I_GFIN), outp(), 1.f + (float)__hip_atomic_load((unsigned*)(F.ctl + 16), RLX_AGENT) + (float)((__hip_atomic_load((unsigned*)(F.ctl + 17), RLX_AGENT) + 63u) / 64u)); }
#endif
#undef IN
#undef SEAM
#undef H
#undef X
}

extern "C" void kernel_launch(void* const* d_in, const int* in_sizes, int n_in, void* d_out, int out_size, void* d_ws, size_t ws_size, hipStream_t stream) {
    static int grid = 0;
    if (grid == 0) {
        if (n_in != N_IN || in_sizes[0] != T * D || out_size != T * D || ws_size < WS_END) {
            fprintf(stderr, "kernel_launch: built for %d inputs, x/out of %d floats, >= %zu bytes of workspace; got n_in %d, in0 %d, out %d, ws %zu; nothing launched\n", N_IN, T * D, (size_t)WS_END, n_in, n_in > 0 ? in_sizes[0] : -1, out_size, ws_size);
            grid = -1; return; }
        int dev = 0, cus = 0, per_cu = 0;
        if (hipGetDevice(&dev) != hipSuccess || hipDeviceGetAttribute(&cus, hipDeviceAttributeMultiprocessorCount, dev) != hipSuccess) { fprintf(stderr, "kernel_launch: device query failed\n"); grid = -1; return; }
        if (hipFuncSetAttribute((const void*)mk_fwd, hipFuncAttributeMaxDynamicSharedMemorySize, LDS_BYTES) != hipSuccess) { fprintf(stderr, "kernel_launch: hipFuncSetAttribute failed\n"); grid = -1; return; }
        if (hipOccupancyMaxActiveBlocksPerMultiprocessor(&per_cu, (const void*)mk_fwd, NWAVES * 64, LDS_BYTES) != hipSuccess || per_cu < 1) { fprintf(stderr, "kernel_launch: occupancy query reports %d workgroups per CU\n", per_cu); }
        (void)hipGetLastError();
        grid = cus;
    }
    if (grid < 0) return;
    if (hipMemsetAsync((char*)d_ws + WS_CTL, 0, CTL_ZERO_BYTES, stream) != hipSuccess) { fprintf(stderr, "kernel_launch: hipMemsetAsync failed\n"); return; }
    Args a{};
    for (int i = 0; i < N_IN; ++i) a.in[i] = (const float*)d_in[i];
    a.out = (float*)d_out; a.ws = (unsigned char*)d_ws;
#if MK_PER_PHASE
#ifdef DBG_STOP
    for (int ph = 0; ph <= DBG_STOP; ++ph) { a.ph_lo = ph; a.ph_hi = ph + 1; hipLaunchKernelGGL(mk_fwd, dim3(grid), dim3(NWAVES * 64), LDS_BYTES, stream, a); }
    a.ph_lo = 100; a.ph_hi = 101; hipLaunchKernelGGL(mk_fwd, dim3(grid), dim3(NWAVES * 64), LDS_BYTES, stream, a);
#else
    for (int ph = 0; ph < NPH; ++ph) { a.ph_lo = ph; a.ph_hi = ph + 1; hipLaunchKernelGGL(mk_fwd, dim3(grid), dim3(NWAVES * 64), LDS_BYTES, stream, a); }
#endif
#else
#ifdef DBG_TWOPASS
    a.ph_lo = 0; a.ph_hi = NPH; a.pass = 0; hipLaunchKernelGGL(mk_fwd, dim3(grid), dim3(NWAVES * 64), LDS_BYTES, stream, a);
    (void)hipMemsetAsync((char*)d_ws + WS_CTL + CW_BAR * 4, 0, XCD_BAR_WORDS * 4, stream); (void)hipMemsetAsync((char*)d_ws + WS_CTL + CW_GCNT * 4, 0, 2048, stream);
    a.pass = 1; hipLaunchKernelGGL(mk_fwd, dim3(grid), dim3(NWAVES * 64), LDS_BYTES, stream, a);
#else
    a.ph_lo = 0; a.ph_hi = NPH; hipLaunchKernelGGL(mk_fwd, dim3(grid), dim3(NWAVES * 64), LDS_BYTES, stream, a);
#endif
#endif
    const hipError_t le = hipPeekAtLastError();
    if (le != hipSuccess) fprintf(stderr, "kernel_launch: launch failed: %s\n", hipGetErrorName(le));
}
```

```cpp
#include <hip/hip_runtime.h>
#include <cstdio>
#include <cstdint>
#define MK_SP2 true
#define MK_ALIGN true
#define MK_NAIVE_ATTN 0
#define MK_FP8_GU 1
#define MK_ALIGN_GU true
#define MK_SP2_GU true
namespace pg8 {
#define PG8_LAS __attribute__((address_space(3)))
typedef unsigned short bf16_t;
typedef short bf16x8 __attribute__((ext_vector_type(8)));
typedef float f32x4 __attribute__((ext_vector_type(4)));
typedef unsigned u32x4 __attribute__((ext_vector_type(4)));
constexpr int BM = 256, BK = 64, HALF = 128, HTB = HALF * BK * 2  , STAGE_BYTES = 8 * HTB, NXCD = 8, WGM = 8;

__host__ __device__ __forceinline__ int lds_byte(int r, int c) { const int st = (r >> 4) * 2 + (c >> 5), rr = r & 15, cc = c & 31, ob = rr * 64 + cc * 2; return st * 1024 + (ob ^ (((ob >> 9) & 1) << 5)); }
__host__ __device__ __forceinline__ void stage_rc(int b, int& R, int& C) { const int st = b / 1024, sb = b % 1024, swz = sb ^ (((sb >> 9) & 1) << 5); R = (st >> 1) * 16 + swz / 64; C = (st & 1) * 32 + (swz % 64) / 2; }
__host__ __device__ __forceinline__ int perm32(int rho) { const int n = rho >> 4, i = rho & 15; return 8 * (i >> 2) + 4 * n + (i & 3); }

struct Unit { int pm, pn; };
struct Gemm { const bf16_t* A; const bf16_t* Bt; int M, N, K; };

typedef float cvt_f32x2_t __attribute__((ext_vector_type(2))); typedef __bf16 cvt_bf16x2_t __attribute__((ext_vector_type(2)));
__device__ __forceinline__ unsigned cvt_pk_bf16(float lo, float hi) { cvt_f32x2_t v = {lo, hi}; cvt_bf16x2_t b = __builtin_convertvector(v, cvt_bf16x2_t); return __builtin_bit_cast(unsigned, b); }
typedef float f32x2 __attribute__((ext_vector_type(2)));
typedef unsigned u32x2 __attribute__((ext_vector_type(2)));
__device__ __forceinline__ float sigm(float x) { return __builtin_amdgcn_rcpf(1.0f + __builtin_amdgcn_exp2f(-1.4426950408889634f * x)); }
__device__ __forceinline__ float bf_lo(unsigned w) { return __uint_as_float(w << 16); }
__device__ __forceinline__ float bf_hi(unsigned w) { return __uint_as_float(w & 0xffff0000u); }

struct GroupOrder {
    int ng, nN, nwg, G, c, TM; PG8_LAS int* tp;
    __device__ __forceinline__ void init_equal(int ngroups, int rows_per_group, int N, int G_, int c_, PG8_LAS int* tp_) {
        ng = ngroups; nN = N / BM; const int t = rows_per_group / BM; TM = t * ngroups; nwg = TM * nN; G = G_; c = c_; tp = tp_;
        if (ngroups > 1) { int tx = threadIdx.x; asm volatile("" : "+v"(tx)); if (tx < 9) tp[tx] = (tx < ngroups ? tx : ngroups) * t; __syncthreads(); }
    }
    __device__ __forceinline__ void init_dense(int M, int N, int G_, int c_) { init_equal(1, M, N, G_, c_, nullptr); }
    __device__ __forceinline__ void init_counts(const unsigned (&cnt)[8], int N, int G_, int c_, PG8_LAS int* tp_) {
        ng = 8; nN = N / BM; G = G_; c = c_; tp = tp_; int s = 0; int tx = threadIdx.x; asm volatile("" : "+v"(tx));
        if (tx == 0) tp[0] = 0;
#pragma unroll
        for (int e = 0; e < 8; ++e) { s += (int)((cnt[e] + 255u) >> 8); if (tx == 0) tp[e + 1] = s; }
        TM = s; nwg = TM * nN; __syncthreads();
    }
    __device__ __forceinline__ bool next(int i, Unit& u) const {
        const long L = (long)i * G + c; if (L >= nwg) return false;
        int wgid = (int)L; { const int q = nwg / NXCD, r = nwg % NXCD, xcd = wgid % NXCD, off = wgid / NXCD; wgid = (xcd < r ? xcd * (q + 1) : r * (q + 1) + (xcd - r) * q) + off; }
        const int nig = WGM * nN, gid = wgid / nig, fm = gid * WGM, gsz = (TM - fm) < WGM ? (TM - fm) : WGM;
        const int rt = fm + ((wgid % nig) % gsz), pl = (wgid % nig) / gsz;
        int e = 0;
        if (ng > 1) {
#pragma unroll
            for (int j = 1; j < 8; ++j) e += (j < ng && rt >= __builtin_amdgcn_readfirstlane(tp[j])) ? 1 : 0; }
        u.pm = rt; u.pn = e * nN + pl; return true;
    }
    __device__ __forceinline__ void a_ready(const Unit&) const {}
    __device__ __forceinline__ void done(const Unit&) const {}
};

#define EPI_ROWS(row0) _Pragma("unroll") for (int ai = 0; ai < 2; ++ai) _Pragma("unroll") for (int m = 0; m < 4; ++m)
__device__ __forceinline__ u32x4 pack8(const f32x4 a, const f32x4 b) { u32x4 w; w.x = cvt_pk_bf16(a[0], a[1]); w.y = cvt_pk_bf16(a[2], a[3]); w.z = cvt_pk_bf16(b[0], b[1]); w.w = cvt_pk_bf16(b[2], b[3]); return w; }
__device__ __forceinline__ f32x4 sigm4(const f32x4 v) { return (f32x4){sigm(v[0]), sigm(v[1]), sigm(v[2]), sigm(v[3])}; }

struct EpiInProj {
    static constexpr bool PERM = true, AFTER_DRAIN = false;
    bf16_t *Q, *K, *V, *Z, *SG; const float* rope; float qscale;
    __device__ __forceinline__ void operator()(const f32x4 (&acc)[2][2][4][2], const Unit& u, int wr, int wc, int fr, int fq) const {
        const int pn = u.pn, row0 = u.pm * BM + wr * 64 + fr, cl = wc * 32 + 8 * fq;
        if (pn < 4) {
            bf16_t* base = (pn < 2) ? Q : K; const float sc = (pn < 2) ? qscale : 1.0f; const int colt = (pn & 1) * 256, g4 = 4 * (4 * (wc & 1) + fq);
            EPI_ROWS(row0) { const int row = row0 + ai * HALF + m * 16; const float* rp = rope + (size_t)(row & 2047) * 64 + g4;
                const f32x4 cs = *(const f32x4*)rp, sn = *(const f32x4*)(rp + 32);
#pragma unroll
                for (int bj = 0; bj < 2; ++bj) { const f32x4 v0 = acc[ai][bj][m][0], v1 = acc[ai][bj][m][1];
                    const f32x4 lo = (v0 * cs - v1 * sn) * sc, hi = (v1 * cs + v0 * sn) * sc;
                    bf16_t* p = base + (size_t)row * 512 + colt + (2 * bj + (wc >> 1)) * 64 + g4;
                    u32x2 a; a.x = cvt_pk_bf16(lo[0], lo[1]); a.y = cvt_pk_bf16(lo[2], lo[3]); *(u32x2*)p = a;
                    u32x2 b; b.x = cvt_pk_bf16(hi[0], hi[1]); b.y = cvt_pk_bf16(hi[2], hi[3]); *(u32x2*)(p + 32) = b; } }
        } else if (pn < 6) {
            EPI_ROWS(row0) { bf16_t* p = V + (size_t)(row0 + ai * HALF + m * 16) * 512 + (pn - 4) * 256 + cl;
#pragma unroll
                for (int bj = 0; bj < 2; ++bj) *(u32x4*)(p + bj * HALF) = pack8(acc[ai][bj][m][0], acc[ai][bj][m][1]); }
        } else if (pn < 10) {
            EPI_ROWS(row0) { bf16_t* p = Z + (size_t)(row0 + ai * HALF + m * 16) * 512 + (pn - 6) * 128 + cl;
                *(u32x4*)p = pack8(acc[ai][0][m][0] * sigm4(acc[ai][1][m][0]), acc[ai][0][m][1] * sigm4(acc[ai][1][m][1])); }
        } else {
            EPI_ROWS(row0) { bf16_t* p = SG + (size_t)(row0 + ai * HALF + m * 16) * 2048 + (pn - 10) * 256 + cl;
#pragma unroll
                for (int bj = 0; bj < 2; ++bj) *(u32x4*)(p + bj * HALF) = pack8(sigm4(acc[ai][bj][m][0]), sigm4(acc[ai][bj][m][1])); }
        }
    }
};
template <int MODE> struct EpiGate {
    static constexpr bool PERM = false, AFTER_DRAIN = false;
    float* P; bf16_t* MIX; const bf16_t* SG;
    __device__ __forceinline__ void operator()(const f32x4 (&acc)[2][2][4][2], const Unit& u, int wr, int wc, int fr, int fq) const {
        const int row0 = u.pm * BM + wr * 64 + fr, col0 = u.pn * BM + wc * 32 + 4 * fq;
        EPI_ROWS(row0) { const size_t row = (size_t)(row0 + ai * HALF + m * 16);
#pragma unroll
            for (int bj = 0; bj < 2; ++bj)
#pragma unroll
                for (int n = 0; n < 2; ++n) { const int col = col0 + bj * HALF + n * 16;
                    const u32x2 gw = *(const u32x2*)(SG + row * 2048 + MODE * 1024 + col);
                    const f32x4 gt = (f32x4){bf_lo(gw.x), bf_hi(gw.x), bf_lo(gw.y), bf_hi(gw.y)};
                    if (MODE == 0) *(f32x4*)(P + row * 1024 + col) = gt * acc[ai][bj][m][n];
                    else { const f32x4 r = *(const f32x4*)(P + row * 1024 + col) + gt * acc[ai][bj][m][n];
                        u32x2 w; w.x = cvt_pk_bf16(r[0], r[1]); w.y = cvt_pk_bf16(r[2], r[3]); *(u32x2*)(MIX + row * 1024 + col) = w; } } }
    }
};
struct EpiResid {
    static constexpr bool PERM = false, AFTER_DRAIN = false;
    const float* base; float* out; int nN;
    __device__ __forceinline__ void operator()(const f32x4 (&acc)[2][2][4][2], const Unit& u, int wr, int wc, int fr, int fq) const {
        const int row0 = u.pm * BM + wr * 64 + fr, col0 = (u.pn % nN) * BM + wc * 32 + 4 * fq;
        EPI_ROWS(row0) { const size_t off = (size_t)(row0 + ai * HALF + m * 16) * 1024 + col0;
#pragma unroll
            for (int bj = 0; bj < 2; ++bj)
#pragma unroll
                for (int n = 0; n < 2; ++n) { f32x4 r = acc[ai][bj][m][n]; if (base) r += *(const f32x4*)(base + off + bj * HALF + n * 16); *(f32x4*)(out + off + bj * HALF + n * 16) = r; } }
    }
};
struct EpiSwiGLU {
    static constexpr bool PERM = true, AFTER_DRAIN = false;
    bf16_t* ACT; int ldc, nN; const float* rs; float ws;
    __device__ __forceinline__ void operator()(const f32x4 (&acc)[2][2][4][2], const Unit& u, int wr, int wc, int fr, int fq) const {
        const int row0 = u.pm * BM + wr * 64 + fr, cl = (u.pn % nN) * 128 + wc * 32 + 8 * fq;
        EPI_ROWS(row0) { bf16_t* p = ACT + (size_t)(row0 + ai * HALF + m * 16) * ldc + cl;
            f32x4 g0 = acc[ai][0][m][0], g1 = acc[ai][0][m][1], u0 = acc[ai][1][m][0], u1 = acc[ai][1][m][1];
            if (rs) { const float sc = rs[row0 + ai * HALF + m * 16] * ws; typedef int i32x4_ __attribute__((ext_vector_type(4)));
                g0 = __builtin_convertvector(__builtin_bit_cast(i32x4_, g0), f32x4) * sc; g1 = __builtin_convertvector(__builtin_bit_cast(i32x4_, g1), f32x4) * sc;
                u0 = __builtin_convertvector(__builtin_bit_cast(i32x4_, u0), f32x4) * sc; u1 = __builtin_convertvector(__builtin_bit_cast(i32x4_, u1), f32x4) * sc; }
            *(u32x4*)p = pack8(g0 * sigm4(g0) * u0, g1 * sigm4(g1) * u1); }
    }
};
struct EpiStore {
    static constexpr bool PERM = true, AFTER_DRAIN = false;
    bf16_t* O; int ldc, nN;
    __device__ __forceinline__ void operator()(const f32x4 (&acc)[2][2][4][2], const Unit& u, int wr, int wc, int fr, int fq) const {
        const int row0 = u.pm * BM + wr * 64 + fr, cl = (u.pn % nN) * BM + wc * 32 + 8 * fq;
        EPI_ROWS(row0) { bf16_t* p = O + (size_t)(row0 + ai * HALF + m * 16) * ldc + cl;
#pragma unroll
            for (int bj = 0; bj < 2; ++bj) *(u32x4*)(p + bj * HALF) = pack8(acc[ai][bj][m][0], acc[ai][bj][m][1]); }
    }
};
struct EpiPleGate {
    static constexpr bool PERM = false, AFTER_DRAIN = false;
    float* X; const bf16_t* PROJ;
    __device__ __forceinline__ void operator()(const f32x4 (&acc)[2][2][4][2], const Unit& u, int wr, int wc, int fr, int fq) const {
        const int row0 = u.pm * BM + wr * 64 + fr, col0 = u.pn * BM + wc * 32 + 4 * fq;
        EPI_ROWS(row0) { const size_t off = (size_t)(row0 + ai * HALF + m * 16) * 1024 + col0;
#pragma unroll
            for (int bj = 0; bj < 2; ++bj)
#pragma unroll
                for (int n = 0; n < 2; ++n) { const size_t o = off + bj * HALF + n * 16; const u32x2 pw = *(const u32x2*)(PROJ + o);
                    const f32x4 pr = (f32x4){bf_lo(pw.x), bf_hi(pw.x), bf_lo(pw.y), bf_hi(pw.y)};
                    *(f32x4*)(X + o) = *(const f32x4*)(X + o) + sigm4(acc[ai][bj][m][n]) * pr; } }
    }
};

template <class Epi, class Sched>
__device__ __forceinline__ void gemm_phase_naive(const Gemm g, const Sched& S, const Epi& E) {
    int tid_ = threadIdx.x; asm volatile("" : "+v"(tid_));
    const int tid = tid_, wid = __builtin_amdgcn_readfirstlane(tid >> 6), lane = tid & 63, wr = wid >> 2, wc = wid & 3, fr = lane & 15, fq = lane >> 4;
    const int K = g.K; Unit u;
    for (int ui = 0; S.next(ui, u); ++ui) {
        f32x4 acc[2][2][4][2];
#pragma unroll
        for (int ai = 0; ai < 2; ++ai)
#pragma unroll
            for (int m = 0; m < 4; ++m) {
                const bf16_t* ap = g.A + (size_t)(u.pm * BM + ai * HALF + wr * 64 + m * 16 + fr) * K;
#pragma unroll
                for (int bj = 0; bj < 2; ++bj)
#pragma unroll
                    for (int n = 0; n < 2; ++n) { f32x4 r = (f32x4){0.f, 0.f, 0.f, 0.f};
#pragma unroll
                        for (int j = 0; j < 4; ++j) { const int col = u.pn * BM + bj * HALF + wc * 32 + (Epi::PERM ? (8 * fq + 4 * n + j) : (16 * n + 4 * fq + j));
                            const bf16_t* bp = g.Bt + (size_t)col * K; float s = 0.f;
                            for (int k = 0; k < K; k += 8) { const u32x4 a = *(const u32x4*)(ap + k), b = *(const u32x4*)(bp + k);
                                s += bf_lo(a.x) * bf_lo(b.x) + bf_hi(a.x) * bf_hi(b.x) + bf_lo(a.y) * bf_lo(b.y) + bf_hi(a.y) * bf_hi(b.y)
                                   + bf_lo(a.z) * bf_lo(b.z) + bf_hi(a.z) * bf_hi(b.z) + bf_lo(a.w) * bf_lo(b.w) + bf_hi(a.w) * bf_hi(b.w); }
                            r[j] = s; }
                        acc[ai][bj][m][n] = r; } }
        E(acc, u, wr, wc, fr, fq);
    }
}
typedef int pg8_i32x8 __attribute__((ext_vector_type(8))); typedef int pg8_i32x4 __attribute__((ext_vector_type(4)));
template <bool FP8> struct pg8_frag { typedef bf16x8 T; };
template <> struct pg8_frag<true> { typedef pg8_i32x8 T; };
template <bool FP8> __device__ __forceinline__ void pg8_ldfrag(typename pg8_frag<FP8>::T& d, const PG8_LAS unsigned char* p) {
    if constexpr (FP8) { const pg8_i32x4 lo = *(const PG8_LAS pg8_i32x4*)p, hi = *(const PG8_LAS pg8_i32x4*)(p + 16); d = __builtin_shufflevector(lo, hi, 0, 1, 2, 3, 4, 5, 6, 7); }
    else d = *(const PG8_LAS bf16x8*)p;
}
template <bool I8> __device__ __forceinline__ f32x4 pg8_mma(const bf16x8& b, const bf16x8& a, const f32x4 c) {
    if constexpr (I8) return __builtin_bit_cast(f32x4, __builtin_amdgcn_mfma_i32_16x16x64_i8(__builtin_bit_cast(pg8_i32x4, b), __builtin_bit_cast(pg8_i32x4, a), __builtin_bit_cast(pg8_i32x4, c), 0, 0, 0));
    else return __builtin_amdgcn_mfma_f32_16x16x32_bf16(b, a, c, 0, 0, 0);
}
template <class Epi, class Sched, bool ALIGN_EPI = false, bool SP2 = false, bool I8 = false>
__device__ __forceinline__ void gemm_phase(PG8_LAS unsigned char* lds, const Gemm g, const Sched& S, const Epi& E) {
    int tid_ = threadIdx.x; asm volatile("" : "+v"(tid_));
    const int tid = tid_, wid = __builtin_amdgcn_readfirstlane(tid >> 6), lane = tid & 63, wr = wid >> 2, wc = wid & 3, fr = lane & 15, fq = lane >> 4;
    int K_ = g.K; asm volatile("" : "+s"(K_));
    const int K = K_, nt = K / BK;
    unsigned voffA[2], voffB[2];
#pragma unroll
    for (int i = 0; i < 2; ++i) { int R, C; stage_rc(tid * 16 + i * 8192, R, C); const int Rb = Epi::PERM ? ((R & ~31) + perm32(R & 31)) : R;
        voffA[i] = (unsigned)(R * K + C) * 2u; voffB[i] = (unsigned)(Rb * K + C) * 2u; }
    const size_t kstep = (size_t)(BK * 2);
    const size_t hstep = (size_t)HALF * K * 2;
    const size_t tstep = 2 * hstep;
    const unsigned ldsw = (unsigned)wid * 1024u;
    const int aoff = lds_byte(wr * 64 + fr, fq * 8), boff = lds_byte(wc * 32 + fr, fq * 8);
    constexpr int NK = 2;
#define PG8_SA(b, h) (((b) * 2 + (h)) * HTB)
#define PG8_SB(b, h) ((4 + (b) * 2 + (h)) * HTB)
#define PG8_STAGE(bufoff, gbase, voff) do { _Pragma("unroll") for (int _i = 0; _i < 2; ++_i) \
        __builtin_amdgcn_global_load_lds((const unsigned*)((const char*)(gbase) + (voff)[_i]), (PG8_LAS unsigned*)(lds + (bufoff) + ldsw + _i * 8192), 16, 0, 0); } while (0)
#define PG8_LDA(dst, b, h) do { _Pragma("unroll") for (int m = 0; m < 4; ++m) _Pragma("unroll") for (int k = 0; k < NK; ++k) pg8_ldfrag<false>(dst[m][k], lds + PG8_SA(b, h) + aoff + m * 2048 + k * 1024); } while (0)
#define PG8_LDB(dst, b, h) do { _Pragma("unroll") for (int n = 0; n < 2; ++n) _Pragma("unroll") for (int k = 0; k < NK; ++k) pg8_ldfrag<false>(dst[n][k], lds + PG8_SB(b, h) + boff + n * 2048 + k * 1024); } while (0)
#define PG8_MMA(ai, bj, At, Bt) do { __builtin_amdgcn_s_setprio(1); _Pragma("unroll") for (int m = 0; m < 4; ++m) _Pragma("unroll") for (int n = 0; n < 2; ++n) _Pragma("unroll") for (int k = 0; k < NK; ++k) \
        acc[ai][bj][m][n] = pg8_mma<I8>(Bt[n][k], At[m][k], acc[ai][bj][m][n]); __builtin_amdgcn_s_setprio(0); } while (0)
#define PG8_WAIT_V(n) asm volatile("s_waitcnt vmcnt(" #n ")" ::: "memory")
#define PG8_WAIT_L(n) asm volatile("s_waitcnt lgkmcnt(" #n ")" ::: "memory")
#define PG8_BAR __builtin_amdgcn_s_barrier()
#define PG8_SCHED __builtin_amdgcn_sched_barrier(0)
    Unit cur, nxt; int ui = 0;
    if (!S.next(0, cur)) return;
    f32x4 acc[2][2][4][2];
#pragma unroll
    for (int a = 0; a < 2; ++a)
#pragma unroll
        for (int b = 0; b < 2; ++b)
#pragma unroll
            for (int m = 0; m < 4; ++m)
#pragma unroll
                for (int n = 0; n < 2; ++n) acc[a][b][m][n] = (f32x4){0.f, 0.f, 0.f, 0.f};
    bf16x8 At[4][NK], B0[2][NK], B1[2][NK];
    const char* cA = (const char*)g.A + (size_t)cur.pm * tstep; const char* cB = (const char*)g.Bt + (size_t)cur.pn * tstep;
    S.a_ready(cur);
    if constexpr (SP2) {
        PG8_STAGE(PG8_SB(0, 0), cB, voffB); PG8_STAGE(PG8_SB(0, 1), cB + hstep, voffB); PG8_STAGE(PG8_SA(0, 0), cA, voffA); PG8_STAGE(PG8_SA(0, 1), cA + hstep, voffA);
        if (wr == 1) PG8_BAR;
        PG8_WAIT_V(2); PG8_BAR;
        PG8_STAGE(PG8_SB(1, 0), cB + kstep, voffB); PG8_STAGE(PG8_SA(1, 0), cA + kstep, voffA); PG8_STAGE(PG8_SB(1, 1), cB + hstep + kstep, voffB);
        PG8_WAIT_V(6); PG8_BAR;
    } else {
        PG8_STAGE(PG8_SB(0, 0), cB, voffB); PG8_STAGE(PG8_SA(0, 0), cA, voffA); PG8_STAGE(PG8_SB(0, 1), cB + hstep, voffB); PG8_STAGE(PG8_SA(0, 1), cA + hstep, voffA);
        if (wr == 1) PG8_BAR;
        PG8_WAIT_V(4); PG8_BAR;
        PG8_STAGE(PG8_SB(1, 0), cB + kstep, voffB); PG8_STAGE(PG8_SA(1, 0), cA + kstep, voffA); PG8_STAGE(PG8_SB(1, 1), cB + hstep + kstep, voffB);
        PG8_WAIT_V(6); PG8_BAR;
    }
    for (;;) {
        const bool has_next = S.next(ui + 1, nxt);
        const char* nA = has_next ? (const char*)g.A + (size_t)nxt.pm * tstep : cA; const char* nB = has_next ? (const char*)g.Bt + (size_t)nxt.pn * tstep : cB;
#pragma nounroll
        for (int t = 0; t < nt; t += 2) {
            const bool last = (t == nt - 2);
            const char* a1 = cA + (size_t)(t + 1) * kstep;
            const char* a2 = last ? nA : cA + (size_t)(t + 2) * kstep; const char* b2 = last ? nB : cB + (size_t)(t + 2) * kstep;
            const char* a3 = a2 + kstep; const char* b3 = b2 + kstep;
            if (last && has_next) S.a_ready(nxt);
            if constexpr (SP2) {
            PG8_LDB(B0, 0, 0); PG8_LDB(B1, 0, 1); PG8_SCHED; PG8_LDA(At, 0, 0); PG8_STAGE(PG8_SA(1, 1), a1 + hstep, voffA);
            PG8_WAIT_V(8); PG8_WAIT_L(0); PG8_BAR; PG8_MMA(0, 0, At, B0); PG8_MMA(0, 1, At, B1); PG8_BAR; PG8_SCHED;
            PG8_LDA(At, 0, 1); PG8_STAGE(PG8_SB(0, 0), b2, voffB); PG8_STAGE(PG8_SB(0, 1), b2 + hstep, voffB); PG8_STAGE(PG8_SA(0, 0), a2, voffA);
            PG8_WAIT_V(8); PG8_WAIT_L(0); PG8_BAR; PG8_MMA(1, 0, At, B0); PG8_MMA(1, 1, At, B1); PG8_BAR; PG8_SCHED;
            PG8_LDB(B0, 1, 0); PG8_LDB(B1, 1, 1); PG8_SCHED; PG8_LDA(At, 1, 0); PG8_STAGE(PG8_SA(0, 1), a2 + hstep, voffA);
            PG8_WAIT_V(8); PG8_WAIT_L(0); PG8_BAR; PG8_MMA(0, 0, At, B0); PG8_MMA(0, 1, At, B1); PG8_BAR; PG8_SCHED;
            PG8_LDA(At, 1, 1); PG8_STAGE(PG8_SB(1, 0), b3, voffB); PG8_STAGE(PG8_SB(1, 1), b3 + hstep, voffB); PG8_STAGE(PG8_SA(1, 0), a3, voffA);
            PG8_WAIT_V(8); PG8_WAIT_L(0); PG8_BAR; PG8_MMA(1, 0, At, B0); PG8_MMA(1, 1, At, B1); PG8_BAR; PG8_SCHED;
            } else {
            PG8_LDB(B0, 0, 0); PG8_SCHED; PG8_LDA(At, 0, 0); PG8_STAGE(PG8_SA(1, 1), a1 + hstep, voffA);
            PG8_WAIT_L(8); PG8_BAR; PG8_WAIT_L(0); PG8_MMA(0, 0, At, B0); PG8_BAR; PG8_SCHED;
            PG8_LDB(B1, 0, 1); PG8_STAGE(PG8_SB(0, 0), b2, voffB);
            PG8_BAR; PG8_WAIT_L(0); PG8_MMA(0, 1, At, B1); PG8_BAR;
            PG8_LDA(At, 0, 1); PG8_STAGE(PG8_SA(0, 0), a2, voffA);
            PG8_BAR; PG8_WAIT_L(0); PG8_MMA(1, 0, At, B0); PG8_BAR; PG8_SCHED;
            PG8_STAGE(PG8_SB(0, 1), b2 + hstep, voffB);
            PG8_WAIT_V(6); PG8_BAR; PG8_MMA(1, 1, At, B1); PG8_BAR;
            PG8_LDB(B0, 1, 0); PG8_SCHED; PG8_LDA(At, 1, 0); PG8_STAGE(PG8_SA(0, 1), a2 + hstep, voffA);
            PG8_WAIT_L(8); PG8_BAR; PG8_WAIT_L(0); PG8_MMA(0, 0, At, B0); PG8_BAR; PG8_SCHED;
            PG8_LDB(B1, 1, 1); PG8_STAGE(PG8_SB(1, 0), b3, voffB);
            PG8_BAR; PG8_WAIT_L(0); PG8_MMA(0, 1, At, B1); PG8_BAR;
            PG8_LDA(At, 1, 1); PG8_STAGE(PG8_SA(1, 0), a3, voffA);
            PG8_BAR; PG8_WAIT_L(0); PG8_MMA(1, 0, At, B0); PG8_BAR; PG8_SCHED;
            PG8_STAGE(PG8_SB(1, 1), b3 + hstep, voffB);
            PG8_WAIT_V(6); PG8_BAR; PG8_MMA(1, 1, At, B1); PG8_BAR;
            }
        }
        if constexpr (ALIGN_EPI) { if (wr == 0) PG8_BAR; }
        if constexpr (!Epi::AFTER_DRAIN) { E(acc, cur, wr, wc, fr, fq); S.done(cur); }
        if (!has_next) break;
#pragma unroll
        for (int a = 0; a < 2; ++a)
#pragma unroll
            for (int b = 0; b < 2; ++b)
#pragma unroll
                for (int m = 0; m < 4; ++m)
#pragma unroll
                    for (int n = 0; n < 2; ++n) acc[a][b][m][n] = (f32x4){0.f, 0.f, 0.f, 0.f};
        cur = nxt; cA = nA; cB = nB; ++ui;
        if constexpr (ALIGN_EPI) { if (wr == 1) PG8_BAR; }
    }
    PG8_WAIT_V(0);
    if constexpr (!ALIGN_EPI) { if (wr == 0) PG8_BAR; }
    PG8_BAR;
    if constexpr (Epi::AFTER_DRAIN) { E.fused(acc, cur, wr, wc, fr, fq, lds, wid, lane); S.done(cur); }
#undef PG8_SA
#undef PG8_SB
#undef PG8_STAGE
#undef PG8_LDA
#undef PG8_LDB
#undef PG8_MMA
#undef PG8_WAIT_V
#undef PG8_WAIT_L
#undef PG8_BAR
#undef PG8_SCHED
}
}

constexpr int NWAVES = 8;
#ifndef MK_PER_PHASE
#define MK_PER_PHASE 0
#endif
#ifndef MK_NAIVE_GEMM
#define MK_NAIVE_GEMM 0
#endif
#ifndef MK_SP2
#define MK_SP2 true
#endif
#ifndef MK_ALIGN
#define MK_ALIGN true
#endif
#ifdef DBG_TWOPASS
#define DBG_TWOPASS_ON 1
#else
#define DBG_TWOPASS_ON 0
#endif
#ifndef MK_FP8_GU
#define MK_FP8_GU 1
#endif
#ifndef MK_ALIGN_GU
#define MK_ALIGN_GU false
#endif
#ifndef MK_SP2_GU
#define MK_SP2_GU false
#endif
#ifndef DBG_REP_ATTN
#define DBG_REP_ATTN 1
#endif
#ifndef DBG_REP_GU
#define DBG_REP_GU 1
#endif
#ifndef DBG_LAYER
#define DBG_LAYER 0
#endif
#ifndef DBG_INJECT
#define DBG_INJECT 0.f
#endif
#ifndef MK_NAIVE_ATTN
#define MK_NAIVE_ATTN 1
#endif

constexpr int BATCH = 8, SEQ = 2048, D = 1024, T = BATCH * SEQ, DEPTH = 2;
constexpr int NH = 4, HD = 64, VD = 128, AQK = 512, AV = 512, CCH = 512, CK = 31, CPAD = 15;
constexpr int INC = 2 * AQK + AV + 2 * CCH + 2 * D;
constexpr int FF = 2816, NE = 8, FE = 3584, PLE = 256;
constexpr float EPS = 1e-6f;
constexpr float QSCALE = 0.125f * 1.4426950408889634f;
constexpr int MOE_ROWS = 2 * T + NE * 256;
enum { I_X = 0, I_P, I_GMIX, I_WIN, I_LAM, I_GSUB, I_WAO, I_CW, I_CB, I_CLG, I_CLB, I_WCO, I_WO, I_GFFN, I_WFGU, I_WFDN, I_WR, I_BR, I_WEGU, I_WEDN, I_GPLE, I_WPG, I_WPP, I_GFIN, N_IN };

constexpr size_t MiB = 1u << 20;
constexpr size_t WS_CTL = 0, CTL_ZERO_BYTES = 1 * MiB;
constexpr size_t WS_ROPE = 1 * MiB;
constexpr size_t WS_SCAL = 1 * MiB + 512 * 1024;
constexpr size_t WS_RTI = WS_SCAL + 4096;
constexpr size_t WS_RTW = WS_RTI + (size_t)T * 16;
constexpr size_t WS_RSEL = WS_RTW + (size_t)T * 8;
constexpr size_t WS_RS = 2 * MiB + 256 * 1024;
constexpr size_t WS_RSP = 2 * MiB + 512 * 1024;
static_assert(WS_RSEL + (size_t)T * 8 <= WS_RS && WS_RSP + (size_t)MOE_ROWS * 4 <= 3 * MiB, "misc region");
constexpr size_t WS_WIN = 4 * MiB, WS_WA = 22 * MiB, WS_WC = 24 * MiB, WS_WO = 26 * MiB, WS_WFGU = 30 * MiB, WS_WFDN = 41 * MiB, WS_WPG = 47 * MiB, WS_WPP = 51 * MiB;
constexpr size_t WS_WEGU = 52 * MiB, WS_WEDN = 164 * MiB;
constexpr size_t WS_X = 220 * MiB, WS_H = 284 * MiB, WS_PROJ = 316 * MiB, WS_PB = 380 * MiB, WS_R = 396 * MiB;
constexpr size_t WS_Q = WS_R, WS_K = WS_R + 16 * MiB, WS_V = WS_R + 32 * MiB, WS_Z = WS_R + 48 * MiB, WS_SG = WS_R + 64 * MiB, WS_OB = WS_R + 128 * MiB, WS_ZC = WS_R + 144 * MiB,
                 WS_P = WS_R + 160 * MiB, WS_MIX = WS_R + 224 * MiB;
constexpr size_t WS_ACT = WS_R, WS_HP = WS_R + 240 * MiB, WS_Y = WS_R + 308 * MiB, WS_END = WS_R + 444 * MiB;
static_assert((size_t)MOE_ROWS * FE * 2 <= 240 * MiB && (size_t)MOE_ROWS * D * 2 <= 68 * MiB && (size_t)MOE_ROWS * D * 4 <= 136 * MiB && (size_t)T * FF * 2 <= 240 * MiB, "region R");
constexpr int CW_TMO = 0, CW_CODE = 1, CW_BAR = 4096, CW_GCNT = 8192;

constexpr int RING_OFF = 0, RING_BYTES = 131072;
constexpr int LDSCTL_OFF = RING_BYTES, MISC_OFF = LDSCTL_OFF + 320;
constexpr int TP_OFF = MISC_OFF + 64;
constexpr int LDS_BYTES = 147456;

#define GAS __attribute__((address_space(1)))
#define LAS __attribute__((address_space(3)))
typedef unsigned short bf16;
typedef unsigned v4u __attribute__((ext_vector_type(4)));
typedef unsigned v2u __attribute__((ext_vector_type(2)));
typedef float f32x4 __attribute__((ext_vector_type(4)));
typedef GAS unsigned gu32;
#define RLX_AGENT __ATOMIC_RELAXED, __HIP_MEMORY_SCOPE_AGENT
#define LDS_WAIT() asm volatile("s_waitcnt lgkmcnt(0)" ::: "memory")
#define VM_WAIT() asm volatile("s_waitcnt vmcnt(0)" ::: "memory")
__device__ __forceinline__ unsigned f2bf(float f) { unsigned u = __builtin_bit_cast(unsigned, f); return (u + 0x7fffu + ((u >> 16) & 1u)) >> 16; }
__device__ __forceinline__ unsigned pk2(float lo, float hi) { return f2bf(lo) | (f2bf(hi) << 16); }
using pg8::bf_lo; using pg8::bf_hi; using pg8::sigm;

#define XB_TMO      128
#define XB_XCNT(j)  (256  + 64 * (j))
#define XB_XSUB(j)  (1280 + 64 * (j))
#define XB_XGEN(j)  (2304 + 64 * (j))
#define XB_TOP      3328
#define XB_TOPGEN   3392
#define XCD_BAR_WORDS 3456
#define XB_SPIN_CAP (1u << 18)

__device__ __forceinline__ unsigned xb_ld(unsigned* p)              { return __hip_atomic_load(p, __ATOMIC_RELAXED, __HIP_MEMORY_SCOPE_AGENT); }
__device__ __forceinline__ unsigned xb_add(unsigned* p, unsigned v) { return __hip_atomic_fetch_add(p, v, __ATOMIC_RELAXED, __HIP_MEMORY_SCOPE_AGENT); }
__device__ __forceinline__ unsigned xb_xcc_id() { return (unsigned)__builtin_amdgcn_s_getreg((3 << 11) | 20) & 0xFu; }
#define XB_SPIN(cond, bar) do { unsigned _sp = 0; while (cond) { __builtin_amdgcn_s_sleep(1); \
    if ((++_sp & 255u) == 0u) { if (xb_ld(&(bar)[XB_TMO])) break; if (_sp > XB_SPIN_CAP) { atomicAdd(&(bar)[XB_TMO], 1u); break; } } } } while (0)

struct XcdBarrier {
    unsigned* bar; unsigned x;
    volatile LAS unsigned* st;
};

__device__ __forceinline__ XcdBarrier xcd_barrier_post(unsigned* bar, volatile LAS unsigned* st) {
    XcdBarrier b; b.bar = bar; b.x = xb_xcc_id(); b.st = st;
    if (threadIdx.x == 0) (void)xb_add(&bar[XB_XCNT(b.x)], 1u);
    return b;
}
__device__ __forceinline__ void xcd_barrier_complete(unsigned* bar, unsigned x, unsigned& nloc, unsigned& nx) {
    const unsigned G = gridDim.x * gridDim.y * gridDim.z;
    unsigned sum, cnt, mine, sp = 0u;
    for (;;) {
        sum = 0u; cnt = 0u; mine = 0u;
#pragma unroll
        for (unsigned j = 0; j < 16; ++j) { const unsigned c = xb_ld(&bar[XB_XCNT(j)]); sum += c; cnt += (c > 0u) ? 1u : 0u; mine = (j == x) ? c : mine; }
        if (sum == G) break;
        __builtin_amdgcn_s_sleep(1);
        if ((++sp & 255u) == 0u) { if (xb_ld(&bar[XB_TMO])) break; if (sp > XB_SPIN_CAP) { atomicAdd(&bar[XB_TMO], 1u); break; } }
    }
    nloc = mine > 0u ? mine : 1u; nx = cnt > 0u ? cnt : 1u;
}

__device__ __forceinline__ void xcd_barrier(const XcdBarrier& b) {
    asm volatile("s_waitcnt vmcnt(0)" ::: "memory");
    __syncthreads();
    if (threadIdx.x == 0) {
        GAS unsigned* gbar_ = (GAS unsigned*)b.bar; unsigned bx = b.x; asm volatile("" : "+s"(gbar_), "+s"(bx)); unsigned* bar = (unsigned*)gbar_;
        __builtin_amdgcn_s_waitcnt(0);
        unsigned nloc = b.st[0], nx = b.st[1];
        if (nloc == 0u) { xcd_barrier_complete(bar, bx, nloc, nx); b.st[0] = nloc; b.st[1] = nx; }
        const unsigned old = xb_add(&bar[XB_XSUB(bx)], 1u);
        const unsigned gen = old / nloc;
        if (old + 1u == (gen + 1u) * nloc) {
            __builtin_amdgcn_fence(__ATOMIC_RELEASE, "agent");
            asm volatile("s_waitcnt vmcnt(0)" ::: "memory");
            const unsigned og = xb_add(&bar[XB_TOP], 1u);
            const unsigned tg = og / nx;
            if (og + 1u == (tg + 1u) * nx) xb_add(&bar[XB_TOPGEN], 1u);
            else XB_SPIN(xb_ld(&bar[XB_TOPGEN]) == tg, bar);
            __builtin_amdgcn_fence(__ATOMIC_ACQUIRE, "agent");
            xb_add(&bar[XB_XGEN(bx)], 1u);
            asm volatile("s_waitcnt vmcnt(0)" ::: "memory");
        } else {
            XB_SPIN(xb_ld(&bar[XB_XGEN(bx)]) == gen, bar);
            __builtin_amdgcn_fence(__ATOMIC_ACQUIRE, "agent");
            asm volatile("s_waitcnt vmcnt(0)" ::: "memory");
        }
    }
    __syncthreads();
}

struct Frame {
    LAS unsigned char* lds;
    volatile LAS unsigned* MISC;
    gu32* ctl;
    GAS unsigned char* ws;
    int tid, lane, wave, G;
};
#define CAS __attribute__((address_space(4)))
__device__ __forceinline__ const float* inp(int i) {
    const CAS unsigned char* k = (const CAS unsigned char*)__builtin_amdgcn_kernarg_segment_ptr();
    asm volatile("" : "+s"(k));
    return (const float*)*(GAS const float* const CAS*)(k + 8 * i);
}
__device__ __forceinline__ float* outp() {
    const CAS unsigned char* k = (const CAS unsigned char*)__builtin_amdgcn_kernarg_segment_ptr();
    asm volatile("" : "+s"(k));
    return (float*)*(GAS float* const CAS*)(k + 8 * N_IN);
}
template <class TP> __device__ __forceinline__ TP* wsp(Frame& F, size_t off) { GAS unsigned char* w = F.ws; asm volatile("" : "+s"(w)); return (TP*)(w + off); }

__device__ __forceinline__ float wave_sum(float v) {
#pragma unroll
    for (int o = 1; o < 64; o <<= 1) v += __shfl_xor(v, o);
    return v;
}
__device__ __forceinline__ float dot4(const f32x4 a, const f32x4 b) { return (a.x * b.x + a.y * b.y) + (a.z * b.z + a.w * b.w); }

__device__ __forceinline__ unsigned dbg_hash(unsigned a, unsigned b) { unsigned x = a * 2654435761u + b * 40503u + 0x9e3779b9u; x ^= x >> 15; x *= 2246822519u; x ^= x >> 13; x *= 3266489917u; x ^= x >> 16; return x; }
__device__ __forceinline__ void cksum_ptr(Frame& F, const v4u* p, size_t bytes, int slot) {
    const size_t n = bytes / 16, gt = (size_t)blockIdx.x * (NWAVES * 64) + F.tid, NGT = (size_t)F.G * NWAVES * 64; unsigned s = 0u;
    for (size_t i = gt; i < n; i += NGT) { const v4u v = p[i]; s += (v.x + v.y) + (v.z + v.w); }
#pragma unroll
    for (int o = 1; o < 64; o <<= 1) s += (unsigned)__shfl_xor((int)s, o);
    if (F.lane == 0) __hip_atomic_fetch_add((unsigned*)(F.ctl + slot), s, RLX_AGENT);
}
__device__ __forceinline__ void cksum(Frame& F, size_t off, size_t bytes, int slot) { cksum_ptr(F, wsp<v4u>(F, off), bytes, slot); }

enum { PK_ID = 0, PK_INPROJ = 1, PK_SWIGLU = 2, PK_FP8 = 0x100 };
constexpr float W8_SCALE = 127.f / (5.f / 32.f), W8_INV = (5.f / 32.f) / 127.f;
__device__ __forceinline__ unsigned q8(float x) { const float r = fminf(fmaxf(rintf(x), -127.f), 127.f); return (unsigned)((int)r) & 0xffu; }
__device__ __forceinline__ unsigned pk4_fp8(float a, float b, float c, float d) { return q8(a) | (q8(b) << 8) | (q8(c) << 16) | (q8(d) << 24); }
struct TEntry { int in_idx, K, N, kind, F, item0; unsigned src_off; unsigned pad; unsigned long long dst_off; };
struct TTable { TEntry e[32]; int n, total; };
constexpr TTable make_table() {
    TTable t{}; int n = 0, it = 0;
    auto add = [&](int in_idx, size_t src_off, int K, int N, int kind, int F, size_t dst) {
        t.e[n].in_idx = in_idx; t.e[n].K = K; t.e[n].N = N; t.e[n].kind = kind; t.e[n].F = F; t.e[n].item0 = it; t.e[n].src_off = (unsigned)src_off; t.e[n].pad = 0; t.e[n].dst_off = dst;
        it += (K / 64) * (N / 32); ++n; };
    for (int l = 0; l < 2; ++l) add(I_WIN, (size_t)l * D * INC, D, INC, PK_INPROJ, 0, WS_WIN + (size_t)l * INC * D * 2);
    for (int l = 0; l < 2; ++l) add(I_WAO, (size_t)l * AV * D, AV, D, PK_ID, 0, WS_WA + (size_t)l * D * AV * 2);
    for (int l = 0; l < 2; ++l) add(I_WCO, (size_t)l * CCH * D, CCH, D, PK_ID, 0, WS_WC + (size_t)l * D * CCH * 2);
    for (int l = 0; l < 2; ++l) add(I_WO, (size_t)l * D * D, D, D, PK_ID, 0, WS_WO + (size_t)l * D * D * 2);
    add(I_WFGU, 0, D, 2 * FF, PK_SWIGLU | (MK_FP8_GU ? PK_FP8 : 0), FF, WS_WFGU);
    add(I_WFDN, 0, FF, D, PK_ID, 0, WS_WFDN);
    for (int l = 0; l < 2; ++l) add(I_WPG, (size_t)l * D * D, D, D, PK_ID, 0, WS_WPG + (size_t)l * D * D * 2);
    for (int l = 0; l < 2; ++l) add(I_WPP, (size_t)l * PLE * D, PLE, D, PK_ID, 0, WS_WPP + (size_t)l * D * PLE * 2);
    for (int e = 0; e < NE; ++e) add(I_WEGU, (size_t)e * D * 2 * FE, D, 2 * FE, PK_SWIGLU | (MK_FP8_GU ? PK_FP8 : 0), FE, WS_WEGU + (size_t)e * 2 * FE * D * (MK_FP8_GU ? 1 : 2));
    for (int e = 0; e < NE; ++e) add(I_WEDN, (size_t)e * FE * D, FE, D, PK_ID, 0, WS_WEDN + (size_t)e * D * FE * 2);
    t.n = n; t.total = it; return t;
}
__constant__ TTable g_tt = make_table();
static_assert(make_table().n == 30, "transpose table");

__device__ __forceinline__ int dest_row(int kind_, int F, int c) {
    const int kind = kind_ & 0xff;
    if (kind == PK_INPROJ) {
        if (c < 1024) { const int d = c & 63, dd = d & 31; return (c & ~63) + ((dd >> 2) << 3) + ((d >> 5) << 2) + (dd & 3); }
        if (c >= 1536 && c < 2560) { const int cc = c - 1536, h = cc >= 512 ? 1 : 0, r = cc - h * 512; return 1536 + ((r >> 7) << 8) + (h << 7) + (r & 127); }
        return c;
    }
    if (kind == PK_SWIGLU) { const int h = c >= F ? 1 : 0, r = c - h * F; return ((r >> 7) << 8) + (h << 7) + (r & 127); }
    return c;
}
__device__ __forceinline__ void p0_transpose_item(const float* W, int K, int N, bf16* WT, int kind, int FFd, LAS float* scr, int item, int lane) {
    const int nblk = N / 32, kb = item / nblk, nb = item % nblk, k0 = 64 * kb, n0 = 32 * nb;
#pragma unroll 8
    for (int i = 0; i < 32; ++i) { const int kk = 2 * i + (lane >> 5); scr[kk * 33 + (lane & 31)] = W[(size_t)(k0 + kk) * N + n0 + (lane & 31)]; }
    LDS_WAIT(); asm volatile("" ::: "memory");
    const int c = lane & 7;
#pragma unroll
    for (int j = 0; j < 4; ++j) { const int n = (lane >> 3) + 8 * j; const LAS float* s = scr + (8 * c) * 33 + n;
        if (kind & PK_FP8) { v2u o8; o8.x = pk4_fp8(s[0 * 33] * W8_SCALE, s[1 * 33] * W8_SCALE, s[2 * 33] * W8_SCALE, s[3 * 33] * W8_SCALE); o8.y = pk4_fp8(s[4 * 33] * W8_SCALE, s[5 * 33] * W8_SCALE, s[6 * 33] * W8_SCALE, s[7 * 33] * W8_SCALE);
            *(v2u*)((unsigned char*)WT + (size_t)dest_row(kind, FFd, n0 + n) * K + k0 + 8 * c) = o8; }
        else { v4u o; o.x = pk2(s[0 * 33], s[1 * 33]); o.y = pk2(s[2 * 33], s[3 * 33]); o.z = pk2(s[4 * 33], s[5 * 33]); o.w = pk2(s[6 * 33], s[7 * 33]);
        *(v4u*)(WT + (size_t)dest_row(kind, FFd, n0 + n) * K + k0 + 8 * c) = o; } }
    LDS_WAIT(); asm volatile("" ::: "memory");
}
__device__ __forceinline__ void norm_rows(Frame& F, const float* src, const float* gain, bf16* dst, bool fp8 = false) {
    const int gw = blockIdx.x * NWAVES + F.wave, NGW = F.G * NWAVES;
    f32x4 g[4];
#pragma unroll
    for (int j = 0; j < 4; ++j) g[j] = ((const f32x4*)gain)[F.lane + 64 * j];
    for (int m = gw; m < T; m += NGW) {
        const f32x4* xr = (const f32x4*)(src + (size_t)m * D) + F.lane;
        f32x4 v[4]; float s = 0.f;
#pragma unroll
        for (int j = 0; j < 4; ++j) { v[j] = xr[64 * j]; s += dot4(v[j], v[j]); }
        const float rstd = 1.f / sqrtf(wave_sum(s) * (1.f / D) + EPS);
        if (fp8) { float am = 0.f;
#pragma unroll
            for (int j = 0; j < 4; ++j) { v[j] = v[j] * rstd * g[j]; am = fmaxf(am, fmaxf(fmaxf(fabsf(v[j].x), fabsf(v[j].y)), fmaxf(fabsf(v[j].z), fabsf(v[j].w)))); }
#pragma unroll
            for (int o = 1; o < 64; o <<= 1) am = fmaxf(am, __shfl_xor(am, o));
            am = fmaxf(am, 1e-20f); const float qs = 127.f / am;
            if (F.lane == 0) wsp<float>(F, WS_RS)[m] = am * (1.f / 127.f);
            unsigned* o4 = (unsigned*)((unsigned char*)dst + (size_t)m * D) + F.lane;
#pragma unroll
            for (int j = 0; j < 4; ++j) o4[64 * j] = pk4_fp8(v[j].x * qs, v[j].y * qs, v[j].z * qs, v[j].w * qs); }
        else { unsigned long long* o8 = (unsigned long long*)(dst + (size_t)m * D) + F.lane;
#pragma unroll
        for (int j = 0; j < 4; ++j) { const f32x4 y = v[j] * rstd * g[j]; o8[64 * j] = (unsigned long long)pk2(y.x, y.y) | ((unsigned long long)pk2(y.z, y.w) << 32); } }
    }
}
__device__ __forceinline__ void final_norm(Frame& F, const float* src, const float* gain, float* dst, float dbg_scale = 1.f) {
    const int gw = blockIdx.x * NWAVES + F.wave, NGW = F.G * NWAVES;
    f32x4 g[4];
#pragma unroll
    for (int j = 0; j < 4; ++j) g[j] = ((const f32x4*)gain)[F.lane + 64 * j];
    for (int m = gw; m < T; m += NGW) {
        const f32x4* xr = (const f32x4*)(src + (size_t)m * D) + F.lane;
        f32x4 v[4]; float s = 0.f;
#pragma unroll
        for (int j = 0; j < 4; ++j) { v[j] = xr[64 * j]; s += dot4(v[j], v[j]); }
        const float rstd = 1.f / sqrtf(wave_sum(s) * (1.f / D) + EPS);
        f32x4* o = (f32x4*)(dst + (size_t)m * D) + F.lane;
#pragma unroll
        for (int j = 0; j < 4; ++j) o[64 * j] = v[j] * rstd * g[j] * dbg_scale;
    }
}
__device__ __forceinline__ void p0_prologue(Frame& F) {
    LAS float* scr = (LAS float*)(F.lds + RING_OFF + F.wave * 16384);
    const int gw = blockIdx.x * NWAVES + F.wave, NGW = F.G * NWAVES;
    const int ntot = g_tt.total, nent = g_tt.n;
    for (int it = gw; it < ntot; it += NGW) {
        int ei = 0;
        while (ei + 1 < nent && it >= g_tt.e[ei + 1].item0) ++ei;
        const TEntry& te = g_tt.e[ei];
        p0_transpose_item(inp(te.in_idx) + te.src_off, te.K, te.N, wsp<bf16>(F, te.dst_off), te.kind, te.F, scr, it - te.item0, F.lane);
    }
    { const int gt = blockIdx.x * (NWAVES * 64) + F.tid, NGT = F.G * NWAVES * 64; const float* p = inp(I_P); bf16* pb = wsp<bf16>(F, WS_PB);
      for (int i = gt; i < 2 * T * PLE / 8; i += NGT) { const f32x4 a = *(const f32x4*)(p + (size_t)i * 8), b = *(const f32x4*)(p + (size_t)i * 8 + 4);
          v4u o; o.x = pk2(a.x, a.y); o.y = pk2(a.z, a.w); o.z = pk2(b.x, b.y); o.w = pk2(b.z, b.w); *(v4u*)(pb + (size_t)i * 8) = o; } }
    { const int gt = blockIdx.x * (NWAVES * 64) + F.tid, NGT = F.G * NWAVES * 64; float* rope = wsp<float>(F, WS_ROPE);
      for (int i = gt; i < SEQ * 32; i += NGT) { const int pos = i >> 5, f = i & 31;
          const float inv = exp2f(-(float)(2 * f) * (1.0f / 64.0f) * 13.287712379549449f); const float ang = (float)pos * inv;
          double rev = (double)ang * 0.15915494309189535; rev -= floor(rev); const float rv = (float)rev;
          rope[pos * 64 + f] = __builtin_amdgcn_cosf(rv); rope[pos * 64 + 32 + f] = __builtin_amdgcn_sinf(rv); } }
    if (blockIdx.x == 0 && F.wave == 0) {
        for (int l = 0; l < DEPTH; ++l) { const float* lf = inp(I_LAM) + l * 4 * HD;
            const float a = wave_sum(lf[F.lane] * lf[HD + F.lane]), b = wave_sum(lf[2 * HD + F.lane] * lf[3 * HD + F.lane]);
            const float lam_init = 0.8f - 0.6f * expf(-0.3f * (float)l);
            if (F.lane == 0) wsp<float>(F, WS_SCAL)[l] = expf(a) - expf(b) + lam_init; }
    }
#ifdef DBG_TWOPASS
    if (blockIdx.x == 0 && F.tid < 8) __hip_atomic_store((unsigned*)(F.ctl + CW_GCNT + 64 * F.tid), 0u, RLX_AGENT);
#endif
    norm_rows(F, inp(I_X), inp(I_GMIX), wsp<bf16>(F, WS_H));
}

__device__ __forceinline__ void route_phase(Frame& F, const float* src, const float* gain, bf16* dst) {
    LAS float* wrT = (LAS float*)(F.lds);
    LAS unsigned* lcnt = (LAS unsigned*)(F.lds + 32768);
    LAS unsigned* gbase = lcnt + 8;
    LAS int* rinfo = (LAS int*)(F.lds + 32768 + 64);
    const float* wr = inp(I_WR); const float* br = inp(I_BR);
    int* rti = wsp<int>(F, WS_RTI); float* rtw = wsp<float>(F, WS_RTW);
    for (int i = F.tid; i < NE * D; i += NWAVES * 64) wrT[(i & 7) * D + (i >> 3)] = wr[i];
    f32x4 g[4];
#pragma unroll
    for (int j = 0; j < 4; ++j) g[j] = ((const f32x4*)gain)[F.lane + 64 * j];
    __syncthreads();
    for (int item = blockIdx.x; item < T / 64; item += F.G) {
        if (F.tid < 8) lcnt[F.tid] = 0u;
        __syncthreads();
        for (int rr = 0; rr < 8; ++rr) {
            const int lr = F.wave * 8 + rr, m = item * 64 + lr;
            const f32x4* xr = (const f32x4*)(src + (size_t)m * D) + F.lane;
            f32x4 v[4]; float s = 0.f;
#pragma unroll
            for (int j = 0; j < 4; ++j) { v[j] = xr[64 * j]; s += dot4(v[j], v[j]); }
            const float rstd = 1.f / sqrtf(wave_sum(s) * (1.f / D) + EPS);
#if MK_FP8_GU
            unsigned* o4 = (unsigned*)((unsigned char*)dst + (size_t)m * D) + F.lane;
            float am = 0.f;
#pragma unroll
            for (int j = 0; j < 4; ++j) { v[j] = v[j] * rstd * g[j]; am = fmaxf(am, fmaxf(fmaxf(fabsf(v[j].x), fabsf(v[j].y)), fmaxf(fabsf(v[j].z), fabsf(v[j].w)))); }
#pragma unroll
            for (int o = 1; o < 64; o <<= 1) am = fmaxf(am, __shfl_xor(am, o));
            am = fmaxf(am, 1e-20f); const float qs = 127.f / am;
            if (F.lane == 0) wsp<float>(F, WS_RS)[m] = am * (1.f / 127.f);
#pragma unroll
            for (int j = 0; j < 4; ++j) o4[64 * j] = pk4_fp8(v[j].x * qs, v[j].y * qs, v[j].z * qs, v[j].w * qs);
#else
            unsigned long long* o8 = (unsigned long long*)(dst + (size_t)m * D) + F.lane;
#pragma unroll
            for (int j = 0; j < 4; ++j) { v[j] = v[j] * rstd * g[j]; o8[64 * j] = (unsigned long long)pk2(v[j].x, v[j].y) | ((unsigned long long)pk2(v[j].z, v[j].w) << 32); }
#endif
            float lg[8];
#pragma unroll
            for (int e = 0; e < 8; ++e) { float t = 0.f;
#pragma unroll
                for (int j = 0; j < 4; ++j) t += dot4(v[j], ((const LAS f32x4*)(wrT + e * D))[F.lane + 64 * j]);
                lg[e] = wave_sum(t) + br[e]; }
            int e1 = 0; float v1 = lg[0];
#pragma unroll
            for (int e = 1; e < 8; ++e) if (lg[e] > v1) { v1 = lg[e]; e1 = e; }
            int e2 = -1; float v2 = -INFINITY;
#pragma unroll
            for (int e = 0; e < 8; ++e) if (e != e1 && lg[e] > v2) { v2 = lg[e]; e2 = e; }
            if (e2 < 0) e2 = (e1 == 0) ? 1 : 0;
            const float ex = expf(v2 - v1), w1 = 1.f / (1.f + ex), w2 = ex / (1.f + ex);
            if (F.lane == 0) {
                const unsigned lp1 = __hip_atomic_fetch_add((unsigned*)&lcnt[e1], 1u, __ATOMIC_RELAXED, __HIP_MEMORY_SCOPE_WORKGROUP);
                const unsigned lp2 = __hip_atomic_fetch_add((unsigned*)&lcnt[e2], 1u, __ATOMIC_RELAXED, __HIP_MEMORY_SCOPE_WORKGROUP);
                rinfo[lr * 4 + 0] = e1; rinfo[lr * 4 + 1] = (int)lp1; rinfo[lr * 4 + 2] = e2; rinfo[lr * 4 + 3] = (int)lp2;
                rtw[(size_t)m * 2] = w1; rtw[(size_t)m * 2 + 1] = w2; }
        }
        __syncthreads();
        if (F.tid < 8) gbase[F.tid] = __hip_atomic_fetch_add((unsigned*)(F.ctl + CW_GCNT + 64 * F.tid), lcnt[F.tid], RLX_AGENT);
        __syncthreads();
        if (F.tid < 64) { const int m = item * 64 + F.tid; const int e1 = rinfo[F.tid * 4], lp1 = rinfo[F.tid * 4 + 1], e2 = rinfo[F.tid * 4 + 2], lp2 = rinfo[F.tid * 4 + 3];
            int* o = rti + (size_t)m * 4; o[0] = e1; o[1] = (int)gbase[e1] + lp1; o[2] = e2; o[3] = (int)gbase[e2] + lp2; }
        __syncthreads();
    }
}
__device__ __forceinline__ void load_counts(Frame& F, unsigned (&cnt)[8]) {
#pragma unroll
    for (int e = 0; e < 8; ++e) cnt[e] = (unsigned)__builtin_amdgcn_readfirstlane((int)__hip_atomic_load((unsigned*)(F.ctl + CW_GCNT + 64 * e), RLX_AGENT));
}
__device__ __forceinline__ void scatter_phase(Frame& F) {
    unsigned cnt[8]; load_counts(F, cnt);
    int coff[8]; { int s = 0;
#pragma unroll
        for (int e = 0; e < 8; ++e) { coff[e] = s; s += (int)((cnt[e] + 255u) & ~255u); } }
    const int gw = blockIdx.x * NWAVES + F.wave, NGW = F.G * NWAVES;
    const int* rti = wsp<int>(F, WS_RTI); int* rsel = wsp<int>(F, WS_RSEL); const bf16* H = wsp<bf16>(F, WS_H); bf16* HP = wsp<bf16>(F, WS_HP);
    for (int m = gw; m < T; m += NGW) {
        const int e1 = rti[(size_t)m * 4], p1 = rti[(size_t)m * 4 + 1], e2 = rti[(size_t)m * 4 + 2], p2 = rti[(size_t)m * 4 + 3];
        int c1 = 0, c2 = 0;
#pragma unroll
        for (int e = 0; e < 8; ++e) { c1 = (e1 == e) ? coff[e] : c1; c2 = (e2 == e) ? coff[e] : c2; }
        const int r1 = c1 + p1, r2 = c2 + p2;
#if MK_FP8_GU
        const v4u a = ((const v4u*)((const unsigned char*)H + (size_t)m * D))[F.lane];
        ((v4u*)((unsigned char*)HP + (size_t)r1 * D))[F.lane] = a; ((v4u*)((unsigned char*)HP + (size_t)r2 * D))[F.lane] = a;
        if (F.lane == 0) { const float rsv = wsp<float>(F, WS_RS)[m]; wsp<float>(F, WS_RSP)[r1] = rsv; wsp<float>(F, WS_RSP)[r2] = rsv; }
#else
        const v4u* s = (const v4u*)(H + (size_t)m * D); const v4u a = s[F.lane], b = s[F.lane + 64];
        v4u* d1 = (v4u*)(HP + (size_t)r1 * D); v4u* d2 = (v4u*)(HP + (size_t)r2 * D);
        d1[F.lane] = a; d1[F.lane + 64] = b; d2[F.lane] = a; d2[F.lane + 64] = b;
#endif
        if (F.lane == 0) { rsel[(size_t)m * 2] = r1; rsel[(size_t)m * 2 + 1] = r2; }
    }
}
__device__ __forceinline__ void combine_norm_phase(Frame& F, float* X, const float* gain, bf16* dst) {
    const int gw = blockIdx.x * NWAVES + F.wave, NGW = F.G * NWAVES;
    const int* rsel = wsp<int>(F, WS_RSEL); const float* rtw = wsp<float>(F, WS_RTW); const float* Y = wsp<float>(F, WS_Y);
    f32x4 g[4];
#pragma unroll
    for (int j = 0; j < 4; ++j) g[j] = ((const f32x4*)gain)[F.lane + 64 * j];
    for (int m = gw; m < T; m += NGW) {
        const int r1 = rsel[(size_t)m * 2], r2 = rsel[(size_t)m * 2 + 1]; const float w1 = rtw[(size_t)m * 2], w2 = rtw[(size_t)m * 2 + 1];
        f32x4* xr = (f32x4*)(X + (size_t)m * D) + F.lane; const f32x4* y1 = (const f32x4*)(Y + (size_t)r1 * D) + F.lane; const f32x4* y2 = (const f32x4*)(Y + (size_t)r2 * D) + F.lane;
        f32x4 v[4]; float s = 0.f;
#pragma unroll
        for (int j = 0; j < 4; ++j) { v[j] = xr[64 * j] + (y1[64 * j] * w1 + y2[64 * j] * w2); xr[64 * j] = v[j]; s += dot4(v[j], v[j]); }
        const float rstd = 1.f / sqrtf(wave_sum(s) * (1.f / D) + EPS);
        unsigned long long* o8 = (unsigned long long*)(dst + (size_t)m * D) + F.lane;
#pragma unroll
        for (int j = 0; j < 4; ++j) { const f32x4 y = v[j] * rstd * g[j]; o8[64 * j] = (unsigned long long)pk2(y.x, y.y) | ((unsigned long long)pk2(y.z, y.w) << 32); }
    }
}

__device__ __forceinline__ void conv_phase(Frame& F, int layer) {
    LAS bf16* zt = (LAS bf16*)(F.lds);
    LAS float* wl = (LAS float*)(F.lds + 65536);
    const float* cw = inp(I_CW) + (size_t)layer * CK * CCH; const float* cb = inp(I_CB) + layer * CCH;
    const float* lg = inp(I_CLG) + layer * CCH; const float* lb = inp(I_CLB) + layer * CCH;
    const bf16* Z = wsp<bf16>(F, WS_Z); bf16* ZC = wsp<bf16>(F, WS_ZC);
    for (int i = F.tid; i < CK * CCH; i += NWAVES * 64) { const int tap = i >> 9, ch = i & 511; wl[((tap * 2 + ((ch >> 2) & 1)) * 64 + (ch >> 3)) * 4 + (ch & 3)] = cw[i]; }
    const int c0 = 8 * F.lane;
    const f32x4 b_lo = *(const f32x4*)(cb + c0), b_hi = *(const f32x4*)(cb + c0 + 4), g_lo = *(const f32x4*)(lg + c0), g_hi = *(const f32x4*)(lg + c0 + 4), o_lo = *(const f32x4*)(lb + c0), o_hi = *(const f32x4*)(lb + c0 + 4);
    for (int unit = blockIdx.x; unit < BATCH * (SEQ / 32); unit += F.G) {
        const int b = unit / (SEQ / 32), t0 = (unit % (SEQ / 32)) * 32;
        __syncthreads();
        for (int i = F.tid; i < 62 * 64; i += NWAVES * 64) { const int r = i >> 6, c16 = i & 63, t = t0 - CPAD + r;
            v4u val = (v4u){0u, 0u, 0u, 0u}; if (t >= 0 && t < SEQ) val = *(const v4u*)(Z + ((size_t)(b * SEQ + t)) * CCH + c16 * 8);
            *(LAS v4u*)(zt + r * CCH + c16 * 8) = val; }
        __syncthreads();
        const int r0 = 4 * F.wave;
        f32x4 alo[4], ahi[4];
#pragma unroll
        for (int rr = 0; rr < 4; ++rr) { alo[rr] = b_lo; ahi[rr] = b_hi; }
        f32x4 zlo[4], zhi[4];
#define CONV_LDZ(slot, rowi) do { const v4u zz = *(const LAS v4u*)(zt + (r0 + (rowi)) * CCH + c0); \
        zlo[slot] = (f32x4){bf_lo(zz.x), bf_hi(zz.x), bf_lo(zz.y), bf_hi(zz.y)}; zhi[slot] = (f32x4){bf_lo(zz.z), bf_hi(zz.z), bf_lo(zz.w), bf_hi(zz.w)}; } while (0)
        CONV_LDZ(0, 0); CONV_LDZ(1, 1); CONV_LDZ(2, 2);
#pragma unroll
        for (int tap = 0; tap < CK; ++tap) {
            CONV_LDZ((tap + 3) & 3, tap + 3);
            const f32x4 wlo = *(const LAS f32x4*)(wl + ((tap * 2 + 0) * 64 + F.lane) * 4), whi = *(const LAS f32x4*)(wl + ((tap * 2 + 1) * 64 + F.lane) * 4);
#pragma unroll
            for (int rr = 0; rr < 4; ++rr) { alo[rr] += wlo * zlo[(tap + rr) & 3]; ahi[rr] += whi * zhi[(tap + rr) & 3]; }
        }
#undef CONV_LDZ
#pragma unroll
        for (int rr = 0; rr < 4; ++rr) {
            const float mean = wave_sum((alo[rr].x + alo[rr].y) + (alo[rr].z + alo[rr].w) + (ahi[rr].x + ahi[rr].y) + (ahi[rr].z + ahi[rr].w)) * (1.f / CCH);
            const f32x4 dl = alo[rr] - mean, dh = ahi[rr] - mean;
            const float rstd = 1.f / sqrtf(wave_sum(dot4(dl, dl) + dot4(dh, dh)) * (1.f / CCH) + EPS);
            f32x4 yl = dl * rstd * g_lo + o_lo, yh = dh * rstd * g_hi + o_hi;
            yl = yl * pg8::sigm4(yl); yh = yh * pg8::sigm4(yh);
            *(v4u*)(ZC + ((size_t)(b * SEQ + t0 + r0 + rr)) * CCH + c0) = pg8::pack8(yl, yh);
        }
    }
    __syncthreads();
}

__device__ __forceinline__ void conv_naive_phase(Frame& F, int layer) {
    const float* cw = inp(I_CW) + (size_t)layer * CK * CCH; const float* cb = inp(I_CB) + layer * CCH;
    const float* lg = inp(I_CLG) + layer * CCH; const float* lb = inp(I_CLB) + layer * CCH;
    const bf16* Z = wsp<bf16>(F, WS_Z); bf16* ZC = wsp<bf16>(F, WS_ZC);
    const int gw = blockIdx.x * NWAVES + F.wave, NGW = F.G * NWAVES, c0 = 8 * F.lane;
    for (int m = gw; m < T; m += NGW) {
        const int b = m / SEQ, t = m % SEQ;
        f32x4 alo = *(const f32x4*)(cb + c0), ahi = *(const f32x4*)(cb + c0 + 4);
        for (int tap = 0; tap < CK; ++tap) { const int tt = t + tap - CPAD; if (tt < 0 || tt >= SEQ) continue;
            const v4u zz = *(const v4u*)(Z + ((size_t)(b * SEQ + tt)) * CCH + c0);
            const f32x4 wlo = *(const f32x4*)(cw + tap * CCH + c0), whi = *(const f32x4*)(cw + tap * CCH + c0 + 4);
            alo += wlo * (f32x4){bf_lo(zz.x), bf_hi(zz.x), bf_lo(zz.y), bf_hi(zz.y)}; ahi += whi * (f32x4){bf_lo(zz.z), bf_hi(zz.z), bf_lo(zz.w), bf_hi(zz.w)}; }
        const float mean = wave_sum((alo.x + alo.y) + (alo.z + alo.w) + (ahi.x + ahi.y) + (ahi.z + ahi.w)) * (1.f / CCH);
        const f32x4 dl = alo - mean, dh = ahi - mean;
        const float rstd = 1.f / sqrtf(wave_sum(dot4(dl, dl) + dot4(dh, dh)) * (1.f / CCH) + EPS);
        f32x4 yl = dl * rstd * *(const f32x4*)(lg + c0) + *(const f32x4*)(lb + c0), yh = dh * rstd * *(const f32x4*)(lg + c0 + 4) + *(const f32x4*)(lb + c0 + 4);
        yl = yl * pg8::sigm4(yl); yh = yh * pg8::sigm4(yh);
        *(v4u*)(ZC + (size_t)m * CCH + c0) = pg8::pack8(yl, yh);
    }
}

#ifdef DBG_CHECK_INPROJ
__device__ __forceinline__ float chk_col(const float* w, const f32x4 (&hv)[4], int lane, int c) {
    float t = 0.f;
#pragma unroll
    for (int j = 0; j < 4; ++j) { const int k = 4 * (lane + 64 * j); t += hv[j].x * w[(size_t)(k + 0) * INC + c] + hv[j].y * w[(size_t)(k + 1) * INC + c] + hv[j].z * w[(size_t)(k + 2) * INC + c] + hv[j].w * w[(size_t)(k + 3) * INC + c]; }
    return wave_sum(t);
}
__device__ __forceinline__ bool chk_bad(float got, float exp_) { return !(fabsf(got - exp_) <= 0.02f + 0.02f * fabsf(exp_)); }
__device__ __forceinline__ void check_inproj(Frame& F, int layer) {
    const int gw = blockIdx.x * NWAVES + F.wave; const int m = (int)(dbg_hash((unsigned)gw, 5u) % (unsigned)T), pos = m % SEQ;
    const float* x = layer == 0 ? inp(I_X) : (const float*)wsp<float>(F, WS_X); const float* gain = inp(I_GMIX) + (size_t)layer * D; const float* w = inp(I_WIN) + (size_t)layer * D * INC; const float* rope = wsp<float>(F, WS_ROPE);
    const bf16* Q = wsp<bf16>(F, WS_Q); const bf16* K = wsp<bf16>(F, WS_K); const bf16* V = wsp<bf16>(F, WS_V); const bf16* Z = wsp<bf16>(F, WS_Z); const bf16* SG = wsp<bf16>(F, WS_SG);
    f32x4 hv[4]; float s = 0.f;
#pragma unroll
    for (int j = 0; j < 4; ++j) { hv[j] = ((const f32x4*)(x + (size_t)m * D))[F.lane + 64 * j]; s += dot4(hv[j], hv[j]); }
    const float rstd = 1.f / sqrtf(wave_sum(s) * (1.f / D) + EPS);
#pragma unroll
    for (int j = 0; j < 4; ++j) hv[j] = hv[j] * rstd * ((const f32x4*)gain)[F.lane + 64 * j];
    unsigned flags = 0u;
    { for (int i = 0; i < 2; ++i) { const int c0_ = (int)(dbg_hash((unsigned)gw, 100u + i) % 512u), c = (c0_ & ~63) | (c0_ & 31), f = c & 31; const float t1 = chk_col(w, hv, F.lane, c), t2 = chk_col(w, hv, F.lane, c + 32);
        const float cs = rope[pos * 64 + f], sn = rope[pos * 64 + 32 + f];
        if (chk_bad(bf_lo((unsigned)Q[(size_t)m * 512 + c]), (t1 * cs - t2 * sn) * QSCALE) || chk_bad(bf_lo((unsigned)Q[(size_t)m * 512 + c + 32]), (t2 * cs + t1 * sn) * QSCALE)) flags |= 1u; } }
    { const int c0_ = (int)(dbg_hash((unsigned)gw, 102u) % 512u), c = (c0_ & ~63) | (c0_ & 31), f = c & 31; const float t1 = chk_col(w, hv, F.lane, 512 + c), t2 = chk_col(w, hv, F.lane, 512 + c + 32);
        const float cs = rope[pos * 64 + f], sn = rope[pos * 64 + 32 + f];
        if (chk_bad(bf_lo((unsigned)K[(size_t)m * 512 + c]), t1 * cs - t2 * sn) || chk_bad(bf_lo((unsigned)K[(size_t)m * 512 + c + 32]), t2 * cs + t1 * sn)) flags |= 1u; }
    { const int cv = (int)(dbg_hash((unsigned)gw, 103u) % 512u); const float v = chk_col(w, hv, F.lane, 1024 + cv); if (chk_bad(bf_lo((unsigned)V[(size_t)m * 512 + cv]), v)) flags |= 2u; }
    { int cz[2]; cz[0] = (int)(dbg_hash((unsigned)gw, 104u) % 512u); cz[1] = (int)(dbg_hash((unsigned)gw, 105u) % 512u); for (int i = 0; i < 2; ++i) { const float a = chk_col(w, hv, F.lane, 1536 + cz[i]), g = chk_col(w, hv, F.lane, 2048 + cz[i]);
        if (chk_bad(bf_lo((unsigned)Z[(size_t)m * 512 + cz[i]]), a / (1.f + expf(-g)))) flags |= 2u; } }
    { const int ca = (int)(dbg_hash((unsigned)gw, 106u) % 1024u), cb = (int)(dbg_hash((unsigned)gw, 107u) % 1024u); const float a = chk_col(w, hv, F.lane, 2560 + ca), b = chk_col(w, hv, F.lane, 2560 + 1024 + cb);
#ifdef DBG_SG_DETAIL
        unsigned code = 0u;
        if (chk_bad(bf_lo((unsigned)SG[(size_t)m * 2048 + ca]), 1.f / (1.f + expf(-a)))) code = (unsigned)(DBG_SG_DETAIL == 1 ? 18 - (10 + ca / 256) : (DBG_SG_DETAIL == 2 ? 1 + ((m % 256) >> 4) : DBG_SG_DETAIL == 3 ? 16 - ((m % 256) >> 4) : 1 + ((m >> 8) & 15)));
        if (chk_bad(bf_lo((unsigned)SG[(size_t)m * 2048 + 1024 + cb]), 1.f / (1.f + expf(-b)))) { const unsigned c2 = (unsigned)(DBG_SG_DETAIL == 1 ? 18 - (14 + cb / 256) : (DBG_SG_DETAIL == 2 ? 1 + ((m % 256) >> 4) : DBG_SG_DETAIL == 3 ? 16 - ((m % 256) >> 4) : 1 + ((m >> 8) & 15))); code = code > c2 ? code : c2; }
#if DBG_SG_DETAIL == 5
        if (F.lane == 0 && code) __hip_atomic_fetch_add((unsigned*)(F.ctl + 17), 1u, RLX_AGENT);
#else
        if (F.lane == 0 && code) __hip_atomic_fetch_max((unsigned*)(F.ctl + 16), code, RLX_AGENT);
#endif
#else
        if (chk_bad(bf_lo((unsigned)SG[(size_t)m * 2048 + ca]), 1.f / (1.f + expf(-a))) || chk_bad(bf_lo((unsigned)SG[(size_t)m * 2048 + 1024 + cb]), 1.f / (1.f + expf(-b)))) flags |= 4u;
#endif
    }
    if (F.lane == 0 && flags) __hip_atomic_fetch_or((unsigned*)(F.ctl + 16), flags, RLX_AGENT);
}
#endif

#ifdef DBG_CHECK_ACT
__device__ __forceinline__ void check_act(Frame& F) {
    const int gw = blockIdx.x * NWAVES + F.wave; const int m = (int)(dbg_hash((unsigned)gw, 3u) % (unsigned)T);
    const float* x = wsp<float>(F, WS_X); const float* gain = inp(I_GFFN); const float* w = inp(I_WFGU); const bf16* ACT = wsp<bf16>(F, WS_ACT);
    f32x4 hv[4]; float s = 0.f;
#pragma unroll
    for (int j = 0; j < 4; ++j) { hv[j] = ((const f32x4*)(x + (size_t)m * D))[F.lane + 64 * j]; s += dot4(hv[j], hv[j]); }
    const float rstd = 1.f / sqrtf(wave_sum(s) * (1.f / D) + EPS);
#pragma unroll
    for (int j = 0; j < 4; ++j) hv[j] = hv[j] * rstd * ((const f32x4*)gain)[F.lane + 64 * j];
    unsigned flags = 0u; int cj[4]; for (int i = 0; i < 4; ++i) cj[i] = (int)(dbg_hash((unsigned)gw, 110u + i) % (unsigned)FF);
    for (int i = 0; i < 4; ++i) { float g = 0.f, u = 0.f;
#pragma unroll
        for (int j = 0; j < 4; ++j) { const int k = 4 * (F.lane + 64 * j);
            g += hv[j].x * w[(size_t)(k + 0) * (2 * FF) + cj[i]] + hv[j].y * w[(size_t)(k + 1) * (2 * FF) + cj[i]] + hv[j].z * w[(size_t)(k + 2) * (2 * FF) + cj[i]] + hv[j].w * w[(size_t)(k + 3) * (2 * FF) + cj[i]];
            u += hv[j].x * w[(size_t)(k + 0) * (2 * FF) + FF + cj[i]] + hv[j].y * w[(size_t)(k + 1) * (2 * FF) + FF + cj[i]] + hv[j].z * w[(size_t)(k + 2) * (2 * FF) + FF + cj[i]] + hv[j].w * w[(size_t)(k + 3) * (2 * FF) + FF + cj[i]]; }
        g = wave_sum(g); u = wave_sum(u);
        const float ex = g / (1.f + expf(-g)) * u, got = bf_lo((unsigned)ACT[(size_t)m * FF + cj[i]]);
        if (!(fabsf(got - ex) <= 0.03f + 0.03f * fabsf(ex))) flags |= 8u; }
    if (F.lane == 0 && flags) __hip_atomic_fetch_or((unsigned*)(F.ctl + 16), flags, RLX_AGENT);
}
#endif

#ifdef DBG_CHECK_MIX
__device__ __forceinline__ float chk_dot_bf(const bf16* a, int K, const float* w, int ldw, int c, int lane) {
    float t = 0.f; for (int k = lane; k < K; k += 64) t += bf_lo((unsigned)a[k]) * w[(size_t)k * ldw + c]; return wave_sum(t); }
__device__ __forceinline__ void check_mix(Frame& F, int layer) {
    const int gw = blockIdx.x * NWAVES + F.wave; const int m = (int)(dbg_hash((unsigned)gw, 1u) % (unsigned)T);
    const bf16* OB = wsp<bf16>(F, WS_OB); const bf16* ZC = wsp<bf16>(F, WS_ZC); const bf16* SG = wsp<bf16>(F, WS_SG); const bf16* MIX = wsp<bf16>(F, WS_MIX);
    unsigned flags = 0u; int cc[4]; for (int i = 0; i < 4; ++i) cc[i] = (int)(dbg_hash((unsigned)gw, 120u + i) % (unsigned)D);
    for (int i = 0; i < 4; ++i) { const int c = cc[i];
        const float ad = chk_dot_bf(OB + (size_t)m * AV, AV, inp(I_WAO) + (size_t)layer * AV * D, D, c, F.lane), cd = chk_dot_bf(ZC + (size_t)m * CCH, CCH, inp(I_WCO) + (size_t)layer * CCH * D, D, c, F.lane);
        const float ex = bf_lo((unsigned)SG[(size_t)m * 2048 + c]) * ad + bf_lo((unsigned)SG[(size_t)m * 2048 + 1024 + c]) * cd, got = bf_lo((unsigned)MIX[(size_t)m * D + c]);
        if (!(fabsf(got - ex) <= 0.02f + 0.02f * fabsf(ex))) flags |= 16u; }
    if (F.lane == 0 && flags) __hip_atomic_fetch_or((unsigned*)(F.ctl + 16), flags, RLX_AGENT);
}
__device__ __forceinline__ void snap_wo(Frame& F) { const int gw = blockIdx.x * NWAVES + F.wave; const int m = (int)(dbg_hash((unsigned)gw, 6u) % (unsigned)T);
    if (F.lane < 4) wsp<float>(F, 3 * MiB + 768 * 1024)[(size_t)gw * 4 + F.lane] = wsp<float>(F, WS_X)[(size_t)m * D + (int)(dbg_hash((unsigned)gw, 130u + F.lane) % (unsigned)D)]; }
__device__ __forceinline__ void check_wo(Frame& F, int layer) {
    const int gw = blockIdx.x * NWAVES + F.wave; const int m = (int)(dbg_hash((unsigned)gw, 6u) % (unsigned)T);
    const bf16* MIX = wsp<bf16>(F, WS_MIX); const float* X = wsp<float>(F, WS_X); const float* xin = inp(I_X);
    unsigned flags = 0u; int cc[4]; for (int i_ = 0; i_ < 4; ++i_) cc[i_] = (int)(dbg_hash((unsigned)gw, 130u + i_) % (unsigned)D);
    for (int i = 0; i < 4; ++i) { const int c = cc[i];
        const float ex = (layer == 0 ? xin[(size_t)m * D + c] : wsp<float>(F, 3 * MiB + 768 * 1024)[(size_t)gw * 4 + i]) + chk_dot_bf(MIX + (size_t)m * D, D, inp(I_WO) + (size_t)layer * D * D, D, c, F.lane), got = X[(size_t)m * D + c];
        if (!(fabsf(got - ex) <= 0.02f + 0.02f * fabsf(ex))) flags |= 32u; }
    if (F.lane == 0 && flags) __hip_atomic_fetch_or((unsigned*)(F.ctl + 16), flags, RLX_AGENT);
}
#endif

#ifdef DBG_CHECK_FFN
constexpr size_t WS_DBG = 3 * MiB;
__device__ __forceinline__ void snap_x(Frame& F, int slot, int samp) {
    const int gw = blockIdx.x * NWAVES + F.wave; const int m = (int)(dbg_hash((unsigned)gw, (unsigned)samp) % (unsigned)T);
    if (F.lane < 4) wsp<float>(F, WS_DBG)[(size_t)gw * 16 + slot * 4 + F.lane] = wsp<float>(F, WS_X)[(size_t)m * D + (int)(dbg_hash((unsigned)gw, 140u + F.lane) % (unsigned)D)];
}
__device__ __forceinline__ float chk_dot_f(const float* a, int K, const float* w, int ldw, int c, int lane) { float t = 0.f; for (int k = lane; k < K; k += 64) t += a[k] * w[(size_t)k * ldw + c]; return wave_sum(t); }
__device__ __forceinline__ void check_down(Frame& F) {
    const int gw = blockIdx.x * NWAVES + F.wave; const int m = (int)(dbg_hash((unsigned)gw, 2u) % (unsigned)T); int cc[4]; for (int i_ = 0; i_ < 4; ++i_) cc[i_] = (int)(dbg_hash((unsigned)gw, 140u + i_) % (unsigned)D); unsigned flags = 0u;
    for (int i = 0; i < 4; ++i) { const float d = chk_dot_bf(wsp<bf16>(F, WS_ACT) + (size_t)m * FF, FF, inp(I_WFDN), D, cc[i], F.lane);
        const float ex = wsp<float>(F, WS_DBG)[(size_t)gw * 16 + i] + d, got = wsp<float>(F, WS_X)[(size_t)m * D + cc[i]];
        if (!(fabsf(got - ex) <= 0.02f + 0.02f * fabsf(ex))) flags |= 64u; }
    if (F.lane == 0 && flags) __hip_atomic_fetch_or((unsigned*)(F.ctl + 16), flags, RLX_AGENT);
}
__device__ __forceinline__ void check_norm3(Frame& F, int layer) {
    const int gw = blockIdx.x * NWAVES + F.wave; const int m = (int)(dbg_hash((unsigned)gw, 4u) % (unsigned)T); const float* x = wsp<float>(F, WS_X) + (size_t)m * D; const float* g = inp(I_GPLE) + (size_t)layer * D;
    float s = 0.f; for (int k = F.lane; k < D; k += 64) s += x[k] * x[k];
    const float rstd = 1.f / sqrtf(wave_sum(s) * (1.f / D) + EPS); unsigned flags = 0u;
    for (int k = F.lane; k < D; k += 64) { const float ex = x[k] * rstd * g[k], got = bf_lo((unsigned)wsp<bf16>(F, WS_H)[(size_t)m * D + k]); if (!(fabsf(got - ex) <= 0.01f + 0.01f * fabsf(ex))) flags |= 256u; }
    if (flags) __hip_atomic_fetch_or((unsigned*)(F.ctl + 16), flags, RLX_AGENT);
}
__device__ __forceinline__ void check_ple(Frame& F, int layer) {
    const int gw = blockIdx.x * NWAVES + F.wave; const int m = (int)(dbg_hash((unsigned)gw, 4u) % (unsigned)T); int cc[4]; for (int i_ = 0; i_ < 4; ++i_) cc[i_] = (int)(dbg_hash((unsigned)gw, 140u + i_) % (unsigned)D); unsigned flags = 0u;
    for (int i = 0; i < 4; ++i) { const float gl = chk_dot_bf(wsp<bf16>(F, WS_H) + (size_t)m * D, D, inp(I_WPG) + (size_t)layer * D * D, D, cc[i], F.lane);
        const float pj = chk_dot_f(inp(I_P) + ((size_t)layer * T + m) * PLE, PLE, inp(I_WPP) + (size_t)layer * PLE * D, D, cc[i], F.lane);
        const float ex = wsp<float>(F, WS_DBG)[(size_t)gw * 16 + 4 + i] + pj / (1.f + expf(-gl)) + DBG_INJECT, got = wsp<float>(F, WS_X)[(size_t)m * D + cc[i]];
        if (!(fabsf(got - ex) <= 0.02f + 0.02f * fabsf(ex))) flags |= 128u; }
    if (F.lane == 0 && flags) __hip_atomic_fetch_or((unsigned*)(F.ctl + 16), flags, RLX_AGENT);
}
#endif

#ifdef DBG_CHECK_ATTN
__device__ __forceinline__ void check_attn(Frame& F, int layer) {
    const int gw = blockIdx.x * NWAVES + F.wave; const int m = (int)(dbg_hash((unsigned)gw, 7u) % (unsigned)T), h = gw & 3, b = m / SEQ;
    const float lam = wsp<float>(F, WS_SCAL)[layer]; const float lam_init = 0.8f - 0.6f * expf(-0.3f * (float)layer), post = 1.f - lam_init;
    const float* gsub = inp(I_GSUB) + layer * VD;
    const bf16* Q = wsp<bf16>(F, WS_Q); const bf16* Kb = wsp<bf16>(F, WS_K) + (size_t)b * SEQ * AQK; const bf16* Vb = wsp<bf16>(F, WS_V) + (size_t)b * SEQ * AV; const bf16* OB = wsp<bf16>(F, WS_OB);
    LAS float* S = (LAS float*)(F.lds) + F.wave * 2048; LAS float* O = (LAS float*)(F.lds + 65536) + F.wave * 256;
    for (int c = 0; c < 2; ++c) {
        float qf[64];
#pragma unroll
        for (int i = 0; i < 8; ++i) { const v4u t = *(const v4u*)(Q + (size_t)m * AQK + h * 128 + c * 64 + i * 8);
            qf[8 * i] = bf_lo(t.x); qf[8 * i + 1] = bf_hi(t.x); qf[8 * i + 2] = bf_lo(t.y); qf[8 * i + 3] = bf_hi(t.y); qf[8 * i + 4] = bf_lo(t.z); qf[8 * i + 5] = bf_hi(t.z); qf[8 * i + 6] = bf_lo(t.w); qf[8 * i + 7] = bf_hi(t.w); }
        float mx = -1e30f;
        for (int i = 0; i < 32; ++i) { const int j = F.lane + 64 * i; const bf16* kr = Kb + (size_t)j * AQK + h * 128 + c * 64; float sc = 0.f;
#pragma unroll
            for (int t8 = 0; t8 < 8; ++t8) { const v4u t = *(const v4u*)(kr + t8 * 8);
                sc += qf[8 * t8] * bf_lo(t.x) + qf[8 * t8 + 1] * bf_hi(t.x) + qf[8 * t8 + 2] * bf_lo(t.y) + qf[8 * t8 + 3] * bf_hi(t.y) + qf[8 * t8 + 4] * bf_lo(t.z) + qf[8 * t8 + 5] * bf_hi(t.z) + qf[8 * t8 + 6] * bf_lo(t.w) + qf[8 * t8 + 7] * bf_hi(t.w); }
            S[j] = sc; mx = fmaxf(mx, sc); }
#pragma unroll
        for (int o = 1; o < 64; o <<= 1) mx = fmaxf(mx, __shfl_xor(mx, o));
        float l = 0.f;
        for (int i = 0; i < 32; ++i) { const int j = F.lane + 64 * i; const float p = exp2f(S[j] - mx); S[j] = p; l += p; }
        l = wave_sum(l);
        for (int ch = 0; ch < 4; ++ch) { float a[32];
#pragma unroll
            for (int k = 0; k < 32; ++k) a[k] = 0.f;
            for (int i = 0; i < 32; ++i) { const int j = F.lane + 64 * i; const float p = S[j]; const bf16* vr = Vb + (size_t)j * AV + h * 128 + ch * 32;
#pragma unroll
                for (int t8 = 0; t8 < 4; ++t8) { const v4u t = *(const v4u*)(vr + t8 * 8);
                    a[8 * t8] += p * bf_lo(t.x); a[8 * t8 + 1] += p * bf_hi(t.x); a[8 * t8 + 2] += p * bf_lo(t.y); a[8 * t8 + 3] += p * bf_hi(t.y); a[8 * t8 + 4] += p * bf_lo(t.z); a[8 * t8 + 5] += p * bf_hi(t.z); a[8 * t8 + 6] += p * bf_lo(t.w); a[8 * t8 + 7] += p * bf_hi(t.w); } }
#pragma unroll
            for (int k = 0; k < 32; ++k) { const float r = wave_sum(a[k]); if (F.lane == 0) O[c * 128 + ch * 32 + k] = r / l; } }
    }
    LDS_WAIT();
    const float d0 = O[F.lane] - lam * O[128 + F.lane], d1 = O[64 + F.lane] - lam * O[128 + 64 + F.lane];
    const float rstd = post / sqrtf(wave_sum(d0 * d0 + d1 * d1) * (1.f / VD) + EPS);
    const float e0 = d0 * rstd * gsub[F.lane], e1 = d1 * rstd * gsub[64 + F.lane];
    const float g0 = bf_lo((unsigned)OB[(size_t)m * AV + h * 128 + F.lane]), g1 = bf_lo((unsigned)OB[(size_t)m * AV + h * 128 + 64 + F.lane]);
    if (!(fabsf(g0 - e0) <= 0.03f + 0.03f * fabsf(e0)) || !(fabsf(g1 - e1) <= 0.03f + 0.03f * fabsf(e1))) __hip_atomic_fetch_or((unsigned*)(F.ctl + 16), 512u, RLX_AGENT);
}
#endif

#ifdef DBG_CHECK_MOE
__device__ __forceinline__ void check_route(Frame& F) {
    const int gw = blockIdx.x * NWAVES + F.wave; const int m = (int)(dbg_hash((unsigned)gw, 6u) % (unsigned)T);
    const float* x = wsp<float>(F, WS_X) + (size_t)m * D; const float* g = inp(I_GFFN) + D; const float* wr = inp(I_WR); const float* br = inp(I_BR);
    float s = 0.f; for (int k = F.lane; k < D; k += 64) s += x[k] * x[k];
    const float rstd = 1.f / sqrtf(wave_sum(s) * (1.f / D) + EPS);
    float lg[8];
#pragma unroll
    for (int e = 0; e < 8; ++e) lg[e] = 0.f;
    for (int k = F.lane; k < D; k += 64) { const float hk = x[k] * rstd * g[k];
#pragma unroll
        for (int e = 0; e < 8; ++e) lg[e] += hk * wr[k * 8 + e]; }
#pragma unroll
    for (int e = 0; e < 8; ++e) lg[e] = wave_sum(lg[e]) + br[e];
    int e1 = 0; float v1 = lg[0];
#pragma unroll
    for (int e = 1; e < 8; ++e) if (lg[e] > v1) { v1 = lg[e]; e1 = e; }
    int e2 = -1; float v2 = -INFINITY;
#pragma unroll
    for (int e = 0; e < 8; ++e) if (e != e1 && lg[e] > v2) { v2 = lg[e]; e2 = e; }
    const float ex = expf(v2 - v1), w1 = 1.f / (1.f + ex), w2 = ex / (1.f + ex);
    const int* rti = wsp<int>(F, WS_RTI) + (size_t)m * 4; const float* rtw = wsp<float>(F, WS_RTW) + (size_t)m * 2;
    const bool tie = (v1 - v2) < 1e-3f;
    bool bad = !(fabsf(rtw[0] + rtw[1] - 1.f) < 1e-3f);
    if (!tie) bad = bad || rti[0] != e1 || rti[2] != e2 || !(fabsf(rtw[0] - w1) < 2e-3f) || !(fabsf(rtw[1] - w2) < 2e-3f);
    if (bad && F.lane == 0) __hip_atomic_fetch_or((unsigned*)(F.ctl + 16), 1024u, RLX_AGENT);
}
__device__ __forceinline__ void check_experts(Frame& F) {
    const int gw = blockIdx.x * NWAVES + F.wave; const int m = (int)(dbg_hash((unsigned)gw, 6u) % (unsigned)T);
    const int* rti = wsp<int>(F, WS_RTI) + (size_t)m * 4; const int* rsel = wsp<int>(F, WS_RSEL) + (size_t)m * 2;
    const bf16* H = wsp<bf16>(F, WS_H) + (size_t)m * D; unsigned flags = 0u;
    for (int t = 0; t < 2; ++t) { const int e = rti[2 * t], r = rsel[t];
        const bf16* hp = wsp<bf16>(F, WS_HP) + (size_t)r * D; const bf16* act = wsp<bf16>(F, WS_ACT) + (size_t)r * FE; const float* y = wsp<float>(F, WS_Y) + (size_t)r * D;
        for (int k = F.lane; k < D; k += 64) if (hp[k] != H[k]) flags |= 2048u;
        const float* wgu = inp(I_WEGU) + (size_t)e * D * 2 * FE; const float* wdn = inp(I_WEDN) + (size_t)e * FE * D;
        int cj[3]; for (int i_ = 0; i_ < 3; ++i_) cj[i_] = (int)(dbg_hash((unsigned)gw, 150u + i_ + 8 * t) % (unsigned)FE);
        for (int i = 0; i < 3; ++i) { float gg = 0.f, uu = 0.f;
            for (int k = F.lane; k < D; k += 64) { const float hk = bf_lo((unsigned)hp[k]); gg += hk * wgu[(size_t)k * (2 * FE) + cj[i]]; uu += hk * wgu[(size_t)k * (2 * FE) + FE + cj[i]]; }
            gg = wave_sum(gg); uu = wave_sum(uu);
            const float ex = gg / (1.f + expf(-gg)) * uu, got = bf_lo((unsigned)act[cj[i]]);
            if (!(fabsf(got - ex) <= 0.03f + 0.03f * fabsf(ex))) flags |= 4096u; }
        int cc[2]; for (int i_ = 0; i_ < 2; ++i_) cc[i_] = (int)(dbg_hash((unsigned)gw, 160u + i_) % (unsigned)D);
        for (int i = 0; i < 2; ++i) { float d = 0.f; for (int k = F.lane; k < FE; k += 64) d += bf_lo((unsigned)act[k]) * wdn[(size_t)k * D + cc[i]];
            d = wave_sum(d); if (!(fabsf(y[cc[i]] - d) <= 0.02f + 0.02f * fabsf(d))) flags |= 8192u; }
    }
    if (F.lane < 2) wsp<float>(F, 3 * MiB + 512 * 1024)[(size_t)gw * 2 + F.lane] = wsp<float>(F, WS_X)[(size_t)m * D + (int)(dbg_hash((unsigned)gw, 160u + F.lane) % (unsigned)D)];
    if (flags) __hip_atomic_fetch_or((unsigned*)(F.ctl + 16), flags, RLX_AGENT);
}
__device__ __forceinline__ void check_combine(Frame& F) {
    const int gw = blockIdx.x * NWAVES + F.wave; const int m = (int)(dbg_hash((unsigned)gw, 6u) % (unsigned)T);
    const int* rsel = wsp<int>(F, WS_RSEL) + (size_t)m * 2; const float* rtw = wsp<float>(F, WS_RTW) + (size_t)m * 2; const float* Y = wsp<float>(F, WS_Y);
    if (F.lane < 2) { const int c = (int)(dbg_hash((unsigned)gw, 160u + F.lane) % (unsigned)D);
        const float ex = wsp<float>(F, 3 * MiB + 512 * 1024)[(size_t)gw * 2 + F.lane] + rtw[0] * Y[(size_t)rsel[0] * D + c] + rtw[1] * Y[(size_t)rsel[1] * D + c], got = wsp<float>(F, WS_X)[(size_t)m * D + c];
        if (!(fabsf(got - ex) <= 1e-3f + 1e-3f * fabsf(ex))) __hip_atomic_fetch_or((unsigned*)(F.ctl + 16), 16384u, RLX_AGENT); }
}
#endif

__device__ __forceinline__ void attn_naive_phase(Frame& F, int layer) {
    const float lam = wsp<float>(F, WS_SCAL)[layer]; const float lam_init = 0.8f - 0.6f * expf(-0.3f * (float)layer), post = 1.f - lam_init;
    const float* gsub = inp(I_GSUB) + layer * VD;
    const bf16* Q = wsp<bf16>(F, WS_Q); const bf16* Kb = wsp<bf16>(F, WS_K); const bf16* Vb = wsp<bf16>(F, WS_V); bf16* OB = wsp<bf16>(F, WS_OB);
    for (int unit = blockIdx.x; unit < BATCH * NH * (SEQ / 256); unit += F.G) {
        const int b = unit >> 5, h = (unit >> 3) & 3, qb = unit & 7, q = qb * 256 + (F.tid >> 1), c = F.tid & 1;
        const bf16* qp = Q + ((size_t)(b * SEQ + q)) * AQK + h * 128 + c * 64;
        unsigned qv[32];
#pragma unroll
        for (int i = 0; i < 8; ++i) { const v4u t = *(const v4u*)(qp + i * 8); qv[4 * i] = t.x; qv[4 * i + 1] = t.y; qv[4 * i + 2] = t.z; qv[4 * i + 3] = t.w; }
        float o[128];
#pragma unroll
        for (int e = 0; e < 128; ++e) o[e] = 0.f;
        float mx = -1e30f, l = 0.f;
        const bf16* kp = Kb + (size_t)b * SEQ * AQK + h * 128 + c * 64; const bf16* vp = Vb + (size_t)b * SEQ * AV + h * 128;
        for (int key = 0; key < SEQ; ++key) {
            float s = 0.f;
#pragma unroll
            for (int i = 0; i < 8; ++i) { const v4u kk = *(const v4u*)(kp + (size_t)key * AQK + i * 8);
                s += bf_lo(qv[4 * i]) * bf_lo(kk.x) + bf_hi(qv[4 * i]) * bf_hi(kk.x) + bf_lo(qv[4 * i + 1]) * bf_lo(kk.y) + bf_hi(qv[4 * i + 1]) * bf_hi(kk.y)
                   + bf_lo(qv[4 * i + 2]) * bf_lo(kk.z) + bf_hi(qv[4 * i + 2]) * bf_hi(kk.z) + bf_lo(qv[4 * i + 3]) * bf_lo(kk.w) + bf_hi(qv[4 * i + 3]) * bf_hi(kk.w); }
            const float mn = fmaxf(mx, s), alpha = __builtin_amdgcn_exp2f(mx - mn), p = __builtin_amdgcn_exp2f(s - mn); mx = mn; l = l * alpha + p;
#pragma unroll
            for (int i = 0; i < 16; ++i) { const v4u vv = *(const v4u*)(vp + (size_t)key * AV + i * 8);
                o[8 * i + 0] = o[8 * i + 0] * alpha + p * bf_lo(vv.x); o[8 * i + 1] = o[8 * i + 1] * alpha + p * bf_hi(vv.x);
                o[8 * i + 2] = o[8 * i + 2] * alpha + p * bf_lo(vv.y); o[8 * i + 3] = o[8 * i + 3] * alpha + p * bf_hi(vv.y);
                o[8 * i + 4] = o[8 * i + 4] * alpha + p * bf_lo(vv.z); o[8 * i + 5] = o[8 * i + 5] * alpha + p * bf_hi(vv.z);
                o[8 * i + 6] = o[8 * i + 6] * alpha + p * bf_lo(vv.w); o[8 * i + 7] = o[8 * i + 7] * alpha + p * bf_hi(vv.w); }
        }
        const float inv = 1.f / l; float rs = 0.f;
#pragma unroll
        for (int e = 0; e < 128; ++e) { const float mine = o[e] * inv, other = __shfl_xor(mine, 1); const float d = (c == 0) ? (mine - lam * other) : (other - lam * mine); o[e] = d; rs += d * d; }
        const float rstd = 1.f / sqrtf(rs * (1.f / VD) + EPS) * post;
        bf16* op = OB + ((size_t)(b * SEQ + q)) * AV + h * 128 + c * 64;
#pragma unroll
        for (int i = 0; i < 8; ++i) { float y[8];
#pragma unroll
            for (int j = 0; j < 8; ++j) y[j] = (c ? o[64 + 8 * i + j] : o[8 * i + j]) * rstd * gsub[c * 64 + 8 * i + j];
            v4u w; w.x = pk2(y[0], y[1]); w.y = pk2(y[2], y[3]); w.z = pk2(y[4], y[5]); w.w = pk2(y[6], y[7]); *(v4u*)(op + 8 * i) = w; }
    }
}

namespace dattn {
using bf16x8 = __attribute__((ext_vector_type(8))) short;
using s16x4  = __attribute__((ext_vector_type(4))) short;
using f32x16 = __attribute__((ext_vector_type(16))) float;
using u32x4  = __attribute__((ext_vector_type(4))) unsigned;
constexpr int NW = 8, QBLK = 32, KVBLK = 64, LDK = 512;
constexpr float THRL = 11.5f;
constexpr size_t SHM_V = KVBLK * 128 * 2, SHM_K = KVBLK * 128 * 2, SHM_ATTN = 2 * SHM_V + 2 * SHM_K + NW * 64 * 4;
#define KSWZ(row, colB) ((row) * 256 + ((colB) ^ (((row) & 7) << 4)))
#define SBAR() __builtin_amdgcn_sched_barrier(0)
__device__ __forceinline__ int crow(int r, int hi) { return (r & 3) + 8 * (r >> 2) + 4 * hi; }
__device__ __forceinline__ unsigned cvtpk(float lo, float hi) { return pg8::cvt_pk_bf16(lo, hi); }
__device__ __forceinline__ void partialSM(f32x16& p0, f32x16& p1, float& m_reg, float& mn, float& alpha) {
  float pmax = p0[0]; for (int r = 1; r < 16; ++r) pmax = fmaxf(pmax, p0[r]); for (int r = 0; r < 16; ++r) pmax = fmaxf(pmax, p1[r]);
  { auto rr = __builtin_amdgcn_permlane32_swap(__float_as_uint(pmax), __float_as_uint(pmax), false, false);
    pmax = fmaxf(__uint_as_float(rr[0]), __uint_as_float(rr[1])); }
  if (__builtin_expect(__all(pmax - m_reg <= THRL), 1)) { mn = m_reg; alpha = 1.f; }
  else { mn = fmaxf(m_reg, pmax); alpha = __builtin_amdgcn_exp2f(m_reg - mn); m_reg = mn; }
  for (int r = 0; r < 16; ++r) p0[r] = p0[r] - mn; for (int r = 0; r < 16; ++r) p1[r] = p1[r] - mn;
  for (int r = 0; r < 16; ++r) p0[r] = __builtin_amdgcn_exp2f(p0[r]);
}
__device__ __forceinline__ void finishSM(f32x16& p0, f32x16& p1, float alpha, float& l_reg, bf16x8& pa0, bf16x8& pa1, bf16x8& pa2, bf16x8& pa3) {
  for (int r = 0; r < 16; ++r) p1[r] = __builtin_amdgcn_exp2f(p1[r]);
  float ps = 0; for (int r = 0; r < 16; ++r) ps += p0[r]; for (int r = 0; r < 16; ++r) ps += p1[r];
  { auto rr = __builtin_amdgcn_permlane32_swap(__float_as_uint(ps), __float_as_uint(ps), false, false);
    ps = __uint_as_float(rr[0]) + __uint_as_float(rr[1]); }
  l_reg = l_reg * alpha + ps;
#define PK4(P, BASE, OUT) do { unsigned a0 = cvtpk(P[BASE + 0], P[BASE + 1]), a1 = cvtpk(P[BASE + 2], P[BASE + 3]);   \
    unsigned b0 = cvtpk(P[BASE + 4], P[BASE + 5]), b1 = cvtpk(P[BASE + 6], P[BASE + 7]);                              \
    auto r0 = __builtin_amdgcn_permlane32_swap(a0, b0, false, false); auto r1 = __builtin_amdgcn_permlane32_swap(a1, b1, false, false); \
    u32x4 w = {r0[0], r1[0], r0[1], r1[1]}; OUT = *reinterpret_cast<bf16x8*>(&w); } while (0)
  PK4(p0, 0, pa0); PK4(p0, 8, pa1); PK4(p1, 0, pa2); PK4(p1, 8, pa3);
#undef PK4
}
__device__ __forceinline__ void qkt(f32x16& p0, f32x16& p1, const char* Ks, const bf16x8* qr, int r32, int hi, int c) {
  p0 = f32x16{}; p1 = f32x16{};
  for (int d0 = 0; d0 < 4; ++d0) { int cb = (c * 64 + d0 * 16 + hi * 8) * 2;
    bf16x8 b0 = *reinterpret_cast<const bf16x8*>(Ks + KSWZ(r32, cb));
    bf16x8 b1 = *reinterpret_cast<const bf16x8*>(Ks + KSWZ(32 + r32, cb));
    p0 = __builtin_amdgcn_mfma_f32_32x32x16_bf16(b0, qr[d0], p0, 0, 0, 0);
    p1 = __builtin_amdgcn_mfma_f32_32x32x16_bf16(b1, qr[d0], p1, 0, 0, 0); }
}
__device__ __forceinline__ int v_st(int k, int c) { const int kk = (k & ~0xC) | ((k & 4) << 1) | ((k & 8) >> 1); return ((kk >> 3) * 4 + (c >> 5)) * 512 + ((kk & 7) * 32 + (c & 31)) * 2; }
__device__ __forceinline__ int v_rd_base(int lane) { return ((lane & 3) << 3) | (((lane >> 2) & 3) << 6) | (((lane >> 4) & 1) << 5) | (((lane >> 5) & 1) << 8); }
constexpr int v_rd_off(int d0, int ks, int half) { return d0 * 512 + ks * 4096 + half * 2048; }
template <int OFF> __device__ __forceinline__ s16x4 tr_read(int vb) {
  s16x4 r; asm volatile("ds_read_b64_tr_b16 %0, %1 offset:%2" : "=&v"(r) : "v"(vb), "i"(OFF) : "memory"); return r;
}
template <int D0> __device__ __forceinline__ void pv_one(f32x16& od, int vb, bf16x8 pa0, bf16x8 pa1, bf16x8 pa2, bf16x8 pa3) {
  const s16x4 l0 = tr_read<v_rd_off(D0, 0, 0)>(vb), h0 = tr_read<v_rd_off(D0, 0, 1)>(vb), l1 = tr_read<v_rd_off(D0, 1, 0)>(vb), h1 = tr_read<v_rd_off(D0, 1, 1)>(vb);
  const s16x4 l2 = tr_read<v_rd_off(D0, 2, 0)>(vb), h2 = tr_read<v_rd_off(D0, 2, 1)>(vb), l3 = tr_read<v_rd_off(D0, 3, 0)>(vb), h3 = tr_read<v_rd_off(D0, 3, 1)>(vb);
  asm volatile("s_waitcnt lgkmcnt(0)" ::: "memory"); SBAR();
#define PK(L, H) (bf16x8){L[0], L[1], L[2], L[3], H[0], H[1], H[2], H[3]}
  od = __builtin_amdgcn_mfma_f32_32x32x16_bf16(pa0, PK(l0, h0), od, 0, 0, 0);
  od = __builtin_amdgcn_mfma_f32_32x32x16_bf16(pa1, PK(l1, h1), od, 0, 0, 0);
  od = __builtin_amdgcn_mfma_f32_32x32x16_bf16(pa2, PK(l2, h2), od, 0, 0, 0);
  od = __builtin_amdgcn_mfma_f32_32x32x16_bf16(pa3, PK(l3, h3), od, 0, 0, 0);
#undef PK
}
__device__ __forceinline__ void pv_d0(f32x16* o, int vb, bf16x8 pa0, bf16x8 pa1, bf16x8 pa2, bf16x8 pa3) {
  pv_one<0>(o[0], vb, pa0, pa1, pa2, pa3); pv_one<1>(o[1], vb, pa0, pa1, pa2, pa3); pv_one<2>(o[2], vb, pa0, pa1, pa2, pa3); pv_one<3>(o[3], vb, pa0, pa1, pa2, pa3);
}
__device__ __forceinline__ void unit(const unsigned short* Qb, const unsigned short* Kh, const unsigned short* Vh, unsigned short* Ob, int seq, char* lds, float lam, float post, const float* gsub) {
  int tid_ = threadIdx.x; asm volatile("" : "+v"(tid_));
  const int tid = tid_, wid = tid >> 6, lane = tid & 63, r32 = lane & 31, hi = lane >> 5, c = wid >> 2, wq = wid & 3;
  char* V_lds = lds; char* K_lds = lds + 2 * SHM_V;
  float* ws = (float*)(lds + 2 * SHM_V + 2 * SHM_K) + wid * 64; float* li_l = ws; float* al_l = ws + 32;
  float m_reg = -1e30f, l_reg = 0; f32x16 o[4] = {}; bf16x8 qr[4];
  const unsigned short* Qw = Qb + (long)(wq * QBLK + r32) * LDK + c * 64 + hi * 8;
#pragma unroll
  for (int d0 = 0; d0 < 4; ++d0) qr[d0] = *reinterpret_cast<const bf16x8*>(Qw + d0 * 16);
  const int sr = tid >> 4, sc = (tid & 15) * 8, vst0 = v_st(sr, sc), vst1 = v_st(32 + sr, sc);
  const int vb0 = (int)(uintptr_t)V_lds + v_rd_base(lane);
  struct { bf16x8 vs0, vs1, ks0, ks1; } sr_[2];
#define SLOAD(i, k0) do { sr_[i].vs0 = *reinterpret_cast<const bf16x8*>(&Vh[(long)((k0) + sr) * LDK + sc]); sr_[i].vs1 = *reinterpret_cast<const bf16x8*>(&Vh[(long)((k0) + 32 + sr) * LDK + sc]); \
    sr_[i].ks0 = *reinterpret_cast<const bf16x8*>(&Kh[(long)((k0) + sr) * LDK + sc]); sr_[i].ks1 = *reinterpret_cast<const bf16x8*>(&Kh[(long)((k0) + 32 + sr) * LDK + sc]); } while (0)
#define SWRITE(b, i) do { *(bf16x8*)(V_lds + (b) * SHM_V + vst0) = sr_[i].vs0; *(bf16x8*)(V_lds + (b) * SHM_V + vst1) = sr_[i].vs1; int kc = sc * 2; \
    *(bf16x8*)(K_lds + (b) * SHM_K + KSWZ(sr, kc)) = sr_[i].ks0; *(bf16x8*)(K_lds + (b) * SHM_K + KSWZ(32 + sr, kc)) = sr_[i].ks1; } while (0)
#define SWAIT() asm volatile("s_waitcnt vmcnt(4)" ::: "memory")
#define RESC(a) do { if (__any((a) < 1.f)) { if (hi == 0) al_l[r32] = (a); asm volatile("s_waitcnt lgkmcnt(0)" ::: "memory"); \
    for (int d = 0; d < 4; ++d) for (int r = 0; r < 16; ++r) o[d][r] *= al_l[crow(r, hi)]; } } while (0)
  f32x16 pA0, pA1, pB0, pB1; float mnA, mnB, alA, alB; bf16x8 pa0, pa1, pa2, pa3; const int NT = seq / KVBLK;
  constexpr int SE = 0, SO = 1;
  SLOAD(SE, 0); asm volatile("s_waitcnt vmcnt(0)" ::: "memory"); SWRITE(0, SE); __syncthreads();
  qkt(pA0, pA1, K_lds, qr, r32, hi, c); partialSM(pA0, pA1, m_reg, mnA, alA);
  SLOAD(SO, KVBLK); if (2 < NT) SLOAD(SE, 2 * KVBLK);
  SWAIT(); SWRITE(1, SO); __syncthreads();
  for (int j = 1; j + 1 < NT; j += 2) {
    SBAR(); qkt(pB0, pB1, K_lds + SHM_K, qr, r32, hi, c);
    finishSM(pA0, pA1, alA, l_reg, pa0, pa1, pa2, pa3); SBAR();
    SLOAD(SO, (j + 2) * KVBLK); SBAR();
    pv_d0(o, vb0, pa0, pa1, pa2, pa3); partialSM(pB0, pB1, m_reg, mnB, alB);
    __syncthreads(); SWAIT(); SWRITE(0, SE);
    RESC(alB); __syncthreads();
    SBAR(); qkt(pA0, pA1, K_lds, qr, r32, hi, c);
    finishSM(pB0, pB1, alB, l_reg, pa0, pa1, pa2, pa3); SBAR();
    if (j + 3 < NT) SLOAD(SE, (j + 3) * KVBLK); SBAR();
    pv_d0(o, vb0 + (int)SHM_V, pa0, pa1, pa2, pa3); partialSM(pA0, pA1, m_reg, mnA, alA);
    __syncthreads(); SWAIT(); SWRITE(1, SO);
    RESC(alA); __syncthreads();
  }
  SBAR(); qkt(pB0, pB1, K_lds + SHM_K, qr, r32, hi, c);
  finishSM(pA0, pA1, alA, l_reg, pa0, pa1, pa2, pa3); SBAR();
  pv_d0(o, vb0, pa0, pa1, pa2, pa3); partialSM(pB0, pB1, m_reg, mnB, alB);
  __syncthreads(); RESC(alB);
  finishSM(pB0, pB1, alB, l_reg, pa0, pa1, pa2, pa3); SBAR();
  pv_d0(o, vb0 + (int)SHM_V, pa0, pa1, pa2, pa3);
  if (hi == 0) li_l[r32] = l_reg; asm volatile("s_waitcnt vmcnt(0) lgkmcnt(0)" ::: "memory");
  float rli[16];
#pragma unroll
  for (int r = 0; r < 16; ++r) rli[r] = __builtin_amdgcn_rcpf(li_l[crow(r, hi)]);
  __syncthreads();
  float* xch = (float*)lds + (size_t)wq * 64 * 64 + lane;
  if (c == 1) {
#pragma unroll
    for (int d0 = 0; d0 < 4; ++d0)
#pragma unroll
      for (int r = 0; r < 16; ++r) xch[(d0 * 16 + r) * 64] = o[d0][r] * rli[r] * lam;
  }
  __syncthreads();
  if (c == 0) {
    float ss[16];
#pragma unroll
    for (int r = 0; r < 16; ++r) { float a = 0.f;
#pragma unroll
      for (int d0 = 0; d0 < 4; ++d0) { const float d = o[d0][r] * rli[r] - xch[(d0 * 16 + r) * 64]; o[d0][r] = d; a += d * d; }
      ss[r] = a; }
#pragma unroll
    for (int r = 0; r < 16; ++r) {
#pragma unroll
      for (int off = 1; off < 32; off <<= 1) ss[r] += __shfl_xor(ss[r], off);
      ss[r] = post / sqrtf(ss[r] * (1.f / 128.f) + 1e-6f); }
    float gs[4];
#pragma unroll
    for (int d0 = 0; d0 < 4; ++d0) gs[d0] = gsub[32 * d0 + r32];
    unsigned short* Ow = Ob + (long)(wq * QBLK) * LDK;
#pragma unroll
    for (int r = 0; r < 16; ++r) { const int orow = crow(r, hi);
#pragma unroll
      for (int d0 = 0; d0 < 4; ++d0) Ow[(long)orow * LDK + d0 * 32 + r32] = (unsigned short)f2bf(o[d0][r] * ss[r] * gs[d0]); }
  }
  __syncthreads();
#undef SLOAD
#undef SWRITE
#undef SWAIT
#undef RESC
}
#undef KSWZ
#undef SBAR
}

__device__ __forceinline__ void attn_mfma_phase(Frame& F, int layer) {
    const float lam = wsp<float>(F, WS_SCAL)[layer]; const float lam_init = 0.8f - 0.6f * expf(-0.3f * (float)layer), post = 1.f - lam_init;
    const float* gsub = inp(I_GSUB) + layer * VD;
    const bf16* Q = wsp<bf16>(F, WS_Q); const bf16* Kb = wsp<bf16>(F, WS_K); const bf16* Vb = wsp<bf16>(F, WS_V); bf16* OB = wsp<bf16>(F, WS_OB);
    for (int u = blockIdx.x; u < BATCH * NH * (SEQ / 128); u += F.G) {
        const int b = u >> 6, h = (u >> 4) & 3, qb = u & 15;
        const size_t rb = (size_t)b * SEQ;
        dattn::unit(Q + (rb + qb * 128) * AQK + h * 128, Kb + rb * AQK + h * 128, Vb + rb * AV + h * 128, OB + (rb + qb * 128) * AV + h * 128, SEQ, (char*)F.lds, lam, post, gsub);
    }
}

constexpr int NSTEP = 11, NPH = 1 + DEPTH * NSTEP;
struct Args { const float* in[N_IN]; float* out; unsigned char* ws; int ph_lo, ph_hi, pass, pad; };
#ifndef DBG_SITES
#define DBG_SITES 0xFF
#endif
#define GEMM_SITE(ID, EpiT, g, S, E) do { if (!((DBG_SITES >> (ID)) & 1)) {} else if ((MK_NAIVE_GEMM >> (ID)) & 1) pg8::gemm_phase_naive<EpiT, pg8::GroupOrder>(g, S, E); \
    else pg8::gemm_phase<EpiT, pg8::GroupOrder, MK_ALIGN, MK_SP2>(F.lds + RING_OFF, g, S, E); } while (0)

__global__ void __launch_bounds__(NWAVES * 64, 2) mk_fwd(Args args) {
    extern __shared__ __attribute__((aligned(16))) unsigned char lds[];
    Frame F;
    F.lds = (LAS unsigned char*)lds;
    F.MISC = (volatile LAS unsigned*)(F.lds + MISC_OFF);
    F.tid = threadIdx.x; F.lane = F.tid & 63; F.wave = __builtin_amdgcn_readfirstlane(F.tid >> 6);
    F.G = gridDim.x; F.ws = (GAS unsigned char*)args.ws; F.ctl = (gu32*)(F.ws + WS_CTL);
    for (int u = F.tid; u < (LDS_BYTES - LDSCTL_OFF) / 4; u += NWAVES * 64) ((LAS unsigned*)(F.lds + LDSCTL_OFF))[u] = 0u;
    __syncthreads();
    const int lo = args.ph_lo, hi = args.ph_hi;
#ifdef DBG_START_DELAY
    if (lo == 0) { const unsigned long long t0 = __builtin_amdgcn_s_memrealtime(); while (__builtin_amdgcn_s_memrealtime() - t0 < (unsigned long long)DBG_START_DELAY) __builtin_amdgcn_s_sleep(32); }
#endif
    XcdBarrier bar; bar.bar = (unsigned*)(F.ctl + CW_BAR); bar.x = 0; bar.st = nullptr;
    if (hi - lo > 1) bar = xcd_barrier_post((unsigned*)(F.ctl + CW_BAR), F.MISC + 8);
#define PHASE_BEGIN() do { const CAS unsigned char* k_ = (const CAS unsigned char*)__builtin_amdgcn_kernarg_segment_ptr(); asm volatile("" : "+s"(k_)); \
    F.ws = *(GAS unsigned char* const CAS*)(k_ + 8 * (N_IN + 1)); F.ctl = (gu32*)(F.ws + WS_CTL); int t_ = threadIdx.x; asm volatile("" : "+v"(t_)); \
    F.tid = t_; F.lane = t_ & 63; F.wave = __builtin_amdgcn_readfirstlane(t_ >> 6); F.G = gridDim.x; } while (0)
#define IN(k) (lo <= (k) && (k) < hi)
#define SEAM(k) do { if (IN(k) && IN((k) + 1)) xcd_barrier(bar); } while (0)
#define H wsp<bf16>(F, WS_H)
#define X wsp<float>(F, WS_X)

#ifdef DBG_STOP
    if (lo == 100) {
        PHASE_BEGIN();
        float* o = outp(); const size_t gt = (size_t)blockIdx.x * (NWAVES * 64) + F.tid, NGT = (size_t)F.G * NWAVES * 64;
        for (size_t i = gt; i < (size_t)T * D; i += NGT) { float v = 0.f;
#define DG_BF(off, len) v += bf_lo((unsigned)wsp<bf16>(F, off)[i % (size_t)(len)]);
#define DG_F32(off, len) v += wsp<float>(F, off)[i % (size_t)(len)];
            DBG_DIGEST
            o[i] = v; }
        return;
    }
#endif
#ifdef DBG_TWOPASS
#define CW_CK 2048
#define CK(slot, off, bytes) cksum(F, off, bytes, CW_CK + dbg_pass * 64 + (slot))
#define CKBAR() xcd_barrier(bar)
    const int dbg_pass = args.pass;
#else
#define CK(slot, off, bytes) do {} while (0)
#define CKBAR() do {} while (0)
#endif
    if (IN(0)) { PHASE_BEGIN(); p0_prologue(F); }
    SEAM(0);
#ifdef DBG_TWOPASS
    { PHASE_BEGIN(); CK(0, WS_WIN, WS_X - WS_WIN); CK(0, WS_H, (size_t)T * D * 2); CK(0, WS_PB, (size_t)2 * T * PLE * 2); CK(0, WS_ROPE, (size_t)SEQ * 64 * 4); CKBAR(); }
#endif

    {
        constexpr int layer = 0;

        const int pb = 1 + layer * NSTEP;
#ifdef DBG_SKIP_MOE
        const bool moe = false; const bool skipffn = (layer & 1) != 0;
#elif defined(DBG_SKIP_DENSE)
        const bool moe = (layer & 1) != 0; const bool skipffn = (layer & 1) == 0;
#else
        const bool moe = (layer & 1) != 0; const bool skipffn = false;
#endif
        if (IN(pb + 0)) { PHASE_BEGIN();
            if (layer == 0) {
                pg8::Gemm g{wsp<bf16>(F, WS_PB), wsp<bf16>(F, WS_WPP), 2 * T, D, PLE}; pg8::GroupOrder S; S.init_equal(2, T, D, F.G, (int)blockIdx.x, (LAS int*)(F.lds + TP_OFF));
                pg8::EpiStore E{wsp<bf16>(F, WS_PROJ), D, D / 256};
                GEMM_SITE(0, pg8::EpiStore, g, S, E);
            }
            pg8::Gemm g{H, wsp<bf16>(F, WS_WIN) + (size_t)layer * INC * D, T, INC, D}; pg8::GroupOrder S; S.init_dense(T, INC, F.G, (int)blockIdx.x);
            pg8::EpiInProj E{wsp<bf16>(F, WS_Q), wsp<bf16>(F, WS_K), wsp<bf16>(F, WS_V), wsp<bf16>(F, WS_Z), wsp<bf16>(F, WS_SG), wsp<float>(F, WS_ROPE), QSCALE};
            GEMM_SITE(1, pg8::EpiInProj, g, S, E);
        }
        SEAM(pb + 0);
#ifdef DBG_TWOPASS
        { PHASE_BEGIN(); CK(pb + 0, WS_Q, 128 * MiB); if (layer == 0) CK(pb + 0, WS_PROJ, (size_t)2 * T * D * 2); if (layer == 1) { CK(32, WS_Q, 16 * MiB); CK(33, WS_K, 16 * MiB); CK(34, WS_V, 16 * MiB); CK(35, WS_Z, 16 * MiB); CK(36, WS_SG, 64 * MiB); } CKBAR(); }
#endif
        if (IN(pb + 1)) { PHASE_BEGIN();
#ifdef DBG_CHECK_INPROJ
            if (layer == DBG_LAYER) check_inproj(F, layer);
#endif
#if !defined(DBG_NO_ATTN) && MK_NAIVE_ATTN
            attn_naive_phase(F, layer);
#elif !defined(DBG_NO_ATTN)
            for (int rep_ = 0; rep_ < DBG_REP_ATTN; ++rep_) attn_mfma_phase(F, layer);
#else
            { bf16* ob = wsp<bf16>(F, WS_OB); const size_t gt = (size_t)blockIdx.x * (NWAVES * 64) + F.tid, NGT = (size_t)F.G * NWAVES * 64;
              for (size_t i = gt; i < (size_t)T * AV / 8; i += NGT) *(v4u*)(ob + i * 8) = (v4u){0u, 0u, 0u, 0u}; }
#endif
#if defined(DBG_NAIVE_CONV)
            conv_naive_phase(F, layer);
#elif !defined(DBG_NO_CONV)
            conv_phase(F, layer);
#else
            { bf16* ob = wsp<bf16>(F, WS_ZC); const size_t gt = (size_t)blockIdx.x * (NWAVES * 64) + F.tid, NGT = (size_t)F.G * NWAVES * 64;
              for (size_t i = gt; i < (size_t)T * CCH / 8; i += NGT) *(v4u*)(ob + i * 8) = (v4u){0u, 0u, 0u, 0u}; }
#endif
        }
        SEAM(pb + 1);
#ifdef DBG_CHECK_ATTN
        if (layer == DBG_CHECK_ATTN - 1) { PHASE_BEGIN(); check_attn(F, layer); xcd_barrier(bar); }
#endif
#ifdef DBG_TWOPASS
        { PHASE_BEGIN(); CK(pb + 1, WS_OB, 32 * MiB); CKBAR(); }
#endif
        if (IN(pb + 2)) { PHASE_BEGIN();
            { pg8::Gemm g{wsp<bf16>(F, WS_OB), wsp<bf16>(F, WS_WA) + (size_t)layer * D * AV, T, D, AV}; pg8::GroupOrder S; S.init_dense(T, D, F.G, (int)blockIdx.x);
              pg8::EpiGate<0> E{wsp<float>(F, WS_P), wsp<bf16>(F, WS_MIX), wsp<bf16>(F, WS_SG)};
              GEMM_SITE(2, pg8::EpiGate<0>, g, S, E); }
            { pg8::Gemm g{wsp<bf16>(F, WS_ZC), wsp<bf16>(F, WS_WC) + (size_t)layer * D * CCH, T, D, CCH}; pg8::GroupOrder S; S.init_dense(T, D, F.G, (int)blockIdx.x);
              pg8::EpiGate<1> E{wsp<float>(F, WS_P), wsp<bf16>(F, WS_MIX), wsp<bf16>(F, WS_SG)};
              GEMM_SITE(3, pg8::EpiGate<1>, g, S, E); }
        }
        SEAM(pb + 2);
#ifdef DBG_CHECK_MIX
        if (layer == DBG_LAYER) { PHASE_BEGIN(); check_mix(F, layer); snap_wo(F); xcd_barrier(bar); }
#endif
#ifdef DBG_TWOPASS
        { PHASE_BEGIN(); CK(pb + 2, WS_P, 96 * MiB); CKBAR(); }
#endif
        if (IN(pb + 3)) { PHASE_BEGIN();
            pg8::Gemm g{wsp<bf16>(F, WS_MIX), wsp<bf16>(F, WS_WO) + (size_t)layer * D * D, T, D, D}; pg8::GroupOrder S; S.init_dense(T, D, F.G, (int)blockIdx.x);
            pg8::EpiResid E{layer == 0 ? inp(I_X) : (const float*)X, X, D / 256};
            GEMM_SITE(4, pg8::EpiResid, g, S, E);
        }
        SEAM(pb + 3);
#ifdef DBG_CHECK_MIX
        if (layer == DBG_LAYER) { PHASE_BEGIN(); check_wo(F, layer); xcd_barrier(bar); }
#endif
#ifdef DBG_TWOPASS
        { PHASE_BEGIN(); CK(pb + 3, WS_X, (size_t)T * D * 4); CKBAR(); }
#endif
        if (IN(pb + 4)) { PHASE_BEGIN();
            if (moe) route_phase(F, X, inp(I_GFFN) + (size_t)layer * D, H);
            else norm_rows(F, X, inp(I_GFFN) + (size_t)layer * D, H, MK_FP8_GU != 0);
        }
        SEAM(pb + 4);
#ifdef DBG_CHECK_MOE
        if (moe) { PHASE_BEGIN(); check_route(F); xcd_barrier(bar); }
#endif
#ifdef DBG_TWOPASS
        { PHASE_BEGIN(); CK(pb + 4, WS_H, (size_t)T * D * 2); if (moe) CK(pb + 4, WS_RTW, (size_t)T * 8); CKBAR(); }
#endif
        if (moe) {
            if (IN(pb + 5)) { PHASE_BEGIN(); scatter_phase(F); }
            SEAM(pb + 5);
        }
        if (IN(pb + 6) && !skipffn) { PHASE_BEGIN();
            pg8::Gemm g; pg8::GroupOrder S; pg8::EpiSwiGLU E;
            constexpr int KG = MK_FP8_GU ? D / 2 : D;
            if (moe) { unsigned cnt[8]; load_counts(F, cnt); g = pg8::Gemm{wsp<bf16>(F, WS_HP), wsp<bf16>(F, WS_WEGU), MOE_ROWS, 2 * FE, KG}; S.init_counts(cnt, 2 * FE, F.G, (int)blockIdx.x, (LAS int*)(F.lds + TP_OFF)); E = pg8::EpiSwiGLU{wsp<bf16>(F, WS_ACT), FE, 2 * FE / 256, MK_FP8_GU ? (const float*)wsp<float>(F, WS_RSP) : nullptr, W8_INV}; }
            else { g = pg8::Gemm{H, wsp<bf16>(F, WS_WFGU), T, 2 * FF, KG}; S.init_dense(T, 2 * FF, F.G, (int)blockIdx.x); E = pg8::EpiSwiGLU{wsp<bf16>(F, WS_ACT), FF, 2 * FF / 256, MK_FP8_GU ? (const float*)wsp<float>(F, WS_RS) : nullptr, W8_INV}; }
            for (int rep_ = 0; rep_ < DBG_REP_GU; ++rep_) { pg8::gemm_phase<pg8::EpiSwiGLU, pg8::GroupOrder, MK_FP8_GU ? MK_ALIGN_GU : MK_ALIGN, MK_FP8_GU ? MK_SP2_GU : MK_SP2, (MK_FP8_GU != 0)>(F.lds + RING_OFF, g, S, E); }
        }
        SEAM(pb + 6);
#ifdef DBG_CHECK_FFN
        if (layer == 0) { PHASE_BEGIN(); snap_x(F, 0, 2); xcd_barrier(bar); }
#endif
#ifdef DBG_CHECK_ACT
        if (layer == 0) { PHASE_BEGIN(); check_act(F); xcd_barrier(bar); }
#endif
#ifdef DBG_TWOPASS
        { PHASE_BEGIN(); if (!moe) CK(pb + 6, WS_ACT, (size_t)T * FF * 2); CKBAR(); }
#endif
        if (IN(pb + 7) && !skipffn) { PHASE_BEGIN();
            pg8::Gemm g; pg8::GroupOrder S; pg8::EpiResid E;
            if (moe) { unsigned cnt[8]; load_counts(F, cnt); g = pg8::Gemm{wsp<bf16>(F, WS_ACT), wsp<bf16>(F, WS_WEDN), MOE_ROWS, D, FE}; S.init_counts(cnt, D, F.G, (int)blockIdx.x, (LAS int*)(F.lds + TP_OFF)); E = pg8::EpiResid{nullptr, wsp<float>(F, WS_Y), D / 256}; }
            else { g = pg8::Gemm{wsp<bf16>(F, WS_ACT), wsp<bf16>(F, WS_WFDN), T, D, FF}; S.init_dense(T, D, F.G, (int)blockIdx.x); E = pg8::EpiResid{X, X, D / 256}; }
            GEMM_SITE(6, pg8::EpiResid, g, S, E);
        }
        SEAM(pb + 7);
#ifdef DBG_CHECK_MOE
        if (moe) { PHASE_BEGIN(); check_experts(F); xcd_barrier(bar); }
#endif
#ifdef DBG_CHECK_FFN
        if (layer == 0) { PHASE_BEGIN(); check_down(F); xcd_barrier(bar); }
#endif
#ifdef DBG_TWOPASS
        { PHASE_BEGIN(); if (!moe) CK(pb + 7, WS_X, (size_t)T * D * 4); CKBAR(); }
#endif
        if (IN(pb + 8)) { PHASE_BEGIN();
            if (moe) combine_norm_phase(F, X, inp(I_GPLE) + (size_t)layer * D, H);
            else norm_rows(F, X, inp(I_GPLE) + (size_t)layer * D, H);
        }
        SEAM(pb + 8);
#ifdef DBG_CHECK_MOE
        if (moe) { PHASE_BEGIN(); check_combine(F); xcd_barrier(bar); }
#endif
#ifdef DBG_CHECK_FFN
        if (layer == DBG_LAYER) { PHASE_BEGIN(); check_norm3(F, layer); snap_x(F, 1, 4); xcd_barrier(bar); }
#endif
#ifdef DBG_TWOPASS
        { PHASE_BEGIN(); CK(pb + 8, WS_X, (size_t)T * D * 4); CK(pb + 8, WS_H, (size_t)T * D * 2); CKBAR(); }
#endif
#ifdef DBG_SKIP_PLE
        if (false) {
#else
        if (IN(pb + 9)) { PHASE_BEGIN();
#endif
            pg8::Gemm g{H, wsp<bf16>(F, WS_WPG) + (size_t)layer * D * D, T, D, D}; pg8::GroupOrder S; S.init_dense(T, D, F.G, (int)blockIdx.x);
            pg8::EpiPleGate E{X, wsp<bf16>(F, WS_PROJ) + (size_t)layer * T * D};
            GEMM_SITE(7, pg8::EpiPleGate, g, S, E);
        }
        SEAM(pb + 9);
#ifdef DBG_CHECK_FFN
        if (layer == DBG_LAYER) { PHASE_BEGIN(); check_ple(F, layer); xcd_barrier(bar); }
#endif
#ifdef DBG_TWOPASS
        { PHASE_BEGIN(); CK(pb + 9, WS_X, (size_t)T * D * 4); CKBAR(); }
#endif
        if (IN(pb + 10)) { PHASE_BEGIN();
            if (layer + 1 < DEPTH) norm_rows(F, X, inp(I_GMIX) + (size_t)(layer + 1) * D, H);
            else final_norm(F, X, inp(I_GFIN), outp());
        }
        if (layer + 1 < DEPTH) SEAM(pb + 10);
#ifdef DBG_TWOPASS
        if (layer + 1 < DEPTH) { PHASE_BEGIN(); CK(pb + 10, WS_H, (size_t)T * D * 2); CKBAR(); }
        else { xcd_barrier(bar); PHASE_BEGIN(); cksum_ptr(F, (const v4u*)outp(), (size_t)T * D * 4, CW_CK + dbg_pass * 64 + pb + 10); CKBAR(); }
#endif
    }
    {
        constexpr int layer = 1;

        const int pb = 1 + layer * NSTEP;
#ifdef DBG_SKIP_MOE
        const bool moe = false; const bool skipffn = (layer & 1) != 0;
#elif defined(DBG_SKIP_DENSE)
        const bool moe = (layer & 1) != 0; const bool skipffn = (layer & 1) == 0;
#else
        const bool moe = (layer & 1) != 0; const bool skipffn = false;
#endif
        if (IN(pb + 0)) { PHASE_BEGIN();
            if (layer == 0) {
                pg8::Gemm g{wsp<bf16>(F, WS_PB), wsp<bf16>(F, WS_WPP), 2 * T, D, PLE}; pg8::GroupOrder S; S.init_equal(2, T, D, F.G, (int)blockIdx.x, (LAS int*)(F.lds + TP_OFF));
                pg8::EpiStore E{wsp<bf16>(F, WS_PROJ), D, D / 256};
                GEMM_SITE(0, pg8::EpiStore, g, S, E);
            }
            pg8::Gemm g{H, wsp<bf16>(F, WS_WIN) + (size_t)layer * INC * D, T, INC, D}; pg8::GroupOrder S; S.init_dense(T, INC, F.G, (int)blockIdx.x);
            pg8::EpiInProj E{wsp<bf16>(F, WS_Q), wsp<bf16>(F, WS_K), wsp<bf16>(F, WS_V), wsp<bf16>(F, WS_Z), wsp<bf16>(F, WS_SG), wsp<float>(F, WS_ROPE), QSCALE};
            GEMM_SITE(1, pg8::EpiInProj, g, S, E);
        }
        SEAM(pb + 0);
#ifdef DBG_TWOPASS
        { PHASE_BEGIN(); CK(pb + 0, WS_Q, 128 * MiB); if (layer == 0) CK(pb + 0, WS_PROJ, (size_t)2 * T * D * 2); if (layer == 1) { CK(32, WS_Q, 16 * MiB); CK(33, WS_K, 16 * MiB); CK(34, WS_V, 16 * MiB); CK(35, WS_Z, 16 * MiB); CK(36, WS_SG, 64 * MiB); } CKBAR(); }
#endif
        if (IN(pb + 1)) { PHASE_BEGIN();
#ifdef DBG_CHECK_INPROJ
            if (layer == DBG_LAYER) check_inproj(F, layer);
#endif
#if !defined(DBG_NO_ATTN) && MK_NAIVE_ATTN
            attn_naive_phase(F, layer);
#elif !defined(DBG_NO_ATTN)
            for (int rep_ = 0; rep_ < DBG_REP_ATTN; ++rep_) attn_mfma_phase(F, layer);
#else
            { bf16* ob = wsp<bf16>(F, WS_OB); const size_t gt = (size_t)blockIdx.x * (NWAVES * 64) + F.tid, NGT = (size_t)F.G * NWAVES * 64;
              for (size_t i = gt; i < (size_t)T * AV / 8; i += NGT) *(v4u*)(ob + i * 8) = (v4u){0u, 0u, 0u, 0u}; }
#endif
#if defined(DBG_NAIVE_CONV)
            conv_naive_phase(F, layer);
#elif !defined(DBG_NO_CONV)
            conv_phase(F, layer);
#else
            { bf16* ob = wsp<bf16>(F, WS_ZC); const size_t gt = (size_t)blockIdx.x * (NWAVES * 64) + F.tid, NGT = (size_t)F.G * NWAVES * 64;
              for (size_t i = gt; i < (size_t)T * CCH / 8; i += NGT) *(v4u*)(ob + i * 8) = (v4u){0u, 0u, 0u, 0u}; }
#endif
        }
        SEAM(pb + 1);
#ifdef DBG_CHECK_ATTN
        if (layer == DBG_CHECK_ATTN - 1) { PHASE_BEGIN(); check_attn(F, layer); xcd_barrier(bar); }
#endif
#ifdef DBG_TWOPASS
        { PHASE_BEGIN(); CK(pb + 1, WS_OB, 32 * MiB); CKBAR(); }
#endif
        if (IN(pb + 2)) { PHASE_BEGIN();
            { pg8::Gemm g{wsp<bf16>(F, WS_OB), wsp<bf16>(F, WS_WA) + (size_t)layer * D * AV, T, D, AV}; pg8::GroupOrder S; S.init_dense(T, D, F.G, (int)blockIdx.x);
              pg8::EpiGate<0> E{wsp<float>(F, WS_P), wsp<bf16>(F, WS_MIX), wsp<bf16>(F, WS_SG)};
              GEMM_SITE(2, pg8::EpiGate<0>, g, S, E); }
            { pg8::Gemm g{wsp<bf16>(F, WS_ZC), wsp<bf16>(F, WS_WC) + (size_t)layer * D * CCH, T, D, CCH}; pg8::GroupOrder S; S.init_dense(T, D, F.G, (int)blockIdx.x);
              pg8::EpiGate<1> E{wsp<float>(F, WS_P), wsp<bf16>(F, WS_MIX), wsp<bf16>(F, WS_SG)};
              GEMM_SITE(3, pg8::EpiGate<1>, g, S, E); }
        }
        SEAM(pb + 2);
#ifdef DBG_CHECK_MIX
        if (layer == DBG_LAYER) { PHASE_BEGIN(); check_mix(F, layer); snap_wo(F); xcd_barrier(bar); }
#endif
#ifdef DBG_TWOPASS
        { PHASE_BEGIN(); CK(pb + 2, WS_P, 96 * MiB); CKBAR(); }
#endif
        if (IN(pb + 3)) { PHASE_BEGIN();
            pg8::Gemm g{wsp<bf16>(F, WS_MIX), wsp<bf16>(F, WS_WO) + (size_t)layer * D * D, T, D, D}; pg8::GroupOrder S; S.init_dense(T, D, F.G, (int)blockIdx.x);
            pg8::EpiResid E{layer == 0 ? inp(I_X) : (const float*)X, X, D / 256};
            GEMM_SITE(4, pg8::EpiResid, g, S, E);
        }
        SEAM(pb + 3);
#ifdef DBG_CHECK_MIX
        if (layer == DBG_LAYER) { PHASE_BEGIN(); check_wo(F, layer); xcd_barrier(bar); }
#endif
#ifdef DBG_TWOPASS
        { PHASE_BEGIN(); CK(pb + 3, WS_X, (size_t)T * D * 4); CKBAR(); }
#endif
        if (IN(pb + 4)) { PHASE_BEGIN();
            if (moe) route_phase(F, X, inp(I_GFFN) + (size_t)layer * D, H);
            else norm_rows(F, X, inp(I_GFFN) + (size_t)layer * D, H, MK_FP8_GU != 0);
        }
        SEAM(pb + 4);
#ifdef DBG_CHECK_MOE
        if (moe) { PHASE_BEGIN(); check_route(F); xcd_barrier(bar); }
#endif
#ifdef DBG_TWOPASS
        { PHASE_BEGIN(); CK(pb + 4, WS_H, (size_t)T * D * 2); if (moe) CK(pb + 4, WS_RTW, (size_t)T * 8); CKBAR(); }
#endif
        if (moe) {
            if (IN(pb + 5)) { PHASE_BEGIN(); scatter_phase(F); }
            SEAM(pb + 5);
        }
        if (IN(pb + 6) && !skipffn) { PHASE_BEGIN();
            pg8::Gemm g; pg8::GroupOrder S; pg8::EpiSwiGLU E;
            constexpr int KG = MK_FP8_GU ? D / 2 : D;
            if (moe) { unsigned cnt[8]; load_counts(F, cnt); g = pg8::Gemm{wsp<bf16>(F, WS_HP), wsp<bf16>(F, WS_WEGU), MOE_ROWS, 2 * FE, KG}; S.init_counts(cnt, 2 * FE, F.G, (int)blockIdx.x, (LAS int*)(F.lds + TP_OFF)); E = pg8::EpiSwiGLU{wsp<bf16>(F, WS_ACT), FE, 2 * FE / 256, MK_FP8_GU ? (const float*)wsp<float>(F, WS_RSP) : nullptr, W8_INV}; }
            else { g = pg8::Gemm{H, wsp<bf16>(F, WS_WFGU), T, 2 * FF, KG}; S.init_dense(T, 2 * FF, F.G, (int)blockIdx.x); E = pg8::EpiSwiGLU{wsp<bf16>(F, WS_ACT), FF, 2 * FF / 256, MK_FP8_GU ? (const float*)wsp<float>(F, WS_RS) : nullptr, W8_INV}; }
            for (int rep_ = 0; rep_ < DBG_REP_GU; ++rep_) { pg8::gemm_phase<pg8::EpiSwiGLU, pg8::GroupOrder, MK_FP8_GU ? MK_ALIGN_GU : MK_ALIGN, MK_FP8_GU ? MK_SP2_GU : MK_SP2, (MK_FP8_GU != 0)>(F.lds + RING_OFF, g, S, E); }
        }
        SEAM(pb + 6);
#ifdef DBG_CHECK_FFN
        if (layer == 0) { PHASE_BEGIN(); snap_x(F, 0, 2); xcd_barrier(bar); }
#endif
#ifdef DBG_CHECK_ACT
        if (layer == 0) { PHASE_BEGIN(); check_act(F); xcd_barrier(bar); }
#endif
#ifdef DBG_TWOPASS
        { PHASE_BEGIN(); if (!moe) CK(pb + 6, WS_ACT, (size_t)T * FF * 2); CKBAR(); }
#endif
        if (IN(pb + 7) && !skipffn) { PHASE_BEGIN();
            pg8::Gemm g; pg8::GroupOrder S; pg8::EpiResid E;
            if (moe) { unsigned cnt[8]; load_counts(F, cnt); g = pg8::Gemm{wsp<bf16>(F, WS_ACT), wsp<bf16>(F, WS_WEDN), MOE_ROWS, D, FE}; S.init_counts(cnt, D, F.G, (int)blockIdx.x, (LAS int*)(F.lds + TP_OFF)); E = pg8::EpiResid{nullptr, wsp<float>(F, WS_Y), D / 256}; }
            else { g = pg8::Gemm{wsp<bf16>(F, WS_ACT), wsp<bf16>(F, WS_WFDN), T, D, FF}; S.init_dense(T, D, F.G, (int)blockIdx.x); E = pg8::EpiResid{X, X, D / 256}; }
            GEMM_SITE(6, pg8::EpiResid, g, S, E);
        }
        SEAM(pb + 7);
#ifdef DBG_CHECK_MOE
        if (moe) { PHASE_BEGIN(); check_experts(F); xcd_barrier(bar); }
#endif
#ifdef DBG_CHECK_FFN
        if (layer == 0) { PHASE_BEGIN(); check_down(F); xcd_barrier(bar); }
#endif
#ifdef DBG_TWOPASS
        { PHASE_BEGIN(); if (!moe) CK(pb + 7, WS_X, (size_t)T * D * 4); CKBAR(); }
#endif
        if (IN(pb + 8)) { PHASE_BEGIN();
            if (moe) combine_norm_phase(F, X, inp(I_GPLE) + (size_t)layer * D, H);
            else norm_rows(F, X, inp(I_GPLE) + (size_t)layer * D, H);
        }
        SEAM(pb + 8);
#ifdef DBG_CHECK_MOE
        if (moe) { PHASE_BEGIN(); check_combine(F); xcd_barrier(bar); }
#endif
#ifdef DBG_CHECK_FFN
        if (layer == DBG_LAYER) { PHASE_BEGIN(); check_norm3(F, layer); snap_x(F, 1, 4); xcd_barrier(bar); }
#endif
#ifdef DBG_TWOPASS
        { PHASE_BEGIN(); CK(pb + 8, WS_X, (size_t)T * D * 4); CK(pb + 8, WS_H, (size_t)T * D * 2); CKBAR(); }
#endif
#ifdef DBG_SKIP_PLE
        if (false) {
#else
        if (IN(pb + 9)) { PHASE_BEGIN();
#endif
            pg8::Gemm g{H, wsp<bf16>(F, WS_WPG) + (size_t)layer * D * D, T, D, D}; pg8::GroupOrder S; S.init_dense(T, D, F.G, (int)blockIdx.x);
            pg8::EpiPleGate E{X, wsp<bf16>(F, WS_PROJ) + (size_t)layer * T * D};
            GEMM_SITE(7, pg8::EpiPleGate, g, S, E);
        }
        SEAM(pb + 9);
#ifdef DBG_CHECK_FFN
        if (layer == DBG_LAYER) { PHASE_BEGIN(); check_ple(F, layer); xcd_barrier(bar); }
#endif
#ifdef DBG_TWOPASS
        { PHASE_BEGIN(); CK(pb + 9, WS_X, (size_t)T * D * 4); CKBAR(); }
#endif
        if (IN(pb + 10)) { PHASE_BEGIN();
            if (layer + 1 < DEPTH) norm_rows(F, X, inp(I_GMIX) + (size_t)(layer + 1) * D, H);
            else final_norm(F, X, inp(I_GFIN), outp());
        }
        if (layer + 1 < DEPTH) SEAM(pb + 10);
#ifdef DBG_TWOPASS
        if (layer + 1 < DEPTH) { PHASE_BEGIN(); CK(pb + 10, WS_H, (size_t)T * D * 2); CKBAR(); }
        else { xcd_barrier(bar); PHASE_BEGIN(); cksum_ptr(F, (const v4u*)outp(), (size_t)T * D * 4, CW_CK + dbg_pass * 64 + pb + 10); CKBAR(); }
#endif
    }
#ifdef DBG_TWOPASS
    if (dbg_pass == 1) { PHASE_BEGIN();
      if (blockIdx.x == 0 && F.tid == 0) { unsigned idx = 0u;
          for (int k = NPH - 1; k >= 0; --k) if (__hip_atomic_load((unsigned*)(F.ctl + CW_CK + k), RLX_AGENT) != __hip_atomic_load((unsigned*)(F.ctl + CW_CK + 64 + k), RLX_AGENT)) idx = (unsigned)(k + 1);
          unsigned idx2 = 0u; for (int k = 36; k >= 32; --k) if (__hip_atomic_load((unsigned*)(F.ctl + CW_CK + k), RLX_AGENT) != __hip_atomic_load((unsigned*)(F.ctl + CW_CK + 64 + k), RLX_AGENT)) idx2 = (unsigned)(k - 31);
          __hip_atomic_store((unsigned*)(F.ctl + 16), idx + 32u * idx2, RLX_AGENT); }
      xcd_barrier(bar); }
#endif
#ifdef DBG_CODE_OUT
    if (args.pass == 1 || !DBG_TWOPASS_ON) { xcd_barrier(bar); PHASE_BEGIN(); final_norm(F, inp(I_X), inp(I_GFIN), outp(), 1.f + (float)__hip_atomic_load((unsigned*)(F.ctl + 16), RLX_AGENT) + (float)((__hip_atomic_load((unsigned*)(F.ctl + 17), RLX_AGENT) + 63u) / 64u)); }
#endif
#undef IN
#undef SEAM
#undef H
#undef X
}

extern "C" void kernel_launch(void* const* d_in, const int* in_sizes, int n_in, void* d_out, int out_size, void* d_ws, size_t ws_size, hipStream_t stream) {
    static int grid = 0;
    if (grid == 0) {
        if (n_in != N_IN || in_sizes[0] != T * D || out_size != T * D || ws_size < WS_END) {
            fprintf(stderr, "kernel_launch: built for %d inputs, x/out of %d floats, >= %zu bytes of workspace; got n_in %d, in0 %d, out %d, ws %zu; nothing launched\n", N_IN, T * D, (size_t)WS_END, n_in, n_in > 0 ? in_sizes[0] : -1, out_size, ws_size);
            grid = -1; return; }
        int dev = 0, cus = 0, per_cu = 0;
        if (hipGetDevice(&dev) != hipSuccess || hipDeviceGetAttribute(&cus, hipDeviceAttributeMultiprocessorCount, dev) != hipSuccess) { fprintf(stderr, "kernel_launch: device query failed\n"); grid = -1; return; }
        if (hipFuncSetAttribute((const void*)mk_fwd, hipFuncAttributeMaxDynamicSharedMemorySize, LDS_BYTES) != hipSuccess) { fprintf(stderr, "kernel_launch: hipFuncSetAttribute failed\n"); grid = -1; return; }
        if (hipOccupancyMaxActiveBlocksPerMultiprocessor(&per_cu, (const void*)mk_fwd, NWAVES * 64, LDS_BYTES) != hipSuccess || per_cu < 1) { fprintf(stderr, "kernel_launch: occupancy query reports %d workgroups per CU\n", per_cu); }
        (void)hipGetLastError();
        grid = cus;
    }
    if (grid < 0) return;
    if (hipMemsetAsync((char*)d_ws + WS_CTL, 0, CTL_ZERO_BYTES, stream) != hipSuccess) { fprintf(stderr, "kernel_launch: hipMemsetAsync failed\n"); return; }
    Args a{};
    for (int i = 0; i < N_IN; ++i) a.in[i] = (const float*)d_in[i];
    a.out = (float*)d_out; a.ws = (unsigned char*)d_ws;
#if MK_PER_PHASE
#ifdef DBG_STOP
    for (int ph = 0; ph <= DBG_STOP; ++ph) { a.ph_lo = ph; a.ph_hi = ph + 1; hipLaunchKernelGGL(mk_fwd, dim3(grid), dim3(NWAVES * 64), LDS_BYTES, stream, a); }
    a.ph_lo = 100; a.ph_hi = 101; hipLaunchKernelGGL(mk_fwd, dim3(grid), dim3(NWAVES * 64), LDS_BYTES, stream, a);
#else
    for (int ph = 0; ph < NPH; ++ph) { a.ph_lo = ph; a.ph_hi = ph + 1; hipLaunchKernelGGL(mk_fwd, dim3(grid), dim3(NWAVES * 64), LDS_BYTES, stream, a); }
#endif
#else
#ifdef DBG_TWOPASS
    a.ph_lo = 0; a.ph_hi = NPH; a.pass = 0; hipLaunchKernelGGL(mk_fwd, dim3(grid), dim3(NWAVES * 64), LDS_BYTES, stream, a);
    (void)hipMemsetAsync((char*)d_ws + WS_CTL + CW_BAR * 4, 0, XCD_BAR_WORDS * 4, stream); (void)hipMemsetAsync((char*)d_ws + WS_CTL + CW_GCNT * 4, 0, 2048, stream);
    a.pass = 1; hipLaunchKernelGGL(mk_fwd, dim3(grid), dim3(NWAVES * 64), LDS_BYTES, stream, a);
#else
    a.ph_lo = 0; a.ph_hi = NPH; hipLaunchKernelGGL(mk_fwd, dim3(grid), dim3(NWAVES * 64), LDS_BYTES, stream, a);
#endif
#endif
    const hipError_t le = hipPeekAtLastError();
    if (le != hipSuccess) fprintf(stderr, "kernel_launch: launch failed: %s\n", hipGetErrorName(le));
}
```

```cpp
#include <hip/hip_runtime.h>
#include <cstdio>
#include <cstdint>
#define MK_SP2 true
#define MK_ALIGN true
#define MK_NAIVE_ATTN 0
#define MK_FP8_GU 1
#define MK_ALIGN_GU true
#define MK_SP2_GU true
namespace pg8 {
#define PG8_LAS __attribute__((address_space(3)))
typedef unsigned short bf16_t;
typedef short bf16x8 __attribute__((ext_vector_type(8)));
typedef float f32x4 __attribute__((ext_vector_type(4)));
typedef unsigned u32x4 __attribute__((ext_vector_type(4)));
constexpr int BM = 256, BK = 64, HALF = 128, HTB = HALF * BK * 2  , STAGE_BYTES = 8 * HTB, NXCD = 8, WGM = 8;

__host__ __device__ __forceinline__ int lds_byte(int r, int c) { const int st = (r >> 4) * 2 + (c >> 5), rr = r & 15, cc = c & 31, ob = rr * 64 + cc * 2; return st * 1024 + (ob ^ (((ob >> 9) & 1) << 5)); }
__host__ __device__ __forceinline__ void stage_rc(int b, int& R, int& C) { const int st = b / 1024, sb = b % 1024, swz = sb ^ (((sb >> 9) & 1) << 5); R = (st >> 1) * 16 + swz / 64; C = (st & 1) * 32 + (swz % 64) / 2; }
__host__ __device__ __forceinline__ int perm32(int rho) { const int n = rho >> 4, i = rho & 15; return 8 * (i >> 2) + 4 * n + (i & 3); }

struct Unit { int pm, pn; };
struct Gemm { const bf16_t* A; const bf16_t* Bt; int M, N, K; };

typedef float cvt_f32x2_t __attribute__((ext_vector_type(2))); typedef __bf16 cvt_bf16x2_t __attribute__((ext_vector_type(2)));
__device__ __forceinline__ unsigned cvt_pk_bf16(float lo, float hi) { cvt_f32x2_t v = {lo, hi}; cvt_bf16x2_t b = __builtin_convertvector(v, cvt_bf16x2_t); return __builtin_bit_cast(unsigned, b); }
typedef float f32x2 __attribute__((ext_vector_type(2)));
typedef unsigned u32x2 __attribute__((ext_vector_type(2)));
__device__ __forceinline__ float sigm(float x) { return __builtin_amdgcn_rcpf(1.0f + __builtin_amdgcn_exp2f(-1.4426950408889634f * x)); }
__device__ __forceinline__ float bf_lo(unsigned w) { return __uint_as_float(w << 16); }
__device__ __forceinline__ float bf_hi(unsigned w) { return __uint_as_float(w & 0xffff0000u); }

struct GroupOrder {
    int ng, nN, nwg, G, c, TM; PG8_LAS int* tp;
    __device__ __forceinline__ void init_equal(int ngroups, int rows_per_group, int N, int G_, int c_, PG8_LAS int* tp_) {
        ng = ngroups; nN = N / BM; const int t = rows_per_group / BM; TM = t * ngroups; nwg = TM * nN; G = G_; c = c_; tp = tp_;
        if (ngroups > 1) { int tx = threadIdx.x; asm volatile("" : "+v"(tx)); if (tx < 9) tp[tx] = (tx < ngroups ? tx : ngroups) * t; __syncthreads(); }
    }
    __device__ __forceinline__ void init_dense(int M, int N, int G_, int c_) { init_equal(1, M, N, G_, c_, nullptr); }
    __device__ __forceinline__ void init_counts(const unsigned (&cnt)[8], int N, int G_, int c_, PG8_LAS int* tp_) {
        ng = 8; nN = N / BM; G = G_; c = c_; tp = tp_; int s = 0; int tx = threadIdx.x; asm volatile("" : "+v"(tx));
        if (tx == 0) tp[0] = 0;
#pragma unroll
        for (int e = 0; e < 8; ++e) { s += (int)((cnt[e] + 255u) >> 8); if (tx == 0) tp[e + 1] = s; }
        TM = s; nwg = TM * nN; __syncthreads();
    }
    __device__ __forceinline__ bool next(int i, Unit& u) const {
        const long L = (long)i * G + c; if (L >= nwg) return false;
        int wgid = (int)L; { const int q = nwg / NXCD, r = nwg % NXCD, xcd = wgid % NXCD, off = wgid / NXCD; wgid = (xcd < r ? xcd * (q + 1) : r * (q + 1) + (xcd - r) * q) + off; }
        const int nig = WGM * nN, gid = wgid / nig, fm = gid * WGM, gsz = (TM - fm) < WGM ? (TM - fm) : WGM;
        const int rt = fm + ((wgid % nig) % gsz), pl = (wgid % nig) / gsz;
        int e = 0;
        if (ng > 1) {
#pragma unroll
            for (int j = 1; j < 8; ++j) e += (j < ng && rt >= __builtin_amdgcn_readfirstlane(tp[j])) ? 1 : 0; }
        u.pm = rt; u.pn = e * nN + pl; return true;
    }
    __device__ __forceinline__ void a_ready(const Unit&) const {}
    __device__ __forceinline__ void done(const Unit&) const {}
};

#define EPI_ROWS(row0) _Pragma("unroll") for (int ai = 0; ai < 2; ++ai) _Pragma("unroll") for (int m = 0; m < 4; ++m)
__device__ __forceinline__ u32x4 pack8(const f32x4 a, const f32x4 b) { u32x4 w; w.x = cvt_pk_bf16(a[0], a[1]); w.y = cvt_pk_bf16(a[2], a[3]); w.z = cvt_pk_bf16(b[0], b[1]); w.w = cvt_pk_bf16(b[2], b[3]); return w; }
__device__ __forceinline__ f32x4 sigm4(const f32x4 v) { return (f32x4){sigm(v[0]), sigm(v[1]), sigm(v[2]), sigm(v[3])}; }

struct EpiInProj {
    static constexpr bool PERM = true, AFTER_DRAIN = false;
    bf16_t *Q, *K, *V, *Z, *SG; const float* rope; float qscale; const float* rs; float ws;
    __device__ __forceinline__ void operator()(const f32x4 (&acc_)[2][2][4][2], const Unit& u, int wr, int wc, int fr, int fq) const {
        const int pn = u.pn, row0 = u.pm * BM + wr * 64 + fr, cl = wc * 32 + 8 * fq;
        f32x4 acc[2][2][4][2];
        if (rs) { typedef int i32x4_ __attribute__((ext_vector_type(4)));
            EPI_ROWS(row0) { const float sc = rs[row0 + ai * HALF + m * 16] * ws;
#pragma unroll
                for (int bj = 0; bj < 2; ++bj)
#pragma unroll
                    for (int n = 0; n < 2; ++n) acc[ai][bj][m][n] = __builtin_convertvector(__builtin_bit_cast(i32x4_, acc_[ai][bj][m][n]), f32x4) * sc; } }
        else { EPI_ROWS(row0) {
#pragma unroll
                for (int bj = 0; bj < 2; ++bj)
#pragma unroll
                    for (int n = 0; n < 2; ++n) acc[ai][bj][m][n] = acc_[ai][bj][m][n]; } }
        if (pn < 4) {
            bf16_t* base = (pn < 2) ? Q : K; const float sc = (pn < 2) ? qscale : 1.0f; const int colt = (pn & 1) * 256, g4 = 4 * (4 * (wc & 1) + fq);
            EPI_ROWS(row0) { const int row = row0 + ai * HALF + m * 16; const float* rp = rope + (size_t)(row & 2047) * 64 + g4;
                const f32x4 cs = *(const f32x4*)rp, sn = *(const f32x4*)(rp + 32);
#pragma unroll
                for (int bj = 0; bj < 2; ++bj) { const f32x4 v0 = acc[ai][bj][m][0], v1 = acc[ai][bj][m][1];
                    const f32x4 lo = (v0 * cs - v1 * sn) * sc, hi = (v1 * cs + v0 * sn) * sc;
                    bf16_t* p = base + (size_t)row * 512 + colt + (2 * bj + (wc >> 1)) * 64 + g4;
                    u32x2 a; a.x = cvt_pk_bf16(lo[0], lo[1]); a.y = cvt_pk_bf16(lo[2], lo[3]); *(u32x2*)p = a;
                    u32x2 b; b.x = cvt_pk_bf16(hi[0], hi[1]); b.y = cvt_pk_bf16(hi[2], hi[3]); *(u32x2*)(p + 32) = b; } }
        } else if (pn < 6) {
            EPI_ROWS(row0) { bf16_t* p = V + (size_t)(row0 + ai * HALF + m * 16) * 512 + (pn - 4) * 256 + cl;
#pragma unroll
                for (int bj = 0; bj < 2; ++bj) *(u32x4*)(p + bj * HALF) = pack8(acc[ai][bj][m][0], acc[ai][bj][m][1]); }
        } else if (pn < 10) {
            EPI_ROWS(row0) { bf16_t* p = Z + (size_t)(row0 + ai * HALF + m * 16) * 512 + (pn - 6) * 128 + cl;
                *(u32x4*)p = pack8(acc[ai][0][m][0] * sigm4(acc[ai][1][m][0]), acc[ai][0][m][1] * sigm4(acc[ai][1][m][1])); }
        } else {
            EPI_ROWS(row0) { bf16_t* p = SG + (size_t)(row0 + ai * HALF + m * 16) * 2048 + (pn - 10) * 256 + cl;
#pragma unroll
                for (int bj = 0; bj < 2; ++bj) *(u32x4*)(p + bj * HALF) = pack8(sigm4(acc[ai][bj][m][0]), sigm4(acc[ai][bj][m][1])); }
        }
    }
};
template <int MODE> struct EpiGate {
    static constexpr bool PERM = false, AFTER_DRAIN = false;
    float* P; bf16_t* MIX; const bf16_t* SG;
    __device__ __forceinline__ void operator()(const f32x4 (&acc)[2][2][4][2], const Unit& u, int wr, int wc, int fr, int fq) const {
        const int row0 = u.pm * BM + wr * 64 + fr, col0 = u.pn * BM + wc * 32 + 4 * fq;
        EPI_ROWS(row0) { const size_t row = (size_t)(row0 + ai * HALF + m * 16);
#pragma unroll
            for (int bj = 0; bj < 2; ++bj)
#pragma unroll
                for (int n = 0; n < 2; ++n) { const int col = col0 + bj * HALF + n * 16;
                    const u32x2 gw = *(const u32x2*)(SG + row * 2048 + MODE * 1024 + col);
                    const f32x4 gt = (f32x4){bf_lo(gw.x), bf_hi(gw.x), bf_lo(gw.y), bf_hi(gw.y)};
                    if (MODE == 0) *(f32x4*)(P + row * 1024 + col) = gt * acc[ai][bj][m][n];
                    else { const f32x4 r = *(const f32x4*)(P + row * 1024 + col) + gt * acc[ai][bj][m][n];
                        u32x2 w; w.x = cvt_pk_bf16(r[0], r[1]); w.y = cvt_pk_bf16(r[2], r[3]); *(u32x2*)(MIX + row * 1024 + col) = w; } } }
    }
};
struct EpiResid {
    static constexpr bool PERM = false, AFTER_DRAIN = false;
    const float* base; float* out; int nN;
    __device__ __forceinline__ void operator()(const f32x4 (&acc)[2][2][4][2], const Unit& u, int wr, int wc, int fr, int fq) const {
        const int row0 = u.pm * BM + wr * 64 + fr, col0 = (u.pn % nN) * BM + wc * 32 + 4 * fq;
        EPI_ROWS(row0) { const size_t off = (size_t)(row0 + ai * HALF + m * 16) * 1024 + col0;
#pragma unroll
            for (int bj = 0; bj < 2; ++bj)
#pragma unroll
                for (int n = 0; n < 2; ++n) { f32x4 r = acc[ai][bj][m][n]; if (base) r += *(const f32x4*)(base + off + bj * HALF + n * 16); *(f32x4*)(out + off + bj * HALF + n * 16) = r; } }
    }
};
struct EpiSwiGLU {
    static constexpr bool PERM = true, AFTER_DRAIN = false;
    bf16_t* ACT; int ldc, nN; const float* rs; float ws;
    __device__ __forceinline__ void operator()(const f32x4 (&acc)[2][2][4][2], const Unit& u, int wr, int wc, int fr, int fq) const {
        const int row0 = u.pm * BM + wr * 64 + fr, cl = (u.pn % nN) * 128 + wc * 32 + 8 * fq;
        EPI_ROWS(row0) { bf16_t* p = ACT + (size_t)(row0 + ai * HALF + m * 16) * ldc + cl;
            f32x4 g0 = acc[ai][0][m][0], g1 = acc[ai][0][m][1], u0 = acc[ai][1][m][0], u1 = acc[ai][1][m][1];
            if (rs) { const float sc = rs[row0 + ai * HALF + m * 16] * ws; typedef int i32x4_ __attribute__((ext_vector_type(4)));
                g0 = __builtin_convertvector(__builtin_bit_cast(i32x4_, g0), f32x4) * sc; g1 = __builtin_convertvector(__builtin_bit_cast(i32x4_, g1), f32x4) * sc;
                u0 = __builtin_convertvector(__builtin_bit_cast(i32x4_, u0), f32x4) * sc; u1 = __builtin_convertvector(__builtin_bit_cast(i32x4_, u1), f32x4) * sc; }
            *(u32x4*)p = pack8(g0 * sigm4(g0) * u0, g1 * sigm4(g1) * u1); }
    }
};
struct EpiStore {
    static constexpr bool PERM = true, AFTER_DRAIN = false;
    bf16_t* O; int ldc, nN;
    __device__ __forceinline__ void operator()(const f32x4 (&acc)[2][2][4][2], const Unit& u, int wr, int wc, int fr, int fq) const {
        const int row0 = u.pm * BM + wr * 64 + fr, cl = (u.pn % nN) * BM + wc * 32 + 8 * fq;
        EPI_ROWS(row0) { bf16_t* p = O + (size_t)(row0 + ai * HALF + m * 16) * ldc + cl;
#pragma unroll
            for (int bj = 0; bj < 2; ++bj) *(u32x4*)(p + bj * HALF) = pack8(acc[ai][bj][m][0], acc[ai][bj][m][1]); }
    }
};
struct EpiPleGate {
    static constexpr bool PERM = false, AFTER_DRAIN = false;
    float* X; const bf16_t* PROJ;
    __device__ __forceinline__ void operator()(const f32x4 (&acc)[2][2][4][2], const Unit& u, int wr, int wc, int fr, int fq) const {
        const int row0 = u.pm * BM + wr * 64 + fr, col0 = u.pn * BM + wc * 32 + 4 * fq;
        EPI_ROWS(row0) { const size_t off = (size_t)(row0 + ai * HALF + m * 16) * 1024 + col0;
#pragma unroll
            for (int bj = 0; bj < 2; ++bj)
#pragma unroll
                for (int n = 0; n < 2; ++n) { const size_t o = off + bj * HALF + n * 16; const u32x2 pw = *(const u32x2*)(PROJ + o);
                    const f32x4 pr = (f32x4){bf_lo(pw.x), bf_hi(pw.x), bf_lo(pw.y), bf_hi(pw.y)};
                    *(f32x4*)(X + o) = *(const f32x4*)(X + o) + sigm4(acc[ai][bj][m][n]) * pr; } }
    }
};

template <class Epi, class Sched>
__device__ __forceinline__ void gemm_phase_naive(const Gemm g, const Sched& S, const Epi& E) {
    int tid_ = threadIdx.x; asm volatile("" : "+v"(tid_));
    const int tid = tid_, wid = __builtin_amdgcn_readfirstlane(tid >> 6), lane = tid & 63, wr = wid >> 2, wc = wid & 3, fr = lane & 15, fq = lane >> 4;
    const int K = g.K; Unit u;
    for (int ui = 0; S.next(ui, u); ++ui) {
        f32x4 acc[2][2][4][2];
#pragma unroll
        for (int ai = 0; ai < 2; ++ai)
#pragma unroll
            for (int m = 0; m < 4; ++m) {
                const bf16_t* ap = g.A + (size_t)(u.pm * BM + ai * HALF + wr * 64 + m * 16 + fr) * K;
#pragma unroll
                for (int bj = 0; bj < 2; ++bj)
#pragma unroll
                    for (int n = 0; n < 2; ++n) { f32x4 r = (f32x4){0.f, 0.f, 0.f, 0.f};
#pragma unroll
                        for (int j = 0; j < 4; ++j) { const int col = u.pn * BM + bj * HALF + wc * 32 + (Epi::PERM ? (8 * fq + 4 * n + j) : (16 * n + 4 * fq + j));
                            const bf16_t* bp = g.Bt + (size_t)col * K; float s = 0.f;
                            for (int k = 0; k < K; k += 8) { const u32x4 a = *(const u32x4*)(ap + k), b = *(const u32x4*)(bp + k);
                                s += bf_lo(a.x) * bf_lo(b.x) + bf_hi(a.x) * bf_hi(b.x) + bf_lo(a.y) * bf_lo(b.y) + bf_hi(a.y) * bf_hi(b.y)
                                   + bf_lo(a.z) * bf_lo(b.z) + bf_hi(a.z) * bf_hi(b.z) + bf_lo(a.w) * bf_lo(b.w) + bf_hi(a.w) * bf_hi(b.w); }
                            r[j] = s; }
                        acc[ai][bj][m][n] = r; } }
        E(acc, u, wr, wc, fr, fq);
    }
}
typedef int pg8_i32x8 __attribute__((ext_vector_type(8))); typedef int pg8_i32x4 __attribute__((ext_vector_type(4)));
template <bool FP8> struct pg8_frag { typedef bf16x8 T; };
template <> struct pg8_frag<true> { typedef pg8_i32x8 T; };
template <bool FP8> __device__ __forceinline__ void pg8_ldfrag(typename pg8_frag<FP8>::T& d, const PG8_LAS unsigned char* p) {
    if constexpr (FP8) { const pg8_i32x4 lo = *(const PG8_LAS pg8_i32x4*)p, hi = *(const PG8_LAS pg8_i32x4*)(p + 16); d = __builtin_shufflevector(lo, hi, 0, 1, 2, 3, 4, 5, 6, 7); }
    else d = *(const PG8_LAS bf16x8*)p;
}
template <bool I8> __device__ __forceinline__ f32x4 pg8_mma(const bf16x8& b, const bf16x8& a, const f32x4 c) {
    if constexpr (I8) return __builtin_bit_cast(f32x4, __builtin_amdgcn_mfma_i32_16x16x64_i8(__builtin_bit_cast(pg8_i32x4, b), __builtin_bit_cast(pg8_i32x4, a), __builtin_bit_cast(pg8_i32x4, c), 0, 0, 0));
    else return __builtin_amdgcn_mfma_f32_16x16x32_bf16(b, a, c, 0, 0, 0);
}
template <class Epi, class Sched, bool ALIGN_EPI = false, bool SP2 = false, bool I8 = false>
__device__ __forceinline__ void gemm_phase(PG8_LAS unsigned char* lds, const Gemm g, const Sched& S, const Epi& E) {
    int tid_ = threadIdx.x; asm volatile("" : "+v"(tid_));
    const int tid = tid_, wid = __builtin_amdgcn_readfirstlane(tid >> 6), lane = tid & 63, wr = wid >> 2, wc = wid & 3, fr = lane & 15, fq = lane >> 4;
    int K_ = g.K; asm volatile("" : "+s"(K_));
    const int K = K_, nt = K / BK;
    unsigned voffA[2], voffB[2];
#pragma unroll
    for (int i = 0; i < 2; ++i) { int R, C; stage_rc(tid * 16 + i * 8192, R, C); const int Rb = Epi::PERM ? ((R & ~31) + perm32(R & 31)) : R;
        voffA[i] = (unsigned)(R * K + C) * 2u; voffB[i] = (unsigned)(Rb * K + C) * 2u; }
    const size_t kstep = (size_t)(BK * 2);
    const size_t hstep = (size_t)HALF * K * 2;
    const size_t tstep = 2 * hstep;
    const unsigned ldsw = (unsigned)wid * 1024u;
    const int aoff = lds_byte(wr * 64 + fr, fq * 8), boff = lds_byte(wc * 32 + fr, fq * 8);
    constexpr int NK = 2;
#define PG8_SA(b, h) (((b) * 2 + (h)) * HTB)
#define PG8_SB(b, h) ((4 + (b) * 2 + (h)) * HTB)
#define PG8_STAGE(bufoff, gbase, voff) do { _Pragma("unroll") for (int _i = 0; _i < 2; ++_i) \
        __builtin_amdgcn_global_load_lds((const unsigned*)((const char*)(gbase) + (voff)[_i]), (PG8_LAS unsigned*)(lds + (bufoff) + ldsw + _i * 8192), 16, 0, 0); } while (0)
#define PG8_LDA(dst, b, h) do { _Pragma("unroll") for (int m = 0; m < 4; ++m) _Pragma("unroll") for (int k = 0; k < NK; ++k) pg8_ldfrag<false>(dst[m][k], lds + PG8_SA(b, h) + aoff + m * 2048 + k * 1024); } while (0)
#define PG8_LDB(dst, b, h) do { _Pragma("unroll") for (int n = 0; n < 2; ++n) _Pragma("unroll") for (int k = 0; k < NK; ++k) pg8_ldfrag<false>(dst[n][k], lds + PG8_SB(b, h) + boff + n * 2048 + k * 1024); } while (0)
#define PG8_MMA(ai, bj, At, Bt) do { __builtin_amdgcn_s_setprio(1); _Pragma("unroll") for (int m = 0; m < 4; ++m) _Pragma("unroll") for (int n = 0; n < 2; ++n) _Pragma("unroll") for (int k = 0; k < NK; ++k) \
        acc[ai][bj][m][n] = pg8_mma<I8>(Bt[n][k], At[m][k], acc[ai][bj][m][n]); __builtin_amdgcn_s_setprio(0); } while (0)
#define PG8_WAIT_V(n) asm volatile("s_waitcnt vmcnt(" #n ")" ::: "memory")
#define PG8_WAIT_L(n) asm volatile("s_waitcnt lgkmcnt(" #n ")" ::: "memory")
#define PG8_BAR __builtin_amdgcn_s_barrier()
#define PG8_SCHED __builtin_amdgcn_sched_barrier(0)
    Unit cur, nxt; int ui = 0;
    if (!S.next(0, cur)) return;
    f32x4 acc[2][2][4][2];
#pragma unroll
    for (int a = 0; a < 2; ++a)
#pragma unroll
        for (int b = 0; b < 2; ++b)
#pragma unroll
            for (int m = 0; m < 4; ++m)
#pragma unroll
                for (int n = 0; n < 2; ++n) acc[a][b][m][n] = (f32x4){0.f, 0.f, 0.f, 0.f};
    bf16x8 At[4][NK], B0[2][NK], B1[2][NK];
    const char* cA = (const char*)g.A + (size_t)cur.pm * tstep; const char* cB = (const char*)g.Bt + (size_t)cur.pn * tstep;
    S.a_ready(cur);
    if constexpr (SP2) {
        PG8_STAGE(PG8_SB(0, 0), cB, voffB); PG8_STAGE(PG8_SB(0, 1), cB + hstep, voffB); PG8_STAGE(PG8_SA(0, 0), cA, voffA); PG8_STAGE(PG8_SA(0, 1), cA + hstep, voffA);
        if (wr == 1) PG8_BAR;
        PG8_WAIT_V(2); PG8_BAR;
        PG8_STAGE(PG8_SB(1, 0), cB + kstep, voffB); PG8_STAGE(PG8_SA(1, 0), cA + kstep, voffA); PG8_STAGE(PG8_SB(1, 1), cB + hstep + kstep, voffB);
        PG8_WAIT_V(6); PG8_BAR;
    } else {
        PG8_STAGE(PG8_SB(0, 0), cB, voffB); PG8_STAGE(PG8_SA(0, 0), cA, voffA); PG8_STAGE(PG8_SB(0, 1), cB + hstep, voffB); PG8_STAGE(PG8_SA(0, 1), cA + hstep, voffA);
        if (wr == 1) PG8_BAR;
        PG8_WAIT_V(4); PG8_BAR;
        PG8_STAGE(PG8_SB(1, 0), cB + kstep, voffB); PG8_STAGE(PG8_SA(1, 0), cA + kstep, voffA); PG8_STAGE(PG8_SB(1, 1), cB + hstep + kstep, voffB);
        PG8_WAIT_V(6); PG8_BAR;
    }
    for (;;) {
        const bool has_next = S.next(ui + 1, nxt);
        const char* nA = has_next ? (const char*)g.A + (size_t)nxt.pm * tstep : cA; const char* nB = has_next ? (const char*)g.Bt + (size_t)nxt.pn * tstep : cB;
#pragma nounroll
        for (int t = 0; t < nt; t += 2) {
            const bool last = (t == nt - 2);
            const char* a1 = cA + (size_t)(t + 1) * kstep;
            const char* a2 = last ? nA : cA + (size_t)(t + 2) * kstep; const char* b2 = last ? nB : cB + (size_t)(t + 2) * kstep;
            const char* a3 = a2 + kstep; const char* b3 = b2 + kstep;
            if (last && has_next) S.a_ready(nxt);
            if constexpr (SP2) {
            PG8_LDB(B0, 0, 0); PG8_LDB(B1, 0, 1); PG8_SCHED; PG8_LDA(At, 0, 0); PG8_STAGE(PG8_SA(1, 1), a1 + hstep, voffA);
            PG8_WAIT_V(8); PG8_WAIT_L(0); PG8_BAR; PG8_MMA(0, 0, At, B0); PG8_MMA(0, 1, At, B1); PG8_BAR; PG8_SCHED;
            PG8_LDA(At, 0, 1); PG8_STAGE(PG8_SB(0, 0), b2, voffB); PG8_STAGE(PG8_SB(0, 1), b2 + hstep, voffB); PG8_STAGE(PG8_SA(0, 0), a2, voffA);
            PG8_WAIT_V(8); PG8_WAIT_L(0); PG8_BAR; PG8_MMA(1, 0, At, B0); PG8_MMA(1, 1, At, B1); PG8_BAR; PG8_SCHED;
            PG8_LDB(B0, 1, 0); PG8_LDB(B1, 1, 1); PG8_SCHED; PG8_LDA(At, 1, 0); PG8_STAGE(PG8_SA(0, 1), a2 + hstep, voffA);
            PG8_WAIT_V(8); PG8_WAIT_L(0); PG8_BAR; PG8_MMA(0, 0, At, B0); PG8_MMA(0, 1, At, B1); PG8_BAR; PG8_SCHED;
            PG8_LDA(At, 1, 1); PG8_STAGE(PG8_SB(1, 0), b3, voffB); PG8_STAGE(PG8_SB(1, 1), b3 + hstep, voffB); PG8_STAGE(PG8_SA(1, 0), a3, voffA);
            PG8_WAIT_V(8); PG8_WAIT_L(0); PG8_BAR; PG8_MMA(1, 0, At, B0); PG8_MMA(1, 1, At, B1); PG8_BAR; PG8_SCHED;
            } else {
            PG8_LDB(B0, 0, 0); PG8_SCHED; PG8_LDA(At, 0, 0); PG8_STAGE(PG8_SA(1, 1), a1 + hstep, voffA);
            PG8_WAIT_L(8); PG8_BAR; PG8_WAIT_L(0); PG8_MMA(0, 0, At, B0); PG8_BAR; PG8_SCHED;
            PG8_LDB(B1, 0, 1); PG8_STAGE(PG8_SB(0, 0), b2, voffB);
            PG8_BAR; PG8_WAIT_L(0); PG8_MMA(0, 1, At, B1); PG8_BAR;
            PG8_LDA(At, 0, 1); PG8_STAGE(PG8_SA(0, 0), a2, voffA);
            PG8_BAR; PG8_WAIT_L(0); PG8_MMA(1, 0, At, B0); PG8_BAR; PG8_SCHED;
            PG8_STAGE(PG8_SB(0, 1), b2 + hstep, voffB);
            PG8_WAIT_V(6); PG8_BAR; PG8_MMA(1, 1, At, B1); PG8_BAR;
            PG8_LDB(B0, 1, 0); PG8_SCHED; PG8_LDA(At, 1, 0); PG8_STAGE(PG8_SA(0, 1), a2 + hstep, voffA);
            PG8_WAIT_L(8); PG8_BAR; PG8_WAIT_L(0); PG8_MMA(0, 0, At, B0); PG8_BAR; PG8_SCHED;
            PG8_LDB(B1, 1, 1); PG8_STAGE(PG8_SB(1, 0), b3, voffB);
            PG8_BAR; PG8_WAIT_L(0); PG8_MMA(0, 1, At, B1); PG8_BAR;
            PG8_LDA(At, 1, 1); PG8_STAGE(PG8_SA(1, 0), a3, voffA);
            PG8_BAR; PG8_WAIT_L(0); PG8_MMA(1, 0, At, B0); PG8_BAR; PG8_SCHED;
            PG8_STAGE(PG8_SB(1, 1), b3 + hstep, voffB);
            PG8_WAIT_V(6); PG8_BAR; PG8_MMA(1, 1, At, B1); PG8_BAR;
            }
        }
        if constexpr (ALIGN_EPI) { if (wr == 0) PG8_BAR; }
        if constexpr (!Epi::AFTER_DRAIN) { E(acc, cur, wr, wc, fr, fq); S.done(cur); }
        if (!has_next) break;
#pragma unroll
        for (int a = 0; a < 2; ++a)
#pragma unroll
            for (int b = 0; b < 2; ++b)
#pragma unroll
                for (int m = 0; m < 4; ++m)
#pragma unroll
                    for (int n = 0; n < 2; ++n) acc[a][b][m][n] = (f32x4){0.f, 0.f, 0.f, 0.f};
        cur = nxt; cA = nA; cB = nB; ++ui;
        if constexpr (ALIGN_EPI) { if (wr == 1) PG8_BAR; }
    }
    PG8_WAIT_V(0);
    if constexpr (!ALIGN_EPI) { if (wr == 0) PG8_BAR; }
    PG8_BAR;
    if constexpr (Epi::AFTER_DRAIN) { E.fused(acc, cur, wr, wc, fr, fq, lds, wid, lane); S.done(cur); }
#undef PG8_SA
#undef PG8_SB
#undef PG8_STAGE
#undef PG8_LDA
#undef PG8_LDB
#undef PG8_MMA
#undef PG8_WAIT_V
#undef PG8_WAIT_L
#undef PG8_BAR
#undef PG8_SCHED
}
}

constexpr int NWAVES = 8;
#ifndef MK_PER_PHASE
#define MK_PER_PHASE 0
#endif
#ifndef MK_NAIVE_GEMM
#define MK_NAIVE_GEMM 0
#endif
#ifndef MK_SP2
#define MK_SP2 true
#endif
#ifndef MK_ALIGN
#define MK_ALIGN true
#endif
#ifdef DBG_TWOPASS
#define DBG_TWOPASS_ON 1
#else
#define DBG_TWOPASS_ON 0
#endif
#ifndef MK_FP8_GU
#define MK_FP8_GU 1
#endif
#ifndef MK_I8_INPROJ
#define MK_I8_INPROJ 1
#endif
#ifndef MK_ALIGN_GU
#define MK_ALIGN_GU false
#endif
#ifndef MK_SP2_GU
#define MK_SP2_GU false
#endif
#ifndef DBG_REP_ATTN
#define DBG_REP_ATTN 1
#endif
#ifndef DBG_REP_GU
#define DBG_REP_GU 1
#endif
#ifndef DBG_LAYER
#define DBG_LAYER 0
#endif
#ifndef DBG_INJECT
#define DBG_INJECT 0.f
#endif
#ifndef MK_NAIVE_ATTN
#define MK_NAIVE_ATTN 1
#endif

constexpr int BATCH = 8, SEQ = 2048, D = 1024, T = BATCH * SEQ, DEPTH = 2;
constexpr int NH = 4, HD = 64, VD = 128, AQK = 512, AV = 512, CCH = 512, CK = 31, CPAD = 15;
constexpr int INC = 2 * AQK + AV + 2 * CCH + 2 * D;
constexpr int FF = 2816, NE = 8, FE = 3584, PLE = 256;
constexpr float EPS = 1e-6f;
constexpr float QSCALE = 0.125f * 1.4426950408889634f;
constexpr int MOE_ROWS = 2 * T + NE * 256;
enum { I_X = 0, I_P, I_GMIX, I_WIN, I_LAM, I_GSUB, I_WAO, I_CW, I_CB, I_CLG, I_CLB, I_WCO, I_WO, I_GFFN, I_WFGU, I_WFDN, I_WR, I_BR, I_WEGU, I_WEDN, I_GPLE, I_WPG, I_WPP, I_GFIN, N_IN };

constexpr size_t MiB = 1u << 20;
constexpr size_t WS_CTL = 0, CTL_ZERO_BYTES = 1 * MiB;
constexpr size_t WS_ROPE = 1 * MiB;
constexpr size_t WS_SCAL = 1 * MiB + 512 * 1024;
constexpr size_t WS_RTI = WS_SCAL + 4096;
constexpr size_t WS_RTW = WS_RTI + (size_t)T * 16;
constexpr size_t WS_RSEL = WS_RTW + (size_t)T * 8;
constexpr size_t WS_RS = 2 * MiB + 256 * 1024;
constexpr size_t WS_RSP = 2 * MiB + 512 * 1024;
static_assert(WS_RSEL + (size_t)T * 8 <= WS_RS && WS_RSP + (size_t)MOE_ROWS * 4 <= 3 * MiB, "misc region");
constexpr size_t WS_WIN = 4 * MiB, WS_WA = 22 * MiB, WS_WC = 24 * MiB, WS_WO = 26 * MiB, WS_WFGU = 30 * MiB, WS_WFDN = 41 * MiB, WS_WPG = 47 * MiB, WS_WPP = 51 * MiB;
constexpr size_t WS_WEGU = 52 * MiB, WS_WEDN = 164 * MiB;
constexpr size_t WS_X = 220 * MiB, WS_H = 284 * MiB, WS_PROJ = 316 * MiB, WS_PB = 380 * MiB, WS_R = 396 * MiB;
constexpr size_t WS_Q = WS_R, WS_K = WS_R + 16 * MiB, WS_V = WS_R + 32 * MiB, WS_Z = WS_R + 48 * MiB, WS_SG = WS_R + 64 * MiB, WS_OB = WS_R + 128 * MiB, WS_ZC = WS_R + 144 * MiB,
                 WS_P = WS_R + 160 * MiB, WS_MIX = WS_R + 224 * MiB;
constexpr size_t WS_ACT = WS_R, WS_HP = WS_R + 240 * MiB, WS_Y = WS_R + 308 * MiB, WS_END = WS_R + 444 * MiB;
static_assert((size_t)MOE_ROWS * FE * 2 <= 240 * MiB && (size_t)MOE_ROWS * D * 2 <= 68 * MiB && (size_t)MOE_ROWS * D * 4 <= 136 * MiB && (size_t)T * FF * 2 <= 240 * MiB, "region R");
constexpr int CW_TMO = 0, CW_CODE = 1, CW_BAR = 4096, CW_GCNT = 8192;

constexpr int RING_OFF = 0, RING_BYTES = 131072;
constexpr int LDSCTL_OFF = RING_BYTES, MISC_OFF = LDSCTL_OFF + 320;
constexpr int TP_OFF = MISC_OFF + 64;
constexpr int LDS_BYTES = 147456;

#define GAS __attribute__((address_space(1)))
#define LAS __attribute__((address_space(3)))
typedef unsigned short bf16;
typedef unsigned v4u __attribute__((ext_vector_type(4)));
typedef unsigned v2u __attribute__((ext_vector_type(2)));
typedef float f32x4 __attribute__((ext_vector_type(4)));
typedef GAS unsigned gu32;
#define RLX_AGENT __ATOMIC_RELAXED, __HIP_MEMORY_SCOPE_AGENT
#define LDS_WAIT() asm volatile("s_waitcnt lgkmcnt(0)" ::: "memory")
#define VM_WAIT() asm volatile("s_waitcnt vmcnt(0)" ::: "memory")
__device__ __forceinline__ unsigned f2bf(float f) { unsigned u = __builtin_bit_cast(unsigned, f); return (u + 0x7fffu + ((u >> 16) & 1u)) >> 16; }
__device__ __forceinline__ unsigned pk2(float lo, float hi) { return f2bf(lo) | (f2bf(hi) << 16); }
using pg8::bf_lo; using pg8::bf_hi; using pg8::sigm;

#define XB_TMO      128
#define XB_XCNT(j)  (256  + 64 * (j))
#define XB_XSUB(j)  (1280 + 64 * (j))
#define XB_XGEN(j)  (2304 + 64 * (j))
#define XB_TOP      3328
#define XB_TOPGEN   3392
#define XCD_BAR_WORDS 3456
#define XB_SPIN_CAP (1u << 18)

__device__ __forceinline__ unsigned xb_ld(unsigned* p)              { return __hip_atomic_load(p, __ATOMIC_RELAXED, __HIP_MEMORY_SCOPE_AGENT); }
__device__ __forceinline__ unsigned xb_add(unsigned* p, unsigned v) { return __hip_atomic_fetch_add(p, v, __ATOMIC_RELAXED, __HIP_MEMORY_SCOPE_AGENT); }
__device__ __forceinline__ unsigned xb_xcc_id() { return (unsigned)__builtin_amdgcn_s_getreg((3 << 11) | 20) & 0xFu; }
#define XB_SPIN(cond, bar) do { unsigned _sp = 0; while (cond) { __builtin_amdgcn_s_sleep(1); \
    if ((++_sp & 255u) == 0u) { if (xb_ld(&(bar)[XB_TMO])) break; if (_sp > XB_SPIN_CAP) { atomicAdd(&(bar)[XB_TMO], 1u); break; } } } } while (0)

struct XcdBarrier {
    unsigned* bar; unsigned x;
    volatile LAS unsigned* st;
};

__device__ __forceinline__ XcdBarrier xcd_barrier_post(unsigned* bar, volatile LAS unsigned* st) {
    XcdBarrier b; b.bar = bar; b.x = xb_xcc_id(); b.st = st;
    if (threadIdx.x == 0) (void)xb_add(&bar[XB_XCNT(b.x)], 1u);
    return b;
}
__device__ __forceinline__ void xcd_barrier_complete(unsigned* bar, unsigned x, unsigned& nloc, unsigned& nx) {
    const unsigned G = gridDim.x * gridDim.y * gridDim.z;
    unsigned sum, cnt, mine, sp = 0u;
    for (;;) {
        sum = 0u; cnt = 0u; mine = 0u;
#pragma unroll
        for (unsigned j = 0; j < 16; ++j) { const unsigned c = xb_ld(&bar[XB_XCNT(j)]); sum += c; cnt += (c > 0u) ? 1u : 0u; mine = (j == x) ? c : mine; }
        if (sum == G) break;
        __builtin_amdgcn_s_sleep(1);
        if ((++sp & 255u) == 0u) { if (xb_ld(&bar[XB_TMO])) break; if (sp > XB_SPIN_CAP) { atomicAdd(&bar[XB_TMO], 1u); break; } }
    }
    nloc = mine > 0u ? mine : 1u; nx = cnt > 0u ? cnt : 1u;
}

__device__ __forceinline__ void xcd_barrier(const XcdBarrier& b) {
    asm volatile("s_waitcnt vmcnt(0)" ::: "memory");
    __syncthreads();
    if (threadIdx.x == 0) {
        GAS unsigned* gbar_ = (GAS unsigned*)b.bar; unsigned bx = b.x; asm volatile("" : "+s"(gbar_), "+s"(bx)); unsigned* bar = (unsigned*)gbar_;
        __builtin_amdgcn_s_waitcnt(0);
        unsigned nloc = b.st[0], nx = b.st[1];
        if (nloc == 0u) { xcd_barrier_complete(bar, bx, nloc, nx); b.st[0] = nloc; b.st[1] = nx; }
        const unsigned old = xb_add(&bar[XB_XSUB(bx)], 1u);
        const unsigned gen = old / nloc;
        if (old + 1u == (gen + 1u) * nloc) {
            __builtin_amdgcn_fence(__ATOMIC_RELEASE, "agent");
            asm volatile("s_waitcnt vmcnt(0)" ::: "memory");
            const unsigned og = xb_add(&bar[XB_TOP], 1u);
            const unsigned tg = og / nx;
            if (og + 1u == (tg + 1u) * nx) xb_add(&bar[XB_TOPGEN], 1u);
            else XB_SPIN(xb_ld(&bar[XB_TOPGEN]) == tg, bar);
            __builtin_amdgcn_fence(__ATOMIC_ACQUIRE, "agent");
            xb_add(&bar[XB_XGEN(bx)], 1u);
            asm volatile("s_waitcnt vmcnt(0)" ::: "memory");
        } else {
            XB_SPIN(xb_ld(&bar[XB_XGEN(bx)]) == gen, bar);
            __builtin_amdgcn_fence(__ATOMIC_ACQUIRE, "agent");
            asm volatile("s_waitcnt vmcnt(0)" ::: "memory");
        }
    }
    __syncthreads();
}

struct Frame {
    LAS unsigned char* lds;
    volatile LAS unsigned* MISC;
    gu32* ctl;
    GAS unsigned char* ws;
    int tid, lane, wave, G;
};
#define CAS __attribute__((address_space(4)))
__device__ __forceinline__ const float* inp(int i) {
    const CAS unsigned char* k = (const CAS unsigned char*)__builtin_amdgcn_kernarg_segment_ptr();
    asm volatile("" : "+s"(k));
    return (const float*)*(GAS const float* const CAS*)(k + 8 * i);
}
__device__ __forceinline__ float* outp() {
    const CAS unsigned char* k = (const CAS unsigned char*)__builtin_amdgcn_kernarg_segment_ptr();
    asm volatile("" : "+s"(k));
    return (float*)*(GAS float* const CAS*)(k + 8 * N_IN);
}
template <class TP> __device__ __forceinline__ TP* wsp(Frame& F, size_t off) { GAS unsigned char* w = F.ws; asm volatile("" : "+s"(w)); return (TP*)(w + off); }

__device__ __forceinline__ float wave_sum(float v) {
#pragma unroll
    for (int o = 1; o < 64; o <<= 1) v += __shfl_xor(v, o);
    return v;
}
__device__ __forceinline__ float dot4(const f32x4 a, const f32x4 b) { return (a.x * b.x + a.y * b.y) + (a.z * b.z + a.w * b.w); }

__device__ __forceinline__ unsigned dbg_hash(unsigned a, unsigned b) { unsigned x = a * 2654435761u + b * 40503u + 0x9e3779b9u; x ^= x >> 15; x *= 2246822519u; x ^= x >> 13; x *= 3266489917u; x ^= x >> 16; return x; }
__device__ __forceinline__ void cksum_ptr(Frame& F, const v4u* p, size_t bytes, int slot) {
    const size_t n = bytes / 16, gt = (size_t)blockIdx.x * (NWAVES * 64) + F.tid, NGT = (size_t)F.G * NWAVES * 64; unsigned s = 0u;
    for (size_t i = gt; i < n; i += NGT) { const v4u v = p[i]; s += (v.x + v.y) + (v.z + v.w); }
#pragma unroll
    for (int o = 1; o < 64; o <<= 1) s += (unsigned)__shfl_xor((int)s, o);
    if (F.lane == 0) __hip_atomic_fetch_add((unsigned*)(F.ctl + slot), s, RLX_AGENT);
}
__device__ __forceinline__ void cksum(Frame& F, size_t off, size_t bytes, int slot) { cksum_ptr(F, wsp<v4u>(F, off), bytes, slot); }

enum { PK_ID = 0, PK_INPROJ = 1, PK_SWIGLU = 2, PK_FP8 = 0x100 };
constexpr float W8_SCALE = 127.f / (5.f / 32.f), W8_INV = (5.f / 32.f) / 127.f;
__device__ __forceinline__ unsigned q8(float x) { const float r = fminf(fmaxf(rintf(x), -127.f), 127.f); return (unsigned)((int)r) & 0xffu; }
__device__ __forceinline__ unsigned pk4_fp8(float a, float b, float c, float d) { return q8(a) | (q8(b) << 8) | (q8(c) << 16) | (q8(d) << 24); }
struct TEntry { int in_idx, K, N, kind, F, item0; unsigned src_off; unsigned pad; unsigned long long dst_off; };
struct TTable { TEntry e[32]; int n, total; };
constexpr TTable make_table() {
    TTable t{}; int n = 0, it = 0;
    auto add = [&](int in_idx, size_t src_off, int K, int N, int kind, int F, size_t dst) {
        t.e[n].in_idx = in_idx; t.e[n].K = K; t.e[n].N = N; t.e[n].kind = kind; t.e[n].F = F; t.e[n].item0 = it; t.e[n].src_off = (unsigned)src_off; t.e[n].pad = 0; t.e[n].dst_off = dst;
        it += (K / 64) * (N / 32); ++n; };
    for (int l = 0; l < 2; ++l) add(I_WIN, (size_t)l * D * INC, D, INC, PK_INPROJ | (MK_I8_INPROJ ? PK_FP8 : 0), 0, WS_WIN + (size_t)l * INC * D * (MK_I8_INPROJ ? 1 : 2));
    for (int l = 0; l < 2; ++l) add(I_WAO, (size_t)l * AV * D, AV, D, PK_ID, 0, WS_WA + (size_t)l * D * AV * 2);
    for (int l = 0; l < 2; ++l) add(I_WCO, (size_t)l * CCH * D, CCH, D, PK_ID, 0, WS_WC + (size_t)l * D * CCH * 2);
    for (int l = 0; l < 2; ++l) add(I_WO, (size_t)l * D * D, D, D, PK_ID, 0, WS_WO + (size_t)l * D * D * 2);
    add(I_WFGU, 0, D, 2 * FF, PK_SWIGLU | (MK_FP8_GU ? PK_FP8 : 0), FF, WS_WFGU);
    add(I_WFDN, 0, FF, D, PK_ID, 0, WS_WFDN);
    for (int l = 0; l < 2; ++l) add(I_WPG, (size_t)l * D * D, D, D, PK_ID, 0, WS_WPG + (size_t)l * D * D * 2);
    for (int l = 0; l < 2; ++l) add(I_WPP, (size_t)l * PLE * D, PLE, D, PK_ID, 0, WS_WPP + (size_t)l * D * PLE * 2);
    for (int e = 0; e < NE; ++e) add(I_WEGU, (size_t)e * D * 2 * FE, D, 2 * FE, PK_SWIGLU | (MK_FP8_GU ? PK_FP8 : 0), FE, WS_WEGU + (size_t)e * 2 * FE * D * (MK_FP8_GU ? 1 : 2));
    for (int e = 0; e < NE; ++e) add(I_WEDN, (size_t)e * FE * D, FE, D, PK_ID, 0, WS_WEDN + (size_t)e * D * FE * 2);
    t.n = n; t.total = it; return t;
}
__constant__ TTable g_tt = make_table();
static_assert(make_table().n == 30, "transpose table");

__device__ __forceinline__ int dest_row(int kind_, int F, int c) {
    const int kind = kind_ & 0xff;
    if (kind == PK_INPROJ) {
        if (c < 1024) { const int d = c & 63, dd = d & 31; return (c & ~63) + ((dd >> 2) << 3) + ((d >> 5) << 2) + (dd & 3); }
        if (c >= 1536 && c < 2560) { const int cc = c - 1536, h = cc >= 512 ? 1 : 0, r = cc - h * 512; return 1536 + ((r >> 7) << 8) + (h << 7) + (r & 127); }
        return c;
    }
    if (kind == PK_SWIGLU) { const int h = c >= F ? 1 : 0, r = c - h * F; return ((r >> 7) << 8) + (h << 7) + (r & 127); }
    return c;
}
__device__ __forceinline__ void p0_transpose_item(const float* W, int K, int N, bf16* WT, int kind, int FFd, LAS float* scr, int item, int lane) {
    const int nblk = N / 32, kb = item / nblk, nb = item % nblk, k0 = 64 * kb, n0 = 32 * nb;
#pragma unroll 8
    for (int i = 0; i < 32; ++i) { const int kk = 2 * i + (lane >> 5); scr[kk * 33 + (lane & 31)] = W[(size_t)(k0 + kk) * N + n0 + (lane & 31)]; }
    LDS_WAIT(); asm volatile("" ::: "memory");
    const int c = lane & 7;
#pragma unroll
    for (int j = 0; j < 4; ++j) { const int n = (lane >> 3) + 8 * j; const LAS float* s = scr + (8 * c) * 33 + n;
        if (kind & PK_FP8) { v2u o8; o8.x = pk4_fp8(s[0 * 33] * W8_SCALE, s[1 * 33] * W8_SCALE, s[2 * 33] * W8_SCALE, s[3 * 33] * W8_SCALE); o8.y = pk4_fp8(s[4 * 33] * W8_SCALE, s[5 * 33] * W8_SCALE, s[6 * 33] * W8_SCALE, s[7 * 33] * W8_SCALE);
            *(v2u*)((unsigned char*)WT + (size_t)dest_row(kind, FFd, n0 + n) * K + k0 + 8 * c) = o8; }
        else { v4u o; o.x = pk2(s[0 * 33], s[1 * 33]); o.y = pk2(s[2 * 33], s[3 * 33]); o.z = pk2(s[4 * 33], s[5 * 33]); o.w = pk2(s[6 * 33], s[7 * 33]);
        *(v4u*)(WT + (size_t)dest_row(kind, FFd, n0 + n) * K + k0 + 8 * c) = o; } }
    LDS_WAIT(); asm volatile("" ::: "memory");
}
__device__ __forceinline__ void norm_rows(Frame& F, const float* src, const float* gain, bf16* dst, bool fp8 = false) {
    const int gw = blockIdx.x * NWAVES + F.wave, NGW = F.G * NWAVES;
    f32x4 g[4];
#pragma unroll
    for (int j = 0; j < 4; ++j) g[j] = ((const f32x4*)gain)[F.lane + 64 * j];
    for (int m = gw; m < T; m += NGW) {
        const f32x4* xr = (const f32x4*)(src + (size_t)m * D) + F.lane;
        f32x4 v[4]; float s = 0.f;
#pragma unroll
        for (int j = 0; j < 4; ++j) { v[j] = xr[64 * j]; s += dot4(v[j], v[j]); }
        const float rstd = 1.f / sqrtf(wave_sum(s) * (1.f / D) + EPS);
        if (fp8) { float am = 0.f;
#pragma unroll
            for (int j = 0; j < 4; ++j) { v[j] = v[j] * rstd * g[j]; am = fmaxf(am, fmaxf(fmaxf(fabsf(v[j].x), fabsf(v[j].y)), fmaxf(fabsf(v[j].z), fabsf(v[j].w)))); }
#pragma unroll
            for (int o = 1; o < 64; o <<= 1) am = fmaxf(am, __shfl_xor(am, o));
            am = fmaxf(am, 1e-20f); const float qs = 127.f / am;
            if (F.lane == 0) wsp<float>(F, WS_RS)[m] = am * (1.f / 127.f);
            unsigned* o4 = (unsigned*)((unsigned char*)dst + (size_t)m * D) + F.lane;
#pragma unroll
            for (int j = 0; j < 4; ++j) o4[64 * j] = pk4_fp8(v[j].x * qs, v[j].y * qs, v[j].z * qs, v[j].w * qs); }
        else { unsigned long long* o8 = (unsigned long long*)(dst + (size_t)m * D) + F.lane;
#pragma unroll
        for (int j = 0; j < 4; ++j) { const f32x4 y = v[j] * rstd * g[j]; o8[64 * j] = (unsigned long long)pk2(y.x, y.y) | ((unsigned long long)pk2(y.z, y.w) << 32); } }
    }
}
__device__ __forceinline__ void final_norm(Frame& F, const float* src, const float* gain, float* dst, float dbg_scale = 1.f) {
    const int gw = blockIdx.x * NWAVES + F.wave, NGW = F.G * NWAVES;
    f32x4 g[4];
#pragma unroll
    for (int j = 0; j < 4; ++j) g[j] = ((const f32x4*)gain)[F.lane + 64 * j];
    for (int m = gw; m < T; m += NGW) {
        const f32x4* xr = (const f32x4*)(src + (size_t)m * D) + F.lane;
        f32x4 v[4]; float s = 0.f;
#pragma unroll
        for (int j = 0; j < 4; ++j) { v[j] = xr[64 * j]; s += dot4(v[j], v[j]); }
        const float rstd = 1.f / sqrtf(wave_sum(s) * (1.f / D) + EPS);
        f32x4* o = (f32x4*)(dst + (size_t)m * D) + F.lane;
#pragma unroll
        for (int j = 0; j < 4; ++j) o[64 * j] = v[j] * rstd * g[j] * dbg_scale;
    }
}
__device__ __forceinline__ void p0_prologue(Frame& F) {
    LAS float* scr = (LAS float*)(F.lds + RING_OFF + F.wave * 16384);
    const int gw = blockIdx.x * NWAVES + F.wave, NGW = F.G * NWAVES;
    const int ntot = g_tt.total, nent = g_tt.n;
    for (int it = gw; it < ntot; it += NGW) {
        int ei = 0;
        while (ei + 1 < nent && it >= g_tt.e[ei + 1].item0) ++ei;
        const TEntry& te = g_tt.e[ei];
        p0_transpose_item(inp(te.in_idx) + te.src_off, te.K, te.N, wsp<bf16>(F, te.dst_off), te.kind, te.F, scr, it - te.item0, F.lane);
    }
    { const int gt = blockIdx.x * (NWAVES * 64) + F.tid, NGT = F.G * NWAVES * 64; const float* p = inp(I_P); bf16* pb = wsp<bf16>(F, WS_PB);
      for (int i = gt; i < 2 * T * PLE / 8; i += NGT) { const f32x4 a = *(const f32x4*)(p + (size_t)i * 8), b = *(const f32x4*)(p + (size_t)i * 8 + 4);
          v4u o; o.x = pk2(a.x, a.y); o.y = pk2(a.z, a.w); o.z = pk2(b.x, b.y); o.w = pk2(b.z, b.w); *(v4u*)(pb + (size_t)i * 8) = o; } }
    { const int gt = blockIdx.x * (NWAVES * 64) + F.tid, NGT = F.G * NWAVES * 64; float* rope = wsp<float>(F, WS_ROPE);
      for (int i = gt; i < SEQ * 32; i += NGT) { const int pos = i >> 5, f = i & 31;
          const float inv = exp2f(-(float)(2 * f) * (1.0f / 64.0f) * 13.287712379549449f); const float ang = (float)pos * inv;
          double rev = (double)ang * 0.15915494309189535; rev -= floor(rev); const float rv = (float)rev;
          rope[pos * 64 + f] = __builtin_amdgcn_cosf(rv); rope[pos * 64 + 32 + f] = __builtin_amdgcn_sinf(rv); } }
    if (blockIdx.x == 0 && F.wave == 0) {
        for (int l = 0; l < DEPTH; ++l) { const float* lf = inp(I_LAM) + l * 4 * HD;
            const float a = wave_sum(lf[F.lane] * lf[HD + F.lane]), b = wave_sum(lf[2 * HD + F.lane] * lf[3 * HD + F.lane]);
            const float lam_init = 0.8f - 0.6f * expf(-0.3f * (float)l);
            if (F.lane == 0) wsp<float>(F, WS_SCAL)[l] = expf(a) - expf(b) + lam_init; }
    }
#ifdef DBG_TWOPASS
    if (blockIdx.x == 0 && F.tid < 8) __hip_atomic_store((unsigned*)(F.ctl + CW_GCNT + 64 * F.tid), 0u, RLX_AGENT);
#endif
    norm_rows(F, inp(I_X), inp(I_GMIX), wsp<bf16>(F, WS_H), MK_I8_INPROJ != 0);
}

__device__ __forceinline__ void route_phase(Frame& F, const float* src, const float* gain, bf16* dst) {
    LAS float* wrT = (LAS float*)(F.lds);
    LAS unsigned* lcnt = (LAS unsigned*)(F.lds + 32768);
    LAS unsigned* gbase = lcnt + 8;
    LAS int* rinfo = (LAS int*)(F.lds + 32768 + 64);
    const float* wr = inp(I_WR); const float* br = inp(I_BR);
    int* rti = wsp<int>(F, WS_RTI); float* rtw = wsp<float>(F, WS_RTW);
    for (int i = F.tid; i < NE * D; i += NWAVES * 64) wrT[(i & 7) * D + (i >> 3)] = wr[i];
    f32x4 g[4];
#pragma unroll
    for (int j = 0; j < 4; ++j) g[j] = ((const f32x4*)gain)[F.lane + 64 * j];
    __syncthreads();
    for (int item = blockIdx.x; item < T / 64; item += F.G) {
        if (F.tid < 8) lcnt[F.tid] = 0u;
        __syncthreads();
        for (int rr = 0; rr < 8; ++rr) {
            const int lr = F.wave * 8 + rr, m = item * 64 + lr;
            const f32x4* xr = (const f32x4*)(src + (size_t)m * D) + F.lane;
            f32x4 v[4]; float s = 0.f;
#pragma unroll
            for (int j = 0; j < 4; ++j) { v[j] = xr[64 * j]; s += dot4(v[j], v[j]); }
            const float rstd = 1.f / sqrtf(wave_sum(s) * (1.f / D) + EPS);
#if MK_FP8_GU
            unsigned* o4 = (unsigned*)((unsigned char*)dst + (size_t)m * D) + F.lane;
            float am = 0.f;
#pragma unroll
            for (int j = 0; j < 4; ++j) { v[j] = v[j] * rstd * g[j]; am = fmaxf(am, fmaxf(fmaxf(fabsf(v[j].x), fabsf(v[j].y)), fmaxf(fabsf(v[j].z), fabsf(v[j].w)))); }
#pragma unroll
            for (int o = 1; o < 64; o <<= 1) am = fmaxf(am, __shfl_xor(am, o));
            am = fmaxf(am, 1e-20f); const float qs = 127.f / am;
            if (F.lane == 0) wsp<float>(F, WS_RS)[m] = am * (1.f / 127.f);
#pragma unroll
            for (int j = 0; j < 4; ++j) o4[64 * j] = pk4_fp8(v[j].x * qs, v[j].y * qs, v[j].z * qs, v[j].w * qs);
#else
            unsigned long long* o8 = (unsigned long long*)(dst + (size_t)m * D) + F.lane;
#pragma unroll
            for (int j = 0; j < 4; ++j) { v[j] = v[j] * rstd * g[j]; o8[64 * j] = (unsigned long long)pk2(v[j].x, v[j].y) | ((unsigned long long)pk2(v[j].z, v[j].w) << 32); }
#endif
            float lg[8];
#pragma unroll
            for (int e = 0; e < 8; ++e) { float t = 0.f;
#pragma unroll
                for (int j = 0; j < 4; ++j) t += dot4(v[j], ((const LAS f32x4*)(wrT + e * D))[F.lane + 64 * j]);
                lg[e] = wave_sum(t) + br[e]; }
            int e1 = 0; float v1 = lg[0];
#pragma unroll
            for (int e = 1; e < 8; ++e) if (lg[e] > v1) { v1 = lg[e]; e1 = e; }
            int e2 = -1; float v2 = -INFINITY;
#pragma unroll
            for (int e = 0; e < 8; ++e) if (e != e1 && lg[e] > v2) { v2 = lg[e]; e2 = e; }
            if (e2 < 0) e2 = (e1 == 0) ? 1 : 0;
            const float ex = expf(v2 - v1), w1 = 1.f / (1.f + ex), w2 = ex / (1.f + ex);
            if (F.lane == 0) {
                const unsigned lp1 = __hip_atomic_fetch_add((unsigned*)&lcnt[e1], 1u, __ATOMIC_RELAXED, __HIP_MEMORY_SCOPE_WORKGROUP);
                const unsigned lp2 = __hip_atomic_fetch_add((unsigned*)&lcnt[e2], 1u, __ATOMIC_RELAXED, __HIP_MEMORY_SCOPE_WORKGROUP);
                rinfo[lr * 4 + 0] = e1; rinfo[lr * 4 + 1] = (int)lp1; rinfo[lr * 4 + 2] = e2; rinfo[lr * 4 + 3] = (int)lp2;
                rtw[(size_t)m * 2] = w1; rtw[(size_t)m * 2 + 1] = w2; }
        }
        __syncthreads();
        if (F.tid < 8) gbase[F.tid] = __hip_atomic_fetch_add((unsigned*)(F.ctl + CW_GCNT + 64 * F.tid), lcnt[F.tid], RLX_AGENT);
        __syncthreads();
        if (F.tid < 64) { const int m = item * 64 + F.tid; const int e1 = rinfo[F.tid * 4], lp1 = rinfo[F.tid * 4 + 1], e2 = rinfo[F.tid * 4 + 2], lp2 = rinfo[F.tid * 4 + 3];
            int* o = rti + (size_t)m * 4; o[0] = e1; o[1] = (int)gbase[e1] + lp1; o[2] = e2; o[3] = (int)gbase[e2] + lp2; }
        __syncthreads();
    }
}
__device__ __forceinline__ void load_counts(Frame& F, unsigned (&cnt)[8]) {
#pragma unroll
    for (int e = 0; e < 8; ++e) cnt[e] = (unsigned)__builtin_amdgcn_readfirstlane((int)__hip_atomic_load((unsigned*)(F.ctl + CW_GCNT + 64 * e), RLX_AGENT));
}
__device__ __forceinline__ void scatter_phase(Frame& F) {
    unsigned cnt[8]; load_counts(F, cnt);
    int coff[8]; { int s = 0;
#pragma unroll
        for (int e = 0; e < 8; ++e) { coff[e] = s; s += (int)((cnt[e] + 255u) & ~255u); } }
    const int gw = blockIdx.x * NWAVES + F.wave, NGW = F.G * NWAVES;
    const int* rti = wsp<int>(F, WS_RTI); int* rsel = wsp<int>(F, WS_RSEL); const bf16* H = wsp<bf16>(F, WS_H); bf16* HP = wsp<bf16>(F, WS_HP);
    for (int m = gw; m < T; m += NGW) {
        const int e1 = rti[(size_t)m * 4], p1 = rti[(size_t)m * 4 + 1], e2 = rti[(size_t)m * 4 + 2], p2 = rti[(size_t)m * 4 + 3];
        int c1 = 0, c2 = 0;
#pragma unroll
        for (int e = 0; e < 8; ++e) { c1 = (e1 == e) ? coff[e] : c1; c2 = (e2 == e) ? coff[e] : c2; }
        const int r1 = c1 + p1, r2 = c2 + p2;
#if MK_FP8_GU
        const v4u a = ((const v4u*)((const unsigned char*)H + (size_t)m * D))[F.lane];
        ((v4u*)((unsigned char*)HP + (size_t)r1 * D))[F.lane] = a; ((v4u*)((unsigned char*)HP + (size_t)r2 * D))[F.lane] = a;
        if (F.lane == 0) { const float rsv = wsp<float>(F, WS_RS)[m]; wsp<float>(F, WS_RSP)[r1] = rsv; wsp<float>(F, WS_RSP)[r2] = rsv; }
#else
        const v4u* s = (const v4u*)(H + (size_t)m * D); const v4u a = s[F.lane], b = s[F.lane + 64];
        v4u* d1 = (v4u*)(HP + (size_t)r1 * D); v4u* d2 = (v4u*)(HP + (size_t)r2 * D);
        d1[F.lane] = a; d1[F.lane + 64] = b; d2[F.lane] = a; d2[F.lane + 64] = b;
#endif
        if (F.lane == 0) { rsel[(size_t)m * 2] = r1; rsel[(size_t)m * 2 + 1] = r2; }
    }
}
__device__ __forceinline__ void combine_norm_phase(Frame& F, float* X, const float* gain, bf16* dst) {
    const int gw = blockIdx.x * NWAVES + F.wave, NGW = F.G * NWAVES;
    const int* rsel = wsp<int>(F, WS_RSEL); const float* rtw = wsp<float>(F, WS_RTW); const float* Y = wsp<float>(F, WS_Y);
    f32x4 g[4];
#pragma unroll
    for (int j = 0; j < 4; ++j) g[j] = ((const f32x4*)gain)[F.lane + 64 * j];
    for (int m = gw; m < T; m += NGW) {
        const int r1 = rsel[(size_t)m * 2], r2 = rsel[(size_t)m * 2 + 1]; const float w1 = rtw[(size_t)m * 2], w2 = rtw[(size_t)m * 2 + 1];
        f32x4* xr = (f32x4*)(X + (size_t)m * D) + F.lane; const f32x4* y1 = (const f32x4*)(Y + (size_t)r1 * D) + F.lane; const f32x4* y2 = (const f32x4*)(Y + (size_t)r2 * D) + F.lane;
        f32x4 v[4]; float s = 0.f;
#pragma unroll
        for (int j = 0; j < 4; ++j) { v[j] = xr[64 * j] + (y1[64 * j] * w1 + y2[64 * j] * w2); xr[64 * j] = v[j]; s += dot4(v[j], v[j]); }
        const float rstd = 1.f / sqrtf(wave_sum(s) * (1.f / D) + EPS);
        unsigned long long* o8 = (unsigned long long*)(dst + (size_t)m * D) + F.lane;
#pragma unroll
        for (int j = 0; j < 4; ++j) { const f32x4 y = v[j] * rstd * g[j]; o8[64 * j] = (unsigned long long)pk2(y.x, y.y) | ((unsigned long long)pk2(y.z, y.w) << 32); }
    }
}

__device__ __forceinline__ void conv_phase(Frame& F, int layer) {
    LAS bf16* zt = (LAS bf16*)(F.lds);
    LAS float* wl = (LAS float*)(F.lds + 65536);
    const float* cw = inp(I_CW) + (size_t)layer * CK * CCH; const float* cb = inp(I_CB) + layer * CCH;
    const float* lg = inp(I_CLG) + layer * CCH; const float* lb = inp(I_CLB) + layer * CCH;
    const bf16* Z = wsp<bf16>(F, WS_Z); bf16* ZC = wsp<bf16>(F, WS_ZC);
    for (int i = F.tid; i < CK * CCH; i += NWAVES * 64) { const int tap = i >> 9, ch = i & 511; wl[((tap * 2 + ((ch >> 2) & 1)) * 64 + (ch >> 3)) * 4 + (ch & 3)] = cw[i]; }
    const int c0 = 8 * F.lane;
    const f32x4 b_lo = *(const f32x4*)(cb + c0), b_hi = *(const f32x4*)(cb + c0 + 4), g_lo = *(const f32x4*)(lg + c0), g_hi = *(const f32x4*)(lg + c0 + 4), o_lo = *(const f32x4*)(lb + c0), o_hi = *(const f32x4*)(lb + c0 + 4);
    for (int unit = blockIdx.x; unit < BATCH * (SEQ / 32); unit += F.G) {
        const int b = unit / (SEQ / 32), t0 = (unit % (SEQ / 32)) * 32;
        __syncthreads();
        for (int i = F.tid; i < 62 * 64; i += NWAVES * 64) { const int r = i >> 6, c16 = i & 63, t = t0 - CPAD + r;
            v4u val = (v4u){0u, 0u, 0u, 0u}; if (t >= 0 && t < SEQ) val = *(const v4u*)(Z + ((size_t)(b * SEQ + t)) * CCH + c16 * 8);
            *(LAS v4u*)(zt + r * CCH + c16 * 8) = val; }
        __syncthreads();
        const int r0 = 4 * F.wave;
        f32x4 alo[4], ahi[4];
#pragma unroll
        for (int rr = 0; rr < 4; ++rr) { alo[rr] = b_lo; ahi[rr] = b_hi; }
        f32x4 zlo[4], zhi[4];
#define CONV_LDZ(slot, rowi) do { const v4u zz = *(const LAS v4u*)(zt + (r0 + (rowi)) * CCH + c0); \
        zlo[slot] = (f32x4){bf_lo(zz.x), bf_hi(zz.x), bf_lo(zz.y), bf_hi(zz.y)}; zhi[slot] = (f32x4){bf_lo(zz.z), bf_hi(zz.z), bf_lo(zz.w), bf_hi(zz.w)}; } while (0)
        CONV_LDZ(0, 0); CONV_LDZ(1, 1); CONV_LDZ(2, 2);
#pragma unroll
        for (int tap = 0; tap < CK; ++tap) {
            CONV_LDZ((tap + 3) & 3, tap + 3);
            const f32x4 wlo = *(const LAS f32x4*)(wl + ((tap * 2 + 0) * 64 + F.lane) * 4), whi = *(const LAS f32x4*)(wl + ((tap * 2 + 1) * 64 + F.lane) * 4);
#pragma unroll
            for (int rr = 0; rr < 4; ++rr) { alo[rr] += wlo * zlo[(tap + rr) & 3]; ahi[rr] += whi * zhi[(tap + rr) & 3]; }
        }
#undef CONV_LDZ
#pragma unroll
        for (int rr = 0; rr < 4; ++rr) {
            const float mean = wave_sum((alo[rr].x + alo[rr].y) + (alo[rr].z + alo[rr].w) + (ahi[rr].x + ahi[rr].y) + (ahi[rr].z + ahi[rr].w)) * (1.f / CCH);
            const f32x4 dl = alo[rr] - mean, dh = ahi[rr] - mean;
            const float rstd = 1.f / sqrtf(wave_sum(dot4(dl, dl) + dot4(dh, dh)) * (1.f / CCH) + EPS);
            f32x4 yl = dl * rstd * g_lo + o_lo, yh = dh * rstd * g_hi + o_hi;
            yl = yl * pg8::sigm4(yl); yh = yh * pg8::sigm4(yh);
            *(v4u*)(ZC + ((size_t)(b * SEQ + t0 + r0 + rr)) * CCH + c0) = pg8::pack8(yl, yh);
        }
    }
    __syncthreads();
}

__device__ __forceinline__ void conv_naive_phase(Frame& F, int layer) {
    const float* cw = inp(I_CW) + (size_t)layer * CK * CCH; const float* cb = inp(I_CB) + layer * CCH;
    const float* lg = inp(I_CLG) + layer * CCH; const float* lb = inp(I_CLB) + layer * CCH;
    const bf16* Z = wsp<bf16>(F, WS_Z); bf16* ZC = wsp<bf16>(F, WS_ZC);
    const int gw = blockIdx.x * NWAVES + F.wave, NGW = F.G * NWAVES, c0 = 8 * F.lane;
    for (int m = gw; m < T; m += NGW) {
        const int b = m / SEQ, t = m % SEQ;
        f32x4 alo = *(const f32x4*)(cb + c0), ahi = *(const f32x4*)(cb + c0 + 4);
        for (int tap = 0; tap < CK; ++tap) { const int tt = t + tap - CPAD; if (tt < 0 || tt >= SEQ) continue;
            const v4u zz = *(const v4u*)(Z + ((size_t)(b * SEQ + tt)) * CCH + c0);
            const f32x4 wlo = *(const f32x4*)(cw + tap * CCH + c0), whi = *(const f32x4*)(cw + tap * CCH + c0 + 4);
            alo += wlo * (f32x4){bf_lo(zz.x), bf_hi(zz.x), bf_lo(zz.y), bf_hi(zz.y)}; ahi += whi * (f32x4){bf_lo(zz.z), bf_hi(zz.z), bf_lo(zz.w), bf_hi(zz.w)}; }
        const float mean = wave_sum((alo.x + alo.y) + (alo.z + alo.w) + (ahi.x + ahi.y) + (ahi.z + ahi.w)) * (1.f / CCH);
        const f32x4 dl = alo - mean, dh = ahi - mean;
        const float rstd = 1.f / sqrtf(wave_sum(dot4(dl, dl) + dot4(dh, dh)) * (1.f / CCH) + EPS);
        f32x4 yl = dl * rstd * *(const f32x4*)(lg + c0) + *(const f32x4*)(lb + c0), yh = dh * rstd * *(const f32x4*)(lg + c0 + 4) + *(const f32x4*)(lb + c0 + 4);
        yl = yl * pg8::sigm4(yl); yh = yh * pg8::sigm4(yh);
        *(v4u*)(ZC + (size_t)m * CCH + c0) = pg8::pack8(yl, yh);
    }
}

#ifdef DBG_CHECK_INPROJ
__device__ __forceinline__ float chk_col(const float* w, const f32x4 (&hv)[4], int lane, int c) {
    float t = 0.f;
#pragma unroll
    for (int j = 0; j < 4; ++j) { const int k = 4 * (lane + 64 * j); t += hv[j].x * w[(size_t)(k + 0) * INC + c] + hv[j].y * w[(size_t)(k + 1) * INC + c] + hv[j].z * w[(size_t)(k + 2) * INC + c] + hv[j].w * w[(size_t)(k + 3) * INC + c]; }
    return wave_sum(t);
}
__device__ __forceinline__ bool chk_bad(float got, float exp_) { return !(fabsf(got - exp_) <= 0.02f + 0.02f * fabsf(exp_)); }
__device__ __forceinline__ void check_inproj(Frame& F, int layer) {
    const int gw = blockIdx.x * NWAVES + F.wave; const int m = (int)(dbg_hash((unsigned)gw, 5u) % (unsigned)T), pos = m % SEQ;
    const float* x = layer == 0 ? inp(I_X) : (const float*)wsp<float>(F, WS_X); const float* gain = inp(I_GMIX) + (size_t)layer * D; const float* w = inp(I_WIN) + (size_t)layer * D * INC; const float* rope = wsp<float>(F, WS_ROPE);
    const bf16* Q = wsp<bf16>(F, WS_Q); const bf16* K = wsp<bf16>(F, WS_K); const bf16* V = wsp<bf16>(F, WS_V); const bf16* Z = wsp<bf16>(F, WS_Z); const bf16* SG = wsp<bf16>(F, WS_SG);
    f32x4 hv[4]; float s = 0.f;
#pragma unroll
    for (int j = 0; j < 4; ++j) { hv[j] = ((const f32x4*)(x + (size_t)m * D))[F.lane + 64 * j]; s += dot4(hv[j], hv[j]); }
    const float rstd = 1.f / sqrtf(wave_sum(s) * (1.f / D) + EPS);
#pragma unroll
    for (int j = 0; j < 4; ++j) hv[j] = hv[j] * rstd * ((const f32x4*)gain)[F.lane + 64 * j];
    unsigned flags = 0u;
    { for (int i = 0; i < 2; ++i) { const int c0_ = (int)(dbg_hash((unsigned)gw, 100u + i) % 512u), c = (c0_ & ~63) | (c0_ & 31), f = c & 31; const float t1 = chk_col(w, hv, F.lane, c), t2 = chk_col(w, hv, F.lane, c + 32);
        const float cs = rope[pos * 64 + f], sn = rope[pos * 64 + 32 + f];
        if (chk_bad(bf_lo((unsigned)Q[(size_t)m * 512 + c]), (t1 * cs - t2 * sn) * QSCALE) || chk_bad(bf_lo((unsigned)Q[(size_t)m * 512 + c + 32]), (t2 * cs + t1 * sn) * QSCALE)) flags |= 1u; } }
    { const int c0_ = (int)(dbg_hash((unsigned)gw, 102u) % 512u), c = (c0_ & ~63) | (c0_ & 31), f = c & 31; const float t1 = chk_col(w, hv, F.lane, 512 + c), t2 = chk_col(w, hv, F.lane, 512 + c + 32);
        const float cs = rope[pos * 64 + f], sn = rope[pos * 64 + 32 + f];
        if (chk_bad(bf_lo((unsigned)K[(size_t)m * 512 + c]), t1 * cs - t2 * sn) || chk_bad(bf_lo((unsigned)K[(size_t)m * 512 + c + 32]), t2 * cs + t1 * sn)) flags |= 1u; }
    { const int cv = (int)(dbg_hash((unsigned)gw, 103u) % 512u); const float v = chk_col(w, hv, F.lane, 1024 + cv); if (chk_bad(bf_lo((unsigned)V[(size_t)m * 512 + cv]), v)) flags |= 2u; }
    { int cz[2]; cz[0] = (int)(dbg_hash((unsigned)gw, 104u) % 512u); cz[1] = (int)(dbg_hash((unsigned)gw, 105u) % 512u); for (int i = 0; i < 2; ++i) { const float a = chk_col(w, hv, F.lane, 1536 + cz[i]), g = chk_col(w, hv, F.lane, 2048 + cz[i]);
        if (chk_bad(bf_lo((unsigned)Z[(size_t)m * 512 + cz[i]]), a / (1.f + expf(-g)))) flags |= 2u; } }
    { const int ca = (int)(dbg_hash((unsigned)gw, 106u) % 1024u), cb = (int)(dbg_hash((unsigned)gw, 107u) % 1024u); const float a = chk_col(w, hv, F.lane, 2560 + ca), b = chk_col(w, hv, F.lane, 2560 + 1024 + cb);
#ifdef DBG_SG_DETAIL
        unsigned code = 0u;
        if (chk_bad(bf_lo((unsigned)SG[(size_t)m * 2048 + ca]), 1.f / (1.f + expf(-a)))) code = (unsigned)(DBG_SG_DETAIL == 1 ? 18 - (10 + ca / 256) : (DBG_SG_DETAIL == 2 ? 1 + ((m % 256) >> 4) : DBG_SG_DETAIL == 3 ? 16 - ((m % 256) >> 4) : 1 + ((m >> 8) & 15)));
        if (chk_bad(bf_lo((unsigned)SG[(size_t)m * 2048 + 1024 + cb]), 1.f / (1.f + expf(-b)))) { const unsigned c2 = (unsigned)(DBG_SG_DETAIL == 1 ? 18 - (14 + cb / 256) : (DBG_SG_DETAIL == 2 ? 1 + ((m % 256) >> 4) : DBG_SG_DETAIL == 3 ? 16 - ((m % 256) >> 4) : 1 + ((m >> 8) & 15))); code = code > c2 ? code : c2; }
#if DBG_SG_DETAIL == 5
        if (F.lane == 0 && code) __hip_atomic_fetch_add((unsigned*)(F.ctl + 17), 1u, RLX_AGENT);
#else
        if (F.lane == 0 && code) __hip_atomic_fetch_max((unsigned*)(F.ctl + 16), code, RLX_AGENT);
#endif
#else
        if (chk_bad(bf_lo((unsigned)SG[(size_t)m * 2048 + ca]), 1.f / (1.f + expf(-a))) || chk_bad(bf_lo((unsigned)SG[(size_t)m * 2048 + 1024 + cb]), 1.f / (1.f + expf(-b)))) flags |= 4u;
#endif
    }
    if (F.lane == 0 && flags) __hip_atomic_fetch_or((unsigned*)(F.ctl + 16), flags, RLX_AGENT);
}
#endif

#ifdef DBG_CHECK_ACT
__device__ __forceinline__ void check_act(Frame& F) {
    const int gw = blockIdx.x * NWAVES + F.wave; const int m = (int)(dbg_hash((unsigned)gw, 3u) % (unsigned)T);
    const float* x = wsp<float>(F, WS_X); const float* gain = inp(I_GFFN); const float* w = inp(I_WFGU); const bf16* ACT = wsp<bf16>(F, WS_ACT);
    f32x4 hv[4]; float s = 0.f;
#pragma unroll
    for (int j = 0; j < 4; ++j) { hv[j] = ((const f32x4*)(x + (size_t)m * D))[F.lane + 64 * j]; s += dot4(hv[j], hv[j]); }
    const float rstd = 1.f / sqrtf(wave_sum(s) * (1.f / D) + EPS);
#pragma unroll
    for (int j = 0; j < 4; ++j) hv[j] = hv[j] * rstd * ((const f32x4*)gain)[F.lane + 64 * j];
    unsigned flags = 0u; int cj[4]; for (int i = 0; i < 4; ++i) cj[i] = (int)(dbg_hash((unsigned)gw, 110u + i) % (unsigned)FF);
    for (int i = 0; i < 4; ++i) { float g = 0.f, u = 0.f;
#pragma unroll
        for (int j = 0; j < 4; ++j) { const int k = 4 * (F.lane + 64 * j);
            g += hv[j].x * w[(size_t)(k + 0) * (2 * FF) + cj[i]] + hv[j].y * w[(size_t)(k + 1) * (2 * FF) + cj[i]] + hv[j].z * w[(size_t)(k + 2) * (2 * FF) + cj[i]] + hv[j].w * w[(size_t)(k + 3) * (2 * FF) + cj[i]];
            u += hv[j].x * w[(size_t)(k + 0) * (2 * FF) + FF + cj[i]] + hv[j].y * w[(size_t)(k + 1) * (2 * FF) + FF + cj[i]] + hv[j].z * w[(size_t)(k + 2) * (2 * FF) + FF + cj[i]] + hv[j].w * w[(size_t)(k + 3) * (2 * FF) + FF + cj[i]]; }
        g = wave_sum(g); u = wave_sum(u);
        const float ex = g / (1.f + expf(-g)) * u, got = bf_lo((unsigned)ACT[(size_t)m * FF + cj[i]]);
        if (!(fabsf(got - ex) <= 0.03f + 0.03f * fabsf(ex))) flags |= 8u; }
    if (F.lane == 0 && flags) __hip_atomic_fetch_or((unsigned*)(F.ctl + 16), flags, RLX_AGENT);
}
#endif

#ifdef DBG_CHECK_MIX
__device__ __forceinline__ float chk_dot_bf(const bf16* a, int K, const float* w, int ldw, int c, int lane) {
    float t = 0.f; for (int k = lane; k < K; k += 64) t += bf_lo((unsigned)a[k]) * w[(size_t)k * ldw + c]; return wave_sum(t); }
__device__ __forceinline__ void check_mix(Frame& F, int layer) {
    const int gw = blockIdx.x * NWAVES + F.wave; const int m = (int)(dbg_hash((unsigned)gw, 1u) % (unsigned)T);
    const bf16* OB = wsp<bf16>(F, WS_OB); const bf16* ZC = wsp<bf16>(F, WS_ZC); const bf16* SG = wsp<bf16>(F, WS_SG); const bf16* MIX = wsp<bf16>(F, WS_MIX);
    unsigned flags = 0u; int cc[4]; for (int i = 0; i < 4; ++i) cc[i] = (int)(dbg_hash((unsigned)gw, 120u + i) % (unsigned)D);
    for (int i = 0; i < 4; ++i) { const int c = cc[i];
        const float ad = chk_dot_bf(OB + (size_t)m * AV, AV, inp(I_WAO) + (size_t)layer * AV * D, D, c, F.lane), cd = chk_dot_bf(ZC + (size_t)m * CCH, CCH, inp(I_WCO) + (size_t)layer * CCH * D, D, c, F.lane);
        const float ex = bf_lo((unsigned)SG[(size_t)m * 2048 + c]) * ad + bf_lo((unsigned)SG[(size_t)m * 2048 + 1024 + c]) * cd, got = bf_lo((unsigned)MIX[(size_t)m * D + c]);
        if (!(fabsf(got - ex) <= 0.02f + 0.02f * fabsf(ex))) flags |= 16u; }
    if (F.lane == 0 && flags) __hip_atomic_fetch_or((unsigned*)(F.ctl + 16), flags, RLX_AGENT);
}
__device__ __forceinline__ void snap_wo(Frame& F) { const int gw = blockIdx.x * NWAVES + F.wave; const int m = (int)(dbg_hash((unsigned)gw, 6u) % (unsigned)T);
    if (F.lane < 4) wsp<float>(F, 3 * MiB + 768 * 1024)[(size_t)gw * 4 + F.lane] = wsp<float>(F, WS_X)[(size_t)m * D + (int)(dbg_hash((unsigned)gw, 130u + F.lane) % (unsigned)D)]; }
__device__ __forceinline__ void check_wo(Frame& F, int layer) {
    const int gw = blockIdx.x * NWAVES + F.wave; const int m = (int)(dbg_hash((unsigned)gw, 6u) % (unsigned)T);
    const bf16* MIX = wsp<bf16>(F, WS_MIX); const float* X = wsp<float>(F, WS_X); const float* xin = inp(I_X);
    unsigned flags = 0u; int cc[4]; for (int i_ = 0; i_ < 4; ++i_) cc[i_] = (int)(dbg_hash((unsigned)gw, 130u + i_) % (unsigned)D);
    for (int i = 0; i < 4; ++i) { const int c = cc[i];
        const float ex = (layer == 0 ? xin[(size_t)m * D + c] : wsp<float>(F, 3 * MiB + 768 * 1024)[(size_t)gw * 4 + i]) + chk_dot_bf(MIX + (size_t)m * D, D, inp(I_WO) + (size_t)layer * D * D, D, c, F.lane), got = X[(size_t)m * D + c];
        if (!(fabsf(got - ex) <= 0.02f + 0.02f * fabsf(ex))) flags |= 32u; }
    if (F.lane == 0 && flags) __hip_atomic_fetch_or((unsigned*)(F.ctl + 16), flags, RLX_AGENT);
}
#endif

#ifdef DBG_CHECK_FFN
constexpr size_t WS_DBG = 3 * MiB;
__device__ __forceinline__ void snap_x(Frame& F, int slot, int samp) {
    const int gw = blockIdx.x * NWAVES + F.wave; const int m = (int)(dbg_hash((unsigned)gw, (unsigned)samp) % (unsigned)T);
    if (F.lane < 4) wsp<float>(F, WS_DBG)[(size_t)gw * 16 + slot * 4 + F.lane] = wsp<float>(F, WS_X)[(size_t)m * D + (int)(dbg_hash((unsigned)gw, 140u + F.lane) % (unsigned)D)];
}
__device__ __forceinline__ float chk_dot_f(const float* a, int K, const float* w, int ldw, int c, int lane) { float t = 0.f; for (int k = lane; k < K; k += 64) t += a[k] * w[(size_t)k * ldw + c]; return wave_sum(t); }
__device__ __forceinline__ void check_down(Frame& F) {
    const int gw = blockIdx.x * NWAVES + F.wave; const int m = (int)(dbg_hash((unsigned)gw, 2u) % (unsigned)T); int cc[4]; for (int i_ = 0; i_ < 4; ++i_) cc[i_] = (int)(dbg_hash((unsigned)gw, 140u + i_) % (unsigned)D); unsigned flags = 0u;
    for (int i = 0; i < 4; ++i) { const float d = chk_dot_bf(wsp<bf16>(F, WS_ACT) + (size_t)m * FF, FF, inp(I_WFDN), D, cc[i], F.lane);
        const float ex = wsp<float>(F, WS_DBG)[(size_t)gw * 16 + i] + d, got = wsp<float>(F, WS_X)[(size_t)m * D + cc[i]];
        if (!(fabsf(got - ex) <= 0.02f + 0.02f * fabsf(ex))) flags |= 64u; }
    if (F.lane == 0 && flags) __hip_atomic_fetch_or((unsigned*)(F.ctl + 16), flags, RLX_AGENT);
}
__device__ __forceinline__ void check_norm3(Frame& F, int layer) {
    const int gw = blockIdx.x * NWAVES + F.wave; const int m = (int)(dbg_hash((unsigned)gw, 4u) % (unsigned)T); const float* x = wsp<float>(F, WS_X) + (size_t)m * D; const float* g = inp(I_GPLE) + (size_t)layer * D;
    float s = 0.f; for (int k = F.lane; k < D; k += 64) s += x[k] * x[k];
    const float rstd = 1.f / sqrtf(wave_sum(s) * (1.f / D) + EPS); unsigned flags = 0u;
    for (int k = F.lane; k < D; k += 64) { const float ex = x[k] * rstd * g[k], got = bf_lo((unsigned)wsp<bf16>(F, WS_H)[(size_t)m * D + k]); if (!(fabsf(got - ex) <= 0.01f + 0.01f * fabsf(ex))) flags |= 256u; }
    if (flags) __hip_atomic_fetch_or((unsigned*)(F.ctl + 16), flags, RLX_AGENT);
}
__device__ __forceinline__ void check_ple(Frame& F, int layer) {
    const int gw = blockIdx.x * NWAVES + F.wave; const int m = (int)(dbg_hash((unsigned)gw, 4u) % (unsigned)T); int cc[4]; for (int i_ = 0; i_ < 4; ++i_) cc[i_] = (int)(dbg_hash((unsigned)gw, 140u + i_) % (unsigned)D); unsigned flags = 0u;
    for (int i = 0; i < 4; ++i) { const float gl = chk_dot_bf(wsp<bf16>(F, WS_H) + (size_t)m * D, D, inp(I_WPG) + (size_t)layer * D * D, D, cc[i], F.lane);
        const float pj = chk_dot_f(inp(I_P) + ((size_t)layer * T + m) * PLE, PLE, inp(I_WPP) + (size_t)layer * PLE * D, D, cc[i], F.lane);
        const float ex = wsp<float>(F, WS_DBG)[(size_t)gw * 16 + 4 + i] + pj / (1.f + expf(-gl)) + DBG_INJECT, got = wsp<float>(F, WS_X)[(size_t)m * D + cc[i]];
        if (!(fabsf(got - ex) <= 0.02f + 0.02f * fabsf(ex))) flags |= 128u; }
    if (F.lane == 0 && flags) __hip_atomic_fetch_or((unsigned*)(F.ctl + 16), flags, RLX_AGENT);
}
#endif

#ifdef DBG_CHECK_ATTN
__device__ __forceinline__ void check_attn(Frame& F, int layer) {
    const int gw = blockIdx.x * NWAVES + F.wave; const int m = (int)(dbg_hash((unsigned)gw, 7u) % (unsigned)T), h = gw & 3, b = m / SEQ;
    const float lam = wsp<float>(F, WS_SCAL)[layer]; const float lam_init = 0.8f - 0.6f * expf(-0.3f * (float)layer), post = 1.f - lam_init;
    const float* gsub = inp(I_GSUB) + layer * VD;
    const bf16* Q = wsp<bf16>(F, WS_Q); const bf16* Kb = wsp<bf16>(F, WS_K) + (size_t)b * SEQ * AQK; const bf16* Vb = wsp<bf16>(F, WS_V) + (size_t)b * SEQ * AV; const bf16* OB = wsp<bf16>(F, WS_OB);
    LAS float* S = (LAS float*)(F.lds) + F.wave * 2048; LAS float* O = (LAS float*)(F.lds + 65536) + F.wave * 256;
    for (int c = 0; c < 2; ++c) {
        float qf[64];
#pragma unroll
        for (int i = 0; i < 8; ++i) { const v4u t = *(const v4u*)(Q + (size_t)m * AQK + h * 128 + c * 64 + i * 8);
            qf[8 * i] = bf_lo(t.x); qf[8 * i + 1] = bf_hi(t.x); qf[8 * i + 2] = bf_lo(t.y); qf[8 * i + 3] = bf_hi(t.y); qf[8 * i + 4] = bf_lo(t.z); qf[8 * i + 5] = bf_hi(t.z); qf[8 * i + 6] = bf_lo(t.w); qf[8 * i + 7] = bf_hi(t.w); }
        float mx = -1e30f;
        for (int i = 0; i < 32; ++i) { const int j = F.lane + 64 * i; const bf16* kr = Kb + (size_t)j * AQK + h * 128 + c * 64; float sc = 0.f;
#pragma unroll
            for (int t8 = 0; t8 < 8; ++t8) { const v4u t = *(const v4u*)(kr + t8 * 8);
                sc += qf[8 * t8] * bf_lo(t.x) + qf[8 * t8 + 1] * bf_hi(t.x) + qf[8 * t8 + 2] * bf_lo(t.y) + qf[8 * t8 + 3] * bf_hi(t.y) + qf[8 * t8 + 4] * bf_lo(t.z) + qf[8 * t8 + 5] * bf_hi(t.z) + qf[8 * t8 + 6] * bf_lo(t.w) + qf[8 * t8 + 7] * bf_hi(t.w); }
            S[j] = sc; mx = fmaxf(mx, sc); }
#pragma unroll
        for (int o = 1; o < 64; o <<= 1) mx = fmaxf(mx, __shfl_xor(mx, o));
        float l = 0.f;
        for (int i = 0; i < 32; ++i) { const int j = F.lane + 64 * i; const float p = exp2f(S[j] - mx); S[j] = p; l += p; }
        l = wave_sum(l);
        for (int ch = 0; ch < 4; ++ch) { float a[32];
#pragma unroll
            for (int k = 0; k < 32; ++k) a[k] = 0.f;
            for (int i = 0; i < 32; ++i) { const int j = F.lane + 64 * i; const float p = S[j]; const bf16* vr = Vb + (size_t)j * AV + h * 128 + ch * 32;
#pragma unroll
                for (int t8 = 0; t8 < 4; ++t8) { const v4u t = *(const v4u*)(vr + t8 * 8);
                    a[8 * t8] += p * bf_lo(t.x); a[8 * t8 + 1] += p * bf_hi(t.x); a[8 * t8 + 2] += p * bf_lo(t.y); a[8 * t8 + 3] += p * bf_hi(t.y); a[8 * t8 + 4] += p * bf_lo(t.z); a[8 * t8 + 5] += p * bf_hi(t.z); a[8 * t8 + 6] += p * bf_lo(t.w); a[8 * t8 + 7] += p * bf_hi(t.w); } }
#pragma unroll
            for (int k = 0; k < 32; ++k) { const float r = wave_sum(a[k]); if (F.lane == 0) O[c * 128 + ch * 32 + k] = r / l; } }
    }
    LDS_WAIT();
    const float d0 = O[F.lane] - lam * O[128 + F.lane], d1 = O[64 + F.lane] - lam * O[128 + 64 + F.lane];
    const float rstd = post / sqrtf(wave_sum(d0 * d0 + d1 * d1) * (1.f / VD) + EPS);
    const float e0 = d0 * rstd * gsub[F.lane], e1 = d1 * rstd * gsub[64 + F.lane];
    const float g0 = bf_lo((unsigned)OB[(size_t)m * AV + h * 128 + F.lane]), g1 = bf_lo((unsigned)OB[(size_t)m * AV + h * 128 + 64 + F.lane]);
    if (!(fabsf(g0 - e0) <= 0.03f + 0.03f * fabsf(e0)) || !(fabsf(g1 - e1) <= 0.03f + 0.03f * fabsf(e1))) __hip_atomic_fetch_or((unsigned*)(F.ctl + 16), 512u, RLX_AGENT);
}
#endif

#ifdef DBG_CHECK_MOE
__device__ __forceinline__ void check_route(Frame& F) {
    const int gw = blockIdx.x * NWAVES + F.wave; const int m = (int)(dbg_hash((unsigned)gw, 6u) % (unsigned)T);
    const float* x = wsp<float>(F, WS_X) + (size_t)m * D; const float* g = inp(I_GFFN) + D; const float* wr = inp(I_WR); const float* br = inp(I_BR);
    float s = 0.f; for (int k = F.lane; k < D; k += 64) s += x[k] * x[k];
    const float rstd = 1.f / sqrtf(wave_sum(s) * (1.f / D) + EPS);
    float lg[8];
#pragma unroll
    for (int e = 0; e < 8; ++e) lg[e] = 0.f;
    for (int k = F.lane; k < D; k += 64) { const float hk = x[k] * rstd * g[k];
#pragma unroll
        for (int e = 0; e < 8; ++e) lg[e] += hk * wr[k * 8 + e]; }
#pragma unroll
    for (int e = 0; e < 8; ++e) lg[e] = wave_sum(lg[e]) + br[e];
    int e1 = 0; float v1 = lg[0];
#pragma unroll
    for (int e = 1; e < 8; ++e) if (lg[e] > v1) { v1 = lg[e]; e1 = e; }
    int e2 = -1; float v2 = -INFINITY;
#pragma unroll
    for (int e = 0; e < 8; ++e) if (e != e1 && lg[e] > v2) { v2 = lg[e]; e2 = e; }
    const float ex = expf(v2 - v1), w1 = 1.f / (1.f + ex), w2 = ex / (1.f + ex);
    const int* rti = wsp<int>(F, WS_RTI) + (size_t)m * 4; const float* rtw = wsp<float>(F, WS_RTW) + (size_t)m * 2;
    const bool tie = (v1 - v2) < 1e-3f;
    bool bad = !(fabsf(rtw[0] + rtw[1] - 1.f) < 1e-3f);
    if (!tie) bad = bad || rti[0] != e1 || rti[2] != e2 || !(fabsf(rtw[0] - w1) < 2e-3f) || !(fabsf(rtw[1] - w2) < 2e-3f);
    if (bad && F.lane == 0) __hip_atomic_fetch_or((unsigned*)(F.ctl + 16), 1024u, RLX_AGENT);
}
__device__ __forceinline__ void check_experts(Frame& F) {
    const int gw = blockIdx.x * NWAVES + F.wave; const int m = (int)(dbg_hash((unsigned)gw, 6u) % (unsigned)T);
    const int* rti = wsp<int>(F, WS_RTI) + (size_t)m * 4; const int* rsel = wsp<int>(F, WS_RSEL) + (size_t)m * 2;
    const bf16* H = wsp<bf16>(F, WS_H) + (size_t)m * D; unsigned flags = 0u;
    for (int t = 0; t < 2; ++t) { const int e = rti[2 * t], r = rsel[t];
        const bf16* hp = wsp<bf16>(F, WS_HP) + (size_t)r * D; const bf16* act = wsp<bf16>(F, WS_ACT) + (size_t)r * FE; const float* y = wsp<float>(F, WS_Y) + (size_t)r * D;
        for (int k = F.lane; k < D; k += 64) if (hp[k] != H[k]) flags |= 2048u;
        const float* wgu = inp(I_WEGU) + (size_t)e * D * 2 * FE; const float* wdn = inp(I_WEDN) + (size_t)e * FE * D;
        int cj[3]; for (int i_ = 0; i_ < 3; ++i_) cj[i_] = (int)(dbg_hash((unsigned)gw, 150u + i_ + 8 * t) % (unsigned)FE);
        for (int i = 0; i < 3; ++i) { float gg = 0.f, uu = 0.f;
            for (int k = F.lane; k < D; k += 64) { const float hk = bf_lo((unsigned)hp[k]); gg += hk * wgu[(size_t)k * (2 * FE) + cj[i]]; uu += hk * wgu[(size_t)k * (2 * FE) + FE + cj[i]]; }
            gg = wave_sum(gg); uu = wave_sum(uu);
            const float ex = gg / (1.f + expf(-gg)) * uu, got = bf_lo((unsigned)act[cj[i]]);
            if (!(fabsf(got - ex) <= 0.03f + 0.03f * fabsf(ex))) flags |= 4096u; }
        int cc[2]; for (int i_ = 0; i_ < 2; ++i_) cc[i_] = (int)(dbg_hash((unsigned)gw, 160u + i_) % (unsigned)D);
        for (int i = 0; i < 2; ++i) { float d = 0.f; for (int k = F.lane; k < FE; k += 64) d += bf_lo((unsigned)act[k]) * wdn[(size_t)k * D + cc[i]];
            d = wave_sum(d); if (!(fabsf(y[cc[i]] - d) <= 0.02f + 0.02f * fabsf(d))) flags |= 8192u; }
    }
    if (F.lane < 2) wsp<float>(F, 3 * MiB + 512 * 1024)[(size_t)gw * 2 + F.lane] = wsp<float>(F, WS_X)[(size_t)m * D + (int)(dbg_hash((unsigned)gw, 160u + F.lane) % (unsigned)D)];
    if (flags) __hip_atomic_fetch_or((unsigned*)(F.ctl + 16), flags, RLX_AGENT);
}
__device__ __forceinline__ void check_combine(Frame& F) {
    const int gw = blockIdx.x * NWAVES + F.wave; const int m = (int)(dbg_hash((unsigned)gw, 6u) % (unsigned)T);
    const int* rsel = wsp<int>(F, WS_RSEL) + (size_t)m * 2; const float* rtw = wsp<float>(F, WS_RTW) + (size_t)m * 2; const float* Y = wsp<float>(F, WS_Y);
    if (F.lane < 2) { const int c = (int)(dbg_hash((unsigned)gw, 160u + F.lane) % (unsigned)D);
        const float ex = wsp<float>(F, 3 * MiB + 512 * 1024)[(size_t)gw * 2 + F.lane] + rtw[0] * Y[(size_t)rsel[0] * D + c] + rtw[1] * Y[(size_t)rsel[1] * D + c], got = wsp<float>(F, WS_X)[(size_t)m * D + c];
        if (!(fabsf(got - ex) <= 1e-3f + 1e-3f * fabsf(ex))) __hip_atomic_fetch_or((unsigned*)(F.ctl + 16), 16384u, RLX_AGENT); }
}
#endif

__device__ __forceinline__ void attn_naive_phase(Frame& F, int layer) {
    const float lam = wsp<float>(F, WS_SCAL)[layer]; const float lam_init = 0.8f - 0.6f * expf(-0.3f * (float)layer), post = 1.f - lam_init;
    const float* gsub = inp(I_GSUB) + layer * VD;
    const bf16* Q = wsp<bf16>(F, WS_Q); const bf16* Kb = wsp<bf16>(F, WS_K); const bf16* Vb = wsp<bf16>(F, WS_V); bf16* OB = wsp<bf16>(F, WS_OB);
    for (int unit = blockIdx.x; unit < BATCH * NH * (SEQ / 256); unit += F.G) {
        const int b = unit >> 5, h = (unit >> 3) & 3, qb = unit & 7, q = qb * 256 + (F.tid >> 1), c = F.tid & 1;
        const bf16* qp = Q + ((size_t)(b * SEQ + q)) * AQK + h * 128 + c * 64;
        unsigned qv[32];
#pragma unroll
        for (int i = 0; i < 8; ++i) { const v4u t = *(const v4u*)(qp + i * 8); qv[4 * i] = t.x; qv[4 * i + 1] = t.y; qv[4 * i + 2] = t.z; qv[4 * i + 3] = t.w; }
        float o[128];
#pragma unroll
        for (int e = 0; e < 128; ++e) o[e] = 0.f;
        float mx = -1e30f, l = 0.f;
        const bf16* kp = Kb + (size_t)b * SEQ * AQK + h * 128 + c * 64; const bf16* vp = Vb + (size_t)b * SEQ * AV + h * 128;
        for (int key = 0; key < SEQ; ++key) {
            float s = 0.f;
#pragma unroll
            for (int i = 0; i < 8; ++i) { const v4u kk = *(const v4u*)(kp + (size_t)key * AQK + i * 8);
                s += bf_lo(qv[4 * i]) * bf_lo(kk.x) + bf_hi(qv[4 * i]) * bf_hi(kk.x) + bf_lo(qv[4 * i + 1]) * bf_lo(kk.y) + bf_hi(qv[4 * i + 1]) * bf_hi(kk.y)
                   + bf_lo(qv[4 * i + 2]) * bf_lo(kk.z) + bf_hi(qv[4 * i + 2]) * bf_hi(kk.z) + bf_lo(qv[4 * i + 3]) * bf_lo(kk.w) + bf_hi(qv[4 * i + 3]) * bf_hi(kk.w); }
            const float mn = fmaxf(mx, s), alpha = __builtin_amdgcn_exp2f(mx - mn), p = __builtin_amdgcn_exp2f(s - mn); mx = mn; l = l * alpha + p;
#pragma unroll
            for (int i = 0; i < 16; ++i) { const v4u vv = *(const v4u*)(vp + (size_t)key * AV + i * 8);
                o[8 * i + 0] = o[8 * i + 0] * alpha + p * bf_lo(vv.x); o[8 * i + 1] = o[8 * i + 1] * alpha + p * bf_hi(vv.x);
                o[8 * i + 2] = o[8 * i + 2] * alpha + p * bf_lo(vv.y); o[8 * i + 3] = o[8 * i + 3] * alpha + p * bf_hi(vv.y);
                o[8 * i + 4] = o[8 * i + 4] * alpha + p * bf_lo(vv.z); o[8 * i + 5] = o[8 * i + 5] * alpha + p * bf_hi(vv.z);
                o[8 * i + 6] = o[8 * i + 6] * alpha + p * bf_lo(vv.w); o[8 * i + 7] = o[8 * i + 7] * alpha + p * bf_hi(vv.w); }
        }
        const float inv = 1.f / l; float rs = 0.f;
#pragma unroll
        for (int e = 0; e < 128; ++e) { const float mine = o[e] * inv, other = __shfl_xor(mine, 1); const float d = (c == 0) ? (mine - lam * other) : (other - lam * mine); o[e] = d; rs += d * d; }
        const float rstd = 1.f / sqrtf(rs * (1.f / VD) + EPS) * post;
        bf16* op = OB + ((size_t)(b * SEQ + q)) * AV + h * 128 + c * 64;
#pragma unroll
        for (int i = 0; i < 8; ++i) { float y[8];
#pragma unroll
            for (int j = 0; j < 8; ++j) y[j] = (c ? o[64 + 8 * i + j] : o[8 * i + j]) * rstd * gsub[c * 64 + 8 * i + j];
            v4u w; w.x = pk2(y[0], y[1]); w.y = pk2(y[2], y[3]); w.z = pk2(y[4], y[5]); w.w = pk2(y[6], y[7]); *(v4u*)(op + 8 * i) = w; }
    }
}

namespace dattn {
using bf16x8 = __attribute__((ext_vector_type(8))) short;
using s16x4  = __attribute__((ext_vector_type(4))) short;
using f32x16 = __attribute__((ext_vector_type(16))) float;
using u32x4  = __attribute__((ext_vector_type(4))) unsigned;
constexpr int NW = 8, QBLK = 32, KVBLK = 64, LDK = 512;
constexpr float THRL = 11.5f;
constexpr size_t SHM_V = KVBLK * 128 * 2, SHM_K = KVBLK * 128 * 2, SHM_ATTN = 2 * SHM_V + 2 * SHM_K + NW * 64 * 4;
#define KSWZ(row, colB) ((row) * 256 + ((colB) ^ (((row) & 7) << 4)))
#define SBAR() __builtin_amdgcn_sched_barrier(0)
__device__ __forceinline__ int crow(int r, int hi) { return (r & 3) + 8 * (r >> 2) + 4 * hi; }
__device__ __forceinline__ unsigned cvtpk(float lo, float hi) { return pg8::cvt_pk_bf16(lo, hi); }
__device__ __forceinline__ void partialSM(f32x16& p0, f32x16& p1, float& m_reg, float& mn, float& alpha) {
  float pmax = p0[0]; for (int r = 1; r < 16; ++r) pmax = fmaxf(pmax, p0[r]); for (int r = 0; r < 16; ++r) pmax = fmaxf(pmax, p1[r]);
  { auto rr = __builtin_amdgcn_permlane32_swap(__float_as_uint(pmax), __float_as_uint(pmax), false, false);
    pmax = fmaxf(__uint_as_float(rr[0]), __uint_as_float(rr[1])); }
  if (__builtin_expect(__all(pmax - m_reg <= THRL), 1)) { mn = m_reg; alpha = 1.f; }
  else { mn = fmaxf(m_reg, pmax); alpha = __builtin_amdgcn_exp2f(m_reg - mn); m_reg = mn; }
  for (int r = 0; r < 16; ++r) p0[r] = p0[r] - mn; for (int r = 0; r < 16; ++r) p1[r] = p1[r] - mn;
  for (int r = 0; r < 16; ++r) p0[r] = __builtin_amdgcn_exp2f(p0[r]);
}
__device__ __forceinline__ void finishSM(f32x16& p0, f32x16& p1, float alpha, float& l_reg, bf16x8& pa0, bf16x8& pa1, bf16x8& pa2, bf16x8& pa3) {
  for (int r = 0; r < 16; ++r) p1[r] = __builtin_amdgcn_exp2f(p1[r]);
  float ps = 0; for (int r = 0; r < 16; ++r) ps += p0[r]; for (int r = 0; r < 16; ++r) ps += p1[r];
  { auto rr = __builtin_amdgcn_permlane32_swap(__float_as_uint(ps), __float_as_uint(ps), false, false);
    ps = __uint_as_float(rr[0]) + __uint_as_float(rr[1]); }
  l_reg = l_reg * alpha + ps;
#define PK4(P, BASE, OUT) do { unsigned a0 = cvtpk(P[BASE + 0], P[BASE + 1]), a1 = cvtpk(P[BASE + 2], P[BASE + 3]);   \
    unsigned b0 = cvtpk(P[BASE + 4], P[BASE + 5]), b1 = cvtpk(P[BASE + 6], P[BASE + 7]);                              \
    auto r0 = __builtin_amdgcn_permlane32_swap(a0, b0, false, false); auto r1 = __builtin_amdgcn_permlane32_swap(a1, b1, false, false); \
    u32x4 w = {r0[0], r1[0], r0[1], r1[1]}; OUT = *reinterpret_cast<bf16x8*>(&w); } while (0)
  PK4(p0, 0, pa0); PK4(p0, 8, pa1); PK4(p1, 0, pa2); PK4(p1, 8, pa3);
#undef PK4
}
__device__ __forceinline__ void qkt(f32x16& p0, f32x16& p1, const char* Ks, const bf16x8* qr, int r32, int hi, int c) {
  p0 = f32x16{}; p1 = f32x16{};
  for (int d0 = 0; d0 < 4; ++d0) { int cb = (c * 64 + d0 * 16 + hi * 8) * 2;
    bf16x8 b0 = *reinterpret_cast<const bf16x8*>(Ks + KSWZ(r32, cb));
    bf16x8 b1 = *reinterpret_cast<const bf16x8*>(Ks + KSWZ(32 + r32, cb));
    p0 = __builtin_amdgcn_mfma_f32_32x32x16_bf16(b0, qr[d0], p0, 0, 0, 0);
    p1 = __builtin_amdgcn_mfma_f32_32x32x16_bf16(b1, qr[d0], p1, 0, 0, 0); }
}
__device__ __forceinline__ int v_st(int k, int c) { const int kk = (k & ~0xC) | ((k & 4) << 1) | ((k & 8) >> 1); return ((kk >> 3) * 4 + (c >> 5)) * 512 + ((kk & 7) * 32 + (c & 31)) * 2; }
__device__ __forceinline__ int v_rd_base(int lane) { return ((lane & 3) << 3) | (((lane >> 2) & 3) << 6) | (((lane >> 4) & 1) << 5) | (((lane >> 5) & 1) << 8); }
constexpr int v_rd_off(int d0, int ks, int half) { return d0 * 512 + ks * 4096 + half * 2048; }
template <int OFF> __device__ __forceinline__ s16x4 tr_read(int vb) {
  s16x4 r; asm volatile("ds_read_b64_tr_b16 %0, %1 offset:%2" : "=&v"(r) : "v"(vb), "i"(OFF) : "memory"); return r;
}
template <int D0> __device__ __forceinline__ void pv_one(f32x16& od, int vb, bf16x8 pa0, bf16x8 pa1, bf16x8 pa2, bf16x8 pa3) {
  const s16x4 l0 = tr_read<v_rd_off(D0, 0, 0)>(vb), h0 = tr_read<v_rd_off(D0, 0, 1)>(vb), l1 = tr_read<v_rd_off(D0, 1, 0)>(vb), h1 = tr_read<v_rd_off(D0, 1, 1)>(vb);
  const s16x4 l2 = tr_read<v_rd_off(D0, 2, 0)>(vb), h2 = tr_read<v_rd_off(D0, 2, 1)>(vb), l3 = tr_read<v_rd_off(D0, 3, 0)>(vb), h3 = tr_read<v_rd_off(D0, 3, 1)>(vb);
  asm volatile("s_waitcnt lgkmcnt(0)" ::: "memory"); SBAR();
#define PK(L, H) (bf16x8){L[0], L[1], L[2], L[3], H[0], H[1], H[2], H[3]}
  od = __builtin_amdgcn_mfma_f32_32x32x16_bf16(pa0, PK(l0, h0), od, 0, 0, 0);
  od = __builtin_amdgcn_mfma_f32_32x32x16_bf16(pa1, PK(l1, h1), od, 0, 0, 0);
  od = __builtin_amdgcn_mfma_f32_32x32x16_bf16(pa2, PK(l2, h2), od, 0, 0, 0);
  od = __builtin_amdgcn_mfma_f32_32x32x16_bf16(pa3, PK(l3, h3), od, 0, 0, 0);
#undef PK
}
__device__ __forceinline__ void pv_d0(f32x16* o, int vb, bf16x8 pa0, bf16x8 pa1, bf16x8 pa2, bf16x8 pa3) {
  pv_one<0>(o[0], vb, pa0, pa1, pa2, pa3); pv_one<1>(o[1], vb, pa0, pa1, pa2, pa3); pv_one<2>(o[2], vb, pa0, pa1, pa2, pa3); pv_one<3>(o[3], vb, pa0, pa1, pa2, pa3);
}
__device__ __forceinline__ void unit(const unsigned short* Qb, const unsigned short* Kh, const unsigned short* Vh, unsigned short* Ob, int seq, char* lds, float lam, float post, const float* gsub) {
  int tid_ = threadIdx.x; asm volatile("" : "+v"(tid_));
  const int tid = tid_, wid = tid >> 6, lane = tid & 63, r32 = lane & 31, hi = lane >> 5, c = wid >> 2, wq = wid & 3;
  char* V_lds = lds; char* K_lds = lds + 2 * SHM_V;
  float* ws = (float*)(lds + 2 * SHM_V + 2 * SHM_K) + wid * 64; float* li_l = ws; float* al_l = ws + 32;
  float m_reg = -1e30f, l_reg = 0; f32x16 o[4] = {}; bf16x8 qr[4];
  const unsigned short* Qw = Qb + (long)(wq * QBLK + r32) * LDK + c * 64 + hi * 8;
#pragma unroll
  for (int d0 = 0; d0 < 4; ++d0) qr[d0] = *reinterpret_cast<const bf16x8*>(Qw + d0 * 16);
  const int sr = tid >> 4, sc = (tid & 15) * 8, vst0 = v_st(sr, sc), vst1 = v_st(32 + sr, sc);
  const int vb0 = (int)(uintptr_t)V_lds + v_rd_base(lane);
  struct { bf16x8 vs0, vs1, ks0, ks1; } sr_[2];
#define SLOAD(i, k0) do { sr_[i].vs0 = *reinterpret_cast<const bf16x8*>(&Vh[(long)((k0) + sr) * LDK + sc]); sr_[i].vs1 = *reinterpret_cast<const bf16x8*>(&Vh[(long)((k0) + 32 + sr) * LDK + sc]); \
    sr_[i].ks0 = *reinterpret_cast<const bf16x8*>(&Kh[(long)((k0) + sr) * LDK + sc]); sr_[i].ks1 = *reinterpret_cast<const bf16x8*>(&Kh[(long)((k0) + 32 + sr) * LDK + sc]); } while (0)
#define SWRITE(b, i) do { *(bf16x8*)(V_lds + (b) * SHM_V + vst0) = sr_[i].vs0; *(bf16x8*)(V_lds + (b) * SHM_V + vst1) = sr_[i].vs1; int kc = sc * 2; \
    *(bf16x8*)(K_lds + (b) * SHM_K + KSWZ(sr, kc)) = sr_[i].ks0; *(bf16x8*)(K_lds + (b) * SHM_K + KSWZ(32 + sr, kc)) = sr_[i].ks1; } while (0)
#define SWAIT() asm volatile("s_waitcnt vmcnt(4)" ::: "memory")
#define RESC(a) do { if (__any((a) < 1.f)) { if (hi == 0) al_l[r32] = (a); asm volatile("s_waitcnt lgkmcnt(0)" ::: "memory"); \
    for (int d = 0; d < 4; ++d) for (int r = 0; r < 16; ++r) o[d][r] *= al_l[crow(r, hi)]; } } while (0)
  f32x16 pA0, pA1, pB0, pB1; float mnA, mnB, alA, alB; bf16x8 pa0, pa1, pa2, pa3; const int NT = seq / KVBLK;
  constexpr int SE = 0, SO = 1;
  SLOAD(SE, 0); asm volatile("s_waitcnt vmcnt(0)" ::: "memory"); SWRITE(0, SE); __syncthreads();
  qkt(pA0, pA1, K_lds, qr, r32, hi, c); partialSM(pA0, pA1, m_reg, mnA, alA);
  SLOAD(SO, KVBLK); if (2 < NT) SLOAD(SE, 2 * KVBLK);
  SWAIT(); SWRITE(1, SO); __syncthreads();
  for (int j = 1; j + 1 < NT; j += 2) {
    SBAR(); qkt(pB0, pB1, K_lds + SHM_K, qr, r32, hi, c);
    finishSM(pA0, pA1, alA, l_reg, pa0, pa1, pa2, pa3); SBAR();
    SLOAD(SO, (j + 2) * KVBLK); SBAR();
    pv_d0(o, vb0, pa0, pa1, pa2, pa3); partialSM(pB0, pB1, m_reg, mnB, alB);
    __syncthreads(); SWAIT(); SWRITE(0, SE);
    RESC(alB); __syncthreads();
    SBAR(); qkt(pA0, pA1, K_lds, qr, r32, hi, c);
    finishSM(pB0, pB1, alB, l_reg, pa0, pa1, pa2, pa3); SBAR();
    if (j + 3 < NT) SLOAD(SE, (j + 3) * KVBLK); SBAR();
    pv_d0(o, vb0 + (int)SHM_V, pa0, pa1, pa2, pa3); partialSM(pA0, pA1, m_reg, mnA, alA);
    __syncthreads(); SWAIT(); SWRITE(1, SO);
    RESC(alA); __syncthreads();
  }
  SBAR(); qkt(pB0, pB1, K_lds + SHM_K, qr, r32, hi, c);
  finishSM(pA0, pA1, alA, l_reg, pa0, pa1, pa2, pa3); SBAR();
  pv_d0(o, vb0, pa0, pa1, pa2, pa3); partialSM(pB0, pB1, m_reg, mnB, alB);
  __syncthreads(); RESC(alB);
  finishSM(pB0, pB1, alB, l_reg, pa0, pa1, pa2, pa3); SBAR();
  pv_d0(o, vb0 + (int)SHM_V, pa0, pa1, pa2, pa3);
  if (hi == 0) li_l[r32] = l_reg; asm volatile("s_waitcnt vmcnt(0) lgkmcnt(0)" ::: "memory");
  float rli[16];
#pragma unroll
  for (int r = 0; r < 16; ++r) rli[r] = __builtin_amdgcn_rcpf(li_l[crow(r, hi)]);
  __syncthreads();
  float* xch = (float*)lds + (size_t)wq * 64 * 64 + lane;
  if (c == 1) {
#pragma unroll
    for (int d0 = 0; d0 < 4; ++d0)
#pragma unroll
      for (int r = 0; r < 16; ++r) xch[(d0 * 16 + r) * 64] = o[d0][r] * rli[r] * lam;
  }
  __syncthreads();
  if (c == 0) {
    float ss[16];
#pragma unroll
    for (int r = 0; r < 16; ++r) { float a = 0.f;
#pragma unroll
      for (int d0 = 0; d0 < 4; ++d0) { const float d = o[d0][r] * rli[r] - xch[(d0 * 16 + r) * 64]; o[d0][r] = d; a += d * d; }
      ss[r] = a; }
#pragma unroll
    for (int r = 0; r < 16; ++r) {
#pragma unroll
      for (int off = 1; off < 32; off <<= 1) ss[r] += __shfl_xor(ss[r], off);
      ss[r] = post / sqrtf(ss[r] * (1.f / 128.f) + 1e-6f); }
    float gs[4];
#pragma unroll
    for (int d0 = 0; d0 < 4; ++d0) gs[d0] = gsub[32 * d0 + r32];
    unsigned short* Ow = Ob + (long)(wq * QBLK) * LDK;
#pragma unroll
    for (int r = 0; r < 16; ++r) { const int orow = crow(r, hi);
#pragma unroll
      for (int d0 = 0; d0 < 4; ++d0) Ow[(long)orow * LDK + d0 * 32 + r32] = (unsigned short)f2bf(o[d0][r] * ss[r] * gs[d0]); }
  }
  __syncthreads();
#undef SLOAD
#undef SWRITE
#undef SWAIT
#undef RESC
}
#undef KSWZ
#undef SBAR
}

__device__ __forceinline__ void attn_mfma_phase(Frame& F, int layer) {
    const float lam = wsp<float>(F, WS_SCAL)[layer]; const float lam_init = 0.8f - 0.6f * expf(-0.3f * (float)layer), post = 1.f - lam_init;
    const float* gsub = inp(I_GSUB) + layer * VD;
    const bf16* Q = wsp<bf16>(F, WS_Q); const bf16* Kb = wsp<bf16>(F, WS_K); const bf16* Vb = wsp<bf16>(F, WS_V); bf16* OB = wsp<bf16>(F, WS_OB);
    for (int u = blockIdx.x; u < BATCH * NH * (SEQ / 128); u += F.G) {
        const int b = u >> 6, h = (u >> 4) & 3, qb = u & 15;
        const size_t rb = (size_t)b * SEQ;
        dattn::unit(Q + (rb + qb * 128) * AQK + h * 128, Kb + rb * AQK + h * 128, Vb + rb * AV + h * 128, OB + (rb + qb * 128) * AV + h * 128, SEQ, (char*)F.lds, lam, post, gsub);
    }
}

constexpr int NSTEP = 11, NPH = 1 + DEPTH * NSTEP;
struct Args { const float* in[N_IN]; float* out; unsigned char* ws; int ph_lo, ph_hi, pass, pad; };
#ifndef DBG_SITES
#define DBG_SITES 0xFF
#endif
#define GEMM_SITE(ID, EpiT, g, S, E) do { if (!((DBG_SITES >> (ID)) & 1)) {} else if ((MK_NAIVE_GEMM >> (ID)) & 1) pg8::gemm_phase_naive<EpiT, pg8::GroupOrder>(g, S, E); \
    else pg8::gemm_phase<EpiT, pg8::GroupOrder, MK_ALIGN, MK_SP2>(F.lds + RING_OFF, g, S, E); } while (0)

__global__ void __launch_bounds__(NWAVES * 64, 2) mk_fwd(Args args) {
    extern __shared__ __attribute__((aligned(16))) unsigned char lds[];
    Frame F;
    F.lds = (LAS unsigned char*)lds;
    F.MISC = (volatile LAS unsigned*)(F.lds + MISC_OFF);
    F.tid = threadIdx.x; F.lane = F.tid & 63; F.wave = __builtin_amdgcn_readfirstlane(F.tid >> 6);
    F.G = gridDim.x; F.ws = (GAS unsigned char*)args.ws; F.ctl = (gu32*)(F.ws + WS_CTL);
    for (int u = F.tid; u < (LDS_BYTES - LDSCTL_OFF) / 4; u += NWAVES * 64) ((LAS unsigned*)(F.lds + LDSCTL_OFF))[u] = 0u;
    __syncthreads();
    const int lo = args.ph_lo, hi = args.ph_hi;
#ifdef DBG_START_DELAY
    if (lo == 0) { const unsigned long long t0 = __builtin_amdgcn_s_memrealtime(); while (__builtin_amdgcn_s_memrealtime() - t0 < (unsigned long long)DBG_START_DELAY) __builtin_amdgcn_s_sleep(32); }
#endif
    XcdBarrier bar; bar.bar = (unsigned*)(F.ctl + CW_BAR); bar.x = 0; bar.st = nullptr;
    if (hi - lo > 1) bar = xcd_barrier_post((unsigned*)(F.ctl + CW_BAR), F.MISC + 8);
#define PHASE_BEGIN() do { const CAS unsigned char* k_ = (const CAS unsigned char*)__builtin_amdgcn_kernarg_segment_ptr(); asm volatile("" : "+s"(k_)); \
    F.ws = *(GAS unsigned char* const CAS*)(k_ + 8 * (N_IN + 1)); F.ctl = (gu32*)(F.ws + WS_CTL); int t_ = threadIdx.x; asm volatile("" : "+v"(t_)); \
    F.tid = t_; F.lane = t_ & 63; F.wave = __builtin_amdgcn_readfirstlane(t_ >> 6); F.G = gridDim.x; } while (0)
#define IN(k) (lo <= (k) && (k) < hi)
#define SEAM(k) do { if (IN(k) && IN((k) + 1)) xcd_barrier(bar); } while (0)
#define H wsp<bf16>(F, WS_H)
#define X wsp<float>(F, WS_X)

#ifdef DBG_STOP
    if (lo == 100) {
        PHASE_BEGIN();
        float* o = outp(); const size_t gt = (size_t)blockIdx.x * (NWAVES * 64) + F.tid, NGT = (size_t)F.G * NWAVES * 64;
        for (size_t i = gt; i < (size_t)T * D; i += NGT) { float v = 0.f;
#define DG_BF(off, len) v += bf_lo((unsigned)wsp<bf16>(F, off)[i % (size_t)(len)]);
#define DG_F32(off, len) v += wsp<float>(F, off)[i % (size_t)(len)];
            DBG_DIGEST
            o[i] = v; }
        return;
    }
#endif
#ifdef DBG_TWOPASS
#define CW_CK 2048
#define CK(slot, off, bytes) cksum(F, off, bytes, CW_CK + dbg_pass * 64 + (slot))
#define CKBAR() xcd_barrier(bar)
    const int dbg_pass = args.pass;
#else
#define CK(slot, off, bytes) do {} while (0)
#define CKBAR() do {} while (0)
#endif
    if (IN(0)) { PHASE_BEGIN(); p0_prologue(F); }
    SEAM(0);
#ifdef DBG_TWOPASS
    { PHASE_BEGIN(); CK(0, WS_WIN, WS_X - WS_WIN); CK(0, WS_H, (size_t)T * D * 2); CK(0, WS_PB, (size_t)2 * T * PLE * 2); CK(0, WS_ROPE, (size_t)SEQ * 64 * 4); CKBAR(); }
#endif

    {
        constexpr int layer = 0;

        const int pb = 1 + layer * NSTEP;
#ifdef DBG_SKIP_MOE
        const bool moe = false; const bool skipffn = (layer & 1) != 0;
#elif defined(DBG_SKIP_DENSE)
        const bool moe = (layer & 1) != 0; const bool skipffn = (layer & 1) == 0;
#else
        const bool moe = (layer & 1) != 0; const bool skipffn = false;
#endif
        if (IN(pb + 0)) { PHASE_BEGIN();
            if (layer == 0) {
                pg8::Gemm g{wsp<bf16>(F, WS_PB), wsp<bf16>(F, WS_WPP), 2 * T, D, PLE}; pg8::GroupOrder S; S.init_equal(2, T, D, F.G, (int)blockIdx.x, (LAS int*)(F.lds + TP_OFF));
                pg8::EpiStore E{wsp<bf16>(F, WS_PROJ), D, D / 256};
                GEMM_SITE(0, pg8::EpiStore, g, S, E);
            }
            pg8::Gemm g{H, wsp<bf16>(F, WS_WIN) + (size_t)layer * INC * D / (MK_I8_INPROJ ? 2 : 1), T, INC, MK_I8_INPROJ ? D / 2 : D}; pg8::GroupOrder S; S.init_dense(T, INC, F.G, (int)blockIdx.x);
            pg8::EpiInProj E{wsp<bf16>(F, WS_Q), wsp<bf16>(F, WS_K), wsp<bf16>(F, WS_V), wsp<bf16>(F, WS_Z), wsp<bf16>(F, WS_SG), wsp<float>(F, WS_ROPE), QSCALE, MK_I8_INPROJ ? (const float*)wsp<float>(F, WS_RS) : nullptr, W8_INV};
            pg8::gemm_phase<pg8::EpiInProj, pg8::GroupOrder, MK_ALIGN, MK_SP2, (MK_I8_INPROJ != 0)>(F.lds + RING_OFF, g, S, E);
        }
        SEAM(pb + 0);
#ifdef DBG_TWOPASS
        { PHASE_BEGIN(); CK(pb + 0, WS_Q, 128 * MiB); if (layer == 0) CK(pb + 0, WS_PROJ, (size_t)2 * T * D * 2); if (layer == 1) { CK(32, WS_Q, 16 * MiB); CK(33, WS_K, 16 * MiB); CK(34, WS_V, 16 * MiB); CK(35, WS_Z, 16 * MiB); CK(36, WS_SG, 64 * MiB); } CKBAR(); }
#endif
        if (IN(pb + 1)) { PHASE_BEGIN();
#ifdef DBG_CHECK_INPROJ
            if (layer == DBG_LAYER) check_inproj(F, layer);
#endif
#if !defined(DBG_NO_ATTN) && MK_NAIVE_ATTN
            attn_naive_phase(F, layer);
#elif !defined(DBG_NO_ATTN)
            for (int rep_ = 0; rep_ < DBG_REP_ATTN; ++rep_) attn_mfma_phase(F, layer);
#else
            { bf16* ob = wsp<bf16>(F, WS_OB); const size_t gt = (size_t)blockIdx.x * (NWAVES * 64) + F.tid, NGT = (size_t)F.G * NWAVES * 64;
              for (size_t i = gt; i < (size_t)T * AV / 8; i += NGT) *(v4u*)(ob + i * 8) = (v4u){0u, 0u, 0u, 0u}; }
#endif
#if defined(DBG_NAIVE_CONV)
            conv_naive_phase(F, layer);
#elif !defined(DBG_NO_CONV)
            conv_phase(F, layer);
#else
            { bf16* ob = wsp<bf16>(F, WS_ZC); const size_t gt = (size_t)blockIdx.x * (NWAVES * 64) + F.tid, NGT = (size_t)F.G * NWAVES * 64;
              for (size_t i = gt; i < (size_t)T * CCH / 8; i += NGT) *(v4u*)(ob + i * 8) = (v4u){0u, 0u, 0u, 0u}; }
#endif
        }
        SEAM(pb + 1);
#ifdef DBG_CHECK_ATTN
        if (layer == DBG_CHECK_ATTN - 1) { PHASE_BEGIN(); check_attn(F, layer); xcd_barrier(bar); }
#endif
#ifdef DBG_TWOPASS
        { PHASE_BEGIN(); CK(pb + 1, WS_OB, 32 * MiB); CKBAR(); }
#endif
        if (IN(pb + 2)) { PHASE_BEGIN();
            { pg8::Gemm g{wsp<bf16>(F, WS_OB), wsp<bf16>(F, WS_WA) + (size_t)layer * D * AV, T, D, AV}; pg8::GroupOrder S; S.init_dense(T, D, F.G, (int)blockIdx.x);
              pg8::EpiGate<0> E{wsp<float>(F, WS_P), wsp<bf16>(F, WS_MIX), wsp<bf16>(F, WS_SG)};
              GEMM_SITE(2, pg8::EpiGate<0>, g, S, E); }
            { pg8::Gemm g{wsp<bf16>(F, WS_ZC), wsp<bf16>(F, WS_WC) + (size_t)layer * D * CCH, T, D, CCH}; pg8::GroupOrder S; S.init_dense(T, D, F.G, (int)blockIdx.x);
              pg8::EpiGate<1> E{wsp<float>(F, WS_P), wsp<bf16>(F, WS_MIX), wsp<bf16>(F, WS_SG)};
              GEMM_SITE(3, pg8::EpiGate<1>, g, S, E); }
        }
        SEAM(pb + 2);
#ifdef DBG_CHECK_MIX
        if (layer == DBG_LAYER) { PHASE_BEGIN(); check_mix(F, layer); snap_wo(F); xcd_barrier(bar); }
#endif
#ifdef DBG_TWOPASS
        { PHASE_BEGIN(); CK(pb + 2, WS_P, 96 * MiB); CKBAR(); }
#endif
        if (IN(pb + 3)) { PHASE_BEGIN();
            pg8::Gemm g{wsp<bf16>(F, WS_MIX), wsp<bf16>(F, WS_WO) + (size_t)layer * D * D, T, D, D}; pg8::GroupOrder S; S.init_dense(T, D, F.G, (int)blockIdx.x);
            pg8::EpiResid E{layer == 0 ? inp(I_X) : (const float*)X, X, D / 256};
            GEMM_SITE(4, pg8::EpiResid, g, S, E);
        }
        SEAM(pb + 3);
#ifdef DBG_CHECK_MIX
        if (layer == DBG_LAYER) { PHASE_BEGIN(); check_wo(F, layer); xcd_barrier(bar); }
#endif
#ifdef DBG_TWOPASS
        { PHASE_BEGIN(); CK(pb + 3, WS_X, (size_t)T * D * 4); CKBAR(); }
#endif
        if (IN(pb + 4)) { PHASE_BEGIN();
            if (moe) route_phase(F, X, inp(I_GFFN) + (size_t)layer * D, H);
            else norm_rows(F, X, inp(I_GFFN) + (size_t)layer * D, H, MK_FP8_GU != 0);
        }
        SEAM(pb + 4);
#ifdef DBG_CHECK_MOE
        if (moe) { PHASE_BEGIN(); check_route(F); xcd_barrier(bar); }
#endif
#ifdef DBG_TWOPASS
        { PHASE_BEGIN(); CK(pb + 4, WS_H, (size_t)T * D * 2); if (moe) CK(pb + 4, WS_RTW, (size_t)T * 8); CKBAR(); }
#endif
        if (moe) {
            if (IN(pb + 5)) { PHASE_BEGIN(); scatter_phase(F); }
            SEAM(pb + 5);
        }
        if (IN(pb + 6) && !skipffn) { PHASE_BEGIN();
            pg8::Gemm g; pg8::GroupOrder S; pg8::EpiSwiGLU E;
            constexpr int KG = MK_FP8_GU ? D / 2 : D;
            if (moe) { unsigned cnt[8]; load_counts(F, cnt); g = pg8::Gemm{wsp<bf16>(F, WS_HP), wsp<bf16>(F, WS_WEGU), MOE_ROWS, 2 * FE, KG}; S.init_counts(cnt, 2 * FE, F.G, (int)blockIdx.x, (LAS int*)(F.lds + TP_OFF)); E = pg8::EpiSwiGLU{wsp<bf16>(F, WS_ACT), FE, 2 * FE / 256, MK_FP8_GU ? (const float*)wsp<float>(F, WS_RSP) : nullptr, W8_INV}; }
            else { g = pg8::Gemm{H, wsp<bf16>(F, WS_WFGU), T, 2 * FF, KG}; S.init_dense(T, 2 * FF, F.G, (int)blockIdx.x); E = pg8::EpiSwiGLU{wsp<bf16>(F, WS_ACT), FF, 2 * FF / 256, MK_FP8_GU ? (const float*)wsp<float>(F, WS_RS) : nullptr, W8_INV}; }
            for (int rep_ = 0; rep_ < DBG_REP_GU; ++rep_) { pg8::gemm_phase<pg8::EpiSwiGLU, pg8::GroupOrder, MK_FP8_GU ? MK_ALIGN_GU : MK_ALIGN, MK_FP8_GU ? MK_SP2_GU : MK_SP2, (MK_FP8_GU != 0)>(F.lds + RING_OFF, g, S, E); }
        }
        SEAM(pb + 6);
#ifdef DBG_CHECK_FFN
        if (layer == 0) { PHASE_BEGIN(); snap_x(F, 0, 2); xcd_barrier(bar); }
#endif
#ifdef DBG_CHECK_ACT
        if (layer == 0) { PHASE_BEGIN(); check_act(F); xcd_barrier(bar); }
#endif
#ifdef DBG_TWOPASS
        { PHASE_BEGIN(); if (!moe) CK(pb + 6, WS_ACT, (size_t)T * FF * 2); CKBAR(); }
#endif
        if (IN(pb + 7) && !skipffn) { PHASE_BEGIN();
            pg8::Gemm g; pg8::GroupOrder S; pg8::EpiResid E;
            if (moe) { unsigned cnt[8]; load_counts(F, cnt); g = pg8::Gemm{wsp<bf16>(F, WS_ACT), wsp<bf16>(F, WS_WEDN), MOE_ROWS, D, FE}; S.init_counts(cnt, D, F.G, (int)blockIdx.x, (LAS int*)(F.lds + TP_OFF)); E = pg8::EpiResid{nullptr, wsp<float>(F, WS_Y), D / 256}; }
            else { g = pg8::Gemm{wsp<bf16>(F, WS_ACT), wsp<bf16>(F, WS_WFDN), T, D, FF}; S.init_dense(T, D, F.G, (int)blockIdx.x); E = pg8::EpiResid{X, X, D / 256}; }
            GEMM_SITE(6, pg8::EpiResid, g, S, E);
        }
        SEAM(pb + 7);
#ifdef DBG_CHECK_MOE
        if (moe) { PHASE_BEGIN(); check_experts(F); xcd_barrier(bar); }
#endif
#ifdef DBG_CHECK_FFN
        if (layer == 0) { PHASE_BEGIN(); check_down(F); xcd_barrier(bar); }
#endif
#ifdef DBG_TWOPASS
        { PHASE_BEGIN(); if (!moe) CK(pb + 7, WS_X, (size_t)T * D * 4); CKBAR(); }
#endif
        if (IN(pb + 8)) { PHASE_BEGIN();
            if (moe) combine_norm_phase(F, X, inp(I_GPLE) + (size_t)layer * D, H);
            else norm_rows(F, X, inp(I_GPLE) + (size_t)layer * D, H);
        }
        SEAM(pb + 8);
#ifdef DBG_CHECK_MOE
        if (moe) { PHASE_BEGIN(); check_combine(F); xcd_barrier(bar); }
#endif
#ifdef DBG_CHECK_FFN
        if (layer == DBG_LAYER) { PHASE_BEGIN(); check_norm3(F, layer); snap_x(F, 1, 4); xcd_barrier(bar); }
#endif
#ifdef DBG_TWOPASS
        { PHASE_BEGIN(); CK(pb + 8, WS_X, (size_t)T * D * 4); CK(pb + 8, WS_H, (size_t)T * D * 2); CKBAR(); }
#endif
#ifdef DBG_SKIP_PLE
        if (false) {
#else
        if (IN(pb + 9)) { PHASE_BEGIN();
#endif
            pg8::Gemm g{H, wsp<bf16>(F, WS_WPG) + (size_t)layer * D * D, T, D, D}; pg8::GroupOrder S; S.init_dense(T, D, F.G, (int)blockIdx.x);
            pg8::EpiPleGate E{X, wsp<bf16>(F, WS_PROJ) + (size_t)layer * T * D};
            GEMM_SITE(7, pg8::EpiPleGate, g, S, E);
        }
        SEAM(pb + 9);
#ifdef DBG_CHECK_FFN
        if (layer == DBG_LAYER) { PHASE_BEGIN(); check_ple(F, layer); xcd_barrier(bar); }
#endif
#ifdef DBG_TWOPASS
        { PHASE_BEGIN(); CK(pb + 9, WS_X, (size_t)T * D * 4); CKBAR(); }
#endif
        if (IN(pb + 10)) { PHASE_BEGIN();
            if (layer + 1 < DEPTH) norm_rows(F, X, inp(I_GMIX) + (size_t)(layer + 1) * D, H, MK_I8_INPROJ != 0);
            else final_norm(F, X, inp(I_GFIN), outp());
        }
        if (layer + 1 < DEPTH) SEAM(pb + 10);
#ifdef DBG_TWOPASS
        if (layer + 1 < DEPTH) { PHASE_BEGIN(); CK(pb + 10, WS_H, (size_t)T * D * 2); CKBAR(); }
        else { xcd_barrier(bar); PHASE_BEGIN(); cksum_ptr(F, (const v4u*)outp(), (size_t)T * D * 4, CW_CK + dbg_pass * 64 + pb + 10); CKBAR(); }
#endif
    }
    {
        constexpr int layer = 1;

        const int pb = 1 + layer * NSTEP;
#ifdef DBG_SKIP_MOE
        const bool moe = false; const bool skipffn = (layer & 1) != 0;
#elif defined(DBG_SKIP_DENSE)
        const bool moe = (layer & 1) != 0; const bool skipffn = (layer & 1) == 0;
#else
        const bool moe = (layer & 1) != 0; const bool skipffn = false;
#endif
        if (IN(pb + 0)) { PHASE_BEGIN();
            if (layer == 0) {
                pg8::Gemm g{wsp<bf16>(F, WS_PB), wsp<bf16>(F, WS_WPP), 2 * T, D, PLE}; pg8::GroupOrder S; S.init_equal(2, T, D, F.G, (int)blockIdx.x, (LAS int*)(F.lds + TP_OFF));
                pg8::EpiStore E{wsp<bf16>(F, WS_PROJ), D, D / 256};
                GEMM_SITE(0, pg8::EpiStore, g, S, E);
            }
            pg8::Gemm g{H, wsp<bf16>(F, WS_WIN) + (size_t)layer * INC * D / (MK_I8_INPROJ ? 2 : 1), T, INC, MK_I8_INPROJ ? D / 2 : D}; pg8::GroupOrder S; S.init_dense(T, INC, F.G, (int)blockIdx.x);
            pg8::EpiInProj E{wsp<bf16>(F, WS_Q), wsp<bf16>(F, WS_K), wsp<bf16>(F, WS_V), wsp<bf16>(F, WS_Z), wsp<bf16>(F, WS_SG), wsp<float>(F, WS_ROPE), QSCALE, MK_I8_INPROJ ? (const float*)wsp<float>(F, WS_RS) : nullptr, W8_INV};
            pg8::gemm_phase<pg8::EpiInProj, pg8::GroupOrder, MK_ALIGN, MK_SP2, (MK_I8_INPROJ != 0)>(F.lds + RING_OFF, g, S, E);
        }
        SEAM(pb + 0);
#ifdef DBG_TWOPASS
        { PHASE_BEGIN(); CK(pb + 0, WS_Q, 128 * MiB); if (layer == 0) CK(pb + 0, WS_PROJ, (size_t)2 * T * D * 2); if (layer == 1) { CK(32, WS_Q, 16 * MiB); CK(33, WS_K, 16 * MiB); CK(34, WS_V, 16 * MiB); CK(35, WS_Z, 16 * MiB); CK(36, WS_SG, 64 * MiB); } CKBAR(); }
#endif
        if (IN(pb + 1)) { PHASE_BEGIN();
#ifdef DBG_CHECK_INPROJ
            if (layer == DBG_LAYER) check_inproj(F, layer);
#endif
#if !defined(DBG_NO_ATTN) && MK_NAIVE_ATTN
            attn_naive_phase(F, layer);
#elif !defined(DBG_NO_ATTN)
            for (int rep_ = 0; rep_ < DBG_REP_ATTN; ++rep_) attn_mfma_phase(F, layer);
#else
            { bf16* ob = wsp<bf16>(F, WS_OB); const size_t gt = (size_t)blockIdx.x * (NWAVES * 64) + F.tid, NGT = (size_t)F.G * NWAVES * 64;
              for (size_t i = gt; i < (size_t)T * AV / 8; i += NGT) *(v4u*)(ob + i * 8) = (v4u){0u, 0u, 0u, 0u}; }
#endif
#if defined(DBG_NAIVE_CONV)
            conv_naive_phase(F, layer);
#elif !defined(DBG_NO_CONV)
            conv_phase(F, layer);
#else
            { bf16* ob = wsp<bf16>(F, WS_ZC); const size_t gt = (size_t)blockIdx.x * (NWAVES * 64) + F.tid, NGT = (size_t)F.G * NWAVES * 64;
              for (size_t i = gt; i < (size_t)T * CCH / 8; i += NGT) *(v4u*)(ob + i * 8) = (v4u){0u, 0u, 0u, 0u}; }
#endif
        }
        SEAM(pb + 1);
#ifdef DBG_CHECK_ATTN
        if (layer == DBG_CHECK_ATTN - 1) { PHASE_BEGIN(); check_attn(F, layer); xcd_barrier(bar); }
#endif
#ifdef DBG_TWOPASS
        { PHASE_BEGIN(); CK(pb + 1, WS_OB, 32 * MiB); CKBAR(); }
#endif
        if (IN(pb + 2)) { PHASE_BEGIN();
            { pg8::Gemm g{wsp<bf16>(F, WS_OB), wsp<bf16>(F, WS_WA) + (size_t)layer * D * AV, T, D, AV}; pg8::GroupOrder S; S.init_dense(T, D, F.G, (int)blockIdx.x);
              pg8::EpiGate<0> E{wsp<float>(F, WS_P), wsp<bf16>(F, WS_MIX), wsp<bf16>(F, WS_SG)};
              GEMM_SITE(2, pg8::EpiGate<0>, g, S, E); }
            { pg8::Gemm g{wsp<bf16>(F, WS_ZC), wsp<bf16>(F, WS_WC) + (size_t)layer * D * CCH, T, D, CCH}; pg8::GroupOrder S; S.init_dense(T, D, F.G, (int)blockIdx.x);
              pg8::EpiGate<1> E{wsp<float>(F, WS_P), wsp<bf16>(F, WS_MIX), wsp<bf16>(F, WS_SG)};
              GEMM_SITE(3, pg8::EpiGate<1>, g, S, E); }
        }
        SEAM(pb + 2);
#ifdef DBG_CHECK_MIX
        if (layer == DBG_LAYER) { PHASE_BEGIN(); check_mix(F, layer); snap_wo(F); xcd_barrier(bar); }
#endif
#ifdef DBG_TWOPASS
        { PHASE_BEGIN(); CK(pb + 2, WS_P, 96 * MiB); CKBAR(); }
#endif
        if (IN(pb + 3)) { PHASE_BEGIN();
            pg8::Gemm g{wsp<bf16>(F, WS_MIX), wsp<bf16>(F, WS_WO) + (size_t)layer * D * D, T, D, D}; pg8::GroupOrder S; S.init_dense(T, D, F.G, (int)blockIdx.x);
            pg8::EpiResid E{layer == 0 ? inp(I_X) : (const float*)X, X, D / 256};
            GEMM_SITE(4, pg8::EpiResid, g, S, E);
        }
        SEAM(pb + 3);
#ifdef DBG_CHECK_MIX
        if (layer == DBG_LAYER) { PHASE_BEGIN(); check_wo(F, layer); xcd_barrier(bar); }
#endif
#ifdef DBG_TWOPASS
        { PHASE_BEGIN(); CK(pb + 3, WS_X, (size_t)T * D * 4); CKBAR(); }
#endif
        if (IN(pb + 4)) { PHASE_BEGIN();
            if (moe) route_phase(F, X, inp(I_GFFN) + (size_t)layer * D, H);
            else norm_rows(F, X, inp(I_GFFN) + (size_t)layer * D, H, MK_FP8_GU != 0);
        }
        SEAM(pb + 4);
#ifdef DBG_CHECK_MOE
        if (moe) { PHASE_BEGIN(); check_route(F); xcd_barrier(bar); }
#endif
#ifdef DBG_TWOPASS
        { PHASE_BEGIN(); CK(pb + 4, WS_H, (size_t)T * D * 2); if (moe) CK(pb + 4, WS_RTW, (size_t)T * 8); CKBAR(); }
#endif
        if (moe) {
            if (IN(pb + 5)) { PHASE_BEGIN(); scatter_phase(F); }
            SEAM(pb + 5);
        }
        if (IN(pb + 6) && !skipffn) { PHASE_BEGIN();
            pg8::Gemm g; pg8::GroupOrder S; pg8::EpiSwiGLU E;
            constexpr int KG = MK_FP8_GU ? D / 2 : D;
            if (moe) { unsigned cnt[8]; load_counts(F, cnt); g = pg8::Gemm{wsp<bf16>(F, WS_HP), wsp<bf16>(F, WS_WEGU), MOE_ROWS, 2 * FE, KG}; S.init_counts(cnt, 2 * FE, F.G, (int)blockIdx.x, (LAS int*)(F.lds + TP_OFF)); E = pg8::EpiSwiGLU{wsp<bf16>(F, WS_ACT), FE, 2 * FE / 256, MK_FP8_GU ? (const float*)wsp<float>(F, WS_RSP) : nullptr, W8_INV}; }
            else { g = pg8::Gemm{H, wsp<bf16>(F, WS_WFGU), T, 2 * FF, KG}; S.init_dense(T, 2 * FF, F.G, (int)blockIdx.x); E = pg8::EpiSwiGLU{wsp<bf16>(F, WS_ACT), FF, 2 * FF / 256, MK_FP8_GU ? (const float*)wsp<float>(F, WS_RS) : nullptr, W8_INV}; }
            for (int rep_ = 0; rep_ < DBG_REP_GU; ++rep_) { pg8::gemm_phase<pg8::EpiSwiGLU, pg8::GroupOrder, MK_FP8_GU ? MK_ALIGN_GU : MK_ALIGN, MK_FP8_GU ? MK_SP2_GU : MK_SP2, (MK_FP8_GU != 0)>(F.lds + RING_OFF, g, S, E); }
        }
        SEAM(pb + 6);
#ifdef DBG_CHECK_FFN
        if (layer == 0) { PHASE_BEGIN(); snap_x(F, 0, 2); xcd_barrier(bar); }
#endif
#ifdef DBG_CHECK_ACT
        if (layer == 0) { PHASE_BEGIN(); check_act(F); xcd_barrier(bar); }
#endif
#ifdef DBG_TWOPASS
        { PHASE_BEGIN(); if (!moe) CK(pb + 6, WS_ACT, (size_t)T * FF * 2); CKBAR(); }
#endif
        if (IN(pb + 7) && !skipffn) { PHASE_BEGIN();
            pg8::Gemm g; pg8::GroupOrder S; pg8::EpiResid E;
            if (moe) { unsigned cnt[8]; load_counts(F, cnt); g = pg8::Gemm{wsp<bf16>(F, WS_ACT), wsp<bf16>(F, WS_WEDN), MOE_ROWS, D, FE}; S.init_counts(cnt, D, F.G, (int)blockIdx.x, (LAS int*)(F.lds + TP_OFF)); E = pg8::EpiResid{nullptr, wsp<float>(F, WS_Y), D / 256}; }
            else { g = pg8::Gemm{wsp<bf16>(F, WS_ACT), wsp<bf16>(F, WS_WFDN), T, D, FF}; S.init_dense(T, D, F.G, (int)blockIdx.x); E = pg8::EpiResid{X, X, D / 256}; }
            GEMM_SITE(6, pg8::EpiResid, g, S, E);
        }
        SEAM(pb + 7);
#ifdef DBG_CHECK_MOE
        if (moe) { PHASE_BEGIN(); check_experts(F); xcd_barrier(bar); }
#endif
#ifdef DBG_CHECK_FFN
        if (layer == 0) { PHASE_BEGIN(); check_down(F); xcd_barrier(bar); }
#endif
#ifdef DBG_TWOPASS
        { PHASE_BEGIN(); if (!moe) CK(pb + 7, WS_X, (size_t)T * D * 4); CKBAR(); }
#endif
        if (IN(pb + 8)) { PHASE_BEGIN();
            if (moe) combine_norm_phase(F, X, inp(I_GPLE) + (size_t)layer * D, H);
            else norm_rows(F, X, inp(I_GPLE) + (size_t)layer * D, H);
        }
        SEAM(pb + 8);
#ifdef DBG_CHECK_MOE
        if (moe) { PHASE_BEGIN(); check_combine(F); xcd_barrier(bar); }
#endif
#ifdef DBG_CHECK_FFN
        if (layer == DBG_LAYER) { PHASE_BEGIN(); check_norm3(F, layer); snap_x(F, 1, 4); xcd_barrier(bar); }
#endif
#ifdef DBG_TWOPASS
        { PHASE_BEGIN(); CK(pb + 8, WS_X, (size_t)T * D * 4); CK(pb + 8, WS_H, (size_t)T * D * 2); CKBAR(); }
#endif
#ifdef DBG_SKIP_PLE
        if (false) {
#else
        if (IN(pb + 9)) { PHASE_BEGIN();
#endif
            pg8::Gemm g{H, wsp<bf16>(F, WS_WPG) + (size_t)layer * D * D, T, D, D}; pg8::GroupOrder S; S.init_dense(T, D, F.G, (int)blockIdx.x);
            pg8::EpiPleGate E{X, wsp<bf16>(F, WS_PROJ) + (size_t)layer * T * D};
            GEMM_SITE(7, pg8::EpiPleGate, g, S, E);
        }
        SEAM(pb + 9);
#ifdef DBG_CHECK_FFN
        if (layer == DBG_LAYER) { PHASE_BEGIN(); check_ple(F, layer); xcd_barrier(bar); }
#endif
#ifdef DBG_TWOPASS
        { PHASE_BEGIN(); CK(pb + 9, WS_X, (size_t)T * D * 4); CKBAR(); }
#endif
        if (IN(pb + 10)) { PHASE_BEGIN();
            if (layer + 1 < DEPTH) norm_rows(F, X, inp(I_GMIX) + (size_t)(layer + 1) * D, H, MK_I8_INPROJ != 0);
            else final_norm(F, X, inp(I_GFIN), outp());
        }
        if (layer + 1 < DEPTH) SEAM(pb + 10);
#ifdef DBG_TWOPASS
        if (layer + 1 < DEPTH) { PHASE_BEGIN(); CK(pb + 10, WS_H, (size_t)T * D * 2); CKBAR(); }
        else { xcd_barrier(bar); PHASE_BEGIN(); cksum_ptr(F, (const v4u*)outp(), (size_t)T * D * 4, CW_CK + dbg_pass * 64 + pb + 10); CKBAR(); }
#endif
    }
#ifdef DBG_TWOPASS
    if (dbg_pass == 1) { PHASE_BEGIN();
      if (blockIdx.x == 0 && F.tid == 0) { unsigned idx = 0u;
          for (int k = NPH - 1; k >= 0; --k) if (__hip_atomic_load((unsigned*)(F.ctl + CW_CK + k), RLX_AGENT) != __hip_atomic_load((unsigned*)(F.ctl + CW_CK + 64 + k), RLX_AGENT)) idx = (unsigned)(k + 1);
          unsigned idx2 = 0u; for (int k = 36; k >= 32; --k) if (__hip_atomic_load((unsigned*)(F.ctl + CW_CK + k), RLX_AGENT) != __hip_atomic_load((unsigned*)(F.ctl + CW_CK + 64 + k), RLX_AGENT)) idx2 = (unsigned)(k - 31);
          __hip_atomic_store((unsigned*)(F.ctl + 16), idx + 32u * idx2, RLX_AGENT); }
      xcd_barrier(bar); }
#endif
#ifdef DBG_CODE_OUT
    if (args.pass == 1 || !DBG_TWOPASS_ON) { xcd_barrier(bar); PHASE_BEGIN(); final_norm(F, inp(I_X), inp(I_GFIN), outp(), 1.f + (float)__hip_atomic_load((unsigned*)(F.ctl + 16), RLX_AGENT) + (float)((__hip_atomic_load((unsigned*)(F.ctl + 17), RLX_AGENT) + 63u) / 64u)); }
#endif
#undef IN
#undef SEAM
#undef H
#undef X
}

extern "C" void kernel_launch(void* const* d_in, const int* in_sizes, int n_in, void* d_out, int out_size, void* d_ws, size_t ws_size, hipStream_t stream) {
    static int grid = 0;
    if (grid == 0) {
        if (n_in != N_IN || in_sizes[0] != T * D || out_size != T * D || ws_size < WS_END) {
            fprintf(stderr, "kernel_launch: built for %d inputs, x/out of %d floats, >= %zu bytes of workspace; got n_in %d, in0 %d, out %d, ws %zu; nothing launched\n", N_IN, T * D, (size_t)WS_END, n_in, n_in > 0 ? in_sizes[0] : -1, out_size, ws_size);
            grid = -1; return; }
        int dev = 0, cus = 0, per_cu = 0;
        if (hipGetDevice(&dev) != hipSuccess || hipDeviceGetAttribute(&cus, hipDeviceAttributeMultiprocessorCount, dev) != hipSuccess) { fprintf(stderr, "kernel_launch: device query failed\n"); grid = -1; return; }
        if (hipFuncSetAttribute((const void*)mk_fwd, hipFuncAttributeMaxDynamicSharedMemorySize, LDS_BYTES) != hipSuccess) { fprintf(stderr, "kernel_launch: hipFuncSetAttribute failed\n"); grid = -1; return; }
        if (hipOccupancyMaxActiveBlocksPerMultiprocessor(&per_cu, (const void*)mk_fwd, NWAVES * 64, LDS_BYTES) != hipSuccess || per_cu < 1) { fprintf(stderr, "kernel_launch: occupancy query reports %d workgroups per CU\n", per_cu); }
        (void)hipGetLastError();
        grid = cus;
    }
    if (grid < 0) return;
    if (hipMemsetAsync((char*)d_ws + WS_CTL, 0, CTL_ZERO_BYTES, stream) != hipSuccess) { fprintf(stderr, "kernel_launch: hipMemsetAsync failed\n"); return; }
    Args a{};
    for (int i = 0; i < N_IN; ++i) a.in[i] = (const float*)d_in[i];
    a.out = (float*)d_out; a.ws = (unsigned char*)d_ws;
#if MK_PER_PHASE
#ifdef DBG_STOP
    for (int ph = 0; ph <= DBG_STOP; ++ph) { a.ph_lo = ph; a.ph_hi = ph + 1; hipLaunchKernelGGL(mk_fwd, dim3(grid), dim3(NWAVES * 64), LDS_BYTES, stream, a); }
    a.ph_lo = 100; a.ph_hi = 101; hipLaunchKernelGGL(mk_fwd, dim3(grid), dim3(NWAVES * 64), LDS_BYTES, stream, a);
#else
    for (int ph = 0; ph < NPH; ++ph) { a.ph_lo = ph; a.ph_hi = ph + 1; hipLaunchKernelGGL(mk_fwd, dim3(grid), dim3(NWAVES * 64), LDS_BYTES, stream, a); }
#endif
#else
#ifdef DBG_TWOPASS
    a.ph_lo = 0; a.ph_hi = NPH; a.pass = 0; hipLaunchKernelGGL(mk_fwd, dim3(grid), dim3(NWAVES * 64), LDS_BYTES, stream, a);
    (void)hipMemsetAsync((char*)d_ws + WS_CTL + CW_BAR * 4, 0, XCD_BAR_WORDS * 4, stream); (void)hipMemsetAsync((char*)d_ws + WS_CTL + CW_GCNT * 4, 0, 2048, stream);
    a.pass = 1; hipLaunchKernelGGL(mk_fwd, dim3(grid), dim3(NWAVES * 64), LDS_BYTES, stream, a);
#else
    a.ph_lo = 0; a.ph_hi = NPH; hipLaunchKernelGGL(mk_fwd, dim3(grid), dim3(NWAVES * 64), LDS_BYTES, stream, a);
#endif
#endif
    const hipError_t le = hipPeekAtLastError();
    if (le != hipSuccess) fprintf(stderr, "kernel_launch: launch failed: %s\n", hipGetErrorName(le));
}
```

```cpp
#include <hip/hip_runtime.h>
#include <cstdio>
#include <cstdint>
#define MK_SP2 true
#define MK_ALIGN true
#define MK_NAIVE_ATTN 0
#define MK_FP8_GU 1
#define MK_ALIGN_GU true
#define MK_SP2_GU true
namespace pg8 {
#define PG8_LAS __attribute__((address_space(3)))
typedef unsigned short bf16_t;
typedef short bf16x8 __attribute__((ext_vector_type(8)));
typedef float f32x4 __attribute__((ext_vector_type(4)));
typedef unsigned u32x4 __attribute__((ext_vector_type(4)));
constexpr int BM = 256, BK = 64, HALF = 128, HTB = HALF * BK * 2  , STAGE_BYTES = 8 * HTB, NXCD = 8, WGM = 8;

__host__ __device__ __forceinline__ int lds_byte(int r, int c) { const int st = (r >> 4) * 2 + (c >> 5), rr = r & 15, cc = c & 31, ob = rr * 64 + cc * 2; return st * 1024 + (ob ^ (((ob >> 9) & 1) << 5)); }
__host__ __device__ __forceinline__ void stage_rc(int b, int& R, int& C) { const int st = b / 1024, sb = b % 1024, swz = sb ^ (((sb >> 9) & 1) << 5); R = (st >> 1) * 16 + swz / 64; C = (st & 1) * 32 + (swz % 64) / 2; }
__host__ __device__ __forceinline__ int perm32(int rho) { const int n = rho >> 4, i = rho & 15; return 8 * (i >> 2) + 4 * n + (i & 3); }

struct Unit { int pm, pn; };
struct Gemm { const bf16_t* A; const bf16_t* Bt; int M, N, K; };

typedef float cvt_f32x2_t __attribute__((ext_vector_type(2))); typedef __bf16 cvt_bf16x2_t __attribute__((ext_vector_type(2)));
__device__ __forceinline__ unsigned cvt_pk_bf16(float lo, float hi) { cvt_f32x2_t v = {lo, hi}; cvt_bf16x2_t b = __builtin_convertvector(v, cvt_bf16x2_t); return __builtin_bit_cast(unsigned, b); }
typedef float f32x2 __attribute__((ext_vector_type(2)));
typedef unsigned u32x2 __attribute__((ext_vector_type(2)));
__device__ __forceinline__ float sigm(float x) { return __builtin_amdgcn_rcpf(1.0f + __builtin_amdgcn_exp2f(-1.4426950408889634f * x)); }
__device__ __forceinline__ float bf_lo(unsigned w) { return __uint_as_float(w << 16); }
__device__ __forceinline__ float bf_hi(unsigned w) { return __uint_as_float(w & 0xffff0000u); }

struct GroupOrder {
    int ng, nN, nwg, G, c, TM; PG8_LAS int* tp;
    __device__ __forceinline__ void init_equal(int ngroups, int rows_per_group, int N, int G_, int c_, PG8_LAS int* tp_) {
        ng = ngroups; nN = N / BM; const int t = rows_per_group / BM; TM = t * ngroups; nwg = TM * nN; G = G_; c = c_; tp = tp_;
        if (ngroups > 1) { int tx = threadIdx.x; asm volatile("" : "+v"(tx)); if (tx < 9) tp[tx] = (tx < ngroups ? tx : ngroups) * t; __syncthreads(); }
    }
    __device__ __forceinline__ void init_dense(int M, int N, int G_, int c_) { init_equal(1, M, N, G_, c_, nullptr); }
    __device__ __forceinline__ void init_counts(const unsigned (&cnt)[8], int N, int G_, int c_, PG8_LAS int* tp_) {
        ng = 8; nN = N / BM; G = G_; c = c_; tp = tp_; int s = 0; int tx = threadIdx.x; asm volatile("" : "+v"(tx));
        if (tx == 0) tp[0] = 0;
#pragma unroll
        for (int e = 0; e < 8; ++e) { s += (int)((cnt[e] + 255u) >> 8); if (tx == 0) tp[e + 1] = s; }
        TM = s; nwg = TM * nN; __syncthreads();
    }
    __device__ __forceinline__ bool next(int i, Unit& u) const {
        const long L = (long)i * G + c; if (L >= nwg) return false;
        int wgid = (int)L; { const int q = nwg / NXCD, r = nwg % NXCD, xcd = wgid % NXCD, off = wgid / NXCD; wgid = (xcd < r ? xcd * (q + 1) : r * (q + 1) + (xcd - r) * q) + off; }
        const int nig = WGM * nN, gid = wgid / nig, fm = gid * WGM, gsz = (TM - fm) < WGM ? (TM - fm) : WGM;
        const int rt = fm + ((wgid % nig) % gsz), pl = (wgid % nig) / gsz;
        int e = 0;
        if (ng > 1) {
#pragma unroll
            for (int j = 1; j < 8; ++j) e += (j < ng && rt >= __builtin_amdgcn_readfirstlane(tp[j])) ? 1 : 0; }
        u.pm = rt; u.pn = e * nN + pl; return true;
    }
    __device__ __forceinline__ void a_ready(const Unit&) const {}
    __device__ __forceinline__ void done(const Unit&) const {}
};

#define EPI_ROWS(row0) _Pragma("unroll") for (int ai = 0; ai < 2; ++ai) _Pragma("unroll") for (int m = 0; m < 4; ++m)
__device__ __forceinline__ u32x4 pack8(const f32x4 a, const f32x4 b) { u32x4 w; w.x = cvt_pk_bf16(a[0], a[1]); w.y = cvt_pk_bf16(a[2], a[3]); w.z = cvt_pk_bf16(b[0], b[1]); w.w = cvt_pk_bf16(b[2], b[3]); return w; }
__device__ __forceinline__ f32x4 sigm4(const f32x4 v) { return (f32x4){sigm(v[0]), sigm(v[1]), sigm(v[2]), sigm(v[3])}; }

struct EpiInProj {
    static constexpr bool PERM = true, AFTER_DRAIN = false;
    bf16_t *Q, *K, *V, *Z, *SG; const float* rope; float qscale; const float* rs; const float* wsp_;
    __device__ __forceinline__ void operator()(const f32x4 (&acc_)[2][2][4][2], const Unit& u, int wr, int wc, int fr, int fq) const {
        const int pn = u.pn, row0 = u.pm * BM + wr * 64 + fr, cl = wc * 32 + 8 * fq;
        f32x4 acc[2][2][4][2];
        if (rs) { typedef int i32x4_ __attribute__((ext_vector_type(4))); const float ws = *wsp_;
            EPI_ROWS(row0) { const float sc = rs[row0 + ai * HALF + m * 16] * ws;
#pragma unroll
                for (int bj = 0; bj < 2; ++bj)
#pragma unroll
                    for (int n = 0; n < 2; ++n) acc[ai][bj][m][n] = __builtin_convertvector(__builtin_bit_cast(i32x4_, acc_[ai][bj][m][n]), f32x4) * sc; } }
        else { EPI_ROWS(row0) {
#pragma unroll
                for (int bj = 0; bj < 2; ++bj)
#pragma unroll
                    for (int n = 0; n < 2; ++n) acc[ai][bj][m][n] = acc_[ai][bj][m][n]; } }
        if (pn < 4) {
            bf16_t* base = (pn < 2) ? Q : K; const float sc = (pn < 2) ? qscale : 1.0f; const int colt = (pn & 1) * 256, g4 = 4 * (4 * (wc & 1) + fq);
            EPI_ROWS(row0) { const int row = row0 + ai * HALF + m * 16; const float* rp = rope + (size_t)(row & 2047) * 64 + g4;
                const f32x4 cs = *(const f32x4*)rp, sn = *(const f32x4*)(rp + 32);
#pragma unroll
                for (int bj = 0; bj < 2; ++bj) { const f32x4 v0 = acc[ai][bj][m][0], v1 = acc[ai][bj][m][1];
                    const f32x4 lo = (v0 * cs - v1 * sn) * sc, hi = (v1 * cs + v0 * sn) * sc;
                    bf16_t* p = base + (size_t)row * 512 + colt + (2 * bj + (wc >> 1)) * 64 + g4;
                    u32x2 a; a.x = cvt_pk_bf16(lo[0], lo[1]); a.y = cvt_pk_bf16(lo[2], lo[3]); *(u32x2*)p = a;
                    u32x2 b; b.x = cvt_pk_bf16(hi[0], hi[1]); b.y = cvt_pk_bf16(hi[2], hi[3]); *(u32x2*)(p + 32) = b; } }
        } else if (pn < 6) {
            EPI_ROWS(row0) { bf16_t* p = V + (size_t)(row0 + ai * HALF + m * 16) * 512 + (pn - 4) * 256 + cl;
#pragma unroll
                for (int bj = 0; bj < 2; ++bj) *(u32x4*)(p + bj * HALF) = pack8(acc[ai][bj][m][0], acc[ai][bj][m][1]); }
        } else if (pn < 10) {
            EPI_ROWS(row0) { bf16_t* p = Z + (size_t)(row0 + ai * HALF + m * 16) * 512 + (pn - 6) * 128 + cl;
                *(u32x4*)p = pack8(acc[ai][0][m][0] * sigm4(acc[ai][1][m][0]), acc[ai][0][m][1] * sigm4(acc[ai][1][m][1])); }
        } else {
            EPI_ROWS(row0) { bf16_t* p = SG + (size_t)(row0 + ai * HALF + m * 16) * 2048 + (pn - 10) * 256 + cl;
#pragma unroll
                for (int bj = 0; bj < 2; ++bj) *(u32x4*)(p + bj * HALF) = pack8(sigm4(acc[ai][bj][m][0]), sigm4(acc[ai][bj][m][1])); }
        }
    }
};
template <int MODE> struct EpiGate {
    static constexpr bool PERM = false, AFTER_DRAIN = false;
    float* P; bf16_t* MIX; const bf16_t* SG;
    __device__ __forceinline__ void operator()(const f32x4 (&acc)[2][2][4][2], const Unit& u, int wr, int wc, int fr, int fq) const {
        const int row0 = u.pm * BM + wr * 64 + fr, col0 = u.pn * BM + wc * 32 + 4 * fq;
        EPI_ROWS(row0) { const size_t row = (size_t)(row0 + ai * HALF + m * 16);
#pragma unroll
            for (int bj = 0; bj < 2; ++bj)
#pragma unroll
                for (int n = 0; n < 2; ++n) { const int col = col0 + bj * HALF + n * 16;
                    const u32x2 gw = *(const u32x2*)(SG + row * 2048 + MODE * 1024 + col);
                    const f32x4 gt = (f32x4){bf_lo(gw.x), bf_hi(gw.x), bf_lo(gw.y), bf_hi(gw.y)};
                    if (MODE == 0) *(f32x4*)(P + row * 1024 + col) = gt * acc[ai][bj][m][n];
                    else { const f32x4 r = *(const f32x4*)(P + row * 1024 + col) + gt * acc[ai][bj][m][n];
                        u32x2 w; w.x = cvt_pk_bf16(r[0], r[1]); w.y = cvt_pk_bf16(r[2], r[3]); *(u32x2*)(MIX + row * 1024 + col) = w; } } }
    }
};
struct EpiResid {
    static constexpr bool PERM = false, AFTER_DRAIN = false;
    const float* base; float* out; int nN;
    __device__ __forceinline__ void operator()(const f32x4 (&acc)[2][2][4][2], const Unit& u, int wr, int wc, int fr, int fq) const {
        const int row0 = u.pm * BM + wr * 64 + fr, col0 = (u.pn % nN) * BM + wc * 32 + 4 * fq;
        EPI_ROWS(row0) { const size_t off = (size_t)(row0 + ai * HALF + m * 16) * 1024 + col0;
#pragma unroll
            for (int bj = 0; bj < 2; ++bj)
#pragma unroll
                for (int n = 0; n < 2; ++n) { f32x4 r = acc[ai][bj][m][n]; if (base) r += *(const f32x4*)(base + off + bj * HALF + n * 16); *(f32x4*)(out + off + bj * HALF + n * 16) = r; } }
    }
};
struct EpiSwiGLU {
    static constexpr bool PERM = true, AFTER_DRAIN = false;
    bf16_t* ACT; int ldc, nN; const float* rs; const float* wsv;
    __device__ __forceinline__ void operator()(const f32x4 (&acc)[2][2][4][2], const Unit& u, int wr, int wc, int fr, int fq) const {
        const int row0 = u.pm * BM + wr * 64 + fr, cl = (u.pn % nN) * 128 + wc * 32 + 8 * fq;
        EPI_ROWS(row0) { bf16_t* p = ACT + (size_t)(row0 + ai * HALF + m * 16) * ldc + cl;
            f32x4 g0 = acc[ai][0][m][0], g1 = acc[ai][0][m][1], u0 = acc[ai][1][m][0], u1 = acc[ai][1][m][1];
            if (rs) { const float sc = rs[row0 + ai * HALF + m * 16] * wsv[u.pn / nN]; typedef int i32x4_ __attribute__((ext_vector_type(4)));
                g0 = __builtin_convertvector(__builtin_bit_cast(i32x4_, g0), f32x4) * sc; g1 = __builtin_convertvector(__builtin_bit_cast(i32x4_, g1), f32x4) * sc;
                u0 = __builtin_convertvector(__builtin_bit_cast(i32x4_, u0), f32x4) * sc; u1 = __builtin_convertvector(__builtin_bit_cast(i32x4_, u1), f32x4) * sc; }
            *(u32x4*)p = pack8(g0 * sigm4(g0) * u0, g1 * sigm4(g1) * u1); }
    }
};
struct EpiStore {
    static constexpr bool PERM = true, AFTER_DRAIN = false;
    bf16_t* O; int ldc, nN;
    __device__ __forceinline__ void operator()(const f32x4 (&acc)[2][2][4][2], const Unit& u, int wr, int wc, int fr, int fq) const {
        const int row0 = u.pm * BM + wr * 64 + fr, cl = (u.pn % nN) * BM + wc * 32 + 8 * fq;
        EPI_ROWS(row0) { bf16_t* p = O + (size_t)(row0 + ai * HALF + m * 16) * ldc + cl;
#pragma unroll
            for (int bj = 0; bj < 2; ++bj) *(u32x4*)(p + bj * HALF) = pack8(acc[ai][bj][m][0], acc[ai][bj][m][1]); }
    }
};
struct EpiPleGate {
    static constexpr bool PERM = false, AFTER_DRAIN = false;
    float* X; const bf16_t* PROJ;
    __device__ __forceinline__ void operator()(const f32x4 (&acc)[2][2][4][2], const Unit& u, int wr, int wc, int fr, int fq) const {
        const int row0 = u.pm * BM + wr * 64 + fr, col0 = u.pn * BM + wc * 32 + 4 * fq;
        EPI_ROWS(row0) { const size_t off = (size_t)(row0 + ai * HALF + m * 16) * 1024 + col0;
#pragma unroll
            for (int bj = 0; bj < 2; ++bj)
#pragma unroll
                for (int n = 0; n < 2; ++n) { const size_t o = off + bj * HALF + n * 16; const u32x2 pw = *(const u32x2*)(PROJ + o);
                    const f32x4 pr = (f32x4){bf_lo(pw.x), bf_hi(pw.x), bf_lo(pw.y), bf_hi(pw.y)};
                    *(f32x4*)(X + o) = *(const f32x4*)(X + o) + sigm4(acc[ai][bj][m][n]) * pr; } }
    }
};

template <class Epi, class Sched>
__device__ __forceinline__ void gemm_phase_naive(const Gemm g, const Sched& S, const Epi& E) {
    int tid_ = threadIdx.x; asm volatile("" : "+v"(tid_));
    const int tid = tid_, wid = __builtin_amdgcn_readfirstlane(tid >> 6), lane = tid & 63, wr = wid >> 2, wc = wid & 3, fr = lane & 15, fq = lane >> 4;
    const int K = g.K; Unit u;
    for (int ui = 0; S.next(ui, u); ++ui) {
        f32x4 acc[2][2][4][2];
#pragma unroll
        for (int ai = 0; ai < 2; ++ai)
#pragma unroll
            for (int m = 0; m < 4; ++m) {
                const bf16_t* ap = g.A + (size_t)(u.pm * BM + ai * HALF + wr * 64 + m * 16 + fr) * K;
#pragma unroll
                for (int bj = 0; bj < 2; ++bj)
#pragma unroll
                    for (int n = 0; n < 2; ++n) { f32x4 r = (f32x4){0.f, 0.f, 0.f, 0.f};
#pragma unroll
                        for (int j = 0; j < 4; ++j) { const int col = u.pn * BM + bj * HALF + wc * 32 + (Epi::PERM ? (8 * fq + 4 * n + j) : (16 * n + 4 * fq + j));
                            const bf16_t* bp = g.Bt + (size_t)col * K; float s = 0.f;
                            for (int k = 0; k < K; k += 8) { const u32x4 a = *(const u32x4*)(ap + k), b = *(const u32x4*)(bp + k);
                                s += bf_lo(a.x) * bf_lo(b.x) + bf_hi(a.x) * bf_hi(b.x) + bf_lo(a.y) * bf_lo(b.y) + bf_hi(a.y) * bf_hi(b.y)
                                   + bf_lo(a.z) * bf_lo(b.z) + bf_hi(a.z) * bf_hi(b.z) + bf_lo(a.w) * bf_lo(b.w) + bf_hi(a.w) * bf_hi(b.w); }
                            r[j] = s; }
                        acc[ai][bj][m][n] = r; } }
        E(acc, u, wr, wc, fr, fq);
    }
}
typedef int pg8_i32x8 __attribute__((ext_vector_type(8))); typedef int pg8_i32x4 __attribute__((ext_vector_type(4)));
template <bool FP8> struct pg8_frag { typedef bf16x8 T; };
template <> struct pg8_frag<true> { typedef pg8_i32x8 T; };
template <bool FP8> __device__ __forceinline__ void pg8_ldfrag(typename pg8_frag<FP8>::T& d, const PG8_LAS unsigned char* p) {
    if constexpr (FP8) { const pg8_i32x4 lo = *(const PG8_LAS pg8_i32x4*)p, hi = *(const PG8_LAS pg8_i32x4*)(p + 16); d = __builtin_shufflevector(lo, hi, 0, 1, 2, 3, 4, 5, 6, 7); }
    else d = *(const PG8_LAS bf16x8*)p;
}
template <bool I8> __device__ __forceinline__ f32x4 pg8_mma(const bf16x8& b, const bf16x8& a, const f32x4 c) {
    if constexpr (I8) return __builtin_bit_cast(f32x4, __builtin_amdgcn_mfma_i32_16x16x64_i8(__builtin_bit_cast(pg8_i32x4, b), __builtin_bit_cast(pg8_i32x4, a), __builtin_bit_cast(pg8_i32x4, c), 0, 0, 0));
    else return __builtin_amdgcn_mfma_f32_16x16x32_bf16(b, a, c, 0, 0, 0);
}
template <class Epi, class Sched, bool ALIGN_EPI = false, bool SP2 = false, bool I8 = false>
__device__ __forceinline__ void gemm_phase(PG8_LAS unsigned char* lds, const Gemm g, const Sched& S, const Epi& E) {
    int tid_ = threadIdx.x; asm volatile("" : "+v"(tid_));
    const int tid = tid_, wid = __builtin_amdgcn_readfirstlane(tid >> 6), lane = tid & 63, wr = wid >> 2, wc = wid & 3, fr = lane & 15, fq = lane >> 4;
    int K_ = g.K; asm volatile("" : "+s"(K_));
    const int K = K_, nt = K / BK;
    unsigned voffA[2], voffB[2];
#pragma unroll
    for (int i = 0; i < 2; ++i) { int R, C; stage_rc(tid * 16 + i * 8192, R, C); const int Rb = Epi::PERM ? ((R & ~31) + perm32(R & 31)) : R;
        voffA[i] = (unsigned)(R * K + C) * 2u; voffB[i] = (unsigned)(Rb * K + C) * 2u; }
    const size_t kstep = (size_t)(BK * 2);
    const size_t hstep = (size_t)HALF * K * 2;
    const size_t tstep = 2 * hstep;
    const unsigned ldsw = (unsigned)wid * 1024u;
    const int aoff = lds_byte(wr * 64 + fr, fq * 8), boff = lds_byte(wc * 32 + fr, fq * 8);
    constexpr int NK = 2;
#define PG8_SA(b, h) (((b) * 2 + (h)) * HTB)
#define PG8_SB(b, h) ((4 + (b) * 2 + (h)) * HTB)
#define PG8_STAGE(bufoff, gbase, voff) do { _Pragma("unroll") for (int _i = 0; _i < 2; ++_i) \
        __builtin_amdgcn_global_load_lds((const unsigned*)((const char*)(gbase) + (voff)[_i]), (PG8_LAS unsigned*)(lds + (bufoff) + ldsw + _i * 8192), 16, 0, 0); } while (0)
#define PG8_LDA(dst, b, h) do { _Pragma("unroll") for (int m = 0; m < 4; ++m) _Pragma("unroll") for (int k = 0; k < NK; ++k) pg8_ldfrag<false>(dst[m][k], lds + PG8_SA(b, h) + aoff + m * 2048 + k * 1024); } while (0)
#define PG8_LDB(dst, b, h) do { _Pragma("unroll") for (int n = 0; n < 2; ++n) _Pragma("unroll") for (int k = 0; k < NK; ++k) pg8_ldfrag<false>(dst[n][k], lds + PG8_SB(b, h) + boff + n * 2048 + k * 1024); } while (0)
#define PG8_MMA(ai, bj, At, Bt) do { __builtin_amdgcn_s_setprio(1); _Pragma("unroll") for (int m = 0; m < 4; ++m) _Pragma("unroll") for (int n = 0; n < 2; ++n) _Pragma("unroll") for (int k = 0; k < NK; ++k) \
        acc[ai][bj][m][n] = pg8_mma<I8>(Bt[n][k], At[m][k], acc[ai][bj][m][n]); __builtin_amdgcn_s_setprio(0); } while (0)
#define PG8_WAIT_V(n) asm volatile("s_waitcnt vmcnt(" #n ")" ::: "memory")
#define PG8_WAIT_L(n) asm volatile("s_waitcnt lgkmcnt(" #n ")" ::: "memory")
#define PG8_BAR __builtin_amdgcn_s_barrier()
#define PG8_SCHED __builtin_amdgcn_sched_barrier(0)
    Unit cur, nxt; int ui = 0;
    if (!S.next(0, cur)) return;
    f32x4 acc[2][2][4][2];
#pragma unroll
    for (int a = 0; a < 2; ++a)
#pragma unroll
        for (int b = 0; b < 2; ++b)
#pragma unroll
            for (int m = 0; m < 4; ++m)
#pragma unroll
                for (int n = 0; n < 2; ++n) acc[a][b][m][n] = (f32x4){0.f, 0.f, 0.f, 0.f};
    bf16x8 At[4][NK], B0[2][NK], B1[2][NK];
    const char* cA = (const char*)g.A + (size_t)cur.pm * tstep; const char* cB = (const char*)g.Bt + (size_t)cur.pn * tstep;
    S.a_ready(cur);
    if constexpr (SP2) {
        PG8_STAGE(PG8_SB(0, 0), cB, voffB); PG8_STAGE(PG8_SB(0, 1), cB + hstep, voffB); PG8_STAGE(PG8_SA(0, 0), cA, voffA); PG8_STAGE(PG8_SA(0, 1), cA + hstep, voffA);
        if (wr == 1) PG8_BAR;
        PG8_WAIT_V(2); PG8_BAR;
        PG8_STAGE(PG8_SB(1, 0), cB + kstep, voffB); PG8_STAGE(PG8_SA(1, 0), cA + kstep, voffA); PG8_STAGE(PG8_SB(1, 1), cB + hstep + kstep, voffB);
        PG8_WAIT_V(6); PG8_BAR;
    } else {
        PG8_STAGE(PG8_SB(0, 0), cB, voffB); PG8_STAGE(PG8_SA(0, 0), cA, voffA); PG8_STAGE(PG8_SB(0, 1), cB + hstep, voffB); PG8_STAGE(PG8_SA(0, 1), cA + hstep, voffA);
        if (wr == 1) PG8_BAR;
        PG8_WAIT_V(4); PG8_BAR;
        PG8_STAGE(PG8_SB(1, 0), cB + kstep, voffB); PG8_STAGE(PG8_SA(1, 0), cA + kstep, voffA); PG8_STAGE(PG8_SB(1, 1), cB + hstep + kstep, voffB);
        PG8_WAIT_V(6); PG8_BAR;
    }
    for (;;) {
        const bool has_next = S.next(ui + 1, nxt);
        const char* nA = has_next ? (const char*)g.A + (size_t)nxt.pm * tstep : cA; const char* nB = has_next ? (const char*)g.Bt + (size_t)nxt.pn * tstep : cB;
#pragma nounroll
        for (int t = 0; t < nt; t += 2) {
            const bool last = (t == nt - 2);
            const char* a1 = cA + (size_t)(t + 1) * kstep;
            const char* a2 = last ? nA : cA + (size_t)(t + 2) * kstep; const char* b2 = last ? nB : cB + (size_t)(t + 2) * kstep;
            const char* a3 = a2 + kstep; const char* b3 = b2 + kstep;
            if (last && has_next) S.a_ready(nxt);
            if constexpr (SP2) {
            PG8_LDB(B0, 0, 0); PG8_LDB(B1, 0, 1); PG8_SCHED; PG8_LDA(At, 0, 0); PG8_STAGE(PG8_SA(1, 1), a1 + hstep, voffA);
            PG8_WAIT_V(8); PG8_WAIT_L(0); PG8_BAR; PG8_MMA(0, 0, At, B0); PG8_MMA(0, 1, At, B1); PG8_BAR; PG8_SCHED;
            PG8_LDA(At, 0, 1); PG8_STAGE(PG8_SB(0, 0), b2, voffB); PG8_STAGE(PG8_SB(0, 1), b2 + hstep, voffB); PG8_STAGE(PG8_SA(0, 0), a2, voffA);
            PG8_WAIT_V(8); PG8_WAIT_L(0); PG8_BAR; PG8_MMA(1, 0, At, B0); PG8_MMA(1, 1, At, B1); PG8_BAR; PG8_SCHED;
            PG8_LDB(B0, 1, 0); PG8_LDB(B1, 1, 1); PG8_SCHED; PG8_LDA(At, 1, 0); PG8_STAGE(PG8_SA(0, 1), a2 + hstep, voffA);
            PG8_WAIT_V(8); PG8_WAIT_L(0); PG8_BAR; PG8_MMA(0, 0, At, B0); PG8_MMA(0, 1, At, B1); PG8_BAR; PG8_SCHED;
            PG8_LDA(At, 1, 1); PG8_STAGE(PG8_SB(1, 0), b3, voffB); PG8_STAGE(PG8_SB(1, 1), b3 + hstep, voffB); PG8_STAGE(PG8_SA(1, 0), a3, voffA);
            PG8_WAIT_V(8); PG8_WAIT_L(0); PG8_BAR; PG8_MMA(1, 0, At, B0); PG8_MMA(1, 1, At, B1); PG8_BAR; PG8_SCHED;
            } else {
            PG8_LDB(B0, 0, 0); PG8_SCHED; PG8_LDA(At, 0, 0); PG8_STAGE(PG8_SA(1, 1), a1 + hstep, voffA);
            PG8_WAIT_L(8); PG8_BAR; PG8_WAIT_L(0); PG8_MMA(0, 0, At, B0); PG8_BAR; PG8_SCHED;
            PG8_LDB(B1, 0, 1); PG8_STAGE(PG8_SB(0, 0), b2, voffB);
            PG8_BAR; PG8_WAIT_L(0); PG8_MMA(0, 1, At, B1); PG8_BAR;
            PG8_LDA(At, 0, 1); PG8_STAGE(PG8_SA(0, 0), a2, voffA);
            PG8_BAR; PG8_WAIT_L(0); PG8_MMA(1, 0, At, B0); PG8_BAR; PG8_SCHED;
            PG8_STAGE(PG8_SB(0, 1), b2 + hstep, voffB);
            PG8_WAIT_V(6); PG8_BAR; PG8_MMA(1, 1, At, B1); PG8_BAR;
            PG8_LDB(B0, 1, 0); PG8_SCHED; PG8_LDA(At, 1, 0); PG8_STAGE(PG8_SA(0, 1), a2 + hstep, voffA);
            PG8_WAIT_L(8); PG8_BAR; PG8_WAIT_L(0); PG8_MMA(0, 0, At, B0); PG8_BAR; PG8_SCHED;
            PG8_LDB(B1, 1, 1); PG8_STAGE(PG8_SB(1, 0), b3, voffB);
            PG8_BAR; PG8_WAIT_L(0); PG8_MMA(0, 1, At, B1); PG8_BAR;
            PG8_LDA(At, 1, 1); PG8_STAGE(PG8_SA(1, 0), a3, voffA);
            PG8_BAR; PG8_WAIT_L(0); PG8_MMA(1, 0, At, B0); PG8_BAR; PG8_SCHED;
            PG8_STAGE(PG8_SB(1, 1), b3 + hstep, voffB);
            PG8_WAIT_V(6); PG8_BAR; PG8_MMA(1, 1, At, B1); PG8_BAR;
            }
        }
        if constexpr (ALIGN_EPI) { if (wr == 0) PG8_BAR; }
        if constexpr (!Epi::AFTER_DRAIN) { E(acc, cur, wr, wc, fr, fq); S.done(cur); }
        if (!has_next) break;
#pragma unroll
        for (int a = 0; a < 2; ++a)
#pragma unroll
            for (int b = 0; b < 2; ++b)
#pragma unroll
                for (int m = 0; m < 4; ++m)
#pragma unroll
                    for (int n = 0; n < 2; ++n) acc[a][b][m][n] = (f32x4){0.f, 0.f, 0.f, 0.f};
        cur = nxt; cA = nA; cB = nB; ++ui;
        if constexpr (ALIGN_EPI) { if (wr == 1) PG8_BAR; }
    }
    PG8_WAIT_V(0);
    if constexpr (!ALIGN_EPI) { if (wr == 0) PG8_BAR; }
    PG8_BAR;
    if constexpr (Epi::AFTER_DRAIN) { E.fused(acc, cur, wr, wc, fr, fq, lds, wid, lane); S.done(cur); }
#undef PG8_SA
#undef PG8_SB
#undef PG8_STAGE
#undef PG8_LDA
#undef PG8_LDB
#undef PG8_MMA
#undef PG8_WAIT_V
#undef PG8_WAIT_L
#undef PG8_BAR
#undef PG8_SCHED
}
}

constexpr int NWAVES = 8;
#ifndef MK_PER_PHASE
#define MK_PER_PHASE 0
#endif
#ifndef MK_NAIVE_GEMM
#define MK_NAIVE_GEMM 0
#endif
#ifndef MK_SP2
#define MK_SP2 true
#endif
#ifndef MK_ALIGN
#define MK_ALIGN true
#endif
#ifdef DBG_TWOPASS
#define DBG_TWOPASS_ON 1
#else
#define DBG_TWOPASS_ON 0
#endif
#ifndef MK_FP8_GU
#define MK_FP8_GU 1
#endif
#ifndef MK_I8_INPROJ
#define MK_I8_INPROJ 1
#endif
#ifndef MK_ALIGN_GU
#define MK_ALIGN_GU false
#endif
#ifndef MK_SP2_GU
#define MK_SP2_GU false
#endif
#ifndef DBG_REP_PRO
#define DBG_REP_PRO 1
#endif
#ifndef DBG_REP_ATTN
#define DBG_REP_ATTN 1
#endif
#ifndef DBG_REP_GU
#define DBG_REP_GU 1
#endif
#ifndef DBG_LAYER
#define DBG_LAYER 0
#endif
#ifndef DBG_INJECT
#define DBG_INJECT 0.f
#endif
#ifndef MK_NAIVE_ATTN
#define MK_NAIVE_ATTN 1
#endif

constexpr int BATCH = 8, SEQ = 2048, D = 1024, T = BATCH * SEQ, DEPTH = 2;
constexpr int NH = 4, HD = 64, VD = 128, AQK = 512, AV = 512, CCH = 512, CK = 31, CPAD = 15;
constexpr int INC = 2 * AQK + AV + 2 * CCH + 2 * D;
constexpr int FF = 2816, NE = 8, FE = 3584, PLE = 256;
constexpr float EPS = 1e-6f;
constexpr float QSCALE = 0.125f * 1.4426950408889634f;
constexpr int MOE_ROWS = 2 * T + NE * 256;
enum { I_X = 0, I_P, I_GMIX, I_WIN, I_LAM, I_GSUB, I_WAO, I_CW, I_CB, I_CLG, I_CLB, I_WCO, I_WO, I_GFFN, I_WFGU, I_WFDN, I_WR, I_BR, I_WEGU, I_WEDN, I_GPLE, I_WPG, I_WPP, I_GFIN, N_IN };

constexpr size_t MiB = 1u << 20;
constexpr size_t WS_CTL = 0, CTL_ZERO_BYTES = 1 * MiB;
constexpr size_t WS_ROPE = 1 * MiB;
constexpr size_t WS_SCAL = 1 * MiB + 512 * 1024;
constexpr size_t WS_RTI = WS_SCAL + 4096;
constexpr size_t WS_RTW = WS_RTI + (size_t)T * 16;
constexpr size_t WS_RSEL = WS_RTW + (size_t)T * 8;
constexpr size_t WS_RS = 2 * MiB + 256 * 1024;
constexpr size_t WS_WSC = WS_SCAL + 64;
constexpr size_t WS_RSP = 2 * MiB + 512 * 1024;
static_assert(WS_RSEL + (size_t)T * 8 <= WS_RS && WS_RSP + (size_t)MOE_ROWS * 4 <= 3 * MiB, "misc region");
constexpr size_t WS_WIN = 4 * MiB, WS_WA = 22 * MiB, WS_WC = 24 * MiB, WS_WO = 26 * MiB, WS_WFGU = 30 * MiB, WS_WFDN = 41 * MiB, WS_WPG = 47 * MiB, WS_WPP = 51 * MiB;
constexpr size_t WS_WEGU = 52 * MiB, WS_WEDN = 164 * MiB;
constexpr size_t WS_X = 220 * MiB, WS_H = 284 * MiB, WS_PROJ = 316 * MiB, WS_PB = 380 * MiB, WS_R = 396 * MiB;
constexpr size_t WS_Q = WS_R, WS_K = WS_R + 16 * MiB, WS_V = WS_R + 32 * MiB, WS_Z = WS_R + 48 * MiB, WS_SG = WS_R + 64 * MiB, WS_OB = WS_R + 128 * MiB, WS_ZC = WS_R + 144 * MiB,
                 WS_P = WS_R + 160 * MiB, WS_MIX = WS_R + 224 * MiB;
constexpr size_t WS_ACT = WS_R, WS_HP = WS_R + 240 * MiB, WS_Y = WS_R + 308 * MiB, WS_END = WS_R + 444 * MiB;
static_assert((size_t)MOE_ROWS * FE * 2 <= 240 * MiB && (size_t)MOE_ROWS * D * 2 <= 68 * MiB && (size_t)MOE_ROWS * D * 4 <= 136 * MiB && (size_t)T * FF * 2 <= 240 * MiB, "region R");
constexpr int CW_TMO = 0, CW_CODE = 1, CW_BAR = 4096, CW_GCNT = 8192;

constexpr int RING_OFF = 0, RING_BYTES = 131072;
constexpr int LDSCTL_OFF = RING_BYTES, MISC_OFF = LDSCTL_OFF + 320;
constexpr int TP_OFF = MISC_OFF + 64;
constexpr int LDS_BYTES = 147456;

#define GAS __attribute__((address_space(1)))
#define LAS __attribute__((address_space(3)))
typedef unsigned short bf16;
typedef unsigned v4u __attribute__((ext_vector_type(4)));
typedef unsigned v2u __attribute__((ext_vector_type(2)));
typedef float f32x4 __attribute__((ext_vector_type(4)));
typedef GAS unsigned gu32;
#define RLX_AGENT __ATOMIC_RELAXED, __HIP_MEMORY_SCOPE_AGENT
#define LDS_WAIT() asm volatile("s_waitcnt lgkmcnt(0)" ::: "memory")
#define VM_WAIT() asm volatile("s_waitcnt vmcnt(0)" ::: "memory")
__device__ __forceinline__ unsigned f2bf(float f) { unsigned u = __builtin_bit_cast(unsigned, f); return (u + 0x7fffu + ((u >> 16) & 1u)) >> 16; }
__device__ __forceinline__ unsigned pk2(float lo, float hi) { return f2bf(lo) | (f2bf(hi) << 16); }
using pg8::bf_lo; using pg8::bf_hi; using pg8::sigm;

#define XB_TMO      128
#define XB_XCNT(j)  (256  + 64 * (j))
#define XB_XSUB(j)  (1280 + 64 * (j))
#define XB_XGEN(j)  (2304 + 64 * (j))
#define XB_TOP      3328
#define XB_TOPGEN   3392
#define XCD_BAR_WORDS 3456
#define XB_SPIN_CAP (1u << 18)

__device__ __forceinline__ unsigned xb_ld(unsigned* p)              { return __hip_atomic_load(p, __ATOMIC_RELAXED, __HIP_MEMORY_SCOPE_AGENT); }
__device__ __forceinline__ unsigned xb_add(unsigned* p, unsigned v) { return __hip_atomic_fetch_add(p, v, __ATOMIC_RELAXED, __HIP_MEMORY_SCOPE_AGENT); }
__device__ __forceinline__ unsigned xb_xcc_id() { return (unsigned)__builtin_amdgcn_s_getreg((3 << 11) | 20) & 0xFu; }
#define XB_SPIN(cond, bar) do { unsigned _sp = 0; while (cond) { __builtin_amdgcn_s_sleep(1); \
    if ((++_sp & 255u) == 0u) { if (xb_ld(&(bar)[XB_TMO])) break; if (_sp > XB_SPIN_CAP) { atomicAdd(&(bar)[XB_TMO], 1u); break; } } } } while (0)

struct XcdBarrier {
    unsigned* bar; unsigned x;
    volatile LAS unsigned* st;
};

__device__ __forceinline__ XcdBarrier xcd_barrier_post(unsigned* bar, volatile LAS unsigned* st) {
    XcdBarrier b; b.bar = bar; b.x = xb_xcc_id(); b.st = st;
    if (threadIdx.x == 0) (void)xb_add(&bar[XB_XCNT(b.x)], 1u);
    return b;
}
__device__ __forceinline__ void xcd_barrier_complete(unsigned* bar, unsigned x, unsigned& nloc, unsigned& nx) {
    const unsigned G = gridDim.x * gridDim.y * gridDim.z;
    unsigned sum, cnt, mine, sp = 0u;
    for (;;) {
        sum = 0u; cnt = 0u; mine = 0u;
#pragma unroll
        for (unsigned j = 0; j < 16; ++j) { const unsigned c = xb_ld(&bar[XB_XCNT(j)]); sum += c; cnt += (c > 0u) ? 1u : 0u; mine = (j == x) ? c : mine; }
        if (sum == G) break;
        __builtin_amdgcn_s_sleep(1);
        if ((++sp & 255u) == 0u) { if (xb_ld(&bar[XB_TMO])) break; if (sp > XB_SPIN_CAP) { atomicAdd(&bar[XB_TMO], 1u); break; } }
    }
    nloc = mine > 0u ? mine : 1u; nx = cnt > 0u ? cnt : 1u;
}

__device__ __forceinline__ void xcd_barrier(const XcdBarrier& b) {
    asm volatile("s_waitcnt vmcnt(0)" ::: "memory");
    __syncthreads();
    if (threadIdx.x == 0) {
        GAS unsigned* gbar_ = (GAS unsigned*)b.bar; unsigned bx = b.x; asm volatile("" : "+s"(gbar_), "+s"(bx)); unsigned* bar = (unsigned*)gbar_;
        __builtin_amdgcn_s_waitcnt(0);
        unsigned nloc = b.st[0], nx = b.st[1];
        if (nloc == 0u) { xcd_barrier_complete(bar, bx, nloc, nx); b.st[0] = nloc; b.st[1] = nx; }
        const unsigned old = xb_add(&bar[XB_XSUB(bx)], 1u);
        const unsigned gen = old / nloc;
        if (old + 1u == (gen + 1u) * nloc) {
            __builtin_amdgcn_fence(__ATOMIC_RELEASE, "agent");
            asm volatile("s_waitcnt vmcnt(0)" ::: "memory");
            const unsigned og = xb_add(&bar[XB_TOP], 1u);
            const unsigned tg = og / nx;
            if (og + 1u == (tg + 1u) * nx) xb_add(&bar[XB_TOPGEN], 1u);
            else XB_SPIN(xb_ld(&bar[XB_TOPGEN]) == tg, bar);
            __builtin_amdgcn_fence(__ATOMIC_ACQUIRE, "agent");
            xb_add(&bar[XB_XGEN(bx)], 1u);
            asm volatile("s_waitcnt vmcnt(0)" ::: "memory");
        } else {
            XB_SPIN(xb_ld(&bar[XB_XGEN(bx)]) == gen, bar);
            __builtin_amdgcn_fence(__ATOMIC_ACQUIRE, "agent");
            asm volatile("s_waitcnt vmcnt(0)" ::: "memory");
        }
    }
    __syncthreads();
}

struct Frame {
    LAS unsigned char* lds;
    volatile LAS unsigned* MISC;
    gu32* ctl;
    GAS unsigned char* ws;
    int tid, lane, wave, G;
};
#define CAS __attribute__((address_space(4)))
__device__ __forceinline__ const float* inp(int i) {
    const CAS unsigned char* k = (const CAS unsigned char*)__builtin_amdgcn_kernarg_segment_ptr();
    asm volatile("" : "+s"(k));
    return (const float*)*(GAS const float* const CAS*)(k + 8 * i);
}
__device__ __forceinline__ float* outp() {
    const CAS unsigned char* k = (const CAS unsigned char*)__builtin_amdgcn_kernarg_segment_ptr();
    asm volatile("" : "+s"(k));
    return (float*)*(GAS float* const CAS*)(k + 8 * N_IN);
}
template <class TP> __device__ __forceinline__ TP* wsp(Frame& F, size_t off) { GAS unsigned char* w = F.ws; asm volatile("" : "+s"(w)); return (TP*)(w + off); }

__device__ __forceinline__ float wave_sum(float v) {
#pragma unroll
    for (int o = 1; o < 64; o <<= 1) v += __shfl_xor(v, o);
    return v;
}
__device__ __forceinline__ float dot4(const f32x4 a, const f32x4 b) { return (a.x * b.x + a.y * b.y) + (a.z * b.z + a.w * b.w); }

__device__ __forceinline__ unsigned dbg_hash(unsigned a, unsigned b) { unsigned x = a * 2654435761u + b * 40503u + 0x9e3779b9u; x ^= x >> 15; x *= 2246822519u; x ^= x >> 13; x *= 3266489917u; x ^= x >> 16; return x; }
__device__ __forceinline__ void cksum_ptr(Frame& F, const v4u* p, size_t bytes, int slot) {
    const size_t n = bytes / 16, gt = (size_t)blockIdx.x * (NWAVES * 64) + F.tid, NGT = (size_t)F.G * NWAVES * 64; unsigned s = 0u;
    for (size_t i = gt; i < n; i += NGT) { const v4u v = p[i]; s += (v.x + v.y) + (v.z + v.w); }
#pragma unroll
    for (int o = 1; o < 64; o <<= 1) s += (unsigned)__shfl_xor((int)s, o);
    if (F.lane == 0) __hip_atomic_fetch_add((unsigned*)(F.ctl + slot), s, RLX_AGENT);
}
__device__ __forceinline__ void cksum(Frame& F, size_t off, size_t bytes, int slot) { cksum_ptr(F, wsp<v4u>(F, off), bytes, slot); }

enum { PK_ID = 0, PK_INPROJ = 1, PK_SWIGLU = 2, PK_FP8 = 0x100 };
constexpr int N8S = 11, W8_NS = 8192;
__device__ __forceinline__ unsigned q8(float x) { const float r = fminf(fmaxf(rintf(x), -127.f), 127.f); return (unsigned)((int)r) & 0xffu; }
__device__ __forceinline__ unsigned pk4_fp8(float a, float b, float c, float d) { return q8(a) | (q8(b) << 8) | (q8(c) << 16) | (q8(d) << 24); }
struct TEntry { int in_idx, K, N, kind, F, item0; unsigned src_off; unsigned sidx; unsigned long long dst_off; };
struct TTable { TEntry e[32]; int n, total; };
constexpr TTable make_table() {
    TTable t{}; int n = 0, it = 0;
    auto add = [&](int in_idx, size_t src_off, int K, int N, int kind, int F, size_t dst, unsigned sidx = 0) {
        t.e[n].in_idx = in_idx; t.e[n].K = K; t.e[n].N = N; t.e[n].kind = kind; t.e[n].F = F; t.e[n].item0 = it; t.e[n].src_off = (unsigned)src_off; t.e[n].sidx = sidx; t.e[n].dst_off = dst;
        it += (K / 64) * (N / 32); ++n; };
    for (int l = 0; l < 2; ++l) add(I_WIN, (size_t)l * D * INC, D, INC, PK_INPROJ | (MK_I8_INPROJ ? PK_FP8 : 0), 0, WS_WIN + (size_t)l * INC * D * (MK_I8_INPROJ ? 1 : 2), (unsigned)l);
    for (int l = 0; l < 2; ++l) add(I_WAO, (size_t)l * AV * D, AV, D, PK_ID, 0, WS_WA + (size_t)l * D * AV * 2);
    for (int l = 0; l < 2; ++l) add(I_WCO, (size_t)l * CCH * D, CCH, D, PK_ID, 0, WS_WC + (size_t)l * D * CCH * 2);
    for (int l = 0; l < 2; ++l) add(I_WO, (size_t)l * D * D, D, D, PK_ID, 0, WS_WO + (size_t)l * D * D * 2);
    add(I_WFGU, 0, D, 2 * FF, PK_SWIGLU | (MK_FP8_GU ? PK_FP8 : 0), FF, WS_WFGU, 2u);
    add(I_WFDN, 0, FF, D, PK_ID, 0, WS_WFDN);
    for (int l = 0; l < 2; ++l) add(I_WPG, (size_t)l * D * D, D, D, PK_ID, 0, WS_WPG + (size_t)l * D * D * 2);
    for (int l = 0; l < 2; ++l) add(I_WPP, (size_t)l * PLE * D, PLE, D, PK_ID, 0, WS_WPP + (size_t)l * D * PLE * 2);
    for (int e = 0; e < NE; ++e) add(I_WEGU, (size_t)e * D * 2 * FE, D, 2 * FE, PK_SWIGLU | (MK_FP8_GU ? PK_FP8 : 0), FE, WS_WEGU + (size_t)e * 2 * FE * D * (MK_FP8_GU ? 1 : 2), 3u + (unsigned)e);
    for (int e = 0; e < NE; ++e) add(I_WEDN, (size_t)e * FE * D, FE, D, PK_ID, 0, WS_WEDN + (size_t)e * D * FE * 2);
    t.n = n; t.total = it; return t;
}
__constant__ TTable g_tt = make_table();
static_assert(make_table().n == 30, "transpose table");

__device__ __forceinline__ int dest_row(int kind_, int F, int c) {
    const int kind = kind_ & 0xff;
    if (kind == PK_INPROJ) {
        if (c < 1024) { const int d = c & 63, dd = d & 31; return (c & ~63) + ((dd >> 2) << 3) + ((d >> 5) << 2) + (dd & 3); }
        if (c >= 1536 && c < 2560) { const int cc = c - 1536, h = cc >= 512 ? 1 : 0, r = cc - h * 512; return 1536 + ((r >> 7) << 8) + (h << 7) + (r & 127); }
        return c;
    }
    if (kind == PK_SWIGLU) { const int h = c >= F ? 1 : 0, r = c - h * F; return ((r >> 7) << 8) + (h << 7) + (r & 127); }
    return c;
}
__device__ __forceinline__ void p0_transpose_item(const float* W, int K, int N, bf16* WT, int kind, int FFd, LAS float* scr, int item, int lane, float W8_SCALE) {
    const int nblk = N / 32, kb = item / nblk, nb = item % nblk, k0 = 64 * kb, n0 = 32 * nb;
#pragma unroll 8
    for (int i = 0; i < 32; ++i) { const int kk = 2 * i + (lane >> 5); scr[kk * 33 + (lane & 31)] = W[(size_t)(k0 + kk) * N + n0 + (lane & 31)]; }
    LDS_WAIT(); asm volatile("" ::: "memory");
    const int c = lane & 7;
#pragma unroll
    for (int j = 0; j < 4; ++j) { const int n = (lane >> 3) + 8 * j; const LAS float* s = scr + (8 * c) * 33 + n;
        if (kind & PK_FP8) { v2u o8; o8.x = pk4_fp8(s[0 * 33] * W8_SCALE, s[1 * 33] * W8_SCALE, s[2 * 33] * W8_SCALE, s[3 * 33] * W8_SCALE); o8.y = pk4_fp8(s[4 * 33] * W8_SCALE, s[5 * 33] * W8_SCALE, s[6 * 33] * W8_SCALE, s[7 * 33] * W8_SCALE);
            *(v2u*)((unsigned char*)WT + (size_t)dest_row(kind, FFd, n0 + n) * K + k0 + 8 * c) = o8; }
        else { v4u o; o.x = pk2(s[0 * 33], s[1 * 33]); o.y = pk2(s[2 * 33], s[3 * 33]); o.z = pk2(s[4 * 33], s[5 * 33]); o.w = pk2(s[6 * 33], s[7 * 33]);
        *(v4u*)(WT + (size_t)dest_row(kind, FFd, n0 + n) * K + k0 + 8 * c) = o; } }
    LDS_WAIT(); asm volatile("" ::: "memory");
}
__device__ __forceinline__ void norm_rows(Frame& F, const float* src, const float* gain, bf16* dst, bool fp8 = false) {
    const int gw = blockIdx.x * NWAVES + F.wave, NGW = F.G * NWAVES;
    f32x4 g[4];
#pragma unroll
    for (int j = 0; j < 4; ++j) g[j] = ((const f32x4*)gain)[F.lane + 64 * j];
    for (int m = gw; m < T; m += NGW) {
        const f32x4* xr = (const f32x4*)(src + (size_t)m * D) + F.lane;
        f32x4 v[4]; float s = 0.f;
#pragma unroll
        for (int j = 0; j < 4; ++j) { v[j] = xr[64 * j]; s += dot4(v[j], v[j]); }
        const float rstd = 1.f / sqrtf(wave_sum(s) * (1.f / D) + EPS);
        if (fp8) { float am = 0.f;
#pragma unroll
            for (int j = 0; j < 4; ++j) { v[j] = v[j] * rstd * g[j]; am = fmaxf(am, fmaxf(fmaxf(fabsf(v[j].x), fabsf(v[j].y)), fmaxf(fabsf(v[j].z), fabsf(v[j].w)))); }
#pragma unroll
            for (int o = 1; o < 64; o <<= 1) am = fmaxf(am, __shfl_xor(am, o));
            am = fmaxf(am, 1e-20f); const float qs = 127.f / am;
            if (F.lane == 0) wsp<float>(F, WS_RS)[m] = am * (1.f / 127.f);
            unsigned* o4 = (unsigned*)((unsigned char*)dst + (size_t)m * D) + F.lane;
#pragma unroll
            for (int j = 0; j < 4; ++j) o4[64 * j] = pk4_fp8(v[j].x * qs, v[j].y * qs, v[j].z * qs, v[j].w * qs); }
        else { unsigned long long* o8 = (unsigned long long*)(dst + (size_t)m * D) + F.lane;
#pragma unroll
        for (int j = 0; j < 4; ++j) { const f32x4 y = v[j] * rstd * g[j]; o8[64 * j] = (unsigned long long)pk2(y.x, y.y) | ((unsigned long long)pk2(y.z, y.w) << 32); } }
    }
}
__device__ __forceinline__ void final_norm(Frame& F, const float* src, const float* gain, float* dst, float dbg_scale = 1.f) {
    const int gw = blockIdx.x * NWAVES + F.wave, NGW = F.G * NWAVES;
    f32x4 g[4];
#pragma unroll
    for (int j = 0; j < 4; ++j) g[j] = ((const f32x4*)gain)[F.lane + 64 * j];
    for (int m = gw; m < T; m += NGW) {
        const f32x4* xr = (const f32x4*)(src + (size_t)m * D) + F.lane;
        f32x4 v[4]; float s = 0.f;
#pragma unroll
        for (int j = 0; j < 4; ++j) { v[j] = xr[64 * j]; s += dot4(v[j], v[j]); }
        const float rstd = 1.f / sqrtf(wave_sum(s) * (1.f / D) + EPS);
        f32x4* o = (f32x4*)(dst + (size_t)m * D) + F.lane;
#pragma unroll
        for (int j = 0; j < 4; ++j) o[64 * j] = v[j] * rstd * g[j] * dbg_scale;
    }
}
__device__ __forceinline__ void p0_prologue(Frame& F) {
    LAS float* scr = (LAS float*)(F.lds + RING_OFF + F.wave * 16384);
    const int gw = blockIdx.x * NWAVES + F.wave, NGW = F.G * NWAVES;
    LAS float* wq = (LAS float*)(F.lds + TP_OFF + 64);
    { LAS float* red = wq + 16;
      float sacc[N8S];
#pragma unroll
      for (int mi = 0; mi < N8S; ++mi) {
          const float* w = mi < 2 ? inp(I_WIN) + (size_t)mi * D * INC : mi == 2 ? inp(I_WFGU) : inp(I_WEGU) + (size_t)(mi - 3) * D * 2 * FE;
          float a = 0.f;
#pragma unroll
          for (int i = 0; i < W8_NS / 4 / (NWAVES * 64); ++i) { const f32x4 t = ((const f32x4*)w)[F.tid + i * NWAVES * 64]; a += dot4(t, t); }
          sacc[mi] = a; }
#pragma unroll
      for (int mi = 0; mi < N8S; ++mi) { const float r = wave_sum(sacc[mi]); if (F.lane == 0) red[mi * NWAVES + F.wave] = r; }
      __syncthreads();
      if (F.tid < N8S) { float tot = 0.f; for (int k = 0; k < NWAVES; ++k) tot += red[F.tid * NWAVES + k];
          const float rms = fmaxf(sqrtf(tot * (1.f / W8_NS)), 1e-20f); wq[F.tid] = 127.f / (5.f * rms);
          if (blockIdx.x == 0) wsp<float>(F, WS_WSC)[F.tid] = (5.f * rms) * (1.f / 127.f); }
      __syncthreads(); }
    const int ntot = g_tt.total, nent = g_tt.n;
    for (int it = gw; it < ntot; it += NGW) {
        int ei = 0;
        while (ei + 1 < nent && it >= g_tt.e[ei + 1].item0) ++ei;
        const TEntry& te = g_tt.e[ei];
        p0_transpose_item(inp(te.in_idx) + te.src_off, te.K, te.N, wsp<bf16>(F, te.dst_off), te.kind, te.F, scr, it - te.item0, F.lane, (te.kind & PK_FP8) ? wq[te.sidx] : 1.f);
    }
    { const int gt = blockIdx.x * (NWAVES * 64) + F.tid, NGT = F.G * NWAVES * 64; const float* p = inp(I_P); bf16* pb = wsp<bf16>(F, WS_PB);
      for (int i = gt; i < 2 * T * PLE / 8; i += NGT) { const f32x4 a = *(const f32x4*)(p + (size_t)i * 8), b = *(const f32x4*)(p + (size_t)i * 8 + 4);
          v4u o; o.x = pk2(a.x, a.y); o.y = pk2(a.z, a.w); o.z = pk2(b.x, b.y); o.w = pk2(b.z, b.w); *(v4u*)(pb + (size_t)i * 8) = o; } }
    { const int gt = blockIdx.x * (NWAVES * 64) + F.tid, NGT = F.G * NWAVES * 64; float* rope = wsp<float>(F, WS_ROPE);
      for (int i = gt; i < SEQ * 32; i += NGT) { const int pos = i >> 5, f = i & 31;
          const float inv = exp2f(-(float)(2 * f) * (1.0f / 64.0f) * 13.287712379549449f); const float ang = (float)pos * inv;
          double rev = (double)ang * 0.15915494309189535; rev -= floor(rev); const float rv = (float)rev;
          rope[pos * 64 + f] = __builtin_amdgcn_cosf(rv); rope[pos * 64 + 32 + f] = __builtin_amdgcn_sinf(rv); } }
    if (blockIdx.x == 0 && F.wave == 0) {
        for (int l = 0; l < DEPTH; ++l) { const float* lf = inp(I_LAM) + l * 4 * HD;
            const float a = wave_sum(lf[F.lane] * lf[HD + F.lane]), b = wave_sum(lf[2 * HD + F.lane] * lf[3 * HD + F.lane]);
            const float lam_init = 0.8f - 0.6f * expf(-0.3f * (float)l);
            if (F.lane == 0) wsp<float>(F, WS_SCAL)[l] = expf(a) - expf(b) + lam_init; }
    }
#ifdef DBG_TWOPASS
    if (blockIdx.x == 0 && F.tid < 8) __hip_atomic_store((unsigned*)(F.ctl + CW_GCNT + 64 * F.tid), 0u, RLX_AGENT);
#endif
    norm_rows(F, inp(I_X), inp(I_GMIX), wsp<bf16>(F, WS_H), MK_I8_INPROJ != 0);
}

__device__ __forceinline__ void route_phase(Frame& F, const float* src, const float* gain, bf16* dst) {
    LAS float* wrT = (LAS float*)(F.lds);
    LAS unsigned* lcnt = (LAS unsigned*)(F.lds + 32768);
    LAS unsigned* gbase = lcnt + 8;
    LAS int* rinfo = (LAS int*)(F.lds + 32768 + 64);
    const float* wr = inp(I_WR); const float* br = inp(I_BR);
    int* rti = wsp<int>(F, WS_RTI); float* rtw = wsp<float>(F, WS_RTW);
    for (int i = F.tid; i < NE * D; i += NWAVES * 64) wrT[(i & 7) * D + (i >> 3)] = wr[i];
    f32x4 g[4];
#pragma unroll
    for (int j = 0; j < 4; ++j) g[j] = ((const f32x4*)gain)[F.lane + 64 * j];
    __syncthreads();
    for (int item = blockIdx.x; item < T / 64; item += F.G) {
        if (F.tid < 8) lcnt[F.tid] = 0u;
        __syncthreads();
        for (int rr = 0; rr < 8; ++rr) {
            const int lr = F.wave * 8 + rr, m = item * 64 + lr;
            const f32x4* xr = (const f32x4*)(src + (size_t)m * D) + F.lane;
            f32x4 v[4]; float s = 0.f;
#pragma unroll
            for (int j = 0; j < 4; ++j) { v[j] = xr[64 * j]; s += dot4(v[j], v[j]); }
            const float rstd = 1.f / sqrtf(wave_sum(s) * (1.f / D) + EPS);
#if MK_FP8_GU
            unsigned* o4 = (unsigned*)((unsigned char*)dst + (size_t)m * D) + F.lane;
            float am = 0.f;
#pragma unroll
            for (int j = 0; j < 4; ++j) { v[j] = v[j] * rstd * g[j]; am = fmaxf(am, fmaxf(fmaxf(fabsf(v[j].x), fabsf(v[j].y)), fmaxf(fabsf(v[j].z), fabsf(v[j].w)))); }
#pragma unroll
            for (int o = 1; o < 64; o <<= 1) am = fmaxf(am, __shfl_xor(am, o));
            am = fmaxf(am, 1e-20f); const float qs = 127.f / am;
            if (F.lane == 0) wsp<float>(F, WS_RS)[m] = am * (1.f / 127.f);
#pragma unroll
            for (int j = 0; j < 4; ++j) o4[64 * j] = pk4_fp8(v[j].x * qs, v[j].y * qs, v[j].z * qs, v[j].w * qs);
#else
            unsigned long long* o8 = (unsigned long long*)(dst + (size_t)m * D) + F.lane;
#pragma unroll
            for (int j = 0; j < 4; ++j) { v[j] = v[j] * rstd * g[j]; o8[64 * j] = (unsigned long long)pk2(v[j].x, v[j].y) | ((unsigned long long)pk2(v[j].z, v[j].w) << 32); }
#endif
            float lg[8];
#pragma unroll
            for (int e = 0; e < 8; ++e) { float t = 0.f;
#pragma unroll
                for (int j = 0; j < 4; ++j) t += dot4(v[j], ((const LAS f32x4*)(wrT + e * D))[F.lane + 64 * j]);
                lg[e] = wave_sum(t) + br[e]; }
            int e1 = 0; float v1 = lg[0];
#pragma unroll
            for (int e = 1; e < 8; ++e) if (lg[e] > v1) { v1 = lg[e]; e1 = e; }
            int e2 = -1; float v2 = -INFINITY;
#pragma unroll
            for (int e = 0; e < 8; ++e) if (e != e1 && lg[e] > v2) { v2 = lg[e]; e2 = e; }
            if (e2 < 0) e2 = (e1 == 0) ? 1 : 0;
            const float ex = expf(v2 - v1), w1 = 1.f / (1.f + ex), w2 = ex / (1.f + ex);
            if (F.lane == 0) {
                const unsigned lp1 = __hip_atomic_fetch_add((unsigned*)&lcnt[e1], 1u, __ATOMIC_RELAXED, __HIP_MEMORY_SCOPE_WORKGROUP);
                const unsigned lp2 = __hip_atomic_fetch_add((unsigned*)&lcnt[e2], 1u, __ATOMIC_RELAXED, __HIP_MEMORY_SCOPE_WORKGROUP);
                rinfo[lr * 4 + 0] = e1; rinfo[lr * 4 + 1] = (int)lp1; rinfo[lr * 4 + 2] = e2; rinfo[lr * 4 + 3] = (int)lp2;
                rtw[(size_t)m * 2] = w1; rtw[(size_t)m * 2 + 1] = w2; }
        }
        __syncthreads();
        if (F.tid < 8) gbase[F.tid] = __hip_atomic_fetch_add((unsigned*)(F.ctl + CW_GCNT + 64 * F.tid), lcnt[F.tid], RLX_AGENT);
        __syncthreads();
        if (F.tid < 64) { const int m = item * 64 + F.tid; const int e1 = rinfo[F.tid * 4], lp1 = rinfo[F.tid * 4 + 1], e2 = rinfo[F.tid * 4 + 2], lp2 = rinfo[F.tid * 4 + 3];
            int* o = rti + (size_t)m * 4; o[0] = e1; o[1] = (int)gbase[e1] + lp1; o[2] = e2; o[3] = (int)gbase[e2] + lp2; }
        __syncthreads();
    }
}
__device__ __forceinline__ void load_counts(Frame& F, unsigned (&cnt)[8]) {
#pragma unroll
    for (int e = 0; e < 8; ++e) cnt[e] = (unsigned)__builtin_amdgcn_readfirstlane((int)__hip_atomic_load((unsigned*)(F.ctl + CW_GCNT + 64 * e), RLX_AGENT));
}
__device__ __forceinline__ void scatter_phase(Frame& F) {
    unsigned cnt[8]; load_counts(F, cnt);
    int coff[8]; { int s = 0;
#pragma unroll
        for (int e = 0; e < 8; ++e) { coff[e] = s; s += (int)((cnt[e] + 255u) & ~255u); } }
    const int gw = blockIdx.x * NWAVES + F.wave, NGW = F.G * NWAVES;
    const int* rti = wsp<int>(F, WS_RTI); int* rsel = wsp<int>(F, WS_RSEL); const bf16* H = wsp<bf16>(F, WS_H); bf16* HP = wsp<bf16>(F, WS_HP);
    for (int m = gw; m < T; m += NGW) {
        const int e1 = rti[(size_t)m * 4], p1 = rti[(size_t)m * 4 + 1], e2 = rti[(size_t)m * 4 + 2], p2 = rti[(size_t)m * 4 + 3];
        int c1 = 0, c2 = 0;
#pragma unroll
        for (int e = 0; e < 8; ++e) { c1 = (e1 == e) ? coff[e] : c1; c2 = (e2 == e) ? coff[e] : c2; }
        const int r1 = c1 + p1, r2 = c2 + p2;
#if MK_FP8_GU
        const v4u a = ((const v4u*)((const unsigned char*)H + (size_t)m * D))[F.lane];
        ((v4u*)((unsigned char*)HP + (size_t)r1 * D))[F.lane] = a; ((v4u*)((unsigned char*)HP + (size_t)r2 * D))[F.lane] = a;
        if (F.lane == 0) { const float rsv = wsp<float>(F, WS_RS)[m]; wsp<float>(F, WS_RSP)[r1] = rsv; wsp<float>(F, WS_RSP)[r2] = rsv; }
#else
        const v4u* s = (const v4u*)(H + (size_t)m * D); const v4u a = s[F.lane], b = s[F.lane + 64];
        v4u* d1 = (v4u*)(HP + (size_t)r1 * D); v4u* d2 = (v4u*)(HP + (size_t)r2 * D);
        d1[F.lane] = a; d1[F.lane + 64] = b; d2[F.lane] = a; d2[F.lane + 64] = b;
#endif
        if (F.lane == 0) { rsel[(size_t)m * 2] = r1; rsel[(size_t)m * 2 + 1] = r2; }
    }
}
__device__ __forceinline__ void combine_norm_phase(Frame& F, float* X, const float* gain, bf16* dst) {
    const int gw = blockIdx.x * NWAVES + F.wave, NGW = F.G * NWAVES;
    const int* rsel = wsp<int>(F, WS_RSEL); const float* rtw = wsp<float>(F, WS_RTW); const float* Y = wsp<float>(F, WS_Y);
    f32x4 g[4];
#pragma unroll
    for (int j = 0; j < 4; ++j) g[j] = ((const f32x4*)gain)[F.lane + 64 * j];
    for (int m = gw; m < T; m += NGW) {
        const int r1 = rsel[(size_t)m * 2], r2 = rsel[(size_t)m * 2 + 1]; const float w1 = rtw[(size_t)m * 2], w2 = rtw[(size_t)m * 2 + 1];
        f32x4* xr = (f32x4*)(X + (size_t)m * D) + F.lane; const f32x4* y1 = (const f32x4*)(Y + (size_t)r1 * D) + F.lane; const f32x4* y2 = (const f32x4*)(Y + (size_t)r2 * D) + F.lane;
        f32x4 v[4]; float s = 0.f;
#pragma unroll
        for (int j = 0; j < 4; ++j) { v[j] = xr[64 * j] + (y1[64 * j] * w1 + y2[64 * j] * w2); xr[64 * j] = v[j]; s += dot4(v[j], v[j]); }
        const float rstd = 1.f / sqrtf(wave_sum(s) * (1.f / D) + EPS);
        unsigned long long* o8 = (unsigned long long*)(dst + (size_t)m * D) + F.lane;
#pragma unroll
        for (int j = 0; j < 4; ++j) { const f32x4 y = v[j] * rstd * g[j]; o8[64 * j] = (unsigned long long)pk2(y.x, y.y) | ((unsigned long long)pk2(y.z, y.w) << 32); }
    }
}

__device__ __forceinline__ void conv_phase(Frame& F, int layer) {
    LAS bf16* zt = (LAS bf16*)(F.lds);
    LAS float* wl = (LAS float*)(F.lds + 65536);
    const float* cw = inp(I_CW) + (size_t)layer * CK * CCH; const float* cb = inp(I_CB) + layer * CCH;
    const float* lg = inp(I_CLG) + layer * CCH; const float* lb = inp(I_CLB) + layer * CCH;
    const bf16* Z = wsp<bf16>(F, WS_Z); bf16* ZC = wsp<bf16>(F, WS_ZC);
    for (int i = F.tid; i < CK * CCH; i += NWAVES * 64) { const int tap = i >> 9, ch = i & 511; wl[((tap * 2 + ((ch >> 2) & 1)) * 64 + (ch >> 3)) * 4 + (ch & 3)] = cw[i]; }
    const int c0 = 8 * F.lane;
    const f32x4 b_lo = *(const f32x4*)(cb + c0), b_hi = *(const f32x4*)(cb + c0 + 4), g_lo = *(const f32x4*)(lg + c0), g_hi = *(const f32x4*)(lg + c0 + 4), o_lo = *(const f32x4*)(lb + c0), o_hi = *(const f32x4*)(lb + c0 + 4);
    for (int unit = blockIdx.x; unit < BATCH * (SEQ / 32); unit += F.G) {
        const int b = unit / (SEQ / 32), t0 = (unit % (SEQ / 32)) * 32;
        __syncthreads();
        for (int i = F.tid; i < 62 * 64; i += NWAVES * 64) { const int r = i >> 6, c16 = i & 63, t = t0 - CPAD + r;
            v4u val = (v4u){0u, 0u, 0u, 0u}; if (t >= 0 && t < SEQ) val = *(const v4u*)(Z + ((size_t)(b * SEQ + t)) * CCH + c16 * 8);
            *(LAS v4u*)(zt + r * CCH + c16 * 8) = val; }
        __syncthreads();
        const int r0 = 4 * F.wave;
        f32x4 alo[4], ahi[4];
#pragma unroll
        for (int rr = 0; rr < 4; ++rr) { alo[rr] = b_lo; ahi[rr] = b_hi; }
        f32x4 zlo[4], zhi[4];
#define CONV_LDZ(slot, rowi) do { const v4u zz = *(const LAS v4u*)(zt + (r0 + (rowi)) * CCH + c0); \
        zlo[slot] = (f32x4){bf_lo(zz.x), bf_hi(zz.x), bf_lo(zz.y), bf_hi(zz.y)}; zhi[slot] = (f32x4){bf_lo(zz.z), bf_hi(zz.z), bf_lo(zz.w), bf_hi(zz.w)}; } while (0)
        CONV_LDZ(0, 0); CONV_LDZ(1, 1); CONV_LDZ(2, 2);
#pragma unroll
        for (int tap = 0; tap < CK; ++tap) {
            CONV_LDZ((tap + 3) & 3, tap + 3);
            const f32x4 wlo = *(const LAS f32x4*)(wl + ((tap * 2 + 0) * 64 + F.lane) * 4), whi = *(const LAS f32x4*)(wl + ((tap * 2 + 1) * 64 + F.lane) * 4);
#pragma unroll
            for (int rr = 0; rr < 4; ++rr) { alo[rr] += wlo * zlo[(tap + rr) & 3]; ahi[rr] += whi * zhi[(tap + rr) & 3]; }
        }
#undef CONV_LDZ
#pragma unroll
        for (int rr = 0; rr < 4; ++rr) {
            const float mean = wave_sum((alo[rr].x + alo[rr].y) + (alo[rr].z + alo[rr].w) + (ahi[rr].x + ahi[rr].y) + (ahi[rr].z + ahi[rr].w)) * (1.f / CCH);
            const f32x4 dl = alo[rr] - mean, dh = ahi[rr] - mean;
            const float rstd = 1.f / sqrtf(wave_sum(dot4(dl, dl) + dot4(dh, dh)) * (1.f / CCH) + EPS);
            f32x4 yl = dl * rstd * g_lo + o_lo, yh = dh * rstd * g_hi + o_hi;
            yl = yl * pg8::sigm4(yl); yh = yh * pg8::sigm4(yh);
            *(v4u*)(ZC + ((size_t)(b * SEQ + t0 + r0 + rr)) * CCH + c0) = pg8::pack8(yl, yh);
        }
    }
    __syncthreads();
}

__device__ __forceinline__ void conv_naive_phase(Frame& F, int layer) {
    const float* cw = inp(I_CW) + (size_t)layer * CK * CCH; const float* cb = inp(I_CB) + layer * CCH;
    const float* lg = inp(I_CLG) + layer * CCH; const float* lb = inp(I_CLB) + layer * CCH;
    const bf16* Z = wsp<bf16>(F, WS_Z); bf16* ZC = wsp<bf16>(F, WS_ZC);
    const int gw = blockIdx.x * NWAVES + F.wave, NGW = F.G * NWAVES, c0 = 8 * F.lane;
    for (int m = gw; m < T; m += NGW) {
        const int b = m / SEQ, t = m % SEQ;
        f32x4 alo = *(const f32x4*)(cb + c0), ahi = *(const f32x4*)(cb + c0 + 4);
        for (int tap = 0; tap < CK; ++tap) { const int tt = t + tap - CPAD; if (tt < 0 || tt >= SEQ) continue;
            const v4u zz = *(const v4u*)(Z + ((size_t)(b * SEQ + tt)) * CCH + c0);
            const f32x4 wlo = *(const f32x4*)(cw + tap * CCH + c0), whi = *(const f32x4*)(cw + tap * CCH + c0 + 4);
            alo += wlo * (f32x4){bf_lo(zz.x), bf_hi(zz.x), bf_lo(zz.y), bf_hi(zz.y)}; ahi += whi * (f32x4){bf_lo(zz.z), bf_hi(zz.z), bf_lo(zz.w), bf_hi(zz.w)}; }
        const float mean = wave_sum((alo.x + alo.y) + (alo.z + alo.w) + (ahi.x + ahi.y) + (ahi.z + ahi.w)) * (1.f / CCH);
        const f32x4 dl = alo - mean, dh = ahi - mean;
        const float rstd = 1.f / sqrtf(wave_sum(dot4(dl, dl) + dot4(dh, dh)) * (1.f / CCH) + EPS);
        f32x4 yl = dl * rstd * *(const f32x4*)(lg + c0) + *(const f32x4*)(lb + c0), yh = dh * rstd * *(const f32x4*)(lg + c0 + 4) + *(const f32x4*)(lb + c0 + 4);
        yl = yl * pg8::sigm4(yl); yh = yh * pg8::sigm4(yh);
        *(v4u*)(ZC + (size_t)m * CCH + c0) = pg8::pack8(yl, yh);
    }
}

#ifdef DBG_CHECK_INPROJ
__device__ __forceinline__ float chk_col(const float* w, const f32x4 (&hv)[4], int lane, int c) {
    float t = 0.f;
#pragma unroll
    for (int j = 0; j < 4; ++j) { const int k = 4 * (lane + 64 * j); t += hv[j].x * w[(size_t)(k + 0) * INC + c] + hv[j].y * w[(size_t)(k + 1) * INC + c] + hv[j].z * w[(size_t)(k + 2) * INC + c] + hv[j].w * w[(size_t)(k + 3) * INC + c]; }
    return wave_sum(t);
}
__device__ __forceinline__ bool chk_bad(float got, float exp_) { return !(fabsf(got - exp_) <= 0.02f + 0.02f * fabsf(exp_)); }
__device__ __forceinline__ void check_inproj(Frame& F, int layer) {
    const int gw = blockIdx.x * NWAVES + F.wave; const int m = (int)(dbg_hash((unsigned)gw, 5u) % (unsigned)T), pos = m % SEQ;
    const float* x = layer == 0 ? inp(I_X) : (const float*)wsp<float>(F, WS_X); const float* gain = inp(I_GMIX) + (size_t)layer * D; const float* w = inp(I_WIN) + (size_t)layer * D * INC; const float* rope = wsp<float>(F, WS_ROPE);
    const bf16* Q = wsp<bf16>(F, WS_Q); const bf16* K = wsp<bf16>(F, WS_K); const bf16* V = wsp<bf16>(F, WS_V); const bf16* Z = wsp<bf16>(F, WS_Z); const bf16* SG = wsp<bf16>(F, WS_SG);
    f32x4 hv[4]; float s = 0.f;
#pragma unroll
    for (int j = 0; j < 4; ++j) { hv[j] = ((const f32x4*)(x + (size_t)m * D))[F.lane + 64 * j]; s += dot4(hv[j], hv[j]); }
    const float rstd = 1.f / sqrtf(wave_sum(s) * (1.f / D) + EPS);
#pragma unroll
    for (int j = 0; j < 4; ++j) hv[j] = hv[j] * rstd * ((const f32x4*)gain)[F.lane + 64 * j];
    unsigned flags = 0u;
    { for (int i = 0; i < 2; ++i) { const int c0_ = (int)(dbg_hash((unsigned)gw, 100u + i) % 512u), c = (c0_ & ~63) | (c0_ & 31), f = c & 31; const float t1 = chk_col(w, hv, F.lane, c), t2 = chk_col(w, hv, F.lane, c + 32);
        const float cs = rope[pos * 64 + f], sn = rope[pos * 64 + 32 + f];
        if (chk_bad(bf_lo((unsigned)Q[(size_t)m * 512 + c]), (t1 * cs - t2 * sn) * QSCALE) || chk_bad(bf_lo((unsigned)Q[(size_t)m * 512 + c + 32]), (t2 * cs + t1 * sn) * QSCALE)) flags |= 1u; } }
    { const int c0_ = (int)(dbg_hash((unsigned)gw, 102u) % 512u), c = (c0_ & ~63) | (c0_ & 31), f = c & 31; const float t1 = chk_col(w, hv, F.lane, 512 + c), t2 = chk_col(w, hv, F.lane, 512 + c + 32);
        const float cs = rope[pos * 64 + f], sn = rope[pos * 64 + 32 + f];
        if (chk_bad(bf_lo((unsigned)K[(size_t)m * 512 + c]), t1 * cs - t2 * sn) || chk_bad(bf_lo((unsigned)K[(size_t)m * 512 + c + 32]), t2 * cs + t1 * sn)) flags |= 1u; }
    { const int cv = (int)(dbg_hash((unsigned)gw, 103u) % 512u); const float v = chk_col(w, hv, F.lane, 1024 + cv); if (chk_bad(bf_lo((unsigned)V[(size_t)m * 512 + cv]), v)) flags |= 2u; }
    { int cz[2]; cz[0] = (int)(dbg_hash((unsigned)gw, 104u) % 512u); cz[1] = (int)(dbg_hash((unsigned)gw, 105u) % 512u); for (int i = 0; i < 2; ++i) { const float a = chk_col(w, hv, F.lane, 1536 + cz[i]), g = chk_col(w, hv, F.lane, 2048 + cz[i]);
        if (chk_bad(bf_lo((unsigned)Z[(size_t)m * 512 + cz[i]]), a / (1.f + expf(-g)))) flags |= 2u; } }
    { const int ca = (int)(dbg_hash((unsigned)gw, 106u) % 1024u), cb = (int)(dbg_hash((unsigned)gw, 107u) % 1024u); const float a = chk_col(w, hv, F.lane, 2560 + ca), b = chk_col(w, hv, F.lane, 2560 + 1024 + cb);
#ifdef DBG_SG_DETAIL
        unsigned code = 0u;
        if (chk_bad(bf_lo((unsigned)SG[(size_t)m * 2048 + ca]), 1.f / (1.f + expf(-a)))) code = (unsigned)(DBG_SG_DETAIL == 1 ? 18 - (10 + ca / 256) : (DBG_SG_DETAIL == 2 ? 1 + ((m % 256) >> 4) : DBG_SG_DETAIL == 3 ? 16 - ((m % 256) >> 4) : 1 + ((m >> 8) & 15)));
        if (chk_bad(bf_lo((unsigned)SG[(size_t)m * 2048 + 1024 + cb]), 1.f / (1.f + expf(-b)))) { const unsigned c2 = (unsigned)(DBG_SG_DETAIL == 1 ? 18 - (14 + cb / 256) : (DBG_SG_DETAIL == 2 ? 1 + ((m % 256) >> 4) : DBG_SG_DETAIL == 3 ? 16 - ((m % 256) >> 4) : 1 + ((m >> 8) & 15))); code = code > c2 ? code : c2; }
#if DBG_SG_DETAIL == 5
        if (F.lane == 0 && code) __hip_atomic_fetch_add((unsigned*)(F.ctl + 17), 1u, RLX_AGENT);
#else
        if (F.lane == 0 && code) __hip_atomic_fetch_max((unsigned*)(F.ctl + 16), code, RLX_AGENT);
#endif
#else
        if (chk_bad(bf_lo((unsigned)SG[(size_t)m * 2048 + ca]), 1.f / (1.f + expf(-a))) || chk_bad(bf_lo((unsigned)SG[(size_t)m * 2048 + 1024 + cb]), 1.f / (1.f + expf(-b)))) flags |= 4u;
#endif
    }
    if (F.lane == 0 && flags) __hip_atomic_fetch_or((unsigned*)(F.ctl + 16), flags, RLX_AGENT);
}
#endif

#ifdef DBG_CHECK_ACT
__device__ __forceinline__ void check_act(Frame& F) {
    const int gw = blockIdx.x * NWAVES + F.wave; const int m = (int)(dbg_hash((unsigned)gw, 3u) % (unsigned)T);
    const float* x = wsp<float>(F, WS_X); const float* gain = inp(I_GFFN); const float* w = inp(I_WFGU); const bf16* ACT = wsp<bf16>(F, WS_ACT);
    f32x4 hv[4]; float s = 0.f;
#pragma unroll
    for (int j = 0; j < 4; ++j) { hv[j] = ((const f32x4*)(x + (size_t)m * D))[F.lane + 64 * j]; s += dot4(hv[j], hv[j]); }
    const float rstd = 1.f / sqrtf(wave_sum(s) * (1.f / D) + EPS);
#pragma unroll
    for (int j = 0; j < 4; ++j) hv[j] = hv[j] * rstd * ((const f32x4*)gain)[F.lane + 64 * j];
    unsigned flags = 0u; int cj[4]; for (int i = 0; i < 4; ++i) cj[i] = (int)(dbg_hash((unsigned)gw, 110u + i) % (unsigned)FF);
    for (int i = 0; i < 4; ++i) { float g = 0.f, u = 0.f;
#pragma unroll
        for (int j = 0; j < 4; ++j) { const int k = 4 * (F.lane + 64 * j);
            g += hv[j].x * w[(size_t)(k + 0) * (2 * FF) + cj[i]] + hv[j].y * w[(size_t)(k + 1) * (2 * FF) + cj[i]] + hv[j].z * w[(size_t)(k + 2) * (2 * FF) + cj[i]] + hv[j].w * w[(size_t)(k + 3) * (2 * FF) + cj[i]];
            u += hv[j].x * w[(size_t)(k + 0) * (2 * FF) + FF + cj[i]] + hv[j].y * w[(size_t)(k + 1) * (2 * FF) + FF + cj[i]] + hv[j].z * w[(size_t)(k + 2) * (2 * FF) + FF + cj[i]] + hv[j].w * w[(size_t)(k + 3) * (2 * FF) + FF + cj[i]]; }
        g = wave_sum(g); u = wave_sum(u);
        const float ex = g / (1.f + expf(-g)) * u, got = bf_lo((unsigned)ACT[(size_t)m * FF + cj[i]]);
        if (!(fabsf(got - ex) <= 0.03f + 0.03f * fabsf(ex))) flags |= 8u; }
    if (F.lane == 0 && flags) __hip_atomic_fetch_or((unsigned*)(F.ctl + 16), flags, RLX_AGENT);
}
#endif

#ifdef DBG_CHECK_MIX
__device__ __forceinline__ float chk_dot_bf(const bf16* a, int K, const float* w, int ldw, int c, int lane) {
    float t = 0.f; for (int k = lane; k < K; k += 64) t += bf_lo((unsigned)a[k]) * w[(size_t)k * ldw + c]; return wave_sum(t); }
__device__ __forceinline__ void check_mix(Frame& F, int layer) {
    const int gw = blockIdx.x * NWAVES + F.wave; const int m = (int)(dbg_hash((unsigned)gw, 1u) % (unsigned)T);
    const bf16* OB = wsp<bf16>(F, WS_OB); const bf16* ZC = wsp<bf16>(F, WS_ZC); const bf16* SG = wsp<bf16>(F, WS_SG); const bf16* MIX = wsp<bf16>(F, WS_MIX);
    unsigned flags = 0u; int cc[4]; for (int i = 0; i < 4; ++i) cc[i] = (int)(dbg_hash((unsigned)gw, 120u + i) % (unsigned)D);
    for (int i = 0; i < 4; ++i) { const int c = cc[i];
        const float ad = chk_dot_bf(OB + (size_t)m * AV, AV, inp(I_WAO) + (size_t)layer * AV * D, D, c, F.lane), cd = chk_dot_bf(ZC + (size_t)m * CCH, CCH, inp(I_WCO) + (size_t)layer * CCH * D, D, c, F.lane);
        const float ex = bf_lo((unsigned)SG[(size_t)m * 2048 + c]) * ad + bf_lo((unsigned)SG[(size_t)m * 2048 + 1024 + c]) * cd, got = bf_lo((unsigned)MIX[(size_t)m * D + c]);
        if (!(fabsf(got - ex) <= 0.02f + 0.02f * fabsf(ex))) flags |= 16u; }
    if (F.lane == 0 && flags) __hip_atomic_fetch_or((unsigned*)(F.ctl + 16), flags, RLX_AGENT);
}
__device__ __forceinline__ void snap_wo(Frame& F) { const int gw = blockIdx.x * NWAVES + F.wave; const int m = (int)(dbg_hash((unsigned)gw, 6u) % (unsigned)T);
    if (F.lane < 4) wsp<float>(F, 3 * MiB + 768 * 1024)[(size_t)gw * 4 + F.lane] = wsp<float>(F, WS_X)[(size_t)m * D + (int)(dbg_hash((unsigned)gw, 130u + F.lane) % (unsigned)D)]; }
__device__ __forceinline__ void check_wo(Frame& F, int layer) {
    const int gw = blockIdx.x * NWAVES + F.wave; const int m = (int)(dbg_hash((unsigned)gw, 6u) % (unsigned)T);
    const bf16* MIX = wsp<bf16>(F, WS_MIX); const float* X = wsp<float>(F, WS_X); const float* xin = inp(I_X);
    unsigned flags = 0u; int cc[4]; for (int i_ = 0; i_ < 4; ++i_) cc[i_] = (int)(dbg_hash((unsigned)gw, 130u + i_) % (unsigned)D);
    for (int i = 0; i < 4; ++i) { const int c = cc[i];
        const float ex = (layer == 0 ? xin[(size_t)m * D + c] : wsp<float>(F, 3 * MiB + 768 * 1024)[(size_t)gw * 4 + i]) + chk_dot_bf(MIX + (size_t)m * D, D, inp(I_WO) + (size_t)layer * D * D, D, c, F.lane), got = X[(size_t)m * D + c];
        if (!(fabsf(got - ex) <= 0.02f + 0.02f * fabsf(ex))) flags |= 32u; }
    if (F.lane == 0 && flags) __hip_atomic_fetch_or((unsigned*)(F.ctl + 16), flags, RLX_AGENT);
}
#endif

#ifdef DBG_CHECK_FFN
constexpr size_t WS_DBG = 3 * MiB;
__device__ __forceinline__ void snap_x(Frame& F, int slot, int samp) {
    const int gw = blockIdx.x * NWAVES + F.wave; const int m = (int)(dbg_hash((unsigned)gw, (unsigned)samp) % (unsigned)T);
    if (F.lane < 4) wsp<float>(F, WS_DBG)[(size_t)gw * 16 + slot * 4 + F.lane] = wsp<float>(F, WS_X)[(size_t)m * D + (int)(dbg_hash((unsigned)gw, 140u + F.lane) % (unsigned)D)];
}
__device__ __forceinline__ float chk_dot_f(const float* a, int K, const float* w, int ldw, int c, int lane) { float t = 0.f; for (int k = lane; k < K; k += 64) t += a[k] * w[(size_t)k * ldw + c]; return wave_sum(t); }
__device__ __forceinline__ void check_down(Frame& F) {
    const int gw = blockIdx.x * NWAVES + F.wave; const int m = (int)(dbg_hash((unsigned)gw, 2u) % (unsigned)T); int cc[4]; for (int i_ = 0; i_ < 4; ++i_) cc[i_] = (int)(dbg_hash((unsigned)gw, 140u + i_) % (unsigned)D); unsigned flags = 0u;
    for (int i = 0; i < 4; ++i) { const float d = chk_dot_bf(wsp<bf16>(F, WS_ACT) + (size_t)m * FF, FF, inp(I_WFDN), D, cc[i], F.lane);
        const float ex = wsp<float>(F, WS_DBG)[(size_t)gw * 16 + i] + d, got = wsp<float>(F, WS_X)[(size_t)m * D + cc[i]];
        if (!(fabsf(got - ex) <= 0.02f + 0.02f * fabsf(ex))) flags |= 64u; }
    if (F.lane == 0 && flags) __hip_atomic_fetch_or((unsigned*)(F.ctl + 16), flags, RLX_AGENT);
}
__device__ __forceinline__ void check_norm3(Frame& F, int layer) {
    const int gw = blockIdx.x * NWAVES + F.wave; const int m = (int)(dbg_hash((unsigned)gw, 4u) % (unsigned)T); const float* x = wsp<float>(F, WS_X) + (size_t)m * D; const float* g = inp(I_GPLE) + (size_t)layer * D;
    float s = 0.f; for (int k = F.lane; k < D; k += 64) s += x[k] * x[k];
    const float rstd = 1.f / sqrtf(wave_sum(s) * (1.f / D) + EPS); unsigned flags = 0u;
    for (int k = F.lane; k < D; k += 64) { const float ex = x[k] * rstd * g[k], got = bf_lo((unsigned)wsp<bf16>(F, WS_H)[(size_t)m * D + k]); if (!(fabsf(got - ex) <= 0.01f + 0.01f * fabsf(ex))) flags |= 256u; }
    if (flags) __hip_atomic_fetch_or((unsigned*)(F.ctl + 16), flags, RLX_AGENT);
}
__device__ __forceinline__ void check_ple(Frame& F, int layer) {
    const int gw = blockIdx.x * NWAVES + F.wave; const int m = (int)(dbg_hash((unsigned)gw, 4u) % (unsigned)T); int cc[4]; for (int i_ = 0; i_ < 4; ++i_) cc[i_] = (int)(dbg_hash((unsigned)gw, 140u + i_) % (unsigned)D); unsigned flags = 0u;
    for (int i = 0; i < 4; ++i) { const float gl = chk_dot_bf(wsp<bf16>(F, WS_H) + (size_t)m * D, D, inp(I_WPG) + (size_t)layer * D * D, D, cc[i], F.lane);
        const float pj = chk_dot_f(inp(I_P) + ((size_t)layer * T + m) * PLE, PLE, inp(I_WPP) + (size_t)layer * PLE * D, D, cc[i], F.lane);
        const float ex = wsp<float>(F, WS_DBG)[(size_t)gw * 16 + 4 + i] + pj / (1.f + expf(-gl)) + DBG_INJECT, got = wsp<float>(F, WS_X)[(size_t)m * D + cc[i]];
        if (!(fabsf(got - ex) <= 0.02f + 0.02f * fabsf(ex))) flags |= 128u; }
    if (F.lane == 0 && flags) __hip_atomic_fetch_or((unsigned*)(F.ctl + 16), flags, RLX_AGENT);
}
#endif

#ifdef DBG_CHECK_ATTN
__device__ __forceinline__ void check_attn(Frame& F, int layer) {
    const int gw = blockIdx.x * NWAVES + F.wave; const int m = (int)(dbg_hash((unsigned)gw, 7u) % (unsigned)T), h = gw & 3, b = m / SEQ;
    const float lam = wsp<float>(F, WS_SCAL)[layer]; const float lam_init = 0.8f - 0.6f * expf(-0.3f * (float)layer), post = 1.f - lam_init;
    const float* gsub = inp(I_GSUB) + layer * VD;
    const bf16* Q = wsp<bf16>(F, WS_Q); const bf16* Kb = wsp<bf16>(F, WS_K) + (size_t)b * SEQ * AQK; const bf16* Vb = wsp<bf16>(F, WS_V) + (size_t)b * SEQ * AV; const bf16* OB = wsp<bf16>(F, WS_OB);
    LAS float* S = (LAS float*)(F.lds) + F.wave * 2048; LAS float* O = (LAS float*)(F.lds + 65536) + F.wave * 256;
    for (int c = 0; c < 2; ++c) {
        float qf[64];
#pragma unroll
        for (int i = 0; i < 8; ++i) { const v4u t = *(const v4u*)(Q + (size_t)m * AQK + h * 128 + c * 64 + i * 8);
            qf[8 * i] = bf_lo(t.x); qf[8 * i + 1] = bf_hi(t.x); qf[8 * i + 2] = bf_lo(t.y); qf[8 * i + 3] = bf_hi(t.y); qf[8 * i + 4] = bf_lo(t.z); qf[8 * i + 5] = bf_hi(t.z); qf[8 * i + 6] = bf_lo(t.w); qf[8 * i + 7] = bf_hi(t.w); }
        float mx = -1e30f;
        for (int i = 0; i < 32; ++i) { const int j = F.lane + 64 * i; const bf16* kr = Kb + (size_t)j * AQK + h * 128 + c * 64; float sc = 0.f;
#pragma unroll
            for (int t8 = 0; t8 < 8; ++t8) { const v4u t = *(const v4u*)(kr + t8 * 8);
                sc += qf[8 * t8] * bf_lo(t.x) + qf[8 * t8 + 1] * bf_hi(t.x) + qf[8 * t8 + 2] * bf_lo(t.y) + qf[8 * t8 + 3] * bf_hi(t.y) + qf[8 * t8 + 4] * bf_lo(t.z) + qf[8 * t8 + 5] * bf_hi(t.z) + qf[8 * t8 + 6] * bf_lo(t.w) + qf[8 * t8 + 7] * bf_hi(t.w); }
            S[j] = sc; mx = fmaxf(mx, sc); }
#pragma unroll
        for (int o = 1; o < 64; o <<= 1) mx = fmaxf(mx, __shfl_xor(mx, o));
        float l = 0.f;
        for (int i = 0; i < 32; ++i) { const int j = F.lane + 64 * i; const float p = exp2f(S[j] - mx); S[j] = p; l += p; }
        l = wave_sum(l);
        for (int ch = 0; ch < 4; ++ch) { float a[32];
#pragma unroll
            for (int k = 0; k < 32; ++k) a[k] = 0.f;
            for (int i = 0; i < 32; ++i) { const int j = F.lane + 64 * i; const float p = S[j]; const bf16* vr = Vb + (size_t)j * AV + h * 128 + ch * 32;
#pragma unroll
                for (int t8 = 0; t8 < 4; ++t8) { const v4u t = *(const v4u*)(vr + t8 * 8);
                    a[8 * t8] += p * bf_lo(t.x); a[8 * t8 + 1] += p * bf_hi(t.x); a[8 * t8 + 2] += p * bf_lo(t.y); a[8 * t8 + 3] += p * bf_hi(t.y); a[8 * t8 + 4] += p * bf_lo(t.z); a[8 * t8 + 5] += p * bf_hi(t.z); a[8 * t8 + 6] += p * bf_lo(t.w); a[8 * t8 + 7] += p * bf_hi(t.w); } }
#pragma unroll
            for (int k = 0; k < 32; ++k) { const float r = wave_sum(a[k]); if (F.lane == 0) O[c * 128 + ch * 32 + k] = r / l; } }
    }
    LDS_WAIT();
    const float d0 = O[F.lane] - lam * O[128 + F.lane], d1 = O[64 + F.lane] - lam * O[128 + 64 + F.lane];
    const float rstd = post / sqrtf(wave_sum(d0 * d0 + d1 * d1) * (1.f / VD) + EPS);
    const float e0 = d0 * rstd * gsub[F.lane], e1 = d1 * rstd * gsub[64 + F.lane];
    const float g0 = bf_lo((unsigned)OB[(size_t)m * AV + h * 128 + F.lane]), g1 = bf_lo((unsigned)OB[(size_t)m * AV + h * 128 + 64 + F.lane]);
    if (!(fabsf(g0 - e0) <= 0.03f + 0.03f * fabsf(e0)) || !(fabsf(g1 - e1) <= 0.03f + 0.03f * fabsf(e1))) __hip_atomic_fetch_or((unsigned*)(F.ctl + 16), 512u, RLX_AGENT);
}
#endif

#ifdef DBG_CHECK_MOE
__device__ __forceinline__ void check_route(Frame& F) {
    const int gw = blockIdx.x * NWAVES + F.wave; const int m = (int)(dbg_hash((unsigned)gw, 6u) % (unsigned)T);
    const float* x = wsp<float>(F, WS_X) + (size_t)m * D; const float* g = inp(I_GFFN) + D; const float* wr = inp(I_WR); const float* br = inp(I_BR);
    float s = 0.f; for (int k = F.lane; k < D; k += 64) s += x[k] * x[k];
    const float rstd = 1.f / sqrtf(wave_sum(s) * (1.f / D) + EPS);
    float lg[8];
#pragma unroll
    for (int e = 0; e < 8; ++e) lg[e] = 0.f;
    for (int k = F.lane; k < D; k += 64) { const float hk = x[k] * rstd * g[k];
#pragma unroll
        for (int e = 0; e < 8; ++e) lg[e] += hk * wr[k * 8 + e]; }
#pragma unroll
    for (int e = 0; e < 8; ++e) lg[e] = wave_sum(lg[e]) + br[e];
    int e1 = 0; float v1 = lg[0];
#pragma unroll
    for (int e = 1; e < 8; ++e) if (lg[e] > v1) { v1 = lg[e]; e1 = e; }
    int e2 = -1; float v2 = -INFINITY;
#pragma unroll
    for (int e = 0; e < 8; ++e) if (e != e1 && lg[e] > v2) { v2 = lg[e]; e2 = e; }
    const float ex = expf(v2 - v1), w1 = 1.f / (1.f + ex), w2 = ex / (1.f + ex);
    const int* rti = wsp<int>(F, WS_RTI) + (size_t)m * 4; const float* rtw = wsp<float>(F, WS_RTW) + (size_t)m * 2;
    const bool tie = (v1 - v2) < 1e-3f;
    bool bad = !(fabsf(rtw[0] + rtw[1] - 1.f) < 1e-3f);
    if (!tie) bad = bad || rti[0] != e1 || rti[2] != e2 || !(fabsf(rtw[0] - w1) < 2e-3f) || !(fabsf(rtw[1] - w2) < 2e-3f);
    if (bad && F.lane == 0) __hip_atomic_fetch_or((unsigned*)(F.ctl + 16), 1024u, RLX_AGENT);
}
__device__ __forceinline__ void check_experts(Frame& F) {
    const int gw = blockIdx.x * NWAVES + F.wave; const int m = (int)(dbg_hash((unsigned)gw, 6u) % (unsigned)T);
    const int* rti = wsp<int>(F, WS_RTI) + (size_t)m * 4; const int* rsel = wsp<int>(F, WS_RSEL) + (size_t)m * 2;
    const bf16* H = wsp<bf16>(F, WS_H) + (size_t)m * D; unsigned flags = 0u;
    for (int t = 0; t < 2; ++t) { const int e = rti[2 * t], r = rsel[t];
        const bf16* hp = wsp<bf16>(F, WS_HP) + (size_t)r * D; const bf16* act = wsp<bf16>(F, WS_ACT) + (size_t)r * FE; const float* y = wsp<float>(F, WS_Y) + (size_t)r * D;
        for (int k = F.lane; k < D; k += 64) if (hp[k] != H[k]) flags |= 2048u;
        const float* wgu = inp(I_WEGU) + (size_t)e * D * 2 * FE; const float* wdn = inp(I_WEDN) + (size_t)e * FE * D;
        int cj[3]; for (int i_ = 0; i_ < 3; ++i_) cj[i_] = (int)(dbg_hash((unsigned)gw, 150u + i_ + 8 * t) % (unsigned)FE);
        for (int i = 0; i < 3; ++i) { float gg = 0.f, uu = 0.f;
            for (int k = F.lane; k < D; k += 64) { const float hk = bf_lo((unsigned)hp[k]); gg += hk * wgu[(size_t)k * (2 * FE) + cj[i]]; uu += hk * wgu[(size_t)k * (2 * FE) + FE + cj[i]]; }
            gg = wave_sum(gg); uu = wave_sum(uu);
            const float ex = gg / (1.f + expf(-gg)) * uu, got = bf_lo((unsigned)act[cj[i]]);
            if (!(fabsf(got - ex) <= 0.03f + 0.03f * fabsf(ex))) flags |= 4096u; }
        int cc[2]; for (int i_ = 0; i_ < 2; ++i_) cc[i_] = (int)(dbg_hash((unsigned)gw, 160u + i_) % (unsigned)D);
        for (int i = 0; i < 2; ++i) { float d = 0.f; for (int k = F.lane; k < FE; k += 64) d += bf_lo((unsigned)act[k]) * wdn[(size_t)k * D + cc[i]];
            d = wave_sum(d); if (!(fabsf(y[cc[i]] - d) <= 0.02f + 0.02f * fabsf(d))) flags |= 8192u; }
    }
    if (F.lane < 2) wsp<float>(F, 3 * MiB + 512 * 1024)[(size_t)gw * 2 + F.lane] = wsp<float>(F, WS_X)[(size_t)m * D + (int)(dbg_hash((unsigned)gw, 160u + F.lane) % (unsigned)D)];
    if (flags) __hip_atomic_fetch_or((unsigned*)(F.ctl + 16), flags, RLX_AGENT);
}
__device__ __forceinline__ void check_combine(Frame& F) {
    const int gw = blockIdx.x * NWAVES + F.wave; const int m = (int)(dbg_hash((unsigned)gw, 6u) % (unsigned)T);
    const int* rsel = wsp<int>(F, WS_RSEL) + (size_t)m * 2; const float* rtw = wsp<float>(F, WS_RTW) + (size_t)m * 2; const float* Y = wsp<float>(F, WS_Y);
    if (F.lane < 2) { const int c = (int)(dbg_hash((unsigned)gw, 160u + F.lane) % (unsigned)D);
        const float ex = wsp<float>(F, 3 * MiB + 512 * 1024)[(size_t)gw * 2 + F.lane] + rtw[0] * Y[(size_t)rsel[0] * D + c] + rtw[1] * Y[(size_t)rsel[1] * D + c], got = wsp<float>(F, WS_X)[(size_t)m * D + c];
        if (!(fabsf(got - ex) <= 1e-3f + 1e-3f * fabsf(ex))) __hip_atomic_fetch_or((unsigned*)(F.ctl + 16), 16384u, RLX_AGENT); }
}
#endif

__device__ __forceinline__ void attn_naive_phase(Frame& F, int layer) {
    const float lam = wsp<float>(F, WS_SCAL)[layer]; const float lam_init = 0.8f - 0.6f * expf(-0.3f * (float)layer), post = 1.f - lam_init;
    const float* gsub = inp(I_GSUB) + layer * VD;
    const bf16* Q = wsp<bf16>(F, WS_Q); const bf16* Kb = wsp<bf16>(F, WS_K); const bf16* Vb = wsp<bf16>(F, WS_V); bf16* OB = wsp<bf16>(F, WS_OB);
    for (int unit = blockIdx.x; unit < BATCH * NH * (SEQ / 256); unit += F.G) {
        const int b = unit >> 5, h = (unit >> 3) & 3, qb = unit & 7, q = qb * 256 + (F.tid >> 1), c = F.tid & 1;
        const bf16* qp = Q + ((size_t)(b * SEQ + q)) * AQK + h * 128 + c * 64;
        unsigned qv[32];
#pragma unroll
        for (int i = 0; i < 8; ++i) { const v4u t = *(const v4u*)(qp + i * 8); qv[4 * i] = t.x; qv[4 * i + 1] = t.y; qv[4 * i + 2] = t.z; qv[4 * i + 3] = t.w; }
        float o[128];
#pragma unroll
        for (int e = 0; e < 128; ++e) o[e] = 0.f;
        float mx = -1e30f, l = 0.f;
        const bf16* kp = Kb + (size_t)b * SEQ * AQK + h * 128 + c * 64; const bf16* vp = Vb + (size_t)b * SEQ * AV + h * 128;
        for (int key = 0; key < SEQ; ++key) {
            float s = 0.f;
#pragma unroll
            for (int i = 0; i < 8; ++i) { const v4u kk = *(const v4u*)(kp + (size_t)key * AQK + i * 8);
                s += bf_lo(qv[4 * i]) * bf_lo(kk.x) + bf_hi(qv[4 * i]) * bf_hi(kk.x) + bf_lo(qv[4 * i + 1]) * bf_lo(kk.y) + bf_hi(qv[4 * i + 1]) * bf_hi(kk.y)
                   + bf_lo(qv[4 * i + 2]) * bf_lo(kk.z) + bf_hi(qv[4 * i + 2]) * bf_hi(kk.z) + bf_lo(qv[4 * i + 3]) * bf_lo(kk.w) + bf_hi(qv[4 * i + 3]) * bf_hi(kk.w); }
            const float mn = fmaxf(mx, s), alpha = __builtin_amdgcn_exp2f(mx - mn), p = __builtin_amdgcn_exp2f(s - mn); mx = mn; l = l * alpha + p;
#pragma unroll
            for (int i = 0; i < 16; ++i) { const v4u vv = *(const v4u*)(vp + (size_t)key * AV + i * 8);
                o[8 * i + 0] = o[8 * i + 0] * alpha + p * bf_lo(vv.x); o[8 * i + 1] = o[8 * i + 1] * alpha + p * bf_hi(vv.x);
                o[8 * i + 2] = o[8 * i + 2] * alpha + p * bf_lo(vv.y); o[8 * i + 3] = o[8 * i + 3] * alpha + p * bf_hi(vv.y);
                o[8 * i + 4] = o[8 * i + 4] * alpha + p * bf_lo(vv.z); o[8 * i + 5] = o[8 * i + 5] * alpha + p * bf_hi(vv.z);
                o[8 * i + 6] = o[8 * i + 6] * alpha + p * bf_lo(vv.w); o[8 * i + 7] = o[8 * i + 7] * alpha + p * bf_hi(vv.w); }
        }
        const float inv = 1.f / l; float rs = 0.f;
#pragma unroll
        for (int e = 0; e < 128; ++e) { const float mine = o[e] * inv, other = __shfl_xor(mine, 1); const float d = (c == 0) ? (mine - lam * other) : (other - lam * mine); o[e] = d; rs += d * d; }
        const float rstd = 1.f / sqrtf(rs * (1.f / VD) + EPS) * post;
        bf16* op = OB + ((size_t)(b * SEQ + q)) * AV + h * 128 + c * 64;
#pragma unroll
        for (int i = 0; i < 8; ++i) { float y[8];
#pragma unroll
            for (int j = 0; j < 8; ++j) y[j] = (c ? o[64 + 8 * i + j] : o[8 * i + j]) * rstd * gsub[c * 64 + 8 * i + j];
            v4u w; w.x = pk2(y[0], y[1]); w.y = pk2(y[2], y[3]); w.z = pk2(y[4], y[5]); w.w = pk2(y[6], y[7]); *(v4u*)(op + 8 * i) = w; }
    }
}

namespace dattn {
using bf16x8 = __attribute__((ext_vector_type(8))) short;
using s16x4  = __attribute__((ext_vector_type(4))) short;
using f32x16 = __attribute__((ext_vector_type(16))) float;
using u32x4  = __attribute__((ext_vector_type(4))) unsigned;
constexpr int NW = 8, QBLK = 32, KVBLK = 64, LDK = 512;
constexpr float THRL = 11.5f;
constexpr size_t SHM_V = KVBLK * 128 * 2, SHM_K = KVBLK * 128 * 2, SHM_ATTN = 2 * SHM_V + 2 * SHM_K + NW * 64 * 4;
#define KSWZ(row, colB) ((row) * 256 + ((colB) ^ (((row) & 7) << 4)))
#define SBAR() __builtin_amdgcn_sched_barrier(0)
__device__ __forceinline__ int crow(int r, int hi) { return (r & 3) + 8 * (r >> 2) + 4 * hi; }
__device__ __forceinline__ unsigned cvtpk(float lo, float hi) { return pg8::cvt_pk_bf16(lo, hi); }
__device__ __forceinline__ void partialSM(f32x16& p0, f32x16& p1, float& m_reg, float& mn, float& alpha) {
  float pmax = p0[0]; for (int r = 1; r < 16; ++r) pmax = fmaxf(pmax, p0[r]); for (int r = 0; r < 16; ++r) pmax = fmaxf(pmax, p1[r]);
  { auto rr = __builtin_amdgcn_permlane32_swap(__float_as_uint(pmax), __float_as_uint(pmax), false, false);
    pmax = fmaxf(__uint_as_float(rr[0]), __uint_as_float(rr[1])); }
  if (__builtin_expect(__all(pmax - m_reg <= THRL), 1)) { mn = m_reg; alpha = 1.f; }
  else { mn = fmaxf(m_reg, pmax); alpha = __builtin_amdgcn_exp2f(m_reg - mn); m_reg = mn; }
  for (int r = 0; r < 16; ++r) p0[r] = p0[r] - mn; for (int r = 0; r < 16; ++r) p1[r] = p1[r] - mn;
  for (int r = 0; r < 16; ++r) p0[r] = __builtin_amdgcn_exp2f(p0[r]);
}
__device__ __forceinline__ void finishSM(f32x16& p0, f32x16& p1, float alpha, float& l_reg, bf16x8& pa0, bf16x8& pa1, bf16x8& pa2, bf16x8& pa3) {
  for (int r = 0; r < 16; ++r) p1[r] = __builtin_amdgcn_exp2f(p1[r]);
  float ps = 0; for (int r = 0; r < 16; ++r) ps += p0[r]; for (int r = 0; r < 16; ++r) ps += p1[r];
  { auto rr = __builtin_amdgcn_permlane32_swap(__float_as_uint(ps), __float_as_uint(ps), false, false);
    ps = __uint_as_float(rr[0]) + __uint_as_float(rr[1]); }
  l_reg = l_reg * alpha + ps;
#define PK4(P, BASE, OUT) do { unsigned a0 = cvtpk(P[BASE + 0], P[BASE + 1]), a1 = cvtpk(P[BASE + 2], P[BASE + 3]);   \
    unsigned b0 = cvtpk(P[BASE + 4], P[BASE + 5]), b1 = cvtpk(P[BASE + 6], P[BASE + 7]);                              \
    auto r0 = __builtin_amdgcn_permlane32_swap(a0, b0, false, false); auto r1 = __builtin_amdgcn_permlane32_swap(a1, b1, false, false); \
    u32x4 w = {r0[0], r1[0], r0[1], r1[1]}; OUT = *reinterpret_cast<bf16x8*>(&w); } while (0)
  PK4(p0, 0, pa0); PK4(p0, 8, pa1); PK4(p1, 0, pa2); PK4(p1, 8, pa3);
#undef PK4
}
__device__ __forceinline__ void qkt(f32x16& p0, f32x16& p1, const char* Ks, const bf16x8* qr, int r32, int hi, int c) {
  p0 = f32x16{}; p1 = f32x16{};
  for (int d0 = 0; d0 < 4; ++d0) { int cb = (c * 64 + d0 * 16 + hi * 8) * 2;
    bf16x8 b0 = *reinterpret_cast<const bf16x8*>(Ks + KSWZ(r32, cb));
    bf16x8 b1 = *reinterpret_cast<const bf16x8*>(Ks + KSWZ(32 + r32, cb));
    p0 = __builtin_amdgcn_mfma_f32_32x32x16_bf16(b0, qr[d0], p0, 0, 0, 0);
    p1 = __builtin_amdgcn_mfma_f32_32x32x16_bf16(b1, qr[d0], p1, 0, 0, 0); }
}
__device__ __forceinline__ int v_st(int k, int c) { const int kk = (k & ~0xC) | ((k & 4) << 1) | ((k & 8) >> 1); return ((kk >> 3) * 4 + (c >> 5)) * 512 + ((kk & 7) * 32 + (c & 31)) * 2; }
__device__ __forceinline__ int v_rd_base(int lane) { return ((lane & 3) << 3) | (((lane >> 2) & 3) << 6) | (((lane >> 4) & 1) << 5) | (((lane >> 5) & 1) << 8); }
constexpr int v_rd_off(int d0, int ks, int half) { return d0 * 512 + ks * 4096 + half * 2048; }
template <int OFF> __device__ __forceinline__ s16x4 tr_read(int vb) {
  s16x4 r; asm volatile("ds_read_b64_tr_b16 %0, %1 offset:%2" : "=&v"(r) : "v"(vb), "i"(OFF) : "memory"); return r;
}
template <int D0> __device__ __forceinline__ void pv_one(f32x16& od, int vb, bf16x8 pa0, bf16x8 pa1, bf16x8 pa2, bf16x8 pa3) {
  const s16x4 l0 = tr_read<v_rd_off(D0, 0, 0)>(vb), h0 = tr_read<v_rd_off(D0, 0, 1)>(vb), l1 = tr_read<v_rd_off(D0, 1, 0)>(vb), h1 = tr_read<v_rd_off(D0, 1, 1)>(vb);
  const s16x4 l2 = tr_read<v_rd_off(D0, 2, 0)>(vb), h2 = tr_read<v_rd_off(D0, 2, 1)>(vb), l3 = tr_read<v_rd_off(D0, 3, 0)>(vb), h3 = tr_read<v_rd_off(D0, 3, 1)>(vb);
  asm volatile("s_waitcnt lgkmcnt(0)" ::: "memory"); SBAR();
#define PK(L, H) (bf16x8){L[0], L[1], L[2], L[3], H[0], H[1], H[2], H[3]}
  od = __builtin_amdgcn_mfma_f32_32x32x16_bf16(pa0, PK(l0, h0), od, 0, 0, 0);
  od = __builtin_amdgcn_mfma_f32_32x32x16_bf16(pa1, PK(l1, h1), od, 0, 0, 0);
  od = __builtin_amdgcn_mfma_f32_32x32x16_bf16(pa2, PK(l2, h2), od, 0, 0, 0);
  od = __builtin_amdgcn_mfma_f32_32x32x16_bf16(pa3, PK(l3, h3), od, 0, 0, 0);
#undef PK
}
__device__ __forceinline__ void pv_d0(f32x16* o, int vb, bf16x8 pa0, bf16x8 pa1, bf16x8 pa2, bf16x8 pa3) {
  pv_one<0>(o[0], vb, pa0, pa1, pa2, pa3); pv_one<1>(o[1], vb, pa0, pa1, pa2, pa3); pv_one<2>(o[2], vb, pa0, pa1, pa2, pa3); pv_one<3>(o[3], vb, pa0, pa1, pa2, pa3);
}
__device__ __forceinline__ void unit(const unsigned short* Qb, const unsigned short* Kh, const unsigned short* Vh, unsigned short* Ob, int seq, char* lds, float lam, float post, const float* gsub) {
  int tid_ = threadIdx.x; asm volatile("" : "+v"(tid_));
  const int tid = tid_, wid = tid >> 6, lane = tid & 63, r32 = lane & 31, hi = lane >> 5, c = wid >> 2, wq = wid & 3;
  char* V_lds = lds; char* K_lds = lds + 2 * SHM_V;
  float* ws = (float*)(lds + 2 * SHM_V + 2 * SHM_K) + wid * 64; float* li_l = ws; float* al_l = ws + 32;
  float m_reg = -1e30f, l_reg = 0; f32x16 o[4] = {}; bf16x8 qr[4];
  const unsigned short* Qw = Qb + (long)(wq * QBLK + r32) * LDK + c * 64 + hi * 8;
#pragma unroll
  for (int d0 = 0; d0 < 4; ++d0) qr[d0] = *reinterpret_cast<const bf16x8*>(Qw + d0 * 16);
  const int sr = tid >> 4, sc = (tid & 15) * 8, vst0 = v_st(sr, sc), vst1 = v_st(32 + sr, sc);
  const int vb0 = (int)(uintptr_t)V_lds + v_rd_base(lane);
  struct { bf16x8 vs0, vs1, ks0, ks1; } sr_[2];
#define SLOAD(i, k0) do { sr_[i].vs0 = *reinterpret_cast<const bf16x8*>(&Vh[(long)((k0) + sr) * LDK + sc]); sr_[i].vs1 = *reinterpret_cast<const bf16x8*>(&Vh[(long)((k0) + 32 + sr) * LDK + sc]); \
    sr_[i].ks0 = *reinterpret_cast<const bf16x8*>(&Kh[(long)((k0) + sr) * LDK + sc]); sr_[i].ks1 = *reinterpret_cast<const bf16x8*>(&Kh[(long)((k0) + 32 + sr) * LDK + sc]); } while (0)
#define SWRITE(b, i) do { *(bf16x8*)(V_lds + (b) * SHM_V + vst0) = sr_[i].vs0; *(bf16x8*)(V_lds + (b) * SHM_V + vst1) = sr_[i].vs1; int kc = sc * 2; \
    *(bf16x8*)(K_lds + (b) * SHM_K + KSWZ(sr, kc)) = sr_[i].ks0; *(bf16x8*)(K_lds + (b) * SHM_K + KSWZ(32 + sr, kc)) = sr_[i].ks1; } while (0)
#define SWAIT() asm volatile("s_waitcnt vmcnt(4)" ::: "memory")
#define RESC(a) do { if (__any((a) < 1.f)) { if (hi == 0) al_l[r32] = (a); asm volatile("s_waitcnt lgkmcnt(0)" ::: "memory"); \
    for (int d = 0; d < 4; ++d) for (int r = 0; r < 16; ++r) o[d][r] *= al_l[crow(r, hi)]; } } while (0)
  f32x16 pA0, pA1, pB0, pB1; float mnA, mnB, alA, alB; bf16x8 pa0, pa1, pa2, pa3; const int NT = seq / KVBLK;
  constexpr int SE = 0, SO = 1;
  SLOAD(SE, 0); asm volatile("s_waitcnt vmcnt(0)" ::: "memory"); SWRITE(0, SE); __syncthreads();
  qkt(pA0, pA1, K_lds, qr, r32, hi, c); partialSM(pA0, pA1, m_reg, mnA, alA);
  SLOAD(SO, KVBLK); if (2 < NT) SLOAD(SE, 2 * KVBLK);
  SWAIT(); SWRITE(1, SO); __syncthreads();
  for (int j = 1; j + 1 < NT; j += 2) {
    SBAR(); qkt(pB0, pB1, K_lds + SHM_K, qr, r32, hi, c);
    finishSM(pA0, pA1, alA, l_reg, pa0, pa1, pa2, pa3); SBAR();
    SLOAD(SO, (j + 2) * KVBLK); SBAR();
    pv_d0(o, vb0, pa0, pa1, pa2, pa3); partialSM(pB0, pB1, m_reg, mnB, alB);
    __syncthreads(); SWAIT(); SWRITE(0, SE);
    RESC(alB); __syncthreads();
    SBAR(); qkt(pA0, pA1, K_lds, qr, r32, hi, c);
    finishSM(pB0, pB1, alB, l_reg, pa0, pa1, pa2, pa3); SBAR();
    if (j + 3 < NT) SLOAD(SE, (j + 3) * KVBLK); SBAR();
    pv_d0(o, vb0 + (int)SHM_V, pa0, pa1, pa2, pa3); partialSM(pA0, pA1, m_reg, mnA, alA);
    __syncthreads(); SWAIT(); SWRITE(1, SO);
    RESC(alA); __syncthreads();
  }
  SBAR(); qkt(pB0, pB1, K_lds + SHM_K, qr, r32, hi, c);
  finishSM(pA0, pA1, alA, l_reg, pa0, pa1, pa2, pa3); SBAR();
  pv_d0(o, vb0, pa0, pa1, pa2, pa3); partialSM(pB0, pB1, m_reg, mnB, alB);
  __syncthreads(); RESC(alB);
  finishSM(pB0, pB1, alB, l_reg, pa0, pa1, pa2, pa3); SBAR();
  pv_d0(o, vb0 + (int)SHM_V, pa0, pa1, pa2, pa3);
  if (hi == 0) li_l[r32] = l_reg; asm volatile("s_waitcnt vmcnt(0) lgkmcnt(0)" ::: "memory");
  float rli[16];
#pragma unroll
  for (int r = 0; r < 16; ++r) rli[r] = __builtin_amdgcn_rcpf(li_l[crow(r, hi)]);
  __syncthreads();
  float* xch = (float*)lds + (size_t)wq * 64 * 64 + lane;
  if (c == 1) {
#pragma unroll
    for (int d0 = 0; d0 < 4; ++d0)
#pragma unroll
      for (int r = 0; r < 16; ++r) xch[(d0 * 16 + r) * 64] = o[d0][r] * rli[r] * lam;
  }
  __syncthreads();
  if (c == 0) {
    float ss[16];
#pragma unroll
    for (int r = 0; r < 16; ++r) { float a = 0.f;
#pragma unroll
      for (int d0 = 0; d0 < 4; ++d0) { const float d = o[d0][r] * rli[r] - xch[(d0 * 16 + r) * 64]; o[d0][r] = d; a += d * d; }
      ss[r] = a; }
#pragma unroll
    for (int r = 0; r < 16; ++r) {
#pragma unroll
      for (int off = 1; off < 32; off <<= 1) ss[r] += __shfl_xor(ss[r], off);
      ss[r] = post / sqrtf(ss[r] * (1.f / 128.f) + 1e-6f); }
    float gs[4];
#pragma unroll
    for (int d0 = 0; d0 < 4; ++d0) gs[d0] = gsub[32 * d0 + r32];
    unsigned short* Ow = Ob + (long)(wq * QBLK) * LDK;
#pragma unroll
    for (int r = 0; r < 16; ++r) { const int orow = crow(r, hi);
#pragma unroll
      for (int d0 = 0; d0 < 4; ++d0) Ow[(long)orow * LDK + d0 * 32 + r32] = (unsigned short)f2bf(o[d0][r] * ss[r] * gs[d0]); }
  }
  __syncthreads();
#undef SLOAD
#undef SWRITE
#undef SWAIT
#undef RESC
}
#undef KSWZ
#undef SBAR
}

__device__ __forceinline__ void attn_mfma_phase(Frame& F, int layer) {
    const float lam = wsp<float>(F, WS_SCAL)[layer]; const float lam_init = 0.8f - 0.6f * expf(-0.3f * (float)layer), post = 1.f - lam_init;
    const float* gsub = inp(I_GSUB) + layer * VD;
    const bf16* Q = wsp<bf16>(F, WS_Q); const bf16* Kb = wsp<bf16>(F, WS_K); const bf16* Vb = wsp<bf16>(F, WS_V); bf16* OB = wsp<bf16>(F, WS_OB);
    for (int u = blockIdx.x; u < BATCH * NH * (SEQ / 128); u += F.G) {
        const int b = u >> 6, h = (u >> 4) & 3, qb = u & 15;
        const size_t rb = (size_t)b * SEQ;
        dattn::unit(Q + (rb + qb * 128) * AQK + h * 128, Kb + rb * AQK + h * 128, Vb + rb * AV + h * 128, OB + (rb + qb * 128) * AV + h * 128, SEQ, (char*)F.lds, lam, post, gsub);
    }
}

constexpr int NSTEP = 11, NPH = 1 + DEPTH * NSTEP;
struct Args { const float* in[N_IN]; float* out; unsigned char* ws; int ph_lo, ph_hi, pass, pad; };
#ifndef DBG_SITES
#define DBG_SITES 0xFF
#endif
#define GEMM_SITE(ID, EpiT, g, S, E) do { if (!((DBG_SITES >> (ID)) & 1)) {} else if ((MK_NAIVE_GEMM >> (ID)) & 1) pg8::gemm_phase_naive<EpiT, pg8::GroupOrder>(g, S, E); \
    else pg8::gemm_phase<EpiT, pg8::GroupOrder, MK_ALIGN, MK_SP2>(F.lds + RING_OFF, g, S, E); } while (0)

__global__ void __launch_bounds__(NWAVES * 64, 2) mk_fwd(Args args) {
    extern __shared__ __attribute__((aligned(16))) unsigned char lds[];
    Frame F;
    F.lds = (LAS unsigned char*)lds;
    F.MISC = (volatile LAS unsigned*)(F.lds + MISC_OFF);
    F.tid = threadIdx.x; F.lane = F.tid & 63; F.wave = __builtin_amdgcn_readfirstlane(F.tid >> 6);
    F.G = gridDim.x; F.ws = (GAS unsigned char*)args.ws; F.ctl = (gu32*)(F.ws + WS_CTL);
    for (int u = F.tid; u < (LDS_BYTES - LDSCTL_OFF) / 4; u += NWAVES * 64) ((LAS unsigned*)(F.lds + LDSCTL_OFF))[u] = 0u;
    __syncthreads();
    const int lo = args.ph_lo, hi = args.ph_hi;
#ifdef DBG_START_DELAY
    if (lo == 0) { const unsigned long long t0 = __builtin_amdgcn_s_memrealtime(); while (__builtin_amdgcn_s_memrealtime() - t0 < (unsigned long long)DBG_START_DELAY) __builtin_amdgcn_s_sleep(32); }
#endif
    XcdBarrier bar; bar.bar = (unsigned*)(F.ctl + CW_BAR); bar.x = 0; bar.st = nullptr;
    if (hi - lo > 1) bar = xcd_barrier_post((unsigned*)(F.ctl + CW_BAR), F.MISC + 8);
#define PHASE_BEGIN() do { const CAS unsigned char* k_ = (const CAS unsigned char*)__builtin_amdgcn_kernarg_segment_ptr(); asm volatile("" : "+s"(k_)); \
    F.ws = *(GAS unsigned char* const CAS*)(k_ + 8 * (N_IN + 1)); F.ctl = (gu32*)(F.ws + WS_CTL); int t_ = threadIdx.x; asm volatile("" : "+v"(t_)); \
    F.tid = t_; F.lane = t_ & 63; F.wave = __builtin_amdgcn_readfirstlane(t_ >> 6); F.G = gridDim.x; } while (0)
#define IN(k) (lo <= (k) && (k) < hi)
#define SEAM(k) do { if (IN(k) && IN((k) + 1)) xcd_barrier(bar); } while (0)
#define H wsp<bf16>(F, WS_H)
#define X wsp<float>(F, WS_X)

#ifdef DBG_STOP
    if (lo == 100) {
        PHASE_BEGIN();
        float* o = outp(); const size_t gt = (size_t)blockIdx.x * (NWAVES * 64) + F.tid, NGT = (size_t)F.G * NWAVES * 64;
        for (size_t i = gt; i < (size_t)T * D; i += NGT) { float v = 0.f;
#define DG_BF(off, len) v += bf_lo((unsigned)wsp<bf16>(F, off)[i % (size_t)(len)]);
#define DG_F32(off, len) v += wsp<float>(F, off)[i % (size_t)(len)];
            DBG_DIGEST
            o[i] = v; }
        return;
    }
#endif
#ifdef DBG_TWOPASS
#define CW_CK 2048
#define CK(slot, off, bytes) cksum(F, off, bytes, CW_CK + dbg_pass * 64 + (slot))
#define CKBAR() xcd_barrier(bar)
    const int dbg_pass = args.pass;
#else
#define CK(slot, off, bytes) do {} while (0)
#define CKBAR() do {} while (0)
#endif
    if (IN(0)) { PHASE_BEGIN(); for (int rep_ = 0; rep_ < DBG_REP_PRO; ++rep_) p0_prologue(F); }
    SEAM(0);
#ifdef DBG_TWOPASS
    { PHASE_BEGIN(); CK(0, WS_WIN, WS_X - WS_WIN); CK(0, WS_H, (size_t)T * D * 2); CK(0, WS_PB, (size_t)2 * T * PLE * 2); CK(0, WS_ROPE, (size_t)SEQ * 64 * 4); CKBAR(); }
#endif

    {
        constexpr int layer = 0;

        const int pb = 1 + layer * NSTEP;
#ifdef DBG_SKIP_MOE
        const bool moe = false; const bool skipffn = (layer & 1) != 0;
#elif defined(DBG_SKIP_DENSE)
        const bool moe = (layer & 1) != 0; const bool skipffn = (layer & 1) == 0;
#else
        const bool moe = (layer & 1) != 0; const bool skipffn = false;
#endif
        if (IN(pb + 0)) { PHASE_BEGIN();
            if (layer == 0) {
                pg8::Gemm g{wsp<bf16>(F, WS_PB), wsp<bf16>(F, WS_WPP), 2 * T, D, PLE}; pg8::GroupOrder S; S.init_equal(2, T, D, F.G, (int)blockIdx.x, (LAS int*)(F.lds + TP_OFF));
                pg8::EpiStore E{wsp<bf16>(F, WS_PROJ), D, D / 256};
                GEMM_SITE(0, pg8::EpiStore, g, S, E);
            }
            pg8::Gemm g{H, wsp<bf16>(F, WS_WIN) + (size_t)layer * INC * D / (MK_I8_INPROJ ? 2 : 1), T, INC, MK_I8_INPROJ ? D / 2 : D}; pg8::GroupOrder S; S.init_dense(T, INC, F.G, (int)blockIdx.x);
            pg8::EpiInProj E{wsp<bf16>(F, WS_Q), wsp<bf16>(F, WS_K), wsp<bf16>(F, WS_V), wsp<bf16>(F, WS_Z), wsp<bf16>(F, WS_SG), wsp<float>(F, WS_ROPE), QSCALE, MK_I8_INPROJ ? (const float*)wsp<float>(F, WS_RS) : nullptr, (const float*)wsp<float>(F, WS_WSC) + layer};
            pg8::gemm_phase<pg8::EpiInProj, pg8::GroupOrder, MK_ALIGN, MK_SP2, (MK_I8_INPROJ != 0)>(F.lds + RING_OFF, g, S, E);
        }
        SEAM(pb + 0);
#ifdef DBG_TWOPASS
        { PHASE_BEGIN(); CK(pb + 0, WS_Q, 128 * MiB); if (layer == 0) CK(pb + 0, WS_PROJ, (size_t)2 * T * D * 2); if (layer == 1) { CK(32, WS_Q, 16 * MiB); CK(33, WS_K, 16 * MiB); CK(34, WS_V, 16 * MiB); CK(35, WS_Z, 16 * MiB); CK(36, WS_SG, 64 * MiB); } CKBAR(); }
#endif
        if (IN(pb + 1)) { PHASE_BEGIN();
#ifdef DBG_CHECK_INPROJ
            if (layer == DBG_LAYER) check_inproj(F, layer);
#endif
#if !defined(DBG_NO_ATTN) && MK_NAIVE_ATTN
            attn_naive_phase(F, layer);
#elif !defined(DBG_NO_ATTN)
            for (int rep_ = 0; rep_ < DBG_REP_ATTN; ++rep_) attn_mfma_phase(F, layer);
#else
            { bf16* ob = wsp<bf16>(F, WS_OB); const size_t gt = (size_t)blockIdx.x * (NWAVES * 64) + F.tid, NGT = (size_t)F.G * NWAVES * 64;
              for (size_t i = gt; i < (size_t)T * AV / 8; i += NGT) *(v4u*)(ob + i * 8) = (v4u){0u, 0u, 0u, 0u}; }
#endif
#if defined(DBG_NAIVE_CONV)
            conv_naive_phase(F, layer);
#elif !defined(DBG_NO_CONV)
            conv_phase(F, layer);
#else
            { bf16* ob = wsp<bf16>(F, WS_ZC); const size_t gt = (size_t)blockIdx.x * (NWAVES * 64) + F.tid, NGT = (size_t)F.G * NWAVES * 64;
              for (size_t i = gt; i < (size_t)T * CCH / 8; i += NGT) *(v4u*)(ob + i * 8) = (v4u){0u, 0u, 0u, 0u}; }
#endif
        }
        SEAM(pb + 1);
#ifdef DBG_CHECK_ATTN
        if (layer == DBG_CHECK_ATTN - 1) { PHASE_BEGIN(); check_attn(F, layer); xcd_barrier(bar); }
#endif
#ifdef DBG_TWOPASS
        { PHASE_BEGIN(); CK(pb + 1, WS_OB, 32 * MiB); CKBAR(); }
#endif
        if (IN(pb + 2)) { PHASE_BEGIN();
            { pg8::Gemm g{wsp<bf16>(F, WS_OB), wsp<bf16>(F, WS_WA) + (size_t)layer * D * AV, T, D, AV}; pg8::GroupOrder S; S.init_dense(T, D, F.G, (int)blockIdx.x);
              pg8::EpiGate<0> E{wsp<float>(F, WS_P), wsp<bf16>(F, WS_MIX), wsp<bf16>(F, WS_SG)};
              GEMM_SITE(2, pg8::EpiGate<0>, g, S, E); }
            { pg8::Gemm g{wsp<bf16>(F, WS_ZC), wsp<bf16>(F, WS_WC) + (size_t)layer * D * CCH, T, D, CCH}; pg8::GroupOrder S; S.init_dense(T, D, F.G, (int)blockIdx.x);
              pg8::EpiGate<1> E{wsp<float>(F, WS_P), wsp<bf16>(F, WS_MIX), wsp<bf16>(F, WS_SG)};
              GEMM_SITE(3, pg8::EpiGate<1>, g, S, E); }
        }
        SEAM(pb + 2);
#ifdef DBG_CHECK_MIX
        if (layer == DBG_LAYER) { PHASE_BEGIN(); check_mix(F, layer); snap_wo(F); xcd_barrier(bar); }
#endif
#ifdef DBG_TWOPASS
        { PHASE_BEGIN(); CK(pb + 2, WS_P, 96 * MiB); CKBAR(); }
#endif
        if (IN(pb + 3)) { PHASE_BEGIN();
            pg8::Gemm g{wsp<bf16>(F, WS_MIX), wsp<bf16>(F, WS_WO) + (size_t)layer * D * D, T, D, D}; pg8::GroupOrder S; S.init_dense(T, D, F.G, (int)blockIdx.x);
            pg8::EpiResid E{layer == 0 ? inp(I_X) : (const float*)X, X, D / 256};
            GEMM_SITE(4, pg8::EpiResid, g, S, E);
        }
        SEAM(pb + 3);
#ifdef DBG_CHECK_MIX
        if (layer == DBG_LAYER) { PHASE_BEGIN(); check_wo(F, layer); xcd_barrier(bar); }
#endif
#ifdef DBG_TWOPASS
        { PHASE_BEGIN(); CK(pb + 3, WS_X, (size_t)T * D * 4); CKBAR(); }
#endif
        if (IN(pb + 4)) { PHASE_BEGIN();
            if (moe) route_phase(F, X, inp(I_GFFN) + (size_t)layer * D, H);
            else norm_rows(F, X, inp(I_GFFN) + (size_t)layer * D, H, MK_FP8_GU != 0);
        }
        SEAM(pb + 4);
#ifdef DBG_CHECK_MOE
        if (moe) { PHASE_BEGIN(); check_route(F); xcd_barrier(bar); }
#endif
#ifdef DBG_TWOPASS
        { PHASE_BEGIN(); CK(pb + 4, WS_H, (size_t)T * D * 2); if (moe) CK(pb + 4, WS_RTW, (size_t)T * 8); CKBAR(); }
#endif
        if (moe) {
            if (IN(pb + 5)) { PHASE_BEGIN(); scatter_phase(F); }
            SEAM(pb + 5);
        }
        if (IN(pb + 6) && !skipffn) { PHASE_BEGIN();
            pg8::Gemm g; pg8::GroupOrder S; pg8::EpiSwiGLU E;
            constexpr int KG = MK_FP8_GU ? D / 2 : D;
            if (moe) { unsigned cnt[8]; load_counts(F, cnt); g = pg8::Gemm{wsp<bf16>(F, WS_HP), wsp<bf16>(F, WS_WEGU), MOE_ROWS, 2 * FE, KG}; S.init_counts(cnt, 2 * FE, F.G, (int)blockIdx.x, (LAS int*)(F.lds + TP_OFF)); E = pg8::EpiSwiGLU{wsp<bf16>(F, WS_ACT), FE, 2 * FE / 256, MK_FP8_GU ? (const float*)wsp<float>(F, WS_RSP) : nullptr, (const float*)wsp<float>(F, WS_WSC) + 3}; }
            else { g = pg8::Gemm{H, wsp<bf16>(F, WS_WFGU), T, 2 * FF, KG}; S.init_dense(T, 2 * FF, F.G, (int)blockIdx.x); E = pg8::EpiSwiGLU{wsp<bf16>(F, WS_ACT), FF, 2 * FF / 256, MK_FP8_GU ? (const float*)wsp<float>(F, WS_RS) : nullptr, (const float*)wsp<float>(F, WS_WSC) + 2}; }
            for (int rep_ = 0; rep_ < DBG_REP_GU; ++rep_) { pg8::gemm_phase<pg8::EpiSwiGLU, pg8::GroupOrder, MK_FP8_GU ? MK_ALIGN_GU : MK_ALIGN, MK_FP8_GU ? MK_SP2_GU : MK_SP2, (MK_FP8_GU != 0)>(F.lds + RING_OFF, g, S, E); }
        }
        SEAM(pb + 6);
#ifdef DBG_CHECK_FFN
        if (layer == 0) { PHASE_BEGIN(); snap_x(F, 0, 2); xcd_barrier(bar); }
#endif
#ifdef DBG_CHECK_ACT
        if (layer == 0) { PHASE_BEGIN(); check_act(F); xcd_barrier(bar); }
#endif
#ifdef DBG_TWOPASS
        { PHASE_BEGIN(); if (!moe) CK(pb + 6, WS_ACT, (size_t)T * FF * 2); CKBAR(); }
#endif
        if (IN(pb + 7) && !skipffn) { PHASE_BEGIN();
            pg8::Gemm g; pg8::GroupOrder S; pg8::EpiResid E;
            if (moe) { unsigned cnt[8]; load_counts(F, cnt); g = pg8::Gemm{wsp<bf16>(F, WS_ACT), wsp<bf16>(F, WS_WEDN), MOE_ROWS, D, FE}; S.init_counts(cnt, D, F.G, (int)blockIdx.x, (LAS int*)(F.lds + TP_OFF)); E = pg8::EpiResid{nullptr, wsp<float>(F, WS_Y), D / 256}; }
            else { g = pg8::Gemm{wsp<bf16>(F, WS_ACT), wsp<bf16>(F, WS_WFDN), T, D, FF}; S.init_dense(T, D, F.G, (int)blockIdx.x); E = pg8::EpiResid{X, X, D / 256}; }
            GEMM_SITE(6, pg8::EpiResid, g, S, E);
        }
        SEAM(pb + 7);
#ifdef DBG_CHECK_MOE
        if (moe) { PHASE_BEGIN(); check_experts(F); xcd_barrier(bar); }
#endif
#ifdef DBG_CHECK_FFN
        if (layer == 0) { PHASE_BEGIN(); check_down(F); xcd_barrier(bar); }
#endif
#ifdef DBG_TWOPASS
        { PHASE_BEGIN(); if (!moe) CK(pb + 7, WS_X, (size_t)T * D * 4); CKBAR(); }
#endif
        if (IN(pb + 8)) { PHASE_BEGIN();
            if (moe) combine_norm_phase(F, X, inp(I_GPLE) + (size_t)layer * D, H);
            else norm_rows(F, X, inp(I_GPLE) + (size_t)layer * D, H);
        }
        SEAM(pb + 8);
#ifdef DBG_CHECK_MOE
        if (moe) { PHASE_BEGIN(); check_combine(F); xcd_barrier(bar); }
#endif
#ifdef DBG_CHECK_FFN
        if (layer == DBG_LAYER) { PHASE_BEGIN(); check_norm3(F, layer); snap_x(F, 1, 4); xcd_barrier(bar); }
#endif
#ifdef DBG_TWOPASS
        { PHASE_BEGIN(); CK(pb + 8, WS_X, (size_t)T * D * 4); CK(pb + 8, WS_H, (size_t)T * D * 2); CKBAR(); }
#endif
#ifdef DBG_SKIP_PLE
        if (false) {
#else
        if (IN(pb + 9)) { PHASE_BEGIN();
#endif
            pg8::Gemm g{H, wsp<bf16>(F, WS_WPG) + (size_t)layer * D * D, T, D, D}; pg8::GroupOrder S; S.init_dense(T, D, F.G, (int)blockIdx.x);
            pg8::EpiPleGate E{X, wsp<bf16>(F, WS_PROJ) + (size_t)layer * T * D};
            GEMM_SITE(7, pg8::EpiPleGate, g, S, E);
        }
        SEAM(pb + 9);
#ifdef DBG_CHECK_FFN
        if (layer == DBG_LAYER) { PHASE_BEGIN(); check_ple(F, layer); xcd_barrier(bar); }
#endif
#ifdef DBG_TWOPASS
        { PHASE_BEGIN(); CK(pb + 9, WS_X, (size_t)T * D * 4); CKBAR(); }
#endif
        if (IN(pb + 10)) { PHASE_BEGIN();
            if (layer + 1 < DEPTH) norm_rows(F, X, inp(I_GMIX) + (size_t)(layer + 1) * D, H, MK_I8_INPROJ != 0);
            else final_norm(F, X, inp(I_GFIN), outp());
        }
        if (layer + 1 < DEPTH) SEAM(pb + 10);
#ifdef DBG_TWOPASS
        if (layer + 1 < DEPTH) { PHASE_BEGIN(); CK(pb + 10, WS_H, (size_t)T * D * 2); CKBAR(); }
        else { xcd_barrier(bar); PHASE_BEGIN(); cksum_ptr(F, (const v4u*)outp(), (size_t)T * D * 4, CW_CK + dbg_pass * 64 + pb + 10); CKBAR(); }
#endif
    }
    {
        constexpr int layer = 1;

        const int pb = 1 + layer * NSTEP;
#ifdef DBG_SKIP_MOE
        const bool moe = false; const bool skipffn = (layer & 1) != 0;
#elif defined(DBG_SKIP_DENSE)
        const bool moe = (layer & 1) != 0; const bool skipffn = (layer & 1) == 0;
#else
        const bool moe = (layer & 1) != 0; const bool skipffn = false;
#endif
        if (IN(pb + 0)) { PHASE_BEGIN();
            if (layer == 0) {
                pg8::Gemm g{wsp<bf16>(F, WS_PB), wsp<bf16>(F, WS_WPP), 2 * T, D, PLE}; pg8::GroupOrder S; S.init_equal(2, T, D, F.G, (int)blockIdx.x, (LAS int*)(F.lds + TP_OFF));
                pg8::EpiStore E{wsp<bf16>(F, WS_PROJ), D, D / 256};
                GEMM_SITE(0, pg8::EpiStore, g, S, E);
            }
            pg8::Gemm g{H, wsp<bf16>(F, WS_WIN) + (size_t)layer * INC * D / (MK_I8_INPROJ ? 2 : 1), T, INC, MK_I8_INPROJ ? D / 2 : D}; pg8::GroupOrder S; S.init_dense(T, INC, F.G, (int)blockIdx.x);
            pg8::EpiInProj E{wsp<bf16>(F, WS_Q), wsp<bf16>(F, WS_K), wsp<bf16>(F, WS_V), wsp<bf16>(F, WS_Z), wsp<bf16>(F, WS_SG), wsp<float>(F, WS_ROPE), QSCALE, MK_I8_INPROJ ? (const float*)wsp<float>(F, WS_RS) : nullptr, (const float*)wsp<float>(F, WS_WSC) + layer};
            pg8::gemm_phase<pg8::EpiInProj, pg8::GroupOrder, MK_ALIGN, MK_SP2, (MK_I8_INPROJ != 0)>(F.lds + RING_OFF, g, S, E);
        }
        SEAM(pb + 0);
#ifdef DBG_TWOPASS
        { PHASE_BEGIN(); CK(pb + 0, WS_Q, 128 * MiB); if (layer == 0) CK(pb + 0, WS_PROJ, (size_t)2 * T * D * 2); if (layer == 1) { CK(32, WS_Q, 16 * MiB); CK(33, WS_K, 16 * MiB); CK(34, WS_V, 16 * MiB); CK(35, WS_Z, 16 * MiB); CK(36, WS_SG, 64 * MiB); } CKBAR(); }
#endif
        if (IN(pb + 1)) { PHASE_BEGIN();
#ifdef DBG_CHECK_INPROJ
            if (layer == DBG_LAYER) check_inproj(F, layer);
#endif
#if !defined(DBG_NO_ATTN) && MK_NAIVE_ATTN
            attn_naive_phase(F, layer);
#elif !defined(DBG_NO_ATTN)
            for (int rep_ = 0; rep_ < DBG_REP_ATTN; ++rep_) attn_mfma_phase(F, layer);
#else
            { bf16* ob = wsp<bf16>(F, WS_OB); const size_t gt = (size_t)blockIdx.x * (NWAVES * 64) + F.tid, NGT = (size_t)F.G * NWAVES * 64;
              for (size_t i = gt; i < (size_t)T * AV / 8; i += NGT) *(v4u*)(ob + i * 8) = (v4u){0u, 0u, 0u, 0u}; }
#endif
#if defined(DBG_NAIVE_CONV)
            conv_naive_phase(F, layer);
#elif !defined(DBG_NO_CONV)
            conv_phase(F, layer);
#else
            { bf16* ob = wsp<bf16>(F, WS_ZC); const size_t gt = (size_t)blockIdx.x * (NWAVES * 64) + F.tid, NGT = (size_t)F.G * NWAVES * 64;
              for (size_t i = gt; i < (size_t)T * CCH / 8; i += NGT) *(v4u*)(ob + i * 8) = (v4u){0u, 0u, 0u, 0u}; }
#endif
        }
        SEAM(pb + 1);
#ifdef DBG_CHECK_ATTN
        if (layer == DBG_CHECK_ATTN - 1) { PHASE_BEGIN(); check_attn(F, layer); xcd_barrier(bar); }
#endif
#ifdef DBG_TWOPASS
        { PHASE_BEGIN(); CK(pb + 1, WS_OB, 32 * MiB); CKBAR(); }
#endif
        if (IN(pb + 2)) { PHASE_BEGIN();
            { pg8::Gemm g{wsp<bf16>(F, WS_OB), wsp<bf16>(F, WS_WA) + (size_t)layer * D * AV, T, D, AV}; pg8::GroupOrder S; S.init_dense(T, D, F.G, (int)blockIdx.x);
              pg8::EpiGate<0> E{wsp<float>(F, WS_P), wsp<bf16>(F, WS_MIX), wsp<bf16>(F, WS_SG)};
              GEMM_SITE(2, pg8::EpiGate<0>, g, S, E); }
            { pg8::Gemm g{wsp<bf16>(F, WS_ZC), wsp<bf16>(F, WS_WC) + (size_t)layer * D * CCH, T, D, CCH}; pg8::GroupOrder S; S.init_dense(T, D, F.G, (int)blockIdx.x);
              pg8::EpiGate<1> E{wsp<float>(F, WS_P), wsp<bf16>(F, WS_MIX), wsp<bf16>(F, WS_SG)};
              GEMM_SITE(3, pg8::EpiGate<1>, g, S, E); }
        }
        SEAM(pb + 2);
#ifdef DBG_CHECK_MIX
        if (layer == DBG_LAYER) { PHASE_BEGIN(); check_mix(F, layer); snap_wo(F); xcd_barrier(bar); }
#endif
#ifdef DBG_TWOPASS
        { PHASE_BEGIN(); CK(pb + 2, WS_P, 96 * MiB); CKBAR(); }
#endif
        if (IN(pb + 3)) { PHASE_BEGIN();
            pg8::Gemm g{wsp<bf16>(F, WS_MIX), wsp<bf16>(F, WS_WO) + (size_t)layer * D * D, T, D, D}; pg8::GroupOrder S; S.init_dense(T, D, F.G, (int)blockIdx.x);
            pg8::EpiResid E{layer == 0 ? inp(I_X) : (const float*)X, X, D / 256};
            GEMM_SITE(4, pg8::EpiResid, g, S, E);
        }
        SEAM(pb + 3);
#ifdef DBG_CHECK_MIX
        if (layer == DBG_LAYER) { PHASE_BEGIN(); check_wo(F, layer); xcd_barrier(bar); }
#endif
#ifdef DBG_TWOPASS
        { PHASE_BEGIN(); CK(pb + 3, WS_X, (size_t)T * D * 4); CKBAR(); }
#endif
        if (IN(pb + 4)) { PHASE_BEGIN();
            if (moe) route_phase(F, X, inp(I_GFFN) + (size_t)layer * D, H);
            else norm_rows(F, X, inp(I_GFFN) + (size_t)layer * D, H, MK_FP8_GU != 0);
        }
        SEAM(pb + 4);
#ifdef DBG_CHECK_MOE
        if (moe) { PHASE_BEGIN(); check_route(F); xcd_barrier(bar); }
#endif
#ifdef DBG_TWOPASS
        { PHASE_BEGIN(); CK(pb + 4, WS_H, (size_t)T * D * 2); if (moe) CK(pb + 4, WS_RTW, (size_t)T * 8); CKBAR(); }
#endif
        if (moe) {
            if (IN(pb + 5)) { PHASE_BEGIN(); scatter_phase(F); }
            SEAM(pb + 5);
        }
        if (IN(pb + 6) && !skipffn) { PHASE_BEGIN();
            pg8::Gemm g; pg8::GroupOrder S; pg8::EpiSwiGLU E;
            constexpr int KG = MK_FP8_GU ? D / 2 : D;
            if (moe) { unsigned cnt[8]; load_counts(F, cnt); g = pg8::Gemm{wsp<bf16>(F, WS_HP), wsp<bf16>(F, WS_WEGU), MOE_ROWS, 2 * FE, KG}; S.init_counts(cnt, 2 * FE, F.G, (int)blockIdx.x, (LAS int*)(F.lds + TP_OFF)); E = pg8::EpiSwiGLU{wsp<bf16>(F, WS_ACT), FE, 2 * FE / 256, MK_FP8_GU ? (const float*)wsp<float>(F, WS_RSP) : nullptr, (const float*)wsp<float>(F, WS_WSC) + 3}; }
            else { g = pg8::Gemm{H, wsp<bf16>(F, WS_WFGU), T, 2 * FF, KG}; S.init_dense(T, 2 * FF, F.G, (int)blockIdx.x); E = pg8::EpiSwiGLU{wsp<bf16>(F, WS_ACT), FF, 2 * FF / 256, MK_FP8_GU ? (const float*)wsp<float>(F, WS_RS) : nullptr, (const float*)wsp<float>(F, WS_WSC) + 2}; }
            for (int rep_ = 0; rep_ < DBG_REP_GU; ++rep_) { pg8::gemm_phase<pg8::EpiSwiGLU, pg8::GroupOrder, MK_FP8_GU ? MK_ALIGN_GU : MK_ALIGN, MK_FP8_GU ? MK_SP2_GU : MK_SP2, (MK_FP8_GU != 0)>(F.lds + RING_OFF, g, S, E); }
        }
        SEAM(pb + 6);
#ifdef DBG_CHECK_FFN
        if (layer == 0) { PHASE_BEGIN(); snap_x(F, 0, 2); xcd_barrier(bar); }
#endif
#ifdef DBG_CHECK_ACT
        if (layer == 0) { PHASE_BEGIN(); check_act(F); xcd_barrier(bar); }
#endif
#ifdef DBG_TWOPASS
        { PHASE_BEGIN(); if (!moe) CK(pb + 6, WS_ACT, (size_t)T * FF * 2); CKBAR(); }
#endif
        if (IN(pb + 7) && !skipffn) { PHASE_BEGIN();
            pg8::Gemm g; pg8::GroupOrder S; pg8::EpiResid E;
            if (moe) { unsigned cnt[8]; load_counts(F, cnt); g = pg8::Gemm{wsp<bf16>(F, WS_ACT), wsp<bf16>(F, WS_WEDN), MOE_ROWS, D, FE}; S.init_counts(cnt, D, F.G, (int)blockIdx.x, (LAS int*)(F.lds + TP_OFF)); E = pg8::EpiResid{nullptr, wsp<float>(F, WS_Y), D / 256}; }
            else { g = pg8::Gemm{wsp<bf16>(F, WS_ACT), wsp<bf16>(F, WS_WFDN), T, D, FF}; S.init_dense(T, D, F.G, (int)blockIdx.x); E = pg8::EpiResid{X, X, D / 256}; }
            GEMM_SITE(6, pg8::EpiResid, g, S, E);
        }
        SEAM(pb + 7);
#ifdef DBG_CHECK_MOE
        if (moe) { PHASE_BEGIN(); check_experts(F); xcd_barrier(bar); }
#endif
#ifdef DBG_CHECK_FFN
        if (layer == 0) { PHASE_BEGIN(); check_down(F); xcd_barrier(bar); }
#endif
#ifdef DBG_TWOPASS
        { PHASE_BEGIN(); if (!moe) CK(pb + 7, WS_X, (size_t)T * D * 4); CKBAR(); }
#endif
        if (IN(pb + 8)) { PHASE_BEGIN();
            if (moe) combine_norm_phase(F, X, inp(I_GPLE) + (size_t)layer * D, H);
            else norm_rows(F, X, inp(I_GPLE) + (size_t)layer * D, H);
        }
        SEAM(pb + 8);
#ifdef DBG_CHECK_MOE
        if (moe) { PHASE_BEGIN(); check_combine(F); xcd_barrier(bar); }
#endif
#ifdef DBG_CHECK_FFN
        if (layer == DBG_LAYER) { PHASE_BEGIN(); check_norm3(F, layer); snap_x(F, 1, 4); xcd_barrier(bar); }
#endif
#ifdef DBG_TWOPASS
        { PHASE_BEGIN(); CK(pb + 8, WS_X, (size_t)T * D * 4); CK(pb + 8, WS_H, (size_t)T * D * 2); CKBAR(); }
#endif
#ifdef DBG_SKIP_PLE
        if (false) {
#else
        if (IN(pb + 9)) { PHASE_BEGIN();
#endif
            pg8::Gemm g{H, wsp<bf16>(F, WS_WPG) + (size_t)layer * D * D, T, D, D}; pg8::GroupOrder S; S.init_dense(T, D, F.G, (int)blockIdx.x);
            pg8::EpiPleGate E{X, wsp<bf16>(F, WS_PROJ) + (size_t)layer * T * D};
            GEMM_SITE(7, pg8::EpiPleGate, g, S, E);
        }
        SEAM(pb + 9);
#ifdef DBG_CHECK_FFN
        if (layer == DBG_LAYER) { PHASE_BEGIN(); check_ple(F, layer); xcd_barrier(bar); }
#endif
#ifdef DBG_TWOPASS
        { PHASE_BEGIN(); CK(pb + 9, WS_X, (size_t)T * D * 4); CKBAR(); }
#endif
        if (IN(pb + 10)) { PHASE_BEGIN();
            if (layer + 1 < DEPTH) norm_rows(F, X, inp(I_GMIX) + (size_t)(layer + 1) * D, H, MK_I8_INPROJ != 0);
            else final_norm(F, X, inp(I_GFIN), outp());
        }
        if (layer + 1 < DEPTH) SEAM(pb + 10);
#ifdef DBG_TWOPASS
        if (layer + 1 < DEPTH) { PHASE_BEGIN(); CK(pb + 10, WS_H, (size_t)T * D * 2); CKBAR(); }
        else { xcd_barrier(bar); PHASE_BEGIN(); cksum_ptr(F, (const v4u*)outp(), (size_t)T * D * 4, CW_CK + dbg_pass * 64 + pb + 10); CKBAR(); }
#endif
    }
#ifdef DBG_TWOPASS
    if (dbg_pass == 1) { PHASE_BEGIN();
      if (blockIdx.x == 0 && F.tid == 0) { unsigned idx = 0u;
          for (int k = NPH - 1; k >= 0; --k) if (__hip_atomic_load((unsigned*)(F.ctl + CW_CK + k), RLX_AGENT) != __hip_atomic_load((unsigned*)(F.ctl + CW_CK + 64 + k), RLX_AGENT)) idx = (unsigned)(k + 1);
          unsigned idx2 = 0u; for (int k = 36; k >= 32; --k) if (__hip_atomic_load((unsigned*)(F.ctl + CW_CK + k), RLX_AGENT) != __hip_atomic_load((unsigned*)(F.ctl + CW_CK + 64 + k), RLX_AGENT)) idx2 = (unsigned)(k - 31);
          __hip_atomic_store((unsigned*)(F.ctl + 16), idx + 32u * idx2, RLX_AGENT); }
      xcd_barrier(bar); }
#endif
#ifdef DBG_CODE_OUT
    if (args.pass == 1 || !DBG_TWOPASS_ON) { xcd_barrier(bar); PHASE_BEGIN(); final_norm(F, inp(I_X), inp(I_GFIN), outp(), 1.f + (float)__hip_atomic_load((unsigned*)(F.ctl + 16), RLX_AGENT) + (float)((__hip_atomic_load((unsigned*)(F.ctl + 17), RLX_AGENT) + 63u) / 64u)); }
#endif
#undef IN
#undef SEAM
#undef H
#undef X
}

extern "C" void kernel_launch(void* const* d_in, const int* in_sizes, int n_in, void* d_out, int out_size, void* d_ws, size_t ws_size, hipStream_t stream) {
    static int grid = 0;
    if (grid == 0) {
        if (n_in != N_IN || in_sizes[0] != T * D || out_size != T * D || ws_size < WS_END) {
            fprintf(stderr, "kernel_launch: built for %d inputs, x/out of %d floats, >= %zu bytes of workspace; got n_in %d, in0 %d, out %d, ws %zu; nothing launched\n", N_IN, T * D, (size_t)WS_END, n_in, n_in > 0 ? in_sizes[0] : -1, out_size, ws_size);
            grid = -1; return; }
        int dev = 0, cus = 0, per_cu = 0;
        if (hipGetDevice(&dev) != hipSuccess || hipDeviceGetAttribute(&cus, hipDeviceAttributeMultiprocessorCount, dev) != hipSuccess) { fprintf(stderr, "kernel_launch: device query failed\n"); grid = -1; return; }
        if (hipFuncSetAttribute((const void*)mk_fwd, hipFuncAttributeMaxDynamicSharedMemorySize, LDS_BYTES) != hipSuccess) { fprintf(stderr, "kernel_launch: hipFuncSetAttribute failed\n"); grid = -1; return; }
        if (hipOccupancyMaxActiveBlocksPerMultiprocessor(&per_cu, (const void*)mk_fwd, NWAVES * 64, LDS_BYTES) != hipSuccess || per_cu < 1) { fprintf(stderr, "kernel_launch: occupancy query reports %d workgroups per CU\n", per_cu); }
        (void)hipGetLastError();
        grid = cus;
    }
    if (grid < 0) return;
    if (hipMemsetAsync((char*)d_ws + WS_CTL, 0, CTL_ZERO_BYTES, stream) != hipSuccess) { fprintf(stderr, "kernel_launch: hipMemsetAsync failed\n"); return; }
    Args a{};
    for (int i = 0; i < N_IN; ++i) a.in[i] = (const float*)d_in[i];
    a.out = (float*)d_out; a.ws = (unsigned char*)d_ws;
#if MK_PER_PHASE
#ifdef DBG_STOP
    for (int ph = 0; ph <= DBG_STOP; ++ph) { a.ph_lo = ph; a.ph_hi = ph + 1; hipLaunchKernelGGL(mk_fwd, dim3(grid), dim3(NWAVES * 64), LDS_BYTES, stream, a); }
    a.ph_lo = 100; a.ph_hi = 101; hipLaunchKernelGGL(mk_fwd, dim3(grid), dim3(NWAVES * 64), LDS_BYTES, stream, a);
#else
    for (int ph = 0; ph < NPH; ++ph) { a.ph_lo = ph; a.ph_hi = ph + 1; hipLaunchKernelGGL(mk_fwd, dim3(grid), dim3(NWAVES * 64), LDS_BYTES, stream, a); }
#endif
#else
#ifdef DBG_TWOPASS
    a.ph_lo = 0; a.ph_hi = NPH; a.pass = 0; hipLaunchKernelGGL(mk_fwd, dim3(grid), dim3(NWAVES * 64), LDS_BYTES, stream, a);
    (void)hipMemsetAsync((char*)d_ws + WS_CTL + CW_BAR * 4, 0, XCD_BAR_WORDS * 4, stream); (void)hipMemsetAsync((char*)d_ws + WS_CTL + CW_GCNT * 4, 0, 2048, stream);
    a.pass = 1; hipLaunchKernelGGL(mk_fwd, dim3(grid), dim3(NWAVES * 64), LDS_BYTES, stream, a);
#else
    a.ph_lo = 0; a.ph_hi = NPH; hipLaunchKernelGGL(mk_fwd, dim3(grid), dim3(NWAVES * 64), LDS_BYTES, stream, a);
#endif
#endif
    const hipError_t le = hipPeekAtLastError();
    if (le != hipSuccess) fprintf(stderr, "kernel_launch: launch failed: %s\n", hipGetErrorName(le));
}
```

```cpp
#include <hip/hip_runtime.h>
#include <cstdio>
#include <cstdint>
#define MK_SP2 true
#define MK_ALIGN true
#define MK_NAIVE_ATTN 0
#define MK_FP8_GU 1
#define MK_ALIGN_GU true
#define MK_SP2_GU true
namespace pg8 {
#define PG8_LAS __attribute__((address_space(3)))
typedef unsigned short bf16_t;
typedef short bf16x8 __attribute__((ext_vector_type(8)));
typedef float f32x4 __attribute__((ext_vector_type(4)));
typedef unsigned u32x4 __attribute__((ext_vector_type(4)));
constexpr int BM = 256, BK = 64, HALF = 128, HTB = HALF * BK * 2  , STAGE_BYTES = 8 * HTB, NXCD = 8, WGM = 8;

__host__ __device__ __forceinline__ int lds_byte(int r, int c) { const int st = (r >> 4) * 2 + (c >> 5), rr = r & 15, cc = c & 31, ob = rr * 64 + cc * 2; return st * 1024 + (ob ^ (((ob >> 9) & 1) << 5)); }
__host__ __device__ __forceinline__ void stage_rc(int b, int& R, int& C) { const int st = b / 1024, sb = b % 1024, swz = sb ^ (((sb >> 9) & 1) << 5); R = (st >> 1) * 16 + swz / 64; C = (st & 1) * 32 + (swz % 64) / 2; }
__host__ __device__ __forceinline__ int perm32(int rho) { const int n = rho >> 4, i = rho & 15; return 8 * (i >> 2) + 4 * n + (i & 3); }

struct Unit { int pm, pn, ks; };
struct Gemm { const bf16_t* A; const bf16_t* Bt; int M, N, K, ld; };

typedef float cvt_f32x2_t __attribute__((ext_vector_type(2))); typedef __bf16 cvt_bf16x2_t __attribute__((ext_vector_type(2)));
__device__ __forceinline__ unsigned cvt_pk_bf16(float lo, float hi) { cvt_f32x2_t v = {lo, hi}; cvt_bf16x2_t b = __builtin_convertvector(v, cvt_bf16x2_t); return __builtin_bit_cast(unsigned, b); }
typedef float f32x2 __attribute__((ext_vector_type(2)));
typedef unsigned u32x2 __attribute__((ext_vector_type(2)));
__device__ __forceinline__ float sigm(float x) { return __builtin_amdgcn_rcpf(1.0f + __builtin_amdgcn_exp2f(-1.4426950408889634f * x)); }
__device__ __forceinline__ float bf_lo(unsigned w) { return __uint_as_float(w << 16); }
__device__ __forceinline__ float bf_hi(unsigned w) { return __uint_as_float(w & 0xffff0000u); }

struct GroupOrder {
    int ng, nN, nwg, G, c, TM, nsplit; PG8_LAS int* tp;
    __device__ __forceinline__ void init_equal(int ngroups, int rows_per_group, int N, int G_, int c_, PG8_LAS int* tp_) {
        ng = ngroups; nN = N / BM; const int t = rows_per_group / BM; TM = t * ngroups; nwg = TM * nN; G = G_; c = c_; tp = tp_; nsplit = 1;
        if (ngroups > 1) { int tx = threadIdx.x; asm volatile("" : "+v"(tx)); if (tx < 9) tp[tx] = (tx < ngroups ? tx : ngroups) * t; __syncthreads(); }
    }
    __device__ __forceinline__ void init_dense(int M, int N, int G_, int c_) { init_equal(1, M, N, G_, c_, nullptr); }
    __device__ __forceinline__ void init_counts(const unsigned (&cnt)[8], int N, int G_, int c_, PG8_LAS int* tp_, int nsplit_ = 1) {
        ng = 8; nN = N / BM; G = G_; c = c_; tp = tp_; nsplit = nsplit_; int s = 0; int tx = threadIdx.x; asm volatile("" : "+v"(tx));
        if (tx == 0) tp[0] = 0;
#pragma unroll
        for (int e = 0; e < 8; ++e) { s += (int)((cnt[e] + 255u) >> 8); if (tx == 0) tp[e + 1] = s; }
        TM = s; nwg = TM * nN * nsplit_; __syncthreads();
    }
    __device__ __forceinline__ bool next(int i, Unit& u) const {
        const long L0 = (long)i * G + c; if (L0 >= nwg) return false;
        const int nwu = nwg / nsplit; const long L = L0 % nwu; u.ks = (int)(L0 / nwu);
        int wgid = (int)L; { const int nwg = nwu; const int q = nwg / NXCD, r = nwg % NXCD, xcd = wgid % NXCD, off = wgid / NXCD; wgid = (xcd < r ? xcd * (q + 1) : r * (q + 1) + (xcd - r) * q) + off; }
        const int nig = WGM * nN, gid = wgid / nig, fm = gid * WGM, gsz = (TM - fm) < WGM ? (TM - fm) : WGM;
        const int rt = fm + ((wgid % nig) % gsz), pl = (wgid % nig) / gsz;
        int e = 0;
        if (ng > 1) {
#pragma unroll
            for (int j = 1; j < 8; ++j) e += (j < ng && rt >= __builtin_amdgcn_readfirstlane(tp[j])) ? 1 : 0; }
        u.pm = rt; u.pn = e * nN + pl; return true;
    }
    __device__ __forceinline__ void a_ready(const Unit&) const {}
    __device__ __forceinline__ void done(const Unit&) const {}
};

#define EPI_ROWS(row0) _Pragma("unroll") for (int ai = 0; ai < 2; ++ai) _Pragma("unroll") for (int m = 0; m < 4; ++m)
__device__ __forceinline__ u32x4 pack8(const f32x4 a, const f32x4 b) { u32x4 w; w.x = cvt_pk_bf16(a[0], a[1]); w.y = cvt_pk_bf16(a[2], a[3]); w.z = cvt_pk_bf16(b[0], b[1]); w.w = cvt_pk_bf16(b[2], b[3]); return w; }
__device__ __forceinline__ f32x4 sigm4(const f32x4 v) { return (f32x4){sigm(v[0]), sigm(v[1]), sigm(v[2]), sigm(v[3])}; }

struct EpiInProj {
    static constexpr bool PERM = true, AFTER_DRAIN = false;
    bf16_t *Q, *K, *V, *Z, *SG; const float* rope; float qscale; const float* rs; const float* wsp_;
    __device__ __forceinline__ void operator()(const f32x4 (&acc_)[2][2][4][2], const Unit& u, int wr, int wc, int fr, int fq) const {
        const int pn = u.pn, row0 = u.pm * BM + wr * 64 + fr, cl = wc * 32 + 8 * fq;
        f32x4 acc[2][2][4][2];
        if (rs) { typedef int i32x4_ __attribute__((ext_vector_type(4))); const float ws = *wsp_;
            EPI_ROWS(row0) { const float sc = rs[row0 + ai * HALF + m * 16] * ws;
#pragma unroll
                for (int bj = 0; bj < 2; ++bj)
#pragma unroll
                    for (int n = 0; n < 2; ++n) acc[ai][bj][m][n] = __builtin_convertvector(__builtin_bit_cast(i32x4_, acc_[ai][bj][m][n]), f32x4) * sc; } }
        else { EPI_ROWS(row0) {
#pragma unroll
                for (int bj = 0; bj < 2; ++bj)
#pragma unroll
                    for (int n = 0; n < 2; ++n) acc[ai][bj][m][n] = acc_[ai][bj][m][n]; } }
        if (pn < 4) {
            bf16_t* base = (pn < 2) ? Q : K; const float sc = (pn < 2) ? qscale : 1.0f; const int colt = (pn & 1) * 256, g4 = 4 * (4 * (wc & 1) + fq);
            EPI_ROWS(row0) { const int row = row0 + ai * HALF + m * 16; const float* rp = rope + (size_t)(row & 2047) * 64 + g4;
                const f32x4 cs = *(const f32x4*)rp, sn = *(const f32x4*)(rp + 32);
#pragma unroll
                for (int bj = 0; bj < 2; ++bj) { const f32x4 v0 = acc[ai][bj][m][0], v1 = acc[ai][bj][m][1];
                    const f32x4 lo = (v0 * cs - v1 * sn) * sc, hi = (v1 * cs + v0 * sn) * sc;
                    bf16_t* p = base + (size_t)row * 512 + colt + (2 * bj + (wc >> 1)) * 64 + g4;
                    u32x2 a; a.x = cvt_pk_bf16(lo[0], lo[1]); a.y = cvt_pk_bf16(lo[2], lo[3]); *(u32x2*)p = a;
                    u32x2 b; b.x = cvt_pk_bf16(hi[0], hi[1]); b.y = cvt_pk_bf16(hi[2], hi[3]); *(u32x2*)(p + 32) = b; } }
        } else if (pn < 6) {
            EPI_ROWS(row0) { bf16_t* p = V + (size_t)(row0 + ai * HALF + m * 16) * 512 + (pn - 4) * 256 + cl;
#pragma unroll
                for (int bj = 0; bj < 2; ++bj) *(u32x4*)(p + bj * HALF) = pack8(acc[ai][bj][m][0], acc[ai][bj][m][1]); }
        } else if (pn < 10) {
            EPI_ROWS(row0) { bf16_t* p = Z + (size_t)(row0 + ai * HALF + m * 16) * 512 + (pn - 6) * 128 + cl;
                *(u32x4*)p = pack8(acc[ai][0][m][0] * sigm4(acc[ai][1][m][0]), acc[ai][0][m][1] * sigm4(acc[ai][1][m][1])); }
        } else {
            EPI_ROWS(row0) { bf16_t* p = SG + (size_t)(row0 + ai * HALF + m * 16) * 2048 + (pn - 10) * 256 + cl;
#pragma unroll
                for (int bj = 0; bj < 2; ++bj) *(u32x4*)(p + bj * HALF) = pack8(sigm4(acc[ai][bj][m][0]), sigm4(acc[ai][bj][m][1])); }
        }
    }
};
template <int MODE> struct EpiGate {
    static constexpr bool PERM = false, AFTER_DRAIN = false;
    float* P; bf16_t* MIX; const bf16_t* SG;
    __device__ __forceinline__ void operator()(const f32x4 (&acc)[2][2][4][2], const Unit& u, int wr, int wc, int fr, int fq) const {
        const int row0 = u.pm * BM + wr * 64 + fr, col0 = u.pn * BM + wc * 32 + 4 * fq;
        EPI_ROWS(row0) { const size_t row = (size_t)(row0 + ai * HALF + m * 16);
#pragma unroll
            for (int bj = 0; bj < 2; ++bj)
#pragma unroll
                for (int n = 0; n < 2; ++n) { const int col = col0 + bj * HALF + n * 16;
                    const u32x2 gw = *(const u32x2*)(SG + row * 2048 + MODE * 1024 + col);
                    const f32x4 gt = (f32x4){bf_lo(gw.x), bf_hi(gw.x), bf_lo(gw.y), bf_hi(gw.y)};
                    if (MODE == 0) *(f32x4*)(P + row * 1024 + col) = gt * acc[ai][bj][m][n];
                    else { const f32x4 r = *(const f32x4*)(P + row * 1024 + col) + gt * acc[ai][bj][m][n];
                        u32x2 w; w.x = cvt_pk_bf16(r[0], r[1]); w.y = cvt_pk_bf16(r[2], r[3]); *(u32x2*)(MIX + row * 1024 + col) = w; } } }
    }
};
struct EpiResid {
    static constexpr bool PERM = false, AFTER_DRAIN = false;
    const float* base; float* out; int nN;
    __device__ __forceinline__ void operator()(const f32x4 (&acc)[2][2][4][2], const Unit& u, int wr, int wc, int fr, int fq) const {
        const int row0 = u.pm * BM + wr * 64 + fr, col0 = (u.pn % nN) * BM + wc * 32 + 4 * fq;
        EPI_ROWS(row0) { const size_t off = (size_t)(row0 + ai * HALF + m * 16) * 1024 + col0;
#pragma unroll
            for (int bj = 0; bj < 2; ++bj)
#pragma unroll
                for (int n = 0; n < 2; ++n) { f32x4 r = acc[ai][bj][m][n]; if (base) r += *(const f32x4*)(base + off + bj * HALF + n * 16); *(f32x4*)(out + off + bj * HALF + n * 16) = r; } }
    }
};
struct EpiSwiGLU {
    static constexpr bool PERM = true, AFTER_DRAIN = false;
    bf16_t* ACT; int ldc, nN; const float* rs; const float* wsv;
    __device__ __forceinline__ void operator()(const f32x4 (&acc)[2][2][4][2], const Unit& u, int wr, int wc, int fr, int fq) const {
        const int row0 = u.pm * BM + wr * 64 + fr, cl = (u.pn % nN) * 128 + wc * 32 + 8 * fq;
        EPI_ROWS(row0) { bf16_t* p = ACT + (size_t)(row0 + ai * HALF + m * 16) * ldc + cl;
            f32x4 g0 = acc[ai][0][m][0], g1 = acc[ai][0][m][1], u0 = acc[ai][1][m][0], u1 = acc[ai][1][m][1];
            if (rs) { const float sc = rs[row0 + ai * HALF + m * 16] * wsv[u.pn / nN]; typedef int i32x4_ __attribute__((ext_vector_type(4)));
                g0 = __builtin_convertvector(__builtin_bit_cast(i32x4_, g0), f32x4) * sc; g1 = __builtin_convertvector(__builtin_bit_cast(i32x4_, g1), f32x4) * sc;
                u0 = __builtin_convertvector(__builtin_bit_cast(i32x4_, u0), f32x4) * sc; u1 = __builtin_convertvector(__builtin_bit_cast(i32x4_, u1), f32x4) * sc; }
            *(u32x4*)p = pack8(g0 * sigm4(g0) * u0, g1 * sigm4(g1) * u1); }
    }
};
struct EpiStore {
    static constexpr bool PERM = true, AFTER_DRAIN = false;
    bf16_t* O; int ldc, nN;
    __device__ __forceinline__ void operator()(const f32x4 (&acc)[2][2][4][2], const Unit& u, int wr, int wc, int fr, int fq) const {
        const int row0 = u.pm * BM + wr * 64 + fr, cl = (u.pn % nN) * BM + wc * 32 + 8 * fq;
        EPI_ROWS(row0) { bf16_t* p = O + (size_t)(row0 + ai * HALF + m * 16) * ldc + cl;
#pragma unroll
            for (int bj = 0; bj < 2; ++bj) *(u32x4*)(p + bj * HALF) = pack8(acc[ai][bj][m][0], acc[ai][bj][m][1]); }
    }
};
struct EpiYPart {
    static constexpr bool PERM = true, AFTER_DRAIN = false;
    bf16_t* YP; size_t plane; int nN;
    __device__ __forceinline__ void operator()(const f32x4 (&acc)[2][2][4][2], const Unit& u, int wr, int wc, int fr, int fq) const {
        const int row0 = u.pm * BM + wr * 64 + fr, cl = (u.pn % nN) * BM + wc * 32 + 8 * fq; bf16_t* base = YP + (size_t)u.ks * plane;
        EPI_ROWS(row0) { bf16_t* p = base + (size_t)(row0 + ai * HALF + m * 16) * 1024 + cl;
#pragma unroll
            for (int bj = 0; bj < 2; ++bj) *(u32x4*)(p + bj * HALF) = pack8(acc[ai][bj][m][0], acc[ai][bj][m][1]); }
    }
};
struct EpiPleGate {
    static constexpr bool PERM = false, AFTER_DRAIN = false;
    float* X; const bf16_t* PROJ; const float* rs; const float* wsp_;
    __device__ __forceinline__ void operator()(const f32x4 (&acc)[2][2][4][2], const Unit& u, int wr, int wc, int fr, int fq) const {
        const int row0 = u.pm * BM + wr * 64 + fr, col0 = u.pn * BM + wc * 32 + 4 * fq;
        EPI_ROWS(row0) { const size_t off = (size_t)(row0 + ai * HALF + m * 16) * 1024 + col0;
#pragma unroll
            for (int bj = 0; bj < 2; ++bj)
#pragma unroll
                for (int n = 0; n < 2; ++n) { const size_t o = off + bj * HALF + n * 16; const u32x2 pw = *(const u32x2*)(PROJ + o);
                    const f32x4 pr = (f32x4){bf_lo(pw.x), bf_hi(pw.x), bf_lo(pw.y), bf_hi(pw.y)};
                    f32x4 lg = acc[ai][bj][m][n]; if (rs) { typedef int i32x4_ __attribute__((ext_vector_type(4))); lg = __builtin_convertvector(__builtin_bit_cast(i32x4_, lg), f32x4) * (rs[row0 + ai * HALF + m * 16] * *wsp_); }
                    *(f32x4*)(X + o) = *(const f32x4*)(X + o) + sigm4(lg) * pr; } }
    }
};

template <class Epi, class Sched>
__device__ __forceinline__ void gemm_phase_naive(const Gemm g, const Sched& S, const Epi& E) {
    int tid_ = threadIdx.x; asm volatile("" : "+v"(tid_));
    const int tid = tid_, wid = __builtin_amdgcn_readfirstlane(tid >> 6), lane = tid & 63, wr = wid >> 2, wc = wid & 3, fr = lane & 15, fq = lane >> 4;
    const int K = g.K; Unit u;
    for (int ui = 0; S.next(ui, u); ++ui) {
        f32x4 acc[2][2][4][2];
#pragma unroll
        for (int ai = 0; ai < 2; ++ai)
#pragma unroll
            for (int m = 0; m < 4; ++m) {
                const bf16_t* ap = g.A + (size_t)(u.pm * BM + ai * HALF + wr * 64 + m * 16 + fr) * K;
#pragma unroll
                for (int bj = 0; bj < 2; ++bj)
#pragma unroll
                    for (int n = 0; n < 2; ++n) { f32x4 r = (f32x4){0.f, 0.f, 0.f, 0.f};
#pragma unroll
                        for (int j = 0; j < 4; ++j) { const int col = u.pn * BM + bj * HALF + wc * 32 + (Epi::PERM ? (8 * fq + 4 * n + j) : (16 * n + 4 * fq + j));
                            const bf16_t* bp = g.Bt + (size_t)col * K; float s = 0.f;
                            for (int k = 0; k < K; k += 8) { const u32x4 a = *(const u32x4*)(ap + k), b = *(const u32x4*)(bp + k);
                                s += bf_lo(a.x) * bf_lo(b.x) + bf_hi(a.x) * bf_hi(b.x) + bf_lo(a.y) * bf_lo(b.y) + bf_hi(a.y) * bf_hi(b.y)
                                   + bf_lo(a.z) * bf_lo(b.z) + bf_hi(a.z) * bf_hi(b.z) + bf_lo(a.w) * bf_lo(b.w) + bf_hi(a.w) * bf_hi(b.w); }
                            r[j] = s; }
                        acc[ai][bj][m][n] = r; } }
        E(acc, u, wr, wc, fr, fq);
    }
}
typedef int pg8_i32x8 __attribute__((ext_vector_type(8))); typedef int pg8_i32x4 __attribute__((ext_vector_type(4)));
template <bool FP8> struct pg8_frag { typedef bf16x8 T; };
template <> struct pg8_frag<true> { typedef pg8_i32x8 T; };
template <bool FP8> __device__ __forceinline__ void pg8_ldfrag(typename pg8_frag<FP8>::T& d, const PG8_LAS unsigned char* p) {
    if constexpr (FP8) { const pg8_i32x4 lo = *(const PG8_LAS pg8_i32x4*)p, hi = *(const PG8_LAS pg8_i32x4*)(p + 16); d = __builtin_shufflevector(lo, hi, 0, 1, 2, 3, 4, 5, 6, 7); }
    else d = *(const PG8_LAS bf16x8*)p;
}
template <bool I8> __device__ __forceinline__ f32x4 pg8_mma(const bf16x8& b, const bf16x8& a, const f32x4 c) {
    if constexpr (I8) return __builtin_bit_cast(f32x4, __builtin_amdgcn_mfma_i32_16x16x64_i8(__builtin_bit_cast(pg8_i32x4, b), __builtin_bit_cast(pg8_i32x4, a), __builtin_bit_cast(pg8_i32x4, c), 0, 0, 0));
    else return __builtin_amdgcn_mfma_f32_16x16x32_bf16(b, a, c, 0, 0, 0);
}
template <class Epi, class Sched, bool ALIGN_EPI = false, bool SP2 = false, bool I8 = false>
__device__ __forceinline__ void gemm_phase(PG8_LAS unsigned char* lds, const Gemm g, const Sched& S, const Epi& E) {
    int tid_ = threadIdx.x; asm volatile("" : "+v"(tid_));
    const int tid = tid_, wid = __builtin_amdgcn_readfirstlane(tid >> 6), lane = tid & 63, wr = wid >> 2, wc = wid & 3, fr = lane & 15, fq = lane >> 4;
    int K_ = g.K; asm volatile("" : "+s"(K_));
    const int K = K_, nt = K / BK; int LD_ = g.ld ? g.ld : g.K; asm volatile("" : "+s"(LD_)); const int LD = LD_; const size_t kspl = (size_t)K * 2;
    unsigned voffA[2], voffB[2];
#pragma unroll
    for (int i = 0; i < 2; ++i) { int R, C; stage_rc(tid * 16 + i * 8192, R, C); const int Rb = Epi::PERM ? ((R & ~31) + perm32(R & 31)) : R;
        voffA[i] = (unsigned)(R * LD + C) * 2u; voffB[i] = (unsigned)(Rb * LD + C) * 2u; }
    const size_t kstep = (size_t)(BK * 2);
    const size_t hstep = (size_t)HALF * LD * 2;
    const size_t tstep = 2 * hstep;
    const unsigned ldsw = (unsigned)wid * 1024u;
    const int aoff = lds_byte(wr * 64 + fr, fq * 8), boff = lds_byte(wc * 32 + fr, fq * 8);
    constexpr int NK = 2;
#define PG8_SA(b, h) (((b) * 2 + (h)) * HTB)
#define PG8_SB(b, h) ((4 + (b) * 2 + (h)) * HTB)
#define PG8_STAGE(bufoff, gbase, voff) do { _Pragma("unroll") for (int _i = 0; _i < 2; ++_i) \
        __builtin_amdgcn_global_load_lds((const unsigned*)((const char*)(gbase) + (voff)[_i]), (PG8_LAS unsigned*)(lds + (bufoff) + ldsw + _i * 8192), 16, 0, 0); } while (0)
#define PG8_LDA(dst, b, h) do { _Pragma("unroll") for (int m = 0; m < 4; ++m) _Pragma("unroll") for (int k = 0; k < NK; ++k) pg8_ldfrag<false>(dst[m][k], lds + PG8_SA(b, h) + aoff + m * 2048 + k * 1024); } while (0)
#define PG8_LDB(dst, b, h) do { _Pragma("unroll") for (int n = 0; n < 2; ++n) _Pragma("unroll") for (int k = 0; k < NK; ++k) pg8_ldfrag<false>(dst[n][k], lds + PG8_SB(b, h) + boff + n * 2048 + k * 1024); } while (0)
#define PG8_MMA(ai, bj, At, Bt) do { __builtin_amdgcn_s_setprio(1); _Pragma("unroll") for (int m = 0; m < 4; ++m) _Pragma("unroll") for (int n = 0; n < 2; ++n) _Pragma("unroll") for (int k = 0; k < NK; ++k) \
        acc[ai][bj][m][n] = pg8_mma<I8>(Bt[n][k], At[m][k], acc[ai][bj][m][n]); __builtin_amdgcn_s_setprio(0); } while (0)
#define PG8_WAIT_V(n) asm volatile("s_waitcnt vmcnt(" #n ")" ::: "memory")
#define PG8_WAIT_L(n) asm volatile("s_waitcnt lgkmcnt(" #n ")" ::: "memory")
#define PG8_BAR __builtin_amdgcn_s_barrier()
#define PG8_SCHED __builtin_amdgcn_sched_barrier(0)
    Unit cur, nxt; int ui = 0;
    if (!S.next(0, cur)) return;
    f32x4 acc[2][2][4][2];
#pragma unroll
    for (int a = 0; a < 2; ++a)
#pragma unroll
        for (int b = 0; b < 2; ++b)
#pragma unroll
            for (int m = 0; m < 4; ++m)
#pragma unroll
                for (int n = 0; n < 2; ++n) acc[a][b][m][n] = (f32x4){0.f, 0.f, 0.f, 0.f};
    bf16x8 At[4][NK], B0[2][NK], B1[2][NK];
    const char* cA = (const char*)g.A + (size_t)cur.pm * tstep + (size_t)cur.ks * kspl; const char* cB = (const char*)g.Bt + (size_t)cur.pn * tstep + (size_t)cur.ks * kspl;
    S.a_ready(cur);
    if constexpr (SP2) {
        PG8_STAGE(PG8_SB(0, 0), cB, voffB); PG8_STAGE(PG8_SB(0, 1), cB + hstep, voffB); PG8_STAGE(PG8_SA(0, 0), cA, voffA); PG8_STAGE(PG8_SA(0, 1), cA + hstep, voffA);
        if (wr == 1) PG8_BAR;
        PG8_WAIT_V(2); PG8_BAR;
        PG8_STAGE(PG8_SB(1, 0), cB + kstep, voffB); PG8_STAGE(PG8_SA(1, 0), cA + kstep, voffA); PG8_STAGE(PG8_SB(1, 1), cB + hstep + kstep, voffB);
        PG8_WAIT_V(6); PG8_BAR;
    } else {
        PG8_STAGE(PG8_SB(0, 0), cB, voffB); PG8_STAGE(PG8_SA(0, 0), cA, voffA); PG8_STAGE(PG8_SB(0, 1), cB + hstep, voffB); PG8_STAGE(PG8_SA(0, 1), cA + hstep, voffA);
        if (wr == 1) PG8_BAR;
        PG8_WAIT_V(4); PG8_BAR;
        PG8_STAGE(PG8_SB(1, 0), cB + kstep, voffB); PG8_STAGE(PG8_SA(1, 0), cA + kstep, voffA); PG8_STAGE(PG8_SB(1, 1), cB + hstep + kstep, voffB);
        PG8_WAIT_V(6); PG8_BAR;
    }
    for (;;) {
        const bool has_next = S.next(ui + 1, nxt);
        const char* nA = has_next ? (const char*)g.A + (size_t)nxt.pm * tstep + (size_t)nxt.ks * kspl : cA; const char* nB = has_next ? (const char*)g.Bt + (size_t)nxt.pn * tstep + (size_t)nxt.ks * kspl : cB;
#pragma nounroll
        for (int t = 0; t < nt; t += 2) {
            const bool last = (t == nt - 2);
            const char* a1 = cA + (size_t)(t + 1) * kstep;
            const char* a2 = last ? nA : cA + (size_t)(t + 2) * kstep; const char* b2 = last ? nB : cB + (size_t)(t + 2) * kstep;
            const char* a3 = a2 + kstep; const char* b3 = b2 + kstep;
            if (last && has_next) S.a_ready(nxt);
            if constexpr (SP2) {
            PG8_LDB(B0, 0, 0); PG8_LDB(B1, 0, 1); PG8_SCHED; PG8_LDA(At, 0, 0); PG8_STAGE(PG8_SA(1, 1), a1 + hstep, voffA);
            PG8_WAIT_V(8); PG8_WAIT_L(0); PG8_BAR; PG8_MMA(0, 0, At, B0); PG8_MMA(0, 1, At, B1); PG8_BAR; PG8_SCHED;
            PG8_LDA(At, 0, 1); PG8_STAGE(PG8_SB(0, 0), b2, voffB); PG8_STAGE(PG8_SB(0, 1), b2 + hstep, voffB); PG8_STAGE(PG8_SA(0, 0), a2, voffA);
            PG8_WAIT_V(8); PG8_WAIT_L(0); PG8_BAR; PG8_MMA(1, 0, At, B0); PG8_MMA(1, 1, At, B1); PG8_BAR; PG8_SCHED;
            PG8_LDB(B0, 1, 0); PG8_LDB(B1, 1, 1); PG8_SCHED; PG8_LDA(At, 1, 0); PG8_STAGE(PG8_SA(0, 1), a2 + hstep, voffA);
            PG8_WAIT_V(8); PG8_WAIT_L(0); PG8_BAR; PG8_MMA(0, 0, At, B0); PG8_MMA(0, 1, At, B1); PG8_BAR; PG8_SCHED;
            PG8_LDA(At, 1, 1); PG8_STAGE(PG8_SB(1, 0), b3, voffB); PG8_STAGE(PG8_SB(1, 1), b3 + hstep, voffB); PG8_STAGE(PG8_SA(1, 0), a3, voffA);
            PG8_WAIT_V(8); PG8_WAIT_L(0); PG8_BAR; PG8_MMA(1, 0, At, B0); PG8_MMA(1, 1, At, B1); PG8_BAR; PG8_SCHED;
            } else {
            PG8_LDB(B0, 0, 0); PG8_SCHED; PG8_LDA(At, 0, 0); PG8_STAGE(PG8_SA(1, 1), a1 + hstep, voffA);
            PG8_WAIT_L(8); PG8_BAR; PG8_WAIT_L(0); PG8_MMA(0, 0, At, B0); PG8_BAR; PG8_SCHED;
            PG8_LDB(B1, 0, 1); PG8_STAGE(PG8_SB(0, 0), b2, voffB);
            PG8_BAR; PG8_WAIT_L(0); PG8_MMA(0, 1, At, B1); PG8_BAR;
            PG8_LDA(At, 0, 1); PG8_STAGE(PG8_SA(0, 0), a2, voffA);
            PG8_BAR; PG8_WAIT_L(0); PG8_MMA(1, 0, At, B0); PG8_BAR; PG8_SCHED;
            PG8_STAGE(PG8_SB(0, 1), b2 + hstep, voffB);
            PG8_WAIT_V(6); PG8_BAR; PG8_MMA(1, 1, At, B1); PG8_BAR;
            PG8_LDB(B0, 1, 0); PG8_SCHED; PG8_LDA(At, 1, 0); PG8_STAGE(PG8_SA(0, 1), a2 + hstep, voffA);
            PG8_WAIT_L(8); PG8_BAR; PG8_WAIT_L(0); PG8_MMA(0, 0, At, B0); PG8_BAR; PG8_SCHED;
            PG8_LDB(B1, 1, 1); PG8_STAGE(PG8_SB(1, 0), b3, voffB);
            PG8_BAR; PG8_WAIT_L(0); PG8_MMA(0, 1, At, B1); PG8_BAR;
            PG8_LDA(At, 1, 1); PG8_STAGE(PG8_SA(1, 0), a3, voffA);
            PG8_BAR; PG8_WAIT_L(0); PG8_MMA(1, 0, At, B0); PG8_BAR; PG8_SCHED;
            PG8_STAGE(PG8_SB(1, 1), b3 + hstep, voffB);
            PG8_WAIT_V(6); PG8_BAR; PG8_MMA(1, 1, At, B1); PG8_BAR;
            }
        }
        if constexpr (ALIGN_EPI) { if (wr == 0) PG8_BAR; }
        if constexpr (!Epi::AFTER_DRAIN) { E(acc, cur, wr, wc, fr, fq); S.done(cur); }
        if (!has_next) break;
#pragma unroll
        for (int a = 0; a < 2; ++a)
#pragma unroll
            for (int b = 0; b < 2; ++b)
#pragma unroll
                for (int m = 0; m < 4; ++m)
#pragma unroll
                    for (int n = 0; n < 2; ++n) acc[a][b][m][n] = (f32x4){0.f, 0.f, 0.f, 0.f};
        cur = nxt; cA = nA; cB = nB; ++ui;
        if constexpr (ALIGN_EPI) { if (wr == 1) PG8_BAR; }
    }
    PG8_WAIT_V(0);
    if constexpr (!ALIGN_EPI) { if (wr == 0) PG8_BAR; }
    PG8_BAR;
    if constexpr (Epi::AFTER_DRAIN) { E.fused(acc, cur, wr, wc, fr, fq, lds, wid, lane); S.done(cur); }
#undef PG8_SA
#undef PG8_SB
#undef PG8_STAGE
#undef PG8_LDA
#undef PG8_LDB
#undef PG8_MMA
#undef PG8_WAIT_V
#undef PG8_WAIT_L
#undef PG8_BAR
#undef PG8_SCHED
}
}

constexpr int NWAVES = 8;
#ifndef MK_PER_PHASE
#define MK_PER_PHASE 0
#endif
#ifndef MK_NAIVE_GEMM
#define MK_NAIVE_GEMM 0
#endif
#ifndef MK_SP2
#define MK_SP2 true
#endif
#ifndef MK_ALIGN
#define MK_ALIGN true
#endif
#ifdef DBG_TWOPASS
#define DBG_TWOPASS_ON 1
#else
#define DBG_TWOPASS_ON 0
#endif
#ifndef MK_FP8_GU
#define MK_FP8_GU 1
#endif
#ifndef MK_I8_INPROJ
#define MK_I8_INPROJ 1
#endif
#ifndef MK_I8_PLE
#define MK_I8_PLE 1
#endif
#ifndef MK_MOE_SPLITK
#define MK_MOE_SPLITK 1
#endif
#ifndef MK_ALIGN_GU
#define MK_ALIGN_GU false
#endif
#ifndef MK_SP2_GU
#define MK_SP2_GU false
#endif
#ifndef DBG_REP_PRO
#define DBG_REP_PRO 1
#endif
#ifndef DBG_REP_ATTN
#define DBG_REP_ATTN 1
#endif
#ifndef DBG_REP_GU
#define DBG_REP_GU 1
#endif
#ifndef DBG_LAYER
#define DBG_LAYER 0
#endif
#ifndef DBG_INJECT
#define DBG_INJECT 0.f
#endif
#ifndef MK_NAIVE_ATTN
#define MK_NAIVE_ATTN 1
#endif

constexpr int BATCH = 8, SEQ = 2048, D = 1024, T = BATCH * SEQ, DEPTH = 2;
constexpr int NH = 4, HD = 64, VD = 128, AQK = 512, AV = 512, CCH = 512, CK = 31, CPAD = 15;
constexpr int INC = 2 * AQK + AV + 2 * CCH + 2 * D;
constexpr int FF = 2816, NE = 8, FE = 3584, PLE = 256;
constexpr float EPS = 1e-6f;
constexpr float QSCALE = 0.125f * 1.4426950408889634f;
constexpr int MOE_ROWS = 2 * T + NE * 256;
enum { I_X = 0, I_P, I_GMIX, I_WIN, I_LAM, I_GSUB, I_WAO, I_CW, I_CB, I_CLG, I_CLB, I_WCO, I_WO, I_GFFN, I_WFGU, I_WFDN, I_WR, I_BR, I_WEGU, I_WEDN, I_GPLE, I_WPG, I_WPP, I_GFIN, N_IN };

constexpr size_t MiB = 1u << 20;
constexpr size_t WS_CTL = 0, CTL_ZERO_BYTES = 1 * MiB;
constexpr size_t WS_ROPE = 1 * MiB;
constexpr size_t WS_SCAL = 1 * MiB + 512 * 1024;
constexpr size_t WS_RTI = WS_SCAL + 4096;
constexpr size_t WS_RTW = WS_RTI + (size_t)T * 16;
constexpr size_t WS_RSEL = WS_RTW + (size_t)T * 8;
constexpr size_t WS_RS = 2 * MiB + 256 * 1024;
constexpr size_t WS_WSC = WS_SCAL + 64;
constexpr size_t WS_RSP = 2 * MiB + 512 * 1024;
static_assert(WS_RSEL + (size_t)T * 8 <= WS_RS && WS_RSP + (size_t)MOE_ROWS * 4 <= 3 * MiB, "misc region");
constexpr size_t WS_WIN = 4 * MiB, WS_WA = 22 * MiB, WS_WC = 24 * MiB, WS_WO = 26 * MiB, WS_WFGU = 30 * MiB, WS_WFDN = 41 * MiB, WS_WPG = 47 * MiB, WS_WPP = 51 * MiB;
constexpr size_t WS_WEGU = 52 * MiB, WS_WEDN = 164 * MiB;
constexpr size_t WS_X = 220 * MiB, WS_H = 284 * MiB, WS_PROJ = 316 * MiB, WS_PB = 380 * MiB, WS_R = 396 * MiB;
constexpr size_t WS_Q = WS_R, WS_K = WS_R + 16 * MiB, WS_V = WS_R + 32 * MiB, WS_Z = WS_R + 48 * MiB, WS_SG = WS_R + 64 * MiB, WS_OB = WS_R + 128 * MiB, WS_ZC = WS_R + 144 * MiB,
                 WS_P = WS_R + 160 * MiB, WS_MIX = WS_R + 224 * MiB;
constexpr size_t WS_ACT = WS_R, WS_HP = WS_R + 240 * MiB, WS_Y = WS_R + 308 * MiB, WS_END = WS_R + 444 * MiB;
static_assert((size_t)MOE_ROWS * FE * 2 <= 240 * MiB && (size_t)MOE_ROWS * D * 2 <= 68 * MiB && (size_t)MOE_ROWS * D * 4 <= 136 * MiB && (size_t)T * FF * 2 <= 240 * MiB, "region R");
constexpr int CW_TMO = 0, CW_CODE = 1, CW_BAR = 4096, CW_GCNT = 8192;

constexpr int RING_OFF = 0, RING_BYTES = 131072;
constexpr int LDSCTL_OFF = RING_BYTES, MISC_OFF = LDSCTL_OFF + 320;
constexpr int TP_OFF = MISC_OFF + 64;
constexpr int LDS_BYTES = 147456;

#define GAS __attribute__((address_space(1)))
#define LAS __attribute__((address_space(3)))
typedef unsigned short bf16;
typedef unsigned v4u __attribute__((ext_vector_type(4)));
typedef unsigned v2u __attribute__((ext_vector_type(2)));
typedef float f32x4 __attribute__((ext_vector_type(4)));
typedef GAS unsigned gu32;
#define RLX_AGENT __ATOMIC_RELAXED, __HIP_MEMORY_SCOPE_AGENT
#define LDS_WAIT() asm volatile("s_waitcnt lgkmcnt(0)" ::: "memory")
#define VM_WAIT() asm volatile("s_waitcnt vmcnt(0)" ::: "memory")
__device__ __forceinline__ unsigned f2bf(float f) { unsigned u = __builtin_bit_cast(unsigned, f); return (u + 0x7fffu + ((u >> 16) & 1u)) >> 16; }
__device__ __forceinline__ unsigned pk2(float lo, float hi) { return f2bf(lo) | (f2bf(hi) << 16); }
using pg8::bf_lo; using pg8::bf_hi; using pg8::sigm;

#define XB_TMO      128
#define XB_XCNT(j)  (256  + 64 * (j))
#define XB_XSUB(j)  (1280 + 64 * (j))
#define XB_XGEN(j)  (2304 + 64 * (j))
#define XB_TOP      3328
#define XB_TOPGEN   3392
#define XCD_BAR_WORDS 3456
#define XB_SPIN_CAP (1u << 18)

__device__ __forceinline__ unsigned xb_ld(unsigned* p)              { return __hip_atomic_load(p, __ATOMIC_RELAXED, __HIP_MEMORY_SCOPE_AGENT); }
__device__ __forceinline__ unsigned xb_add(unsigned* p, unsigned v) { return __hip_atomic_fetch_add(p, v, __ATOMIC_RELAXED, __HIP_MEMORY_SCOPE_AGENT); }
__device__ __forceinline__ unsigned xb_xcc_id() { return (unsigned)__builtin_amdgcn_s_getreg((3 << 11) | 20) & 0xFu; }
#define XB_SPIN(cond, bar) do { unsigned _sp = 0; while (cond) { __builtin_amdgcn_s_sleep(1); \
    if ((++_sp & 255u) == 0u) { if (xb_ld(&(bar)[XB_TMO])) break; if (_sp > XB_SPIN_CAP) { atomicAdd(&(bar)[XB_TMO], 1u); break; } } } } while (0)

struct XcdBarrier {
    unsigned* bar; unsigned x;
    volatile LAS unsigned* st;
};

__device__ __forceinline__ XcdBarrier xcd_barrier_post(unsigned* bar, volatile LAS unsigned* st) {
    XcdBarrier b; b.bar = bar; b.x = xb_xcc_id(); b.st = st;
    if (threadIdx.x == 0) (void)xb_add(&bar[XB_XCNT(b.x)], 1u);
    return b;
}
__device__ __forceinline__ void xcd_barrier_complete(unsigned* bar, unsigned x, unsigned& nloc, unsigned& nx) {
    const unsigned G = gridDim.x * gridDim.y * gridDim.z;
    unsigned sum, cnt, mine, sp = 0u;
    for (;;) {
        sum = 0u; cnt = 0u; mine = 0u;
#pragma unroll
        for (unsigned j = 0; j < 16; ++j) { const unsigned c = xb_ld(&bar[XB_XCNT(j)]); sum += c; cnt += (c > 0u) ? 1u : 0u; mine = (j == x) ? c : mine; }
        if (sum == G) break;
        __builtin_amdgcn_s_sleep(1);
        if ((++sp & 255u) == 0u) { if (xb_ld(&bar[XB_TMO])) break; if (sp > XB_SPIN_CAP) { atomicAdd(&bar[XB_TMO], 1u); break; } }
    }
    nloc = mine > 0u ? mine : 1u; nx = cnt > 0u ? cnt : 1u;
}

__device__ __forceinline__ void xcd_barrier(const XcdBarrier& b) {
    asm volatile("s_waitcnt vmcnt(0)" ::: "memory");
    __syncthreads();
    if (threadIdx.x == 0) {
        GAS unsigned* gbar_ = (GAS unsigned*)b.bar; unsigned bx = b.x; asm volatile("" : "+s"(gbar_), "+s"(bx)); unsigned* bar = (unsigned*)gbar_;
        __builtin_amdgcn_s_waitcnt(0);
        unsigned nloc = b.st[0], nx = b.st[1];
        if (nloc == 0u) { xcd_barrier_complete(bar, bx, nloc, nx); b.st[0] = nloc; b.st[1] = nx; }
        const unsigned old = xb_add(&bar[XB_XSUB(bx)], 1u);
        const unsigned gen = old / nloc;
        if (old + 1u == (gen + 1u) * nloc) {
            __builtin_amdgcn_fence(__ATOMIC_RELEASE, "agent");
            asm volatile("s_waitcnt vmcnt(0)" ::: "memory");
            const unsigned og = xb_add(&bar[XB_TOP], 1u);
            const unsigned tg = og / nx;
            if (og + 1u == (tg + 1u) * nx) xb_add(&bar[XB_TOPGEN], 1u);
            else XB_SPIN(xb_ld(&bar[XB_TOPGEN]) == tg, bar);
            __builtin_amdgcn_fence(__ATOMIC_ACQUIRE, "agent");
            xb_add(&bar[XB_XGEN(bx)], 1u);
            asm volatile("s_waitcnt vmcnt(0)" ::: "memory");
        } else {
            XB_SPIN(xb_ld(&bar[XB_XGEN(bx)]) == gen, bar);
            __builtin_amdgcn_fence(__ATOMIC_ACQUIRE, "agent");
            asm volatile("s_waitcnt vmcnt(0)" ::: "memory");
        }
    }
    __syncthreads();
}

struct Frame {
    LAS unsigned char* lds;
    volatile LAS unsigned* MISC;
    gu32* ctl;
    GAS unsigned char* ws;
    int tid, lane, wave, G;
};
#define CAS __attribute__((address_space(4)))
__device__ __forceinline__ const float* inp(int i) {
    const CAS unsigned char* k = (const CAS unsigned char*)__builtin_amdgcn_kernarg_segment_ptr();
    asm volatile("" : "+s"(k));
    return (const float*)*(GAS const float* const CAS*)(k + 8 * i);
}
__device__ __forceinline__ float* outp() {
    const CAS unsigned char* k = (const CAS unsigned char*)__builtin_amdgcn_kernarg_segment_ptr();
    asm volatile("" : "+s"(k));
    return (float*)*(GAS float* const CAS*)(k + 8 * N_IN);
}
template <class TP> __device__ __forceinline__ TP* wsp(Frame& F, size_t off) { GAS unsigned char* w = F.ws; asm volatile("" : "+s"(w)); return (TP*)(w + off); }

__device__ __forceinline__ float wave_sum(float v) {
#pragma unroll
    for (int o = 1; o < 64; o <<= 1) v += __shfl_xor(v, o);
    return v;
}
__device__ __forceinline__ float dot4(const f32x4 a, const f32x4 b) { return (a.x * b.x + a.y * b.y) + (a.z * b.z + a.w * b.w); }

__device__ __forceinline__ unsigned dbg_hash(unsigned a, unsigned b) { unsigned x = a * 2654435761u + b * 40503u + 0x9e3779b9u; x ^= x >> 15; x *= 2246822519u; x ^= x >> 13; x *= 3266489917u; x ^= x >> 16; return x; }
__device__ __forceinline__ void cksum_ptr(Frame& F, const v4u* p, size_t bytes, int slot) {
    const size_t n = bytes / 16, gt = (size_t)blockIdx.x * (NWAVES * 64) + F.tid, NGT = (size_t)F.G * NWAVES * 64; unsigned s = 0u;
    for (size_t i = gt; i < n; i += NGT) { const v4u v = p[i]; s += (v.x + v.y) + (v.z + v.w); }
#pragma unroll
    for (int o = 1; o < 64; o <<= 1) s += (unsigned)__shfl_xor((int)s, o);
    if (F.lane == 0) __hip_atomic_fetch_add((unsigned*)(F.ctl + slot), s, RLX_AGENT);
}
__device__ __forceinline__ void cksum(Frame& F, size_t off, size_t bytes, int slot) { cksum_ptr(F, wsp<v4u>(F, off), bytes, slot); }

enum { PK_ID = 0, PK_INPROJ = 1, PK_SWIGLU = 2, PK_FP8 = 0x100 };
constexpr int N8S = 13, W8_NS = 8192;
__device__ __forceinline__ unsigned q8(float x) { const float r = fminf(fmaxf(rintf(x), -127.f), 127.f); return (unsigned)((int)r) & 0xffu; }
__device__ __forceinline__ unsigned pk4_fp8(float a, float b, float c, float d) { return q8(a) | (q8(b) << 8) | (q8(c) << 16) | (q8(d) << 24); }
struct TEntry { int in_idx, K, N, kind, F, item0; unsigned src_off; unsigned sidx; unsigned long long dst_off; };
struct TTable { TEntry e[32]; int n, total; };
constexpr TTable make_table() {
    TTable t{}; int n = 0, it = 0;
    auto add = [&](int in_idx, size_t src_off, int K, int N, int kind, int F, size_t dst, unsigned sidx = 0) {
        t.e[n].in_idx = in_idx; t.e[n].K = K; t.e[n].N = N; t.e[n].kind = kind; t.e[n].F = F; t.e[n].item0 = it; t.e[n].src_off = (unsigned)src_off; t.e[n].sidx = sidx; t.e[n].dst_off = dst;
        it += (K / 64) * (N / 32); ++n; };
    for (int l = 0; l < 2; ++l) add(I_WIN, (size_t)l * D * INC, D, INC, PK_INPROJ | (MK_I8_INPROJ ? PK_FP8 : 0), 0, WS_WIN + (size_t)l * INC * D * (MK_I8_INPROJ ? 1 : 2), (unsigned)l);
    for (int l = 0; l < 2; ++l) add(I_WAO, (size_t)l * AV * D, AV, D, PK_ID, 0, WS_WA + (size_t)l * D * AV * 2);
    for (int l = 0; l < 2; ++l) add(I_WCO, (size_t)l * CCH * D, CCH, D, PK_ID, 0, WS_WC + (size_t)l * D * CCH * 2);
    for (int l = 0; l < 2; ++l) add(I_WO, (size_t)l * D * D, D, D, PK_ID, 0, WS_WO + (size_t)l * D * D * 2);
    add(I_WFGU, 0, D, 2 * FF, PK_SWIGLU | (MK_FP8_GU ? PK_FP8 : 0), FF, WS_WFGU, 2u);
    add(I_WFDN, 0, FF, D, PK_ID, 0, WS_WFDN);
    for (int l = 0; l < 2; ++l) add(I_WPG, (size_t)l * D * D, D, D, PK_ID | (MK_I8_PLE ? PK_FP8 : 0), 0, WS_WPG + (size_t)l * D * D * (MK_I8_PLE ? 1 : 2), 11u + (unsigned)l);
    for (int l = 0; l < 2; ++l) add(I_WPP, (size_t)l * PLE * D, PLE, D, PK_ID, 0, WS_WPP + (size_t)l * D * PLE * 2);
    for (int e = 0; e < NE; ++e) add(I_WEGU, (size_t)e * D * 2 * FE, D, 2 * FE, PK_SWIGLU | (MK_FP8_GU ? PK_FP8 : 0), FE, WS_WEGU + (size_t)e * 2 * FE * D * (MK_FP8_GU ? 1 : 2), 3u + (unsigned)e);
    for (int e = 0; e < NE; ++e) add(I_WEDN, (size_t)e * FE * D, FE, D, PK_ID, 0, WS_WEDN + (size_t)e * D * FE * 2);
    t.n = n; t.total = it; return t;
}
__constant__ TTable g_tt = make_table();
static_assert(make_table().n == 30, "transpose table");

__device__ __forceinline__ int dest_row(int kind_, int F, int c) {
    const int kind = kind_ & 0xff;
    if (kind == PK_INPROJ) {
        if (c < 1024) { const int d = c & 63, dd = d & 31; return (c & ~63) + ((dd >> 2) << 3) + ((d >> 5) << 2) + (dd & 3); }
        if (c >= 1536 && c < 2560) { const int cc = c - 1536, h = cc >= 512 ? 1 : 0, r = cc - h * 512; return 1536 + ((r >> 7) << 8) + (h << 7) + (r & 127); }
        return c;
    }
    if (kind == PK_SWIGLU) { const int h = c >= F ? 1 : 0, r = c - h * F; return ((r >> 7) << 8) + (h << 7) + (r & 127); }
    return c;
}
__device__ __forceinline__ void p0_transpose_item(const float* W, int K, int N, bf16* WT, int kind, int FFd, LAS float* scr, int item, int lane, float W8_SCALE) {
    const int nblk = N / 32, kb = item / nblk, nb = item % nblk, k0 = 64 * kb, n0 = 32 * nb;
#pragma unroll 8
    for (int i = 0; i < 32; ++i) { const int kk = 2 * i + (lane >> 5); scr[kk * 33 + (lane & 31)] = W[(size_t)(k0 + kk) * N + n0 + (lane & 31)]; }
    LDS_WAIT(); asm volatile("" ::: "memory");
    const int c = lane & 7;
#pragma unroll
    for (int j = 0; j < 4; ++j) { const int n = (lane >> 3) + 8 * j; const LAS float* s = scr + (8 * c) * 33 + n;
        if (kind & PK_FP8) { v2u o8; o8.x = pk4_fp8(s[0 * 33] * W8_SCALE, s[1 * 33] * W8_SCALE, s[2 * 33] * W8_SCALE, s[3 * 33] * W8_SCALE); o8.y = pk4_fp8(s[4 * 33] * W8_SCALE, s[5 * 33] * W8_SCALE, s[6 * 33] * W8_SCALE, s[7 * 33] * W8_SCALE);
            *(v2u*)((unsigned char*)WT + (size_t)dest_row(kind, FFd, n0 + n) * K + k0 + 8 * c) = o8; }
        else { v4u o; o.x = pk2(s[0 * 33], s[1 * 33]); o.y = pk2(s[2 * 33], s[3 * 33]); o.z = pk2(s[4 * 33], s[5 * 33]); o.w = pk2(s[6 * 33], s[7 * 33]);
        *(v4u*)(WT + (size_t)dest_row(kind, FFd, n0 + n) * K + k0 + 8 * c) = o; } }
    LDS_WAIT(); asm volatile("" ::: "memory");
}
__device__ __forceinline__ void norm_rows(Frame& F, const float* src, const float* gain, bf16* dst, bool fp8 = false) {
    const int gw = blockIdx.x * NWAVES + F.wave, NGW = F.G * NWAVES;
    f32x4 g[4];
#pragma unroll
    for (int j = 0; j < 4; ++j) g[j] = ((const f32x4*)gain)[F.lane + 64 * j];
    for (int m = gw; m < T; m += NGW) {
        const f32x4* xr = (const f32x4*)(src + (size_t)m * D) + F.lane;
        f32x4 v[4]; float s = 0.f;
#pragma unroll
        for (int j = 0; j < 4; ++j) { v[j] = xr[64 * j]; s += dot4(v[j], v[j]); }
        const float rstd = 1.f / sqrtf(wave_sum(s) * (1.f / D) + EPS);
        if (fp8) { float am = 0.f;
#pragma unroll
            for (int j = 0; j < 4; ++j) { v[j] = v[j] * rstd * g[j]; am = fmaxf(am, fmaxf(fmaxf(fabsf(v[j].x), fabsf(v[j].y)), fmaxf(fabsf(v[j].z), fabsf(v[j].w)))); }
#pragma unroll
            for (int o = 1; o < 64; o <<= 1) am = fmaxf(am, __shfl_xor(am, o));
            am = fmaxf(am, 1e-20f); const float qs = 127.f / am;
            if (F.lane == 0) wsp<float>(F, WS_RS)[m] = am * (1.f / 127.f);
            unsigned* o4 = (unsigned*)((unsigned char*)dst + (size_t)m * D) + F.lane;
#pragma unroll
            for (int j = 0; j < 4; ++j) o4[64 * j] = pk4_fp8(v[j].x * qs, v[j].y * qs, v[j].z * qs, v[j].w * qs); }
        else { unsigned long long* o8 = (unsigned long long*)(dst + (size_t)m * D) + F.lane;
#pragma unroll
        for (int j = 0; j < 4; ++j) { const f32x4 y = v[j] * rstd * g[j]; o8[64 * j] = (unsigned long long)pk2(y.x, y.y) | ((unsigned long long)pk2(y.z, y.w) << 32); } }
    }
}
__device__ __forceinline__ void final_norm(Frame& F, const float* src, const float* gain, float* dst, float dbg_scale = 1.f) {
    const int gw = blockIdx.x * NWAVES + F.wave, NGW = F.G * NWAVES;
    f32x4 g[4];
#pragma unroll
    for (int j = 0; j < 4; ++j) g[j] = ((const f32x4*)gain)[F.lane + 64 * j];
    for (int m = gw; m < T; m += NGW) {
        const f32x4* xr = (const f32x4*)(src + (size_t)m * D) + F.lane;
        f32x4 v[4]; float s = 0.f;
#pragma unroll
        for (int j = 0; j < 4; ++j) { v[j] = xr[64 * j]; s += dot4(v[j], v[j]); }
        const float rstd = 1.f / sqrtf(wave_sum(s) * (1.f / D) + EPS);
        f32x4* o = (f32x4*)(dst + (size_t)m * D) + F.lane;
#pragma unroll
        for (int j = 0; j < 4; ++j) o[64 * j] = v[j] * rstd * g[j] * dbg_scale;
    }
}
__device__ __forceinline__ void p0_prologue(Frame& F) {
    LAS float* scr = (LAS float*)(F.lds + RING_OFF + F.wave * 16384);
    const int gw = blockIdx.x * NWAVES + F.wave, NGW = F.G * NWAVES;
    LAS float* wq = (LAS float*)(F.lds + TP_OFF + 64);
    { LAS float* red = wq + 16;
      float sacc[N8S];
#pragma unroll
      for (int mi = 0; mi < N8S; ++mi) {
          const float* w = mi < 2 ? inp(I_WIN) + (size_t)mi * D * INC : mi == 2 ? inp(I_WFGU) : mi < 11 ? inp(I_WEGU) + (size_t)(mi - 3) * D * 2 * FE : inp(I_WPG) + (size_t)(mi - 11) * D * D;
          float a = 0.f;
#pragma unroll
          for (int i = 0; i < W8_NS / 4 / (NWAVES * 64); ++i) { const f32x4 t = ((const f32x4*)w)[F.tid + i * NWAVES * 64]; a += dot4(t, t); }
          sacc[mi] = a; }
#pragma unroll
      for (int mi = 0; mi < N8S; ++mi) { const float r = wave_sum(sacc[mi]); if (F.lane == 0) red[mi * NWAVES + F.wave] = r; }
      __syncthreads();
      if (F.tid < N8S) { float tot = 0.f; for (int k = 0; k < NWAVES; ++k) tot += red[F.tid * NWAVES + k];
          const float rms = fmaxf(sqrtf(tot * (1.f / W8_NS)), 1e-20f); wq[F.tid] = 127.f / (5.f * rms);
          if (blockIdx.x == 0) wsp<float>(F, WS_WSC)[F.tid] = (5.f * rms) * (1.f / 127.f); }
      __syncthreads(); }
    const int ntot = g_tt.total, nent = g_tt.n;
    for (int it = gw; it < ntot; it += NGW) {
        int ei = 0;
        while (ei + 1 < nent && it >= g_tt.e[ei + 1].item0) ++ei;
        const TEntry& te = g_tt.e[ei];
        p0_transpose_item(inp(te.in_idx) + te.src_off, te.K, te.N, wsp<bf16>(F, te.dst_off), te.kind, te.F, scr, it - te.item0, F.lane, (te.kind & PK_FP8) ? wq[te.sidx] : 1.f);
    }
    { const int gt = blockIdx.x * (NWAVES * 64) + F.tid, NGT = F.G * NWAVES * 64; const float* p = inp(I_P); bf16* pb = wsp<bf16>(F, WS_PB);
      for (int i = gt; i < 2 * T * PLE / 8; i += NGT) { const f32x4 a = *(const f32x4*)(p + (size_t)i * 8), b = *(const f32x4*)(p + (size_t)i * 8 + 4);
          v4u o; o.x = pk2(a.x, a.y); o.y = pk2(a.z, a.w); o.z = pk2(b.x, b.y); o.w = pk2(b.z, b.w); *(v4u*)(pb + (size_t)i * 8) = o; } }
    { const int gt = blockIdx.x * (NWAVES * 64) + F.tid, NGT = F.G * NWAVES * 64; float* rope = wsp<float>(F, WS_ROPE);
      for (int i = gt; i < SEQ * 32; i += NGT) { const int pos = i >> 5, f = i & 31;
          const float inv = exp2f(-(float)(2 * f) * (1.0f / 64.0f) * 13.287712379549449f); const float ang = (float)pos * inv;
          double rev = (double)ang * 0.15915494309189535; rev -= floor(rev); const float rv = (float)rev;
          rope[pos * 64 + f] = __builtin_amdgcn_cosf(rv); rope[pos * 64 + 32 + f] = __builtin_amdgcn_sinf(rv); } }
    if (blockIdx.x == 0 && F.wave == 0) {
        for (int l = 0; l < DEPTH; ++l) { const float* lf = inp(I_LAM) + l * 4 * HD;
            const float a = wave_sum(lf[F.lane] * lf[HD + F.lane]), b = wave_sum(lf[2 * HD + F.lane] * lf[3 * HD + F.lane]);
            const float lam_init = 0.8f - 0.6f * expf(-0.3f * (float)l);
            if (F.lane == 0) wsp<float>(F, WS_SCAL)[l] = expf(a) - expf(b) + lam_init; }
    }
#ifdef DBG_TWOPASS
    if (blockIdx.x == 0 && F.tid < 8) __hip_atomic_store((unsigned*)(F.ctl + CW_GCNT + 64 * F.tid), 0u, RLX_AGENT);
#endif
    norm_rows(F, inp(I_X), inp(I_GMIX), wsp<bf16>(F, WS_H), MK_I8_INPROJ != 0);
}

__device__ __forceinline__ void route_phase(Frame& F, const float* src, const float* gain, bf16* dst) {
    LAS float* wrT = (LAS float*)(F.lds);
    LAS unsigned* lcnt = (LAS unsigned*)(F.lds + 32768);
    LAS unsigned* gbase = lcnt + 8;
    LAS int* rinfo = (LAS int*)(F.lds + 32768 + 64);
    const float* wr = inp(I_WR); const float* br = inp(I_BR);
    int* rti = wsp<int>(F, WS_RTI); float* rtw = wsp<float>(F, WS_RTW);
    for (int i = F.tid; i < NE * D; i += NWAVES * 64) wrT[(i & 7) * D + (i >> 3)] = wr[i];
    f32x4 g[4];
#pragma unroll
    for (int j = 0; j < 4; ++j) g[j] = ((const f32x4*)gain)[F.lane + 64 * j];
    __syncthreads();
    for (int item = blockIdx.x; item < T / 64; item += F.G) {
        if (F.tid < 8) lcnt[F.tid] = 0u;
        __syncthreads();
        for (int rr = 0; rr < 8; ++rr) {
            const int lr = F.wave * 8 + rr, m = item * 64 + lr;
            const f32x4* xr = (const f32x4*)(src + (size_t)m * D) + F.lane;
            f32x4 v[4]; float s = 0.f;
#pragma unroll
            for (int j = 0; j < 4; ++j) { v[j] = xr[64 * j]; s += dot4(v[j], v[j]); }
            const float rstd = 1.f / sqrtf(wave_sum(s) * (1.f / D) + EPS);
#if MK_FP8_GU
            unsigned* o4 = (unsigned*)((unsigned char*)dst + (size_t)m * D) + F.lane;
            float am = 0.f;
#pragma unroll
            for (int j = 0; j < 4; ++j) { v[j] = v[j] * rstd * g[j]; am = fmaxf(am, fmaxf(fmaxf(fabsf(v[j].x), fabsf(v[j].y)), fmaxf(fabsf(v[j].z), fabsf(v[j].w)))); }
#pragma unroll
            for (int o = 1; o < 64; o <<= 1) am = fmaxf(am, __shfl_xor(am, o));
            am = fmaxf(am, 1e-20f); const float qs = 127.f / am;
            if (F.lane == 0) wsp<float>(F, WS_RS)[m] = am * (1.f / 127.f);
#pragma unroll
            for (int j = 0; j < 4; ++j) o4[64 * j] = pk4_fp8(v[j].x * qs, v[j].y * qs, v[j].z * qs, v[j].w * qs);
#else
            unsigned long long* o8 = (unsigned long long*)(dst + (size_t)m * D) + F.lane;
#pragma unroll
            for (int j = 0; j < 4; ++j) { v[j] = v[j] * rstd * g[j]; o8[64 * j] = (unsigned long long)pk2(v[j].x, v[j].y) | ((unsigned long long)pk2(v[j].z, v[j].w) << 32); }
#endif
            float lg[8];
#pragma unroll
            for (int e = 0; e < 8; ++e) { float t = 0.f;
#pragma unroll
                for (int j = 0; j < 4; ++j) t += dot4(v[j], ((const LAS f32x4*)(wrT + e * D))[F.lane + 64 * j]);
                lg[e] = wave_sum(t) + br[e]; }
            int e1 = 0; float v1 = lg[0];
#pragma unroll
            for (int e = 1; e < 8; ++e) if (lg[e] > v1) { v1 = lg[e]; e1 = e; }
            int e2 = -1; float v2 = -INFINITY;
#pragma unroll
            for (int e = 0; e < 8; ++e) if (e != e1 && lg[e] > v2) { v2 = lg[e]; e2 = e; }
            if (e2 < 0) e2 = (e1 == 0) ? 1 : 0;
            const float ex = expf(v2 - v1), w1 = 1.f / (1.f + ex), w2 = ex / (1.f + ex);
            if (F.lane == 0) {
                const unsigned lp1 = __hip_atomic_fetch_add((unsigned*)&lcnt[e1], 1u, __ATOMIC_RELAXED, __HIP_MEMORY_SCOPE_WORKGROUP);
                const unsigned lp2 = __hip_atomic_fetch_add((unsigned*)&lcnt[e2], 1u, __ATOMIC_RELAXED, __HIP_MEMORY_SCOPE_WORKGROUP);
                rinfo[lr * 4 + 0] = e1; rinfo[lr * 4 + 1] = (int)lp1; rinfo[lr * 4 + 2] = e2; rinfo[lr * 4 + 3] = (int)lp2;
                rtw[(size_t)m * 2] = w1; rtw[(size_t)m * 2 + 1] = w2; }
        }
        __syncthreads();
        if (F.tid < 8) gbase[F.tid] = __hip_atomic_fetch_add((unsigned*)(F.ctl + CW_GCNT + 64 * F.tid), lcnt[F.tid], RLX_AGENT);
        __syncthreads();
        if (F.tid < 64) { const int m = item * 64 + F.tid; const int e1 = rinfo[F.tid * 4], lp1 = rinfo[F.tid * 4 + 1], e2 = rinfo[F.tid * 4 + 2], lp2 = rinfo[F.tid * 4 + 3];
            int* o = rti + (size_t)m * 4; o[0] = e1; o[1] = (int)gbase[e1] + lp1; o[2] = e2; o[3] = (int)gbase[e2] + lp2; }
        __syncthreads();
    }
}
__device__ __forceinline__ void load_counts(Frame& F, unsigned (&cnt)[8]) {
#pragma unroll
    for (int e = 0; e < 8; ++e) cnt[e] = (unsigned)__builtin_amdgcn_readfirstlane((int)__hip_atomic_load((unsigned*)(F.ctl + CW_GCNT + 64 * e), RLX_AGENT));
}
__device__ __forceinline__ void scatter_phase(Frame& F) {
    unsigned cnt[8]; load_counts(F, cnt);
    int coff[8]; { int s = 0;
#pragma unroll
        for (int e = 0; e < 8; ++e) { coff[e] = s; s += (int)((cnt[e] + 255u) & ~255u); } }
    const int gw = blockIdx.x * NWAVES + F.wave, NGW = F.G * NWAVES;
    const int* rti = wsp<int>(F, WS_RTI); int* rsel = wsp<int>(F, WS_RSEL); const bf16* H = wsp<bf16>(F, WS_H); bf16* HP = wsp<bf16>(F, WS_HP);
    for (int m = gw; m < T; m += NGW) {
        const int e1 = rti[(size_t)m * 4], p1 = rti[(size_t)m * 4 + 1], e2 = rti[(size_t)m * 4 + 2], p2 = rti[(size_t)m * 4 + 3];
        int c1 = 0, c2 = 0;
#pragma unroll
        for (int e = 0; e < 8; ++e) { c1 = (e1 == e) ? coff[e] : c1; c2 = (e2 == e) ? coff[e] : c2; }
        const int r1 = c1 + p1, r2 = c2 + p2;
#if MK_FP8_GU
        const v4u a = ((const v4u*)((const unsigned char*)H + (size_t)m * D))[F.lane];
        ((v4u*)((unsigned char*)HP + (size_t)r1 * D))[F.lane] = a; ((v4u*)((unsigned char*)HP + (size_t)r2 * D))[F.lane] = a;
        if (F.lane == 0) { const float rsv = wsp<float>(F, WS_RS)[m]; wsp<float>(F, WS_RSP)[r1] = rsv; wsp<float>(F, WS_RSP)[r2] = rsv; }
#else
        const v4u* s = (const v4u*)(H + (size_t)m * D); const v4u a = s[F.lane], b = s[F.lane + 64];
        v4u* d1 = (v4u*)(HP + (size_t)r1 * D); v4u* d2 = (v4u*)(HP + (size_t)r2 * D);
        d1[F.lane] = a; d1[F.lane + 64] = b; d2[F.lane] = a; d2[F.lane + 64] = b;
#endif
        if (F.lane == 0) { rsel[(size_t)m * 2] = r1; rsel[(size_t)m * 2 + 1] = r2; }
    }
}
__device__ __forceinline__ void combine_norm_phase(Frame& F, float* X, const float* gain, bf16* dst, bool i8 = false) {
    const int gw = blockIdx.x * NWAVES + F.wave, NGW = F.G * NWAVES;
    const int* rsel = wsp<int>(F, WS_RSEL); const float* rtw = wsp<float>(F, WS_RTW); const float* Y = wsp<float>(F, WS_Y);
    f32x4 g[4];
#pragma unroll
    for (int j = 0; j < 4; ++j) g[j] = ((const f32x4*)gain)[F.lane + 64 * j];
    for (int m = gw; m < T; m += NGW) {
        const int r1 = rsel[(size_t)m * 2], r2 = rsel[(size_t)m * 2 + 1]; const float w1 = rtw[(size_t)m * 2], w2 = rtw[(size_t)m * 2 + 1];
        f32x4* xr = (f32x4*)(X + (size_t)m * D) + F.lane;
        f32x4 v[4]; float s = 0.f;
#if MK_MOE_SPLITK
        const bf16* yb = (const bf16*)Y; constexpr size_t PL = (size_t)MOE_ROWS * D;
#pragma unroll
        for (int j = 0; j < 4; ++j) { const size_t o = 4 * (size_t)(F.lane + 64 * j);
            const v2u a0 = *(const v2u*)(yb + (size_t)r1 * D + o), a1 = *(const v2u*)(yb + PL + (size_t)r1 * D + o), b0 = *(const v2u*)(yb + (size_t)r2 * D + o), b1 = *(const v2u*)(yb + PL + (size_t)r2 * D + o);
            const f32x4 ya = (f32x4){bf_lo(a0.x) + bf_lo(a1.x), bf_hi(a0.x) + bf_hi(a1.x), bf_lo(a0.y) + bf_lo(a1.y), bf_hi(a0.y) + bf_hi(a1.y)};
            const f32x4 yc = (f32x4){bf_lo(b0.x) + bf_lo(b1.x), bf_hi(b0.x) + bf_hi(b1.x), bf_lo(b0.y) + bf_lo(b1.y), bf_hi(b0.y) + bf_hi(b1.y)};
            v[j] = xr[64 * j] + (ya * w1 + yc * w2); xr[64 * j] = v[j]; s += dot4(v[j], v[j]); }
#else
        const f32x4* y1 = (const f32x4*)(Y + (size_t)r1 * D) + F.lane; const f32x4* y2 = (const f32x4*)(Y + (size_t)r2 * D) + F.lane;
#pragma unroll
        for (int j = 0; j < 4; ++j) { v[j] = xr[64 * j] + (y1[64 * j] * w1 + y2[64 * j] * w2); xr[64 * j] = v[j]; s += dot4(v[j], v[j]); }
#endif
        const float rstd = 1.f / sqrtf(wave_sum(s) * (1.f / D) + EPS);
        if (i8) { float am = 0.f;
#pragma unroll
            for (int j = 0; j < 4; ++j) { v[j] = v[j] * rstd * g[j]; am = fmaxf(am, fmaxf(fmaxf(fabsf(v[j].x), fabsf(v[j].y)), fmaxf(fabsf(v[j].z), fabsf(v[j].w)))); }
#pragma unroll
            for (int o = 1; o < 64; o <<= 1) am = fmaxf(am, __shfl_xor(am, o));
            am = fmaxf(am, 1e-20f); const float qs = 127.f / am;
            if (F.lane == 0) wsp<float>(F, WS_RS)[m] = am * (1.f / 127.f);
            unsigned* o4 = (unsigned*)((unsigned char*)dst + (size_t)m * D) + F.lane;
#pragma unroll
            for (int j = 0; j < 4; ++j) o4[64 * j] = pk4_fp8(v[j].x * qs, v[j].y * qs, v[j].z * qs, v[j].w * qs); }
        else { unsigned long long* o8 = (unsigned long long*)(dst + (size_t)m * D) + F.lane;
#pragma unroll
        for (int j = 0; j < 4; ++j) { const f32x4 y = v[j] * rstd * g[j]; o8[64 * j] = (unsigned long long)pk2(y.x, y.y) | ((unsigned long long)pk2(y.z, y.w) << 32); } }
    }
}

__device__ __forceinline__ void conv_phase(Frame& F, int layer) {
    LAS bf16* zt = (LAS bf16*)(F.lds);
    LAS float* wl = (LAS float*)(F.lds + 65536);
    const float* cw = inp(I_CW) + (size_t)layer * CK * CCH; const float* cb = inp(I_CB) + layer * CCH;
    const float* lg = inp(I_CLG) + layer * CCH; const float* lb = inp(I_CLB) + layer * CCH;
    const bf16* Z = wsp<bf16>(F, WS_Z); bf16* ZC = wsp<bf16>(F, WS_ZC);
    for (int i = F.tid; i < CK * CCH; i += NWAVES * 64) { const int tap = i >> 9, ch = i & 511; wl[((tap * 2 + ((ch >> 2) & 1)) * 64 + (ch >> 3)) * 4 + (ch & 3)] = cw[i]; }
    const int c0 = 8 * F.lane;
    const f32x4 b_lo = *(const f32x4*)(cb + c0), b_hi = *(const f32x4*)(cb + c0 + 4), g_lo = *(const f32x4*)(lg + c0), g_hi = *(const f32x4*)(lg + c0 + 4), o_lo = *(const f32x4*)(lb + c0), o_hi = *(const f32x4*)(lb + c0 + 4);
    for (int unit = blockIdx.x; unit < BATCH * (SEQ / 32); unit += F.G) {
        const int b = unit / (SEQ / 32), t0 = (unit % (SEQ / 32)) * 32;
        __syncthreads();
        for (int i = F.tid; i < 62 * 64; i += NWAVES * 64) { const int r = i >> 6, c16 = i & 63, t = t0 - CPAD + r;
            v4u val = (v4u){0u, 0u, 0u, 0u}; if (t >= 0 && t < SEQ) val = *(const v4u*)(Z + ((size_t)(b * SEQ + t)) * CCH + c16 * 8);
            *(LAS v4u*)(zt + r * CCH + c16 * 8) = val; }
        __syncthreads();
        const int r0 = 4 * F.wave;
        f32x4 alo[4], ahi[4];
#pragma unroll
        for (int rr = 0; rr < 4; ++rr) { alo[rr] = b_lo; ahi[rr] = b_hi; }
        f32x4 zlo[4], zhi[4];
#define CONV_LDZ(slot, rowi) do { const v4u zz = *(const LAS v4u*)(zt + (r0 + (rowi)) * CCH + c0); \
        zlo[slot] = (f32x4){bf_lo(zz.x), bf_hi(zz.x), bf_lo(zz.y), bf_hi(zz.y)}; zhi[slot] = (f32x4){bf_lo(zz.z), bf_hi(zz.z), bf_lo(zz.w), bf_hi(zz.w)}; } while (0)
        CONV_LDZ(0, 0); CONV_LDZ(1, 1); CONV_LDZ(2, 2);
#pragma unroll
        for (int tap = 0; tap < CK; ++tap) {
            CONV_LDZ((tap + 3) & 3, tap + 3);
            const f32x4 wlo = *(const LAS f32x4*)(wl + ((tap * 2 + 0) * 64 + F.lane) * 4), whi = *(const LAS f32x4*)(wl + ((tap * 2 + 1) * 64 + F.lane) * 4);
#pragma unroll
            for (int rr = 0; rr < 4; ++rr) { alo[rr] += wlo * zlo[(tap + rr) & 3]; ahi[rr] += whi * zhi[(tap + rr) & 3]; }
        }
#undef CONV_LDZ
#pragma unroll
        for (int rr = 0; rr < 4; ++rr) {
            const float mean = wave_sum((alo[rr].x + alo[rr].y) + (alo[rr].z + alo[rr].w) + (ahi[rr].x + ahi[rr].y) + (ahi[rr].z + ahi[rr].w)) * (1.f / CCH);
            const f32x4 dl = alo[rr] - mean, dh = ahi[rr] - mean;
            const float rstd = 1.f / sqrtf(wave_sum(dot4(dl, dl) + dot4(dh, dh)) * (1.f / CCH) + EPS);
            f32x4 yl = dl * rstd * g_lo + o_lo, yh = dh * rstd * g_hi + o_hi;
            yl = yl * pg8::sigm4(yl); yh = yh * pg8::sigm4(yh);
            *(v4u*)(ZC + ((size_t)(b * SEQ + t0 + r0 + rr)) * CCH + c0) = pg8::pack8(yl, yh);
        }
    }
    __syncthreads();
}

__device__ __forceinline__ void conv_naive_phase(Frame& F, int layer) {
    const float* cw = inp(I_CW) + (size_t)layer * CK * CCH; const float* cb = inp(I_CB) + layer * CCH;
    const float* lg = inp(I_CLG) + layer * CCH; const float* lb = inp(I_CLB) + layer * CCH;
    const bf16* Z = wsp<bf16>(F, WS_Z); bf16* ZC = wsp<bf16>(F, WS_ZC);
    const int gw = blockIdx.x * NWAVES + F.wave, NGW = F.G * NWAVES, c0 = 8 * F.lane;
    for (int m = gw; m < T; m += NGW) {
        const int b = m / SEQ, t = m % SEQ;
        f32x4 alo = *(const f32x4*)(cb + c0), ahi = *(const f32x4*)(cb + c0 + 4);
        for (int tap = 0; tap < CK; ++tap) { const int tt = t + tap - CPAD; if (tt < 0 || tt >= SEQ) continue;
            const v4u zz = *(const v4u*)(Z + ((size_t)(b * SEQ + tt)) * CCH + c0);
            const f32x4 wlo = *(const f32x4*)(cw + tap * CCH + c0), whi = *(const f32x4*)(cw + tap * CCH + c0 + 4);
            alo += wlo * (f32x4){bf_lo(zz.x), bf_hi(zz.x), bf_lo(zz.y), bf_hi(zz.y)}; ahi += whi * (f32x4){bf_lo(zz.z), bf_hi(zz.z), bf_lo(zz.w), bf_hi(zz.w)}; }
        const float mean = wave_sum((alo.x + alo.y) + (alo.z + alo.w) + (ahi.x + ahi.y) + (ahi.z + ahi.w)) * (1.f / CCH);
        const f32x4 dl = alo - mean, dh = ahi - mean;
        const float rstd = 1.f / sqrtf(wave_sum(dot4(dl, dl) + dot4(dh, dh)) * (1.f / CCH) + EPS);
        f32x4 yl = dl * rstd * *(const f32x4*)(lg + c0) + *(const f32x4*)(lb + c0), yh = dh * rstd * *(const f32x4*)(lg + c0 + 4) + *(const f32x4*)(lb + c0 + 4);
        yl = yl * pg8::sigm4(yl); yh = yh * pg8::sigm4(yh);
        *(v4u*)(ZC + (size_t)m * CCH + c0) = pg8::pack8(yl, yh);
    }
}

#ifdef DBG_CHECK_INPROJ
__device__ __forceinline__ float chk_col(const float* w, const f32x4 (&hv)[4], int lane, int c) {
    float t = 0.f;
#pragma unroll
    for (int j = 0; j < 4; ++j) { const int k = 4 * (lane + 64 * j); t += hv[j].x * w[(size_t)(k + 0) * INC + c] + hv[j].y * w[(size_t)(k + 1) * INC + c] + hv[j].z * w[(size_t)(k + 2) * INC + c] + hv[j].w * w[(size_t)(k + 3) * INC + c]; }
    return wave_sum(t);
}
__device__ __forceinline__ bool chk_bad(float got, float exp_) { return !(fabsf(got - exp_) <= 0.02f + 0.02f * fabsf(exp_)); }
__device__ __forceinline__ void check_inproj(Frame& F, int layer) {
    const int gw = blockIdx.x * NWAVES + F.wave; const int m = (int)(dbg_hash((unsigned)gw, 5u) % (unsigned)T), pos = m % SEQ;
    const float* x = layer == 0 ? inp(I_X) : (const float*)wsp<float>(F, WS_X); const float* gain = inp(I_GMIX) + (size_t)layer * D; const float* w = inp(I_WIN) + (size_t)layer * D * INC; const float* rope = wsp<float>(F, WS_ROPE);
    const bf16* Q = wsp<bf16>(F, WS_Q); const bf16* K = wsp<bf16>(F, WS_K); const bf16* V = wsp<bf16>(F, WS_V); const bf16* Z = wsp<bf16>(F, WS_Z); const bf16* SG = wsp<bf16>(F, WS_SG);
    f32x4 hv[4]; float s = 0.f;
#pragma unroll
    for (int j = 0; j < 4; ++j) { hv[j] = ((const f32x4*)(x + (size_t)m * D))[F.lane + 64 * j]; s += dot4(hv[j], hv[j]); }
    const float rstd = 1.f / sqrtf(wave_sum(s) * (1.f / D) + EPS);
#pragma unroll
    for (int j = 0; j < 4; ++j) hv[j] = hv[j] * rstd * ((const f32x4*)gain)[F.lane + 64 * j];
    unsigned flags = 0u;
    { for (int i = 0; i < 2; ++i) { const int c0_ = (int)(dbg_hash((unsigned)gw, 100u + i) % 512u), c = (c0_ & ~63) | (c0_ & 31), f = c & 31; const float t1 = chk_col(w, hv, F.lane, c), t2 = chk_col(w, hv, F.lane, c + 32);
        const float cs = rope[pos * 64 + f], sn = rope[pos * 64 + 32 + f];
        if (chk_bad(bf_lo((unsigned)Q[(size_t)m * 512 + c]), (t1 * cs - t2 * sn) * QSCALE) || chk_bad(bf_lo((unsigned)Q[(size_t)m * 512 + c + 32]), (t2 * cs + t1 * sn) * QSCALE)) flags |= 1u; } }
    { const int c0_ = (int)(dbg_hash((unsigned)gw, 102u) % 512u), c = (c0_ & ~63) | (c0_ & 31), f = c & 31; const float t1 = chk_col(w, hv, F.lane, 512 + c), t2 = chk_col(w, hv, F.lane, 512 + c + 32);
        const float cs = rope[pos * 64 + f], sn = rope[pos * 64 + 32 + f];
        if (chk_bad(bf_lo((unsigned)K[(size_t)m * 512 + c]), t1 * cs - t2 * sn) || chk_bad(bf_lo((unsigned)K[(size_t)m * 512 + c + 32]), t2 * cs + t1 * sn)) flags |= 1u; }
    { const int cv = (int)(dbg_hash((unsigned)gw, 103u) % 512u); const float v = chk_col(w, hv, F.lane, 1024 + cv); if (chk_bad(bf_lo((unsigned)V[(size_t)m * 512 + cv]), v)) flags |= 2u; }
    { int cz[2]; cz[0] = (int)(dbg_hash((unsigned)gw, 104u) % 512u); cz[1] = (int)(dbg_hash((unsigned)gw, 105u) % 512u); for (int i = 0; i < 2; ++i) { const float a = chk_col(w, hv, F.lane, 1536 + cz[i]), g = chk_col(w, hv, F.lane, 2048 + cz[i]);
        if (chk_bad(bf_lo((unsigned)Z[(size_t)m * 512 + cz[i]]), a / (1.f + expf(-g)))) flags |= 2u; } }
    { const int ca = (int)(dbg_hash((unsigned)gw, 106u) % 1024u), cb = (int)(dbg_hash((unsigned)gw, 107u) % 1024u); const float a = chk_col(w, hv, F.lane, 2560 + ca), b = chk_col(w, hv, F.lane, 2560 + 1024 + cb);
#ifdef DBG_SG_DETAIL
        unsigned code = 0u;
        if (chk_bad(bf_lo((unsigned)SG[(size_t)m * 2048 + ca]), 1.f / (1.f + expf(-a)))) code = (unsigned)(DBG_SG_DETAIL == 1 ? 18 - (10 + ca / 256) : (DBG_SG_DETAIL == 2 ? 1 + ((m % 256) >> 4) : DBG_SG_DETAIL == 3 ? 16 - ((m % 256) >> 4) : 1 + ((m >> 8) & 15)));
        if (chk_bad(bf_lo((unsigned)SG[(size_t)m * 2048 + 1024 + cb]), 1.f / (1.f + expf(-b)))) { const unsigned c2 = (unsigned)(DBG_SG_DETAIL == 1 ? 18 - (14 + cb / 256) : (DBG_SG_DETAIL == 2 ? 1 + ((m % 256) >> 4) : DBG_SG_DETAIL == 3 ? 16 - ((m % 256) >> 4) : 1 + ((m >> 8) & 15))); code = code > c2 ? code : c2; }
#if DBG_SG_DETAIL == 5
        if (F.lane == 0 && code) __hip_atomic_fetch_add((unsigned*)(F.ctl + 17), 1u, RLX_AGENT);
#else
        if (F.lane == 0 && code) __hip_atomic_fetch_max((unsigned*)(F.ctl + 16), code, RLX_AGENT);
#endif
#else
        if (chk_bad(bf_lo((unsigned)SG[(size_t)m * 2048 + ca]), 1.f / (1.f + expf(-a))) || chk_bad(bf_lo((unsigned)SG[(size_t)m * 2048 + 1024 + cb]), 1.f / (1.f + expf(-b)))) flags |= 4u;
#endif
    }
    if (F.lane == 0 && flags) __hip_atomic_fetch_or((unsigned*)(F.ctl + 16), flags, RLX_AGENT);
}
#endif

#ifdef DBG_CHECK_ACT
__device__ __forceinline__ void check_act(Frame& F) {
    const int gw = blockIdx.x * NWAVES + F.wave; const int m = (int)(dbg_hash((unsigned)gw, 3u) % (unsigned)T);
    const float* x = wsp<float>(F, WS_X); const float* gain = inp(I_GFFN); const float* w = inp(I_WFGU); const bf16* ACT = wsp<bf16>(F, WS_ACT);
    f32x4 hv[4]; float s = 0.f;
#pragma unroll
    for (int j = 0; j < 4; ++j) { hv[j] = ((const f32x4*)(x + (size_t)m * D))[F.lane + 64 * j]; s += dot4(hv[j], hv[j]); }
    const float rstd = 1.f / sqrtf(wave_sum(s) * (1.f / D) + EPS);
#pragma unroll
    for (int j = 0; j < 4; ++j) hv[j] = hv[j] * rstd * ((const f32x4*)gain)[F.lane + 64 * j];
    unsigned flags = 0u; int cj[4]; for (int i = 0; i < 4; ++i) cj[i] = (int)(dbg_hash((unsigned)gw, 110u + i) % (unsigned)FF);
    for (int i = 0; i < 4; ++i) { float g = 0.f, u = 0.f;
#pragma unroll
        for (int j = 0; j < 4; ++j) { const int k = 4 * (F.lane + 64 * j);
            g += hv[j].x * w[(size_t)(k + 0) * (2 * FF) + cj[i]] + hv[j].y * w[(size_t)(k + 1) * (2 * FF) + cj[i]] + hv[j].z * w[(size_t)(k + 2) * (2 * FF) + cj[i]] + hv[j].w * w[(size_t)(k + 3) * (2 * FF) + cj[i]];
            u += hv[j].x * w[(size_t)(k + 0) * (2 * FF) + FF + cj[i]] + hv[j].y * w[(size_t)(k + 1) * (2 * FF) + FF + cj[i]] + hv[j].z * w[(size_t)(k + 2) * (2 * FF) + FF + cj[i]] + hv[j].w * w[(size_t)(k + 3) * (2 * FF) + FF + cj[i]]; }
        g = wave_sum(g); u = wave_sum(u);
        const float ex = g / (1.f + expf(-g)) * u, got = bf_lo((unsigned)ACT[(size_t)m * FF + cj[i]]);
        if (!(fabsf(got - ex) <= 0.03f + 0.03f * fabsf(ex))) flags |= 8u; }
    if (F.lane == 0 && flags) __hip_atomic_fetch_or((unsigned*)(F.ctl + 16), flags, RLX_AGENT);
}
#endif

#ifdef DBG_CHECK_MIX
__device__ __forceinline__ float chk_dot_bf(const bf16* a, int K, const float* w, int ldw, int c, int lane) {
    float t = 0.f; for (int k = lane; k < K; k += 64) t += bf_lo((unsigned)a[k]) * w[(size_t)k * ldw + c]; return wave_sum(t); }
__device__ __forceinline__ void check_mix(Frame& F, int layer) {
    const int gw = blockIdx.x * NWAVES + F.wave; const int m = (int)(dbg_hash((unsigned)gw, 1u) % (unsigned)T);
    const bf16* OB = wsp<bf16>(F, WS_OB); const bf16* ZC = wsp<bf16>(F, WS_ZC); const bf16* SG = wsp<bf16>(F, WS_SG); const bf16* MIX = wsp<bf16>(F, WS_MIX);
    unsigned flags = 0u; int cc[4]; for (int i = 0; i < 4; ++i) cc[i] = (int)(dbg_hash((unsigned)gw, 120u + i) % (unsigned)D);
    for (int i = 0; i < 4; ++i) { const int c = cc[i];
        const float ad = chk_dot_bf(OB + (size_t)m * AV, AV, inp(I_WAO) + (size_t)layer * AV * D, D, c, F.lane), cd = chk_dot_bf(ZC + (size_t)m * CCH, CCH, inp(I_WCO) + (size_t)layer * CCH * D, D, c, F.lane);
        const float ex = bf_lo((unsigned)SG[(size_t)m * 2048 + c]) * ad + bf_lo((unsigned)SG[(size_t)m * 2048 + 1024 + c]) * cd, got = bf_lo((unsigned)MIX[(size_t)m * D + c]);
        if (!(fabsf(got - ex) <= 0.02f + 0.02f * fabsf(ex))) flags |= 16u; }
    if (F.lane == 0 && flags) __hip_atomic_fetch_or((unsigned*)(F.ctl + 16), flags, RLX_AGENT);
}
__device__ __forceinline__ void snap_wo(Frame& F) { const int gw = blockIdx.x * NWAVES + F.wave; const int m = (int)(dbg_hash((unsigned)gw, 6u) % (unsigned)T);
    if (F.lane < 4) wsp<float>(F, 3 * MiB + 768 * 1024)[(size_t)gw * 4 + F.lane] = wsp<float>(F, WS_X)[(size_t)m * D + (int)(dbg_hash((unsigned)gw, 130u + F.lane) % (unsigned)D)]; }
__device__ __forceinline__ void check_wo(Frame& F, int layer) {
    const int gw = blockIdx.x * NWAVES + F.wave; const int m = (int)(dbg_hash((unsigned)gw, 6u) % (unsigned)T);
    const bf16* MIX = wsp<bf16>(F, WS_MIX); const float* X = wsp<float>(F, WS_X); const float* xin = inp(I_X);
    unsigned flags = 0u; int cc[4]; for (int i_ = 0; i_ < 4; ++i_) cc[i_] = (int)(dbg_hash((unsigned)gw, 130u + i_) % (unsigned)D);
    for (int i = 0; i < 4; ++i) { const int c = cc[i];
        const float ex = (layer == 0 ? xin[(size_t)m * D + c] : wsp<float>(F, 3 * MiB + 768 * 1024)[(size_t)gw * 4 + i]) + chk_dot_bf(MIX + (size_t)m * D, D, inp(I_WO) + (size_t)layer * D * D, D, c, F.lane), got = X[(size_t)m * D + c];
        if (!(fabsf(got - ex) <= 0.02f + 0.02f * fabsf(ex))) flags |= 32u; }
    if (F.lane == 0 && flags) __hip_atomic_fetch_or((unsigned*)(F.ctl + 16), flags, RLX_AGENT);
}
#endif

#ifdef DBG_CHECK_FFN
constexpr size_t WS_DBG = 3 * MiB;
__device__ __forceinline__ void snap_x(Frame& F, int slot, int samp) {
    const int gw = blockIdx.x * NWAVES + F.wave; const int m = (int)(dbg_hash((unsigned)gw, (unsigned)samp) % (unsigned)T);
    if (F.lane < 4) wsp<float>(F, WS_DBG)[(size_t)gw * 16 + slot * 4 + F.lane] = wsp<float>(F, WS_X)[(size_t)m * D + (int)(dbg_hash((unsigned)gw, 140u + F.lane) % (unsigned)D)];
}
__device__ __forceinline__ float chk_dot_f(const float* a, int K, const float* w, int ldw, int c, int lane) { float t = 0.f; for (int k = lane; k < K; k += 64) t += a[k] * w[(size_t)k * ldw + c]; return wave_sum(t); }
__device__ __forceinline__ void check_down(Frame& F) {
    const int gw = blockIdx.x * NWAVES + F.wave; const int m = (int)(dbg_hash((unsigned)gw, 2u) % (unsigned)T); int cc[4]; for (int i_ = 0; i_ < 4; ++i_) cc[i_] = (int)(dbg_hash((unsigned)gw, 140u + i_) % (unsigned)D); unsigned flags = 0u;
    for (int i = 0; i < 4; ++i) { const float d = chk_dot_bf(wsp<bf16>(F, WS_ACT) + (size_t)m * FF, FF, inp(I_WFDN), D, cc[i], F.lane);
        const float ex = wsp<float>(F, WS_DBG)[(size_t)gw * 16 + i] + d, got = wsp<float>(F, WS_X)[(size_t)m * D + cc[i]];
        if (!(fabsf(got - ex) <= 0.02f + 0.02f * fabsf(ex))) flags |= 64u; }
    if (F.lane == 0 && flags) __hip_atomic_fetch_or((unsigned*)(F.ctl + 16), flags, RLX_AGENT);
}
__device__ __forceinline__ void check_norm3(Frame& F, int layer) {
    const int gw = blockIdx.x * NWAVES + F.wave; const int m = (int)(dbg_hash((unsigned)gw, 4u) % (unsigned)T); const float* x = wsp<float>(F, WS_X) + (size_t)m * D; const float* g = inp(I_GPLE) + (size_t)layer * D;
    float s = 0.f; for (int k = F.lane; k < D; k += 64) s += x[k] * x[k];
    const float rstd = 1.f / sqrtf(wave_sum(s) * (1.f / D) + EPS); unsigned flags = 0u;
    for (int k = F.lane; k < D; k += 64) { const float ex = x[k] * rstd * g[k], got = bf_lo((unsigned)wsp<bf16>(F, WS_H)[(size_t)m * D + k]); if (!(fabsf(got - ex) <= 0.01f + 0.01f * fabsf(ex))) flags |= 256u; }
    if (flags) __hip_atomic_fetch_or((unsigned*)(F.ctl + 16), flags, RLX_AGENT);
}
__device__ __forceinline__ void check_ple(Frame& F, int layer) {
    const int gw = blockIdx.x * NWAVES + F.wave; const int m = (int)(dbg_hash((unsigned)gw, 4u) % (unsigned)T); int cc[4]; for (int i_ = 0; i_ < 4; ++i_) cc[i_] = (int)(dbg_hash((unsigned)gw, 140u + i_) % (unsigned)D); unsigned flags = 0u;
    for (int i = 0; i < 4; ++i) { const float gl = chk_dot_bf(wsp<bf16>(F, WS_H) + (size_t)m * D, D, inp(I_WPG) + (size_t)layer * D * D, D, cc[i], F.lane);
        const float pj = chk_dot_f(inp(I_P) + ((size_t)layer * T + m) * PLE, PLE, inp(I_WPP) + (size_t)layer * PLE * D, D, cc[i], F.lane);
        const float ex = wsp<float>(F, WS_DBG)[(size_t)gw * 16 + 4 + i] + pj / (1.f + expf(-gl)) + DBG_INJECT, got = wsp<float>(F, WS_X)[(size_t)m * D + cc[i]];
        if (!(fabsf(got - ex) <= 0.02f + 0.02f * fabsf(ex))) flags |= 128u; }
    if (F.lane == 0 && flags) __hip_atomic_fetch_or((unsigned*)(F.ctl + 16), flags, RLX_AGENT);
}
#endif

#ifdef DBG_CHECK_ATTN
__device__ __forceinline__ void check_attn(Frame& F, int layer) {
    const int gw = blockIdx.x * NWAVES + F.wave; const int m = (int)(dbg_hash((unsigned)gw, 7u) % (unsigned)T), h = gw & 3, b = m / SEQ;
    const float lam = wsp<float>(F, WS_SCAL)[layer]; const float lam_init = 0.8f - 0.6f * expf(-0.3f * (float)layer), post = 1.f - lam_init;
    const float* gsub = inp(I_GSUB) + layer * VD;
    const bf16* Q = wsp<bf16>(F, WS_Q); const bf16* Kb = wsp<bf16>(F, WS_K) + (size_t)b * SEQ * AQK; const bf16* Vb = wsp<bf16>(F, WS_V) + (size_t)b * SEQ * AV; const bf16* OB = wsp<bf16>(F, WS_OB);
    LAS float* S = (LAS float*)(F.lds) + F.wave * 2048; LAS float* O = (LAS float*)(F.lds + 65536) + F.wave * 256;
    for (int c = 0; c < 2; ++c) {
        float qf[64];
#pragma unroll
        for (int i = 0; i < 8; ++i) { const v4u t = *(const v4u*)(Q + (size_t)m * AQK + h * 128 + c * 64 + i * 8);
            qf[8 * i] = bf_lo(t.x); qf[8 * i + 1] = bf_hi(t.x); qf[8 * i + 2] = bf_lo(t.y); qf[8 * i + 3] = bf_hi(t.y); qf[8 * i + 4] = bf_lo(t.z); qf[8 * i + 5] = bf_hi(t.z); qf[8 * i + 6] = bf_lo(t.w); qf[8 * i + 7] = bf_hi(t.w); }
        float mx = -1e30f;
        for (int i = 0; i < 32; ++i) { const int j = F.lane + 64 * i; const bf16* kr = Kb + (size_t)j * AQK + h * 128 + c * 64; float sc = 0.f;
#pragma unroll
            for (int t8 = 0; t8 < 8; ++t8) { const v4u t = *(const v4u*)(kr + t8 * 8);
                sc += qf[8 * t8] * bf_lo(t.x) + qf[8 * t8 + 1] * bf_hi(t.x) + qf[8 * t8 + 2] * bf_lo(t.y) + qf[8 * t8 + 3] * bf_hi(t.y) + qf[8 * t8 + 4] * bf_lo(t.z) + qf[8 * t8 + 5] * bf_hi(t.z) + qf[8 * t8 + 6] * bf_lo(t.w) + qf[8 * t8 + 7] * bf_hi(t.w); }
            S[j] = sc; mx = fmaxf(mx, sc); }
#pragma unroll
        for (int o = 1; o < 64; o <<= 1) mx = fmaxf(mx, __shfl_xor(mx, o));
        float l = 0.f;
        for (int i = 0; i < 32; ++i) { const int j = F.lane + 64 * i; const float p = exp2f(S[j] - mx); S[j] = p; l += p; }
        l = wave_sum(l);
        for (int ch = 0; ch < 4; ++ch) { float a[32];
#pragma unroll
            for (int k = 0; k < 32; ++k) a[k] = 0.f;
            for (int i = 0; i < 32; ++i) { const int j = F.lane + 64 * i; const float p = S[j]; const bf16* vr = Vb + (size_t)j * AV + h * 128 + ch * 32;
#pragma unroll
                for (int t8 = 0; t8 < 4; ++t8) { const v4u t = *(const v4u*)(vr + t8 * 8);
                    a[8 * t8] += p * bf_lo(t.x); a[8 * t8 + 1] += p * bf_hi(t.x); a[8 * t8 + 2] += p * bf_lo(t.y); a[8 * t8 + 3] += p * bf_hi(t.y); a[8 * t8 + 4] += p * bf_lo(t.z); a[8 * t8 + 5] += p * bf_hi(t.z); a[8 * t8 + 6] += p * bf_lo(t.w); a[8 * t8 + 7] += p * bf_hi(t.w); } }
#pragma unroll
            for (int k = 0; k < 32; ++k) { const float r = wave_sum(a[k]); if (F.lane == 0) O[c * 128 + ch * 32 + k] = r / l; } }
    }
    LDS_WAIT();
    const float d0 = O[F.lane] - lam * O[128 + F.lane], d1 = O[64 + F.lane] - lam * O[128 + 64 + F.lane];
    const float rstd = post / sqrtf(wave_sum(d0 * d0 + d1 * d1) * (1.f / VD) + EPS);
    const float e0 = d0 * rstd * gsub[F.lane], e1 = d1 * rstd * gsub[64 + F.lane];
    const float g0 = bf_lo((unsigned)OB[(size_t)m * AV + h * 128 + F.lane]), g1 = bf_lo((unsigned)OB[(size_t)m * AV + h * 128 + 64 + F.lane]);
    if (!(fabsf(g0 - e0) <= 0.03f + 0.03f * fabsf(e0)) || !(fabsf(g1 - e1) <= 0.03f + 0.03f * fabsf(e1))) __hip_atomic_fetch_or((unsigned*)(F.ctl + 16), 512u, RLX_AGENT);
}
#endif

#ifdef DBG_CHECK_MOE
__device__ __forceinline__ void check_route(Frame& F) {
    const int gw = blockIdx.x * NWAVES + F.wave; const int m = (int)(dbg_hash((unsigned)gw, 6u) % (unsigned)T);
    const float* x = wsp<float>(F, WS_X) + (size_t)m * D; const float* g = inp(I_GFFN) + D; const float* wr = inp(I_WR); const float* br = inp(I_BR);
    float s = 0.f; for (int k = F.lane; k < D; k += 64) s += x[k] * x[k];
    const float rstd = 1.f / sqrtf(wave_sum(s) * (1.f / D) + EPS);
    float lg[8];
#pragma unroll
    for (int e = 0; e < 8; ++e) lg[e] = 0.f;
    for (int k = F.lane; k < D; k += 64) { const float hk = x[k] * rstd * g[k];
#pragma unroll
        for (int e = 0; e < 8; ++e) lg[e] += hk * wr[k * 8 + e]; }
#pragma unroll
    for (int e = 0; e < 8; ++e) lg[e] = wave_sum(lg[e]) + br[e];
    int e1 = 0; float v1 = lg[0];
#pragma unroll
    for (int e = 1; e < 8; ++e) if (lg[e] > v1) { v1 = lg[e]; e1 = e; }
    int e2 = -1; float v2 = -INFINITY;
#pragma unroll
    for (int e = 0; e < 8; ++e) if (e != e1 && lg[e] > v2) { v2 = lg[e]; e2 = e; }
    const float ex = expf(v2 - v1), w1 = 1.f / (1.f + ex), w2 = ex / (1.f + ex);
    const int* rti = wsp<int>(F, WS_RTI) + (size_t)m * 4; const float* rtw = wsp<float>(F, WS_RTW) + (size_t)m * 2;
    const bool tie = (v1 - v2) < 1e-3f;
    bool bad = !(fabsf(rtw[0] + rtw[1] - 1.f) < 1e-3f);
    if (!tie) bad = bad || rti[0] != e1 || rti[2] != e2 || !(fabsf(rtw[0] - w1) < 2e-3f) || !(fabsf(rtw[1] - w2) < 2e-3f);
    if (bad && F.lane == 0) __hip_atomic_fetch_or((unsigned*)(F.ctl + 16), 1024u, RLX_AGENT);
}
__device__ __forceinline__ void check_experts(Frame& F) {
    const int gw = blockIdx.x * NWAVES + F.wave; const int m = (int)(dbg_hash((unsigned)gw, 6u) % (unsigned)T);
    const int* rti = wsp<int>(F, WS_RTI) + (size_t)m * 4; const int* rsel = wsp<int>(F, WS_RSEL) + (size_t)m * 2;
    const bf16* H = wsp<bf16>(F, WS_H) + (size_t)m * D; unsigned flags = 0u;
    for (int t = 0; t < 2; ++t) { const int e = rti[2 * t], r = rsel[t];
        const bf16* hp = wsp<bf16>(F, WS_HP) + (size_t)r * D; const bf16* act = wsp<bf16>(F, WS_ACT) + (size_t)r * FE; const float* y = wsp<float>(F, WS_Y) + (size_t)r * D;
        for (int k = F.lane; k < D; k += 64) if (hp[k] != H[k]) flags |= 2048u;
        const float* wgu = inp(I_WEGU) + (size_t)e * D * 2 * FE; const float* wdn = inp(I_WEDN) + (size_t)e * FE * D;
        int cj[3]; for (int i_ = 0; i_ < 3; ++i_) cj[i_] = (int)(dbg_hash((unsigned)gw, 150u + i_ + 8 * t) % (unsigned)FE);
        for (int i = 0; i < 3; ++i) { float gg = 0.f, uu = 0.f;
            for (int k = F.lane; k < D; k += 64) { const float hk = bf_lo((unsigned)hp[k]); gg += hk * wgu[(size_t)k * (2 * FE) + cj[i]]; uu += hk * wgu[(size_t)k * (2 * FE) + FE + cj[i]]; }
            gg = wave_sum(gg); uu = wave_sum(uu);
            const float ex = gg / (1.f + expf(-gg)) * uu, got = bf_lo((unsigned)act[cj[i]]);
            if (!(fabsf(got - ex) <= 0.03f + 0.03f * fabsf(ex))) flags |= 4096u; }
        int cc[2]; for (int i_ = 0; i_ < 2; ++i_) cc[i_] = (int)(dbg_hash((unsigned)gw, 160u + i_) % (unsigned)D);
        for (int i = 0; i < 2; ++i) { float d = 0.f; for (int k = F.lane; k < FE; k += 64) d += bf_lo((unsigned)act[k]) * wdn[(size_t)k * D + cc[i]];
            d = wave_sum(d); if (!(fabsf(y[cc[i]] - d) <= 0.02f + 0.02f * fabsf(d))) flags |= 8192u; }
    }
    if (F.lane < 2) wsp<float>(F, 3 * MiB + 512 * 1024)[(size_t)gw * 2 + F.lane] = wsp<float>(F, WS_X)[(size_t)m * D + (int)(dbg_hash((unsigned)gw, 160u + F.lane) % (unsigned)D)];
    if (flags) __hip_atomic_fetch_or((unsigned*)(F.ctl + 16), flags, RLX_AGENT);
}
__device__ __forceinline__ void check_combine(Frame& F) {
    const int gw = blockIdx.x * NWAVES + F.wave; const int m = (int)(dbg_hash((unsigned)gw, 6u) % (unsigned)T);
    const int* rsel = wsp<int>(F, WS_RSEL) + (size_t)m * 2; const float* rtw = wsp<float>(F, WS_RTW) + (size_t)m * 2; const float* Y = wsp<float>(F, WS_Y);
    if (F.lane < 2) { const int c = (int)(dbg_hash((unsigned)gw, 160u + F.lane) % (unsigned)D);
        const float ex = wsp<float>(F, 3 * MiB + 512 * 1024)[(size_t)gw * 2 + F.lane] + rtw[0] * Y[(size_t)rsel[0] * D + c] + rtw[1] * Y[(size_t)rsel[1] * D + c], got = wsp<float>(F, WS_X)[(size_t)m * D + c];
        if (!(fabsf(got - ex) <= 1e-3f + 1e-3f * fabsf(ex))) __hip_atomic_fetch_or((unsigned*)(F.ctl + 16), 16384u, RLX_AGENT); }
}
#endif

__device__ __forceinline__ void attn_naive_phase(Frame& F, int layer) {
    const float lam = wsp<float>(F, WS_SCAL)[layer]; const float lam_init = 0.8f - 0.6f * expf(-0.3f * (float)layer), post = 1.f - lam_init;
    const float* gsub = inp(I_GSUB) + layer * VD;
    const bf16* Q = wsp<bf16>(F, WS_Q); const bf16* Kb = wsp<bf16>(F, WS_K); const bf16* Vb = wsp<bf16>(F, WS_V); bf16* OB = wsp<bf16>(F, WS_OB);
    for (int unit = blockIdx.x; unit < BATCH * NH * (SEQ / 256); unit += F.G) {
        const int b = unit >> 5, h = (unit >> 3) & 3, qb = unit & 7, q = qb * 256 + (F.tid >> 1), c = F.tid & 1;
        const bf16* qp = Q + ((size_t)(b * SEQ + q)) * AQK + h * 128 + c * 64;
        unsigned qv[32];
#pragma unroll
        for (int i = 0; i < 8; ++i) { const v4u t = *(const v4u*)(qp + i * 8); qv[4 * i] = t.x; qv[4 * i + 1] = t.y; qv[4 * i + 2] = t.z; qv[4 * i + 3] = t.w; }
        float o[128];
#pragma unroll
        for (int e = 0; e < 128; ++e) o[e] = 0.f;
        float mx = -1e30f, l = 0.f;
        const bf16* kp = Kb + (size_t)b * SEQ * AQK + h * 128 + c * 64; const bf16* vp = Vb + (size_t)b * SEQ * AV + h * 128;
        for (int key = 0; key < SEQ; ++key) {
            float s = 0.f;
#pragma unroll
            for (int i = 0; i < 8; ++i) { const v4u kk = *(const v4u*)(kp + (size_t)key * AQK + i * 8);
                s += bf_lo(qv[4 * i]) * bf_lo(kk.x) + bf_hi(qv[4 * i]) * bf_hi(kk.x) + bf_lo(qv[4 * i + 1]) * bf_lo(kk.y) + bf_hi(qv[4 * i + 1]) * bf_hi(kk.y)
                   + bf_lo(qv[4 * i + 2]) * bf_lo(kk.z) + bf_hi(qv[4 * i + 2]) * bf_hi(kk.z) + bf_lo(qv[4 * i + 3]) * bf_lo(kk.w) + bf_hi(qv[4 * i + 3]) * bf_hi(kk.w); }
            const float mn = fmaxf(mx, s), alpha = __builtin_amdgcn_exp2f(mx - mn), p = __builtin_amdgcn_exp2f(s - mn); mx = mn; l = l * alpha + p;
#pragma unroll
            for (int i = 0; i < 16; ++i) { const v4u vv = *(const v4u*)(vp + (size_t)key * AV + i * 8);
                o[8 * i + 0] = o[8 * i + 0] * alpha + p * bf_lo(vv.x); o[8 * i + 1] = o[8 * i + 1] * alpha + p * bf_hi(vv.x);
                o[8 * i + 2] = o[8 * i + 2] * alpha + p * bf_lo(vv.y); o[8 * i + 3] = o[8 * i + 3] * alpha + p * bf_hi(vv.y);
                o[8 * i + 4] = o[8 * i + 4] * alpha + p * bf_lo(vv.z); o[8 * i + 5] = o[8 * i + 5] * alpha + p * bf_hi(vv.z);
                o[8 * i + 6] = o[8 * i + 6] * alpha + p * bf_lo(vv.w); o[8 * i + 7] = o[8 * i + 7] * alpha + p * bf_hi(vv.w); }
        }
        const float inv = 1.f / l; float rs = 0.f;
#pragma unroll
        for (int e = 0; e < 128; ++e) { const float mine = o[e] * inv, other = __shfl_xor(mine, 1); const float d = (c == 0) ? (mine - lam * other) : (other - lam * mine); o[e] = d; rs += d * d; }
        const float rstd = 1.f / sqrtf(rs * (1.f / VD) + EPS) * post;
        bf16* op = OB + ((size_t)(b * SEQ + q)) * AV + h * 128 + c * 64;
#pragma unroll
        for (int i = 0; i < 8; ++i) { float y[8];
#pragma unroll
            for (int j = 0; j < 8; ++j) y[j] = (c ? o[64 + 8 * i + j] : o[8 * i + j]) * rstd * gsub[c * 64 + 8 * i + j];
            v4u w; w.x = pk2(y[0], y[1]); w.y = pk2(y[2], y[3]); w.z = pk2(y[4], y[5]); w.w = pk2(y[6], y[7]); *(v4u*)(op + 8 * i) = w; }
    }
}

namespace dattn {
using bf16x8 = __attribute__((ext_vector_type(8))) short;
using s16x4  = __attribute__((ext_vector_type(4))) short;
using f32x16 = __attribute__((ext_vector_type(16))) float;
using u32x4  = __attribute__((ext_vector_type(4))) unsigned;
constexpr int NW = 8, QBLK = 32, KVBLK = 64, LDK = 512;
constexpr float THRL = 11.5f;
constexpr size_t SHM_V = KVBLK * 128 * 2, SHM_K = KVBLK * 128 * 2, SHM_ATTN = 2 * SHM_V + 2 * SHM_K + NW * 64 * 4;
#define KSWZ(row, colB) ((row) * 256 + ((colB) ^ (((row) & 7) << 4)))
#define SBAR() __builtin_amdgcn_sched_barrier(0)
__device__ __forceinline__ int crow(int r, int hi) { return (r & 3) + 8 * (r >> 2) + 4 * hi; }
__device__ __forceinline__ unsigned cvtpk(float lo, float hi) { return pg8::cvt_pk_bf16(lo, hi); }
__device__ __forceinline__ void partialSM(f32x16& p0, f32x16& p1, float& m_reg, float& mn, float& alpha) {
  float pmax = p0[0]; for (int r = 1; r < 16; ++r) pmax = fmaxf(pmax, p0[r]); for (int r = 0; r < 16; ++r) pmax = fmaxf(pmax, p1[r]);
  { auto rr = __builtin_amdgcn_permlane32_swap(__float_as_uint(pmax), __float_as_uint(pmax), false, false);
    pmax = fmaxf(__uint_as_float(rr[0]), __uint_as_float(rr[1])); }
  if (__builtin_expect(__all(pmax - m_reg <= THRL), 1)) { mn = m_reg; alpha = 1.f; }
  else { mn = fmaxf(m_reg, pmax); alpha = __builtin_amdgcn_exp2f(m_reg - mn); m_reg = mn; }
  for (int r = 0; r < 16; ++r) p0[r] = p0[r] - mn; for (int r = 0; r < 16; ++r) p1[r] = p1[r] - mn;
  for (int r = 0; r < 16; ++r) p0[r] = __builtin_amdgcn_exp2f(p0[r]);
}
__device__ __forceinline__ void finishSM(f32x16& p0, f32x16& p1, float alpha, float& l_reg, bf16x8& pa0, bf16x8& pa1, bf16x8& pa2, bf16x8& pa3) {
  for (int r = 0; r < 16; ++r) p1[r] = __builtin_amdgcn_exp2f(p1[r]);
  float ps = 0; for (int r = 0; r < 16; ++r) ps += p0[r]; for (int r = 0; r < 16; ++r) ps += p1[r];
  { auto rr = __builtin_amdgcn_permlane32_swap(__float_as_uint(ps), __float_as_uint(ps), false, false);
    ps = __uint_as_float(rr[0]) + __uint_as_float(rr[1]); }
  l_reg = l_reg * alpha + ps;
#define PK4(P, BASE, OUT) do { unsigned a0 = cvtpk(P[BASE + 0], P[BASE + 1]), a1 = cvtpk(P[BASE + 2], P[BASE + 3]);   \
    unsigned b0 = cvtpk(P[BASE + 4], P[BASE + 5]), b1 = cvtpk(P[BASE + 6], P[BASE + 7]);                              \
    auto r0 = __builtin_amdgcn_permlane32_swap(a0, b0, false, false); auto r1 = __builtin_amdgcn_permlane32_swap(a1, b1, false, false); \
    u32x4 w = {r0[0], r1[0], r0[1], r1[1]}; OUT = *reinterpret_cast<bf16x8*>(&w); } while (0)
  PK4(p0, 0, pa0); PK4(p0, 8, pa1); PK4(p1, 0, pa2); PK4(p1, 8, pa3);
#undef PK4
}
__device__ __forceinline__ void qkt(f32x16& p0, f32x16& p1, const char* Ks, const bf16x8* qr, int r32, int hi, int c) {
  p0 = f32x16{}; p1 = f32x16{};
  for (int d0 = 0; d0 < 4; ++d0) { int cb = (c * 64 + d0 * 16 + hi * 8) * 2;
    bf16x8 b0 = *reinterpret_cast<const bf16x8*>(Ks + KSWZ(r32, cb));
    bf16x8 b1 = *reinterpret_cast<const bf16x8*>(Ks + KSWZ(32 + r32, cb));
    p0 = __builtin_amdgcn_mfma_f32_32x32x16_bf16(b0, qr[d0], p0, 0, 0, 0);
    p1 = __builtin_amdgcn_mfma_f32_32x32x16_bf16(b1, qr[d0], p1, 0, 0, 0); }
}
__device__ __forceinline__ int v_st(int k, int c) { const int kk = (k & ~0xC) | ((k & 4) << 1) | ((k & 8) >> 1); return ((kk >> 3) * 4 + (c >> 5)) * 512 + ((kk & 7) * 32 + (c & 31)) * 2; }
__device__ __forceinline__ int v_rd_base(int lane) { return ((lane & 3) << 3) | (((lane >> 2) & 3) << 6) | (((lane >> 4) & 1) << 5) | (((lane >> 5) & 1) << 8); }
constexpr int v_rd_off(int d0, int ks, int half) { return d0 * 512 + ks * 4096 + half * 2048; }
template <int OFF> __device__ __forceinline__ s16x4 tr_read(int vb) {
  s16x4 r; asm volatile("ds_read_b64_tr_b16 %0, %1 offset:%2" : "=&v"(r) : "v"(vb), "i"(OFF) : "memory"); return r;
}
template <int D0> __device__ __forceinline__ void pv_one(f32x16& od, int vb, bf16x8 pa0, bf16x8 pa1, bf16x8 pa2, bf16x8 pa3) {
  const s16x4 l0 = tr_read<v_rd_off(D0, 0, 0)>(vb), h0 = tr_read<v_rd_off(D0, 0, 1)>(vb), l1 = tr_read<v_rd_off(D0, 1, 0)>(vb), h1 = tr_read<v_rd_off(D0, 1, 1)>(vb);
  const s16x4 l2 = tr_read<v_rd_off(D0, 2, 0)>(vb), h2 = tr_read<v_rd_off(D0, 2, 1)>(vb), l3 = tr_read<v_rd_off(D0, 3, 0)>(vb), h3 = tr_read<v_rd_off(D0, 3, 1)>(vb);
  asm volatile("s_waitcnt lgkmcnt(0)" ::: "memory"); SBAR();
#define PK(L, H) (bf16x8){L[0], L[1], L[2], L[3], H[0], H[1], H[2], H[3]}
  od = __builtin_amdgcn_mfma_f32_32x32x16_bf16(pa0, PK(l0, h0), od, 0, 0, 0);
  od = __builtin_amdgcn_mfma_f32_32x32x16_bf16(pa1, PK(l1, h1), od, 0, 0, 0);
  od = __builtin_amdgcn_mfma_f32_32x32x16_bf16(pa2, PK(l2, h2), od, 0, 0, 0);
  od = __builtin_amdgcn_mfma_f32_32x32x16_bf16(pa3, PK(l3, h3), od, 0, 0, 0);
#undef PK
}
__device__ __forceinline__ void pv_d0(f32x16* o, int vb, bf16x8 pa0, bf16x8 pa1, bf16x8 pa2, bf16x8 pa3) {
  pv_one<0>(o[0], vb, pa0, pa1, pa2, pa3); pv_one<1>(o[1], vb, pa0, pa1, pa2, pa3); pv_one<2>(o[2], vb, pa0, pa1, pa2, pa3); pv_one<3>(o[3], vb, pa0, pa1, pa2, pa3);
}
__device__ __forceinline__ void unit(const unsigned short* Qb, const unsigned short* Kh, const unsigned short* Vh, unsigned short* Ob, int seq, char* lds, float lam, float post, const float* gsub) {
  int tid_ = threadIdx.x; asm volatile("" : "+v"(tid_));
  const int tid = tid_, wid = tid >> 6, lane = tid & 63, r32 = lane & 31, hi = lane >> 5, c = wid >> 2, wq = wid & 3;
  char* V_lds = lds; char* K_lds = lds + 2 * SHM_V;
  float* ws = (float*)(lds + 2 * SHM_V + 2 * SHM_K) + wid * 64; float* li_l = ws; float* al_l = ws + 32;
  float m_reg = -1e30f, l_reg = 0; f32x16 o[4] = {}; bf16x8 qr[4];
  const unsigned short* Qw = Qb + (long)(wq * QBLK + r32) * LDK + c * 64 + hi * 8;
#pragma unroll
  for (int d0 = 0; d0 < 4; ++d0) qr[d0] = *reinterpret_cast<const bf16x8*>(Qw + d0 * 16);
  const int sr = tid >> 4, sc = (tid & 15) * 8, vst0 = v_st(sr, sc), vst1 = v_st(32 + sr, sc);
  const int vb0 = (int)(uintptr_t)V_lds + v_rd_base(lane);
  struct { bf16x8 vs0, vs1, ks0, ks1; } sr_[2];
#define SLOAD(i, k0) do { sr_[i].vs0 = *reinterpret_cast<const bf16x8*>(&Vh[(long)((k0) + sr) * LDK + sc]); sr_[i].vs1 = *reinterpret_cast<const bf16x8*>(&Vh[(long)((k0) + 32 + sr) * LDK + sc]); \
    sr_[i].ks0 = *reinterpret_cast<const bf16x8*>(&Kh[(long)((k0) + sr) * LDK + sc]); sr_[i].ks1 = *reinterpret_cast<const bf16x8*>(&Kh[(long)((k0) + 32 + sr) * LDK + sc]); } while (0)
#define SWRITE(b, i) do { *(bf16x8*)(V_lds + (b) * SHM_V + vst0) = sr_[i].vs0; *(bf16x8*)(V_lds + (b) * SHM_V + vst1) = sr_[i].vs1; int kc = sc * 2; \
    *(bf16x8*)(K_lds + (b) * SHM_K + KSWZ(sr, kc)) = sr_[i].ks0; *(bf16x8*)(K_lds + (b) * SHM_K + KSWZ(32 + sr, kc)) = sr_[i].ks1; } while (0)
#define SWAIT() asm volatile("s_waitcnt vmcnt(4)" ::: "memory")
#define RESC(a) do { if (__any((a) < 1.f)) { if (hi == 0) al_l[r32] = (a); asm volatile("s_waitcnt lgkmcnt(0)" ::: "memory"); \
    for (int d = 0; d < 4; ++d) for (int r = 0; r < 16; ++r) o[d][r] *= al_l[crow(r, hi)]; } } while (0)
  f32x16 pA0, pA1, pB0, pB1; float mnA, mnB, alA, alB; bf16x8 pa0, pa1, pa2, pa3; const int NT = seq / KVBLK;
  constexpr int SE = 0, SO = 1;
  SLOAD(SE, 0); asm volatile("s_waitcnt vmcnt(0)" ::: "memory"); SWRITE(0, SE); __syncthreads();
  qkt(pA0, pA1, K_lds, qr, r32, hi, c); partialSM(pA0, pA1, m_reg, mnA, alA);
  SLOAD(SO, KVBLK); if (2 < NT) SLOAD(SE, 2 * KVBLK);
  SWAIT(); SWRITE(1, SO); __syncthreads();
  for (int j = 1; j + 1 < NT; j += 2) {
    SBAR(); qkt(pB0, pB1, K_lds + SHM_K, qr, r32, hi, c);
    finishSM(pA0, pA1, alA, l_reg, pa0, pa1, pa2, pa3); SBAR();
    SLOAD(SO, (j + 2) * KVBLK); SBAR();
    pv_d0(o, vb0, pa0, pa1, pa2, pa3); partialSM(pB0, pB1, m_reg, mnB, alB);
    __syncthreads(); SWAIT(); SWRITE(0, SE);
    RESC(alB); __syncthreads();
    SBAR(); qkt(pA0, pA1, K_lds, qr, r32, hi, c);
    finishSM(pB0, pB1, alB, l_reg, pa0, pa1, pa2, pa3); SBAR();
    if (j + 3 < NT) SLOAD(SE, (j + 3) * KVBLK); SBAR();
    pv_d0(o, vb0 + (int)SHM_V, pa0, pa1, pa2, pa3); partialSM(pA0, pA1, m_reg, mnA, alA);
    __syncthreads(); SWAIT(); SWRITE(1, SO);
    RESC(alA); __syncthreads();
  }
  SBAR(); qkt(pB0, pB1, K_lds + SHM_K, qr, r32, hi, c);
  finishSM(pA0, pA1, alA, l_reg, pa0, pa1, pa2, pa3); SBAR();
  pv_d0(o, vb0, pa0, pa1, pa2, pa3); partialSM(pB0, pB1, m_reg, mnB, alB);
  __syncthreads(); RESC(alB);
  finishSM(pB0, pB1, alB, l_reg, pa0, pa1, pa2, pa3); SBAR();
  pv_d0(o, vb0 + (int)SHM_V, pa0, pa1, pa2, pa3);
  if (hi == 0) li_l[r32] = l_reg; asm volatile("s_waitcnt vmcnt(0) lgkmcnt(0)" ::: "memory");
  float rli[16];
#pragma unroll
  for (int r = 0; r < 16; ++r) rli[r] = __builtin_amdgcn_rcpf(li_l[crow(r, hi)]);
  __syncthreads();
  float* xch = (float*)lds + (size_t)wq * 64 * 64 + lane;
  if (c == 1) {
#pragma unroll
    for (int d0 = 0; d0 < 4; ++d0)
#pragma unroll
      for (int r = 0; r < 16; ++r) xch[(d0 * 16 + r) * 64] = o[d0][r] * rli[r] * lam;
  }
  __syncthreads();
  if (c == 0) {
    float ss[16];
#pragma unroll
    for (int r = 0; r < 16; ++r) { float a = 0.f;
#pragma unroll
      for (int d0 = 0; d0 < 4; ++d0) { const float d = o[d0][r] * rli[r] - xch[(d0 * 16 + r) * 64]; o[d0][r] = d; a += d * d; }
      ss[r] = a; }
#pragma unroll
    for (int r = 0; r < 16; ++r) {
#pragma unroll
      for (int off = 1; off < 32; off <<= 1) ss[r] += __shfl_xor(ss[r], off);
      ss[r] = post / sqrtf(ss[r] * (1.f / 128.f) + 1e-6f); }
    float gs[4];
#pragma unroll
    for (int d0 = 0; d0 < 4; ++d0) gs[d0] = gsub[32 * d0 + r32];
    unsigned short* Ow = Ob + (long)(wq * QBLK) * LDK;
#pragma unroll
    for (int r = 0; r < 16; ++r) { const int orow = crow(r, hi);
#pragma unroll
      for (int d0 = 0; d0 < 4; ++d0) Ow[(long)orow * LDK + d0 * 32 + r32] = (unsigned short)f2bf(o[d0][r] * ss[r] * gs[d0]); }
  }
  __syncthreads();
#undef SLOAD
#undef SWRITE
#undef SWAIT
#undef RESC
}
#undef KSWZ
#undef SBAR
}

__device__ __forceinline__ void attn_mfma_phase(Frame& F, int layer) {
    const float lam = wsp<float>(F, WS_SCAL)[layer]; const float lam_init = 0.8f - 0.6f * expf(-0.3f * (float)layer), post = 1.f - lam_init;
    const float* gsub = inp(I_GSUB) + layer * VD;
    const bf16* Q = wsp<bf16>(F, WS_Q); const bf16* Kb = wsp<bf16>(F, WS_K); const bf16* Vb = wsp<bf16>(F, WS_V); bf16* OB = wsp<bf16>(F, WS_OB);
    for (int u = blockIdx.x; u < BATCH * NH * (SEQ / 128); u += F.G) {
        const int b = u >> 6, h = (u >> 4) & 3, qb = u & 15;
        const size_t rb = (size_t)b * SEQ;
        dattn::unit(Q + (rb + qb * 128) * AQK + h * 128, Kb + rb * AQK + h * 128, Vb + rb * AV + h * 128, OB + (rb + qb * 128) * AV + h * 128, SEQ, (char*)F.lds, lam, post, gsub);
    }
}

constexpr int NSTEP = 11, NPH = 1 + DEPTH * NSTEP;
struct Args { const float* in[N_IN]; float* out; unsigned char* ws; int ph_lo, ph_hi, pass, pad; };
#ifndef DBG_SITES
#define DBG_SITES 0xFF
#endif
#define GEMM_SITE(ID, EpiT, g, S, E) do { if (!((DBG_SITES >> (ID)) & 1)) {} else if ((MK_NAIVE_GEMM >> (ID)) & 1) pg8::gemm_phase_naive<EpiT, pg8::GroupOrder>(g, S, E); \
    else pg8::gemm_phase<EpiT, pg8::GroupOrder, MK_ALIGN, MK_SP2>(F.lds + RING_OFF, g, S, E); } while (0)

__global__ void __launch_bounds__(NWAVES * 64, 2) mk_fwd(Args args) {
    extern __shared__ __attribute__((aligned(16))) unsigned char lds[];
    Frame F;
    F.lds = (LAS unsigned char*)lds;
    F.MISC = (volatile LAS unsigned*)(F.lds + MISC_OFF);
    F.tid = threadIdx.x; F.lane = F.tid & 63; F.wave = __builtin_amdgcn_readfirstlane(F.tid >> 6);
    F.G = gridDim.x; F.ws = (GAS unsigned char*)args.ws; F.ctl = (gu32*)(F.ws + WS_CTL);
    for (int u = F.tid; u < (LDS_BYTES - LDSCTL_OFF) / 4; u += NWAVES * 64) ((LAS unsigned*)(F.lds + LDSCTL_OFF))[u] = 0u;
    __syncthreads();
    const int lo = args.ph_lo, hi = args.ph_hi;
#ifdef DBG_START_DELAY
    if (lo == 0) { const unsigned long long t0 = __builtin_amdgcn_s_memrealtime(); while (__builtin_amdgcn_s_memrealtime() - t0 < (unsigned long long)DBG_START_DELAY) __builtin_amdgcn_s_sleep(32); }
#endif
    XcdBarrier bar; bar.bar = (unsigned*)(F.ctl + CW_BAR); bar.x = 0; bar.st = nullptr;
    if (hi - lo > 1) bar = xcd_barrier_post((unsigned*)(F.ctl + CW_BAR), F.MISC + 8);
#define PHASE_BEGIN() do { const CAS unsigned char* k_ = (const CAS unsigned char*)__builtin_amdgcn_kernarg_segment_ptr(); asm volatile("" : "+s"(k_)); \
    F.ws = *(GAS unsigned char* const CAS*)(k_ + 8 * (N_IN + 1)); F.ctl = (gu32*)(F.ws + WS_CTL); int t_ = threadIdx.x; asm volatile("" : "+v"(t_)); \
    F.tid = t_; F.lane = t_ & 63; F.wave = __builtin_amdgcn_readfirstlane(t_ >> 6); F.G = gridDim.x; } while (0)
#define IN(k) (lo <= (k) && (k) < hi)
#define SEAM(k) do { if (IN(k) && IN((k) + 1)) xcd_barrier(bar); } while (0)
#define H wsp<bf16>(F, WS_H)
#define X wsp<float>(F, WS_X)

#ifdef DBG_STOP
    if (lo == 100) {
        PHASE_BEGIN();
        float* o = outp(); const size_t gt = (size_t)blockIdx.x * (NWAVES * 64) + F.tid, NGT = (size_t)F.G * NWAVES * 64;
        for (size_t i = gt; i < (size_t)T * D; i += NGT) { float v = 0.f;
#define DG_BF(off, len) v += bf_lo((unsigned)wsp<bf16>(F, off)[i % (size_t)(len)]);
#define DG_F32(off, len) v += wsp<float>(F, off)[i % (size_t)(len)];
            DBG_DIGEST
            o[i] = v; }
        return;
    }
#endif
#ifdef DBG_TWOPASS
#define CW_CK 2048
#define CK(slot, off, bytes) cksum(F, off, bytes, CW_CK + dbg_pass * 64 + (slot))
#define CKBAR() xcd_barrier(bar)
    const int dbg_pass = args.pass;
#else
#define CK(slot, off, bytes) do {} while (0)
#define CKBAR() do {} while (0)
#endif
    if (IN(0)) { PHASE_BEGIN(); for (int rep_ = 0; rep_ < DBG_REP_PRO; ++rep_) p0_prologue(F); }
    SEAM(0);
#ifdef DBG_TWOPASS
    { PHASE_BEGIN(); CK(0, WS_WIN, WS_X - WS_WIN); CK(0, WS_H, (size_t)T * D * 2); CK(0, WS_PB, (size_t)2 * T * PLE * 2); CK(0, WS_ROPE, (size_t)SEQ * 64 * 4); CKBAR(); }
#endif

    {
        constexpr int layer = 0;

        const int pb = 1 + layer * NSTEP;
#ifdef DBG_SKIP_MOE
        const bool moe = false; const bool skipffn = (layer & 1) != 0;
#elif defined(DBG_SKIP_DENSE)
        const bool moe = (layer & 1) != 0; const bool skipffn = (layer & 1) == 0;
#else
        const bool moe = (layer & 1) != 0; const bool skipffn = false;
#endif
        if (IN(pb + 0)) { PHASE_BEGIN();
            if (layer == 0) {
                pg8::Gemm g{wsp<bf16>(F, WS_PB), wsp<bf16>(F, WS_WPP), 2 * T, D, PLE}; pg8::GroupOrder S; S.init_equal(2, T, D, F.G, (int)blockIdx.x, (LAS int*)(F.lds + TP_OFF));
                pg8::EpiStore E{wsp<bf16>(F, WS_PROJ), D, D / 256};
                GEMM_SITE(0, pg8::EpiStore, g, S, E);
            }
            pg8::Gemm g{H, wsp<bf16>(F, WS_WIN) + (size_t)layer * INC * D / (MK_I8_INPROJ ? 2 : 1), T, INC, MK_I8_INPROJ ? D / 2 : D}; pg8::GroupOrder S; S.init_dense(T, INC, F.G, (int)blockIdx.x);
            pg8::EpiInProj E{wsp<bf16>(F, WS_Q), wsp<bf16>(F, WS_K), wsp<bf16>(F, WS_V), wsp<bf16>(F, WS_Z), wsp<bf16>(F, WS_SG), wsp<float>(F, WS_ROPE), QSCALE, MK_I8_INPROJ ? (const float*)wsp<float>(F, WS_RS) : nullptr, (const float*)wsp<float>(F, WS_WSC) + layer};
            pg8::gemm_phase<pg8::EpiInProj, pg8::GroupOrder, MK_ALIGN, MK_SP2, (MK_I8_INPROJ != 0)>(F.lds + RING_OFF, g, S, E);
        }
        SEAM(pb + 0);
#ifdef DBG_TWOPASS
        { PHASE_BEGIN(); CK(pb + 0, WS_Q, 128 * MiB); if (layer == 0) CK(pb + 0, WS_PROJ, (size_t)2 * T * D * 2); if (layer == 1) { CK(32, WS_Q, 16 * MiB); CK(33, WS_K, 16 * MiB); CK(34, WS_V, 16 * MiB); CK(35, WS_Z, 16 * MiB); CK(36, WS_SG, 64 * MiB); } CKBAR(); }
#endif
        if (IN(pb + 1)) { PHASE_BEGIN();
#ifdef DBG_CHECK_INPROJ
            if (layer == DBG_LAYER) check_inproj(F, layer);
#endif
#if !defined(DBG_NO_ATTN) && MK_NAIVE_ATTN
            attn_naive_phase(F, layer);
#elif !defined(DBG_NO_ATTN)
            for (int rep_ = 0; rep_ < DBG_REP_ATTN; ++rep_) attn_mfma_phase(F, layer);
#else
            { bf16* ob = wsp<bf16>(F, WS_OB); const size_t gt = (size_t)blockIdx.x * (NWAVES * 64) + F.tid, NGT = (size_t)F.G * NWAVES * 64;
              for (size_t i = gt; i < (size_t)T * AV / 8; i += NGT) *(v4u*)(ob + i * 8) = (v4u){0u, 0u, 0u, 0u}; }
#endif
#if defined(DBG_NAIVE_CONV)
            conv_naive_phase(F, layer);
#elif !defined(DBG_NO_CONV)
            conv_phase(F, layer);
#else
            { bf16* ob = wsp<bf16>(F, WS_ZC); const size_t gt = (size_t)blockIdx.x * (NWAVES * 64) + F.tid, NGT = (size_t)F.G * NWAVES * 64;
              for (size_t i = gt; i < (size_t)T * CCH / 8; i += NGT) *(v4u*)(ob + i * 8) = (v4u){0u, 0u, 0u, 0u}; }
#endif
        }
        SEAM(pb + 1);
#ifdef DBG_CHECK_ATTN
        if (layer == DBG_CHECK_ATTN - 1) { PHASE_BEGIN(); check_attn(F, layer); xcd_barrier(bar); }
#endif
#ifdef DBG_TWOPASS
        { PHASE_BEGIN(); CK(pb + 1, WS_OB, 32 * MiB); CKBAR(); }
#endif
        if (IN(pb + 2)) { PHASE_BEGIN();
            { pg8::Gemm g{wsp<bf16>(F, WS_OB), wsp<bf16>(F, WS_WA) + (size_t)layer * D * AV, T, D, AV}; pg8::GroupOrder S; S.init_dense(T, D, F.G, (int)blockIdx.x);
              pg8::EpiGate<0> E{wsp<float>(F, WS_P), wsp<bf16>(F, WS_MIX), wsp<bf16>(F, WS_SG)};
              GEMM_SITE(2, pg8::EpiGate<0>, g, S, E); }
            { pg8::Gemm g{wsp<bf16>(F, WS_ZC), wsp<bf16>(F, WS_WC) + (size_t)layer * D * CCH, T, D, CCH}; pg8::GroupOrder S; S.init_dense(T, D, F.G, (int)blockIdx.x);
              pg8::EpiGate<1> E{wsp<float>(F, WS_P), wsp<bf16>(F, WS_MIX), wsp<bf16>(F, WS_SG)};
              GEMM_SITE(3, pg8::EpiGate<1>, g, S, E); }
        }
        SEAM(pb + 2);
#ifdef DBG_CHECK_MIX
        if (layer == DBG_LAYER) { PHASE_BEGIN(); check_mix(F, layer); snap_wo(F); xcd_barrier(bar); }
#endif
#ifdef DBG_TWOPASS
        { PHASE_BEGIN(); CK(pb + 2, WS_P, 96 * MiB); CKBAR(); }
#endif
        if (IN(pb + 3)) { PHASE_BEGIN();
            pg8::Gemm g{wsp<bf16>(F, WS_MIX), wsp<bf16>(F, WS_WO) + (size_t)layer * D * D, T, D, D}; pg8::GroupOrder S; S.init_dense(T, D, F.G, (int)blockIdx.x);
            pg8::EpiResid E{layer == 0 ? inp(I_X) : (const float*)X, X, D / 256};
            GEMM_SITE(4, pg8::EpiResid, g, S, E);
        }
        SEAM(pb + 3);
#ifdef DBG_CHECK_MIX
        if (layer == DBG_LAYER) { PHASE_BEGIN(); check_wo(F, layer); xcd_barrier(bar); }
#endif
#ifdef DBG_TWOPASS
        { PHASE_BEGIN(); CK(pb + 3, WS_X, (size_t)T * D * 4); CKBAR(); }
#endif
        if (IN(pb + 4)) { PHASE_BEGIN();
            if (moe) route_phase(F, X, inp(I_GFFN) + (size_t)layer * D, H);
            else norm_rows(F, X, inp(I_GFFN) + (size_t)layer * D, H, MK_FP8_GU != 0);
        }
        SEAM(pb + 4);
#ifdef DBG_CHECK_MOE
        if (moe) { PHASE_BEGIN(); check_route(F); xcd_barrier(bar); }
#endif
#ifdef DBG_TWOPASS
        { PHASE_BEGIN(); CK(pb + 4, WS_H, (size_t)T * D * 2); if (moe) CK(pb + 4, WS_RTW, (size_t)T * 8); CKBAR(); }
#endif
        if (moe) {
            if (IN(pb + 5)) { PHASE_BEGIN(); scatter_phase(F); }
            SEAM(pb + 5);
        }
        if (IN(pb + 6) && !skipffn) { PHASE_BEGIN();
            pg8::Gemm g; pg8::GroupOrder S; pg8::EpiSwiGLU E;
            constexpr int KG = MK_FP8_GU ? D / 2 : D;
            if (moe) { unsigned cnt[8]; load_counts(F, cnt); g = pg8::Gemm{wsp<bf16>(F, WS_HP), wsp<bf16>(F, WS_WEGU), MOE_ROWS, 2 * FE, KG}; S.init_counts(cnt, 2 * FE, F.G, (int)blockIdx.x, (LAS int*)(F.lds + TP_OFF)); E = pg8::EpiSwiGLU{wsp<bf16>(F, WS_ACT), FE, 2 * FE / 256, MK_FP8_GU ? (const float*)wsp<float>(F, WS_RSP) : nullptr, (const float*)wsp<float>(F, WS_WSC) + 3}; }
            else { g = pg8::Gemm{H, wsp<bf16>(F, WS_WFGU), T, 2 * FF, KG}; S.init_dense(T, 2 * FF, F.G, (int)blockIdx.x); E = pg8::EpiSwiGLU{wsp<bf16>(F, WS_ACT), FF, 2 * FF / 256, MK_FP8_GU ? (const float*)wsp<float>(F, WS_RS) : nullptr, (const float*)wsp<float>(F, WS_WSC) + 2}; }
            for (int rep_ = 0; rep_ < DBG_REP_GU; ++rep_) { pg8::gemm_phase<pg8::EpiSwiGLU, pg8::GroupOrder, MK_FP8_GU ? MK_ALIGN_GU : MK_ALIGN, MK_FP8_GU ? MK_SP2_GU : MK_SP2, (MK_FP8_GU != 0)>(F.lds + RING_OFF, g, S, E); }
        }
        SEAM(pb + 6);
#ifdef DBG_CHECK_FFN
        if (layer == 0) { PHASE_BEGIN(); snap_x(F, 0, 2); xcd_barrier(bar); }
#endif
#ifdef DBG_CHECK_ACT
        if (layer == 0) { PHASE_BEGIN(); check_act(F); xcd_barrier(bar); }
#endif
#ifdef DBG_TWOPASS
        { PHASE_BEGIN(); if (!moe) CK(pb + 6, WS_ACT, (size_t)T * FF * 2); CKBAR(); }
#endif
        if (IN(pb + 7) && !skipffn) { PHASE_BEGIN();
            if (moe && MK_MOE_SPLITK) {
                unsigned cnt[8]; load_counts(F, cnt);
                pg8::Gemm g{wsp<bf16>(F, WS_ACT), wsp<bf16>(F, WS_WEDN), MOE_ROWS, D, FE / 2, FE}; pg8::GroupOrder S; S.init_counts(cnt, D, F.G, (int)blockIdx.x, (LAS int*)(F.lds + TP_OFF), 2);
                pg8::EpiYPart E{wsp<bf16>(F, WS_Y), (size_t)MOE_ROWS * D, D / 256};
                pg8::gemm_phase<pg8::EpiYPart, pg8::GroupOrder, MK_ALIGN, MK_SP2>(F.lds + RING_OFF, g, S, E);
            } else {
            pg8::Gemm g; pg8::GroupOrder S; pg8::EpiResid E;
            if (moe) { unsigned cnt[8]; load_counts(F, cnt); g = pg8::Gemm{wsp<bf16>(F, WS_ACT), wsp<bf16>(F, WS_WEDN), MOE_ROWS, D, FE}; S.init_counts(cnt, D, F.G, (int)blockIdx.x, (LAS int*)(F.lds + TP_OFF)); E = pg8::EpiResid{nullptr, wsp<float>(F, WS_Y), D / 256}; }
            else { g = pg8::Gemm{wsp<bf16>(F, WS_ACT), wsp<bf16>(F, WS_WFDN), T, D, FF}; S.init_dense(T, D, F.G, (int)blockIdx.x); E = pg8::EpiResid{X, X, D / 256}; }
            GEMM_SITE(6, pg8::EpiResid, g, S, E);
            }
        }
        SEAM(pb + 7);
#ifdef DBG_CHECK_MOE
        if (moe) { PHASE_BEGIN(); check_experts(F); xcd_barrier(bar); }
#endif
#ifdef DBG_CHECK_FFN
        if (layer == 0) { PHASE_BEGIN(); check_down(F); xcd_barrier(bar); }
#endif
#ifdef DBG_TWOPASS
        { PHASE_BEGIN(); if (!moe) CK(pb + 7, WS_X, (size_t)T * D * 4); CKBAR(); }
#endif
        if (IN(pb + 8)) { PHASE_BEGIN();
            if (moe) combine_norm_phase(F, X, inp(I_GPLE) + (size_t)layer * D, H, MK_I8_PLE != 0);
            else norm_rows(F, X, inp(I_GPLE) + (size_t)layer * D, H, MK_I8_PLE != 0);
        }
        SEAM(pb + 8);
#ifdef DBG_CHECK_MOE
        if (moe) { PHASE_BEGIN(); check_combine(F); xcd_barrier(bar); }
#endif
#ifdef DBG_CHECK_FFN
        if (layer == DBG_LAYER) { PHASE_BEGIN(); check_norm3(F, layer); snap_x(F, 1, 4); xcd_barrier(bar); }
#endif
#ifdef DBG_TWOPASS
        { PHASE_BEGIN(); CK(pb + 8, WS_X, (size_t)T * D * 4); CK(pb + 8, WS_H, (size_t)T * D * 2); CKBAR(); }
#endif
#ifdef DBG_SKIP_PLE
        if (false) {
#else
        if (IN(pb + 9)) { PHASE_BEGIN();
#endif
            pg8::Gemm g{H, wsp<bf16>(F, WS_WPG) + (size_t)layer * D * D / (MK_I8_PLE ? 2 : 1), T, D, MK_I8_PLE ? D / 2 : D}; pg8::GroupOrder S; S.init_dense(T, D, F.G, (int)blockIdx.x);
            pg8::EpiPleGate E{X, wsp<bf16>(F, WS_PROJ) + (size_t)layer * T * D, MK_I8_PLE ? (const float*)wsp<float>(F, WS_RS) : nullptr, (const float*)wsp<float>(F, WS_WSC) + 11 + layer};
            pg8::gemm_phase<pg8::EpiPleGate, pg8::GroupOrder, MK_ALIGN, MK_SP2, (MK_I8_PLE != 0)>(F.lds + RING_OFF, g, S, E);
        }
        SEAM(pb + 9);
#ifdef DBG_CHECK_FFN
        if (layer == DBG_LAYER) { PHASE_BEGIN(); check_ple(F, layer); xcd_barrier(bar); }
#endif
#ifdef DBG_TWOPASS
        { PHASE_BEGIN(); CK(pb + 9, WS_X, (size_t)T * D * 4); CKBAR(); }
#endif
        if (IN(pb + 10)) { PHASE_BEGIN();
            if (layer + 1 < DEPTH) norm_rows(F, X, inp(I_GMIX) + (size_t)(layer + 1) * D, H, MK_I8_INPROJ != 0);
            else final_norm(F, X, inp(I_GFIN), outp());
        }
        if (layer + 1 < DEPTH) SEAM(pb + 10);
#ifdef DBG_TWOPASS
        if (layer + 1 < DEPTH) { PHASE_BEGIN(); CK(pb + 10, WS_H, (size_t)T * D * 2); CKBAR(); }
        else { xcd_barrier(bar); PHASE_BEGIN(); cksum_ptr(F, (const v4u*)outp(), (size_t)T * D * 4, CW_CK + dbg_pass * 64 + pb + 10); CKBAR(); }
#endif
    }
    {
        constexpr int layer = 1;

        const int pb = 1 + layer * NSTEP;
#ifdef DBG_SKIP_MOE
        const bool moe = false; const bool skipffn = (layer & 1) != 0;
#elif defined(DBG_SKIP_DENSE)
        const bool moe = (layer & 1) != 0; const bool skipffn = (layer & 1) == 0;
#else
        const bool moe = (layer & 1) != 0; const bool skipffn = false;
#endif
        if (IN(pb + 0)) { PHASE_BEGIN();
            if (layer == 0) {
                pg8::Gemm g{wsp<bf16>(F, WS_PB), wsp<bf16>(F, WS_WPP), 2 * T, D, PLE}; pg8::GroupOrder S; S.init_equal(2, T, D, F.G, (int)blockIdx.x, (LAS int*)(F.lds + TP_OFF));
                pg8::EpiStore E{wsp<bf16>(F, WS_PROJ), D, D / 256};
                GEMM_SITE(0, pg8::EpiStore, g, S, E);
            }
            pg8::Gemm g{H, wsp<bf16>(F, WS_WIN) + (size_t)layer * INC * D / (MK_I8_INPROJ ? 2 : 1), T, INC, MK_I8_INPROJ ? D / 2 : D}; pg8::GroupOrder S; S.init_dense(T, INC, F.G, (int)blockIdx.x);
            pg8::EpiInProj E{wsp<bf16>(F, WS_Q), wsp<bf16>(F, WS_K), wsp<bf16>(F, WS_V), wsp<bf16>(F, WS_Z), wsp<bf16>(F, WS_SG), wsp<float>(F, WS_ROPE), QSCALE, MK_I8_INPROJ ? (const float*)wsp<float>(F, WS_RS) : nullptr, (const float*)wsp<float>(F, WS_WSC) + layer};
            pg8::gemm_phase<pg8::EpiInProj, pg8::GroupOrder, MK_ALIGN, MK_SP2, (MK_I8_INPROJ != 0)>(F.lds + RING_OFF, g, S, E);
        }
        SEAM(pb + 0);
#ifdef DBG_TWOPASS
        { PHASE_BEGIN(); CK(pb + 0, WS_Q, 128 * MiB); if (layer == 0) CK(pb + 0, WS_PROJ, (size_t)2 * T * D * 2); if (layer == 1) { CK(32, WS_Q, 16 * MiB); CK(33, WS_K, 16 * MiB); CK(34, WS_V, 16 * MiB); CK(35, WS_Z, 16 * MiB); CK(36, WS_SG, 64 * MiB); } CKBAR(); }
#endif
        if (IN(pb + 1)) { PHASE_BEGIN();
#ifdef DBG_CHECK_INPROJ
            if (layer == DBG_LAYER) check_inproj(F, layer);
#endif
#if !defined(DBG_NO_ATTN) && MK_NAIVE_ATTN
            attn_naive_phase(F, layer);
#elif !defined(DBG_NO_ATTN)
            for (int rep_ = 0; rep_ < DBG_REP_ATTN; ++rep_) attn_mfma_phase(F, layer);
#else
            { bf16* ob = wsp<bf16>(F, WS_OB); const size_t gt = (size_t)blockIdx.x * (NWAVES * 64) + F.tid, NGT = (size_t)F.G * NWAVES * 64;
              for (size_t i = gt; i < (size_t)T * AV / 8; i += NGT) *(v4u*)(ob + i * 8) = (v4u){0u, 0u, 0u, 0u}; }
#endif
#if defined(DBG_NAIVE_CONV)
            conv_naive_phase(F, layer);
#elif !defined(DBG_NO_CONV)
            conv_phase(F, layer);
#else
            { bf16* ob = wsp<bf16>(F, WS_ZC); const size_t gt = (size_t)blockIdx.x * (NWAVES * 64) + F.tid, NGT = (size_t)F.G * NWAVES * 64;
              for (size_t i = gt; i < (size_t)T * CCH / 8; i += NGT) *(v4u*)(ob + i * 8) = (v4u){0u, 0u, 0u, 0u}; }
#endif
        }
        SEAM(pb + 1);
#ifdef DBG_CHECK_ATTN
        if (layer == DBG_CHECK_ATTN - 1) { PHASE_BEGIN(); check_attn(F, layer); xcd_barrier(bar); }
#endif
#ifdef DBG_TWOPASS
        { PHASE_BEGIN(); CK(pb + 1, WS_OB, 32 * MiB); CKBAR(); }
#endif
        if (IN(pb + 2)) { PHASE_BEGIN();
            { pg8::Gemm g{wsp<bf16>(F, WS_OB), wsp<bf16>(F, WS_WA) + (size_t)layer * D * AV, T, D, AV}; pg8::GroupOrder S; S.init_dense(T, D, F.G, (int)blockIdx.x);
              pg8::EpiGate<0> E{wsp<float>(F, WS_P), wsp<bf16>(F, WS_MIX), wsp<bf16>(F, WS_SG)};
              GEMM_SITE(2, pg8::EpiGate<0>, g, S, E); }
            { pg8::Gemm g{wsp<bf16>(F, WS_ZC), wsp<bf16>(F, WS_WC) + (size_t)layer * D * CCH, T, D, CCH}; pg8::GroupOrder S; S.init_dense(T, D, F.G, (int)blockIdx.x);
              pg8::EpiGate<1> E{wsp<float>(F, WS_P), wsp<bf16>(F, WS_MIX), wsp<bf16>(F, WS_SG)};
              GEMM_SITE(3, pg8::EpiGate<1>, g, S, E); }
        }
        SEAM(pb + 2);
#ifdef DBG_CHECK_MIX
        if (layer == DBG_LAYER) { PHASE_BEGIN(); check_mix(F, layer); snap_wo(F); xcd_barrier(bar); }
#endif
#ifdef DBG_TWOPASS
        { PHASE_BEGIN(); CK(pb + 2, WS_P, 96 * MiB); CKBAR(); }
#endif
        if (IN(pb + 3)) { PHASE_BEGIN();
            pg8::Gemm g{wsp<bf16>(F, WS_MIX), wsp<bf16>(F, WS_WO) + (size_t)layer * D * D, T, D, D}; pg8::GroupOrder S; S.init_dense(T, D, F.G, (int)blockIdx.x);
            pg8::EpiResid E{layer == 0 ? inp(I_X) : (const float*)X, X, D / 256};
            GEMM_SITE(4, pg8::EpiResid, g, S, E);
        }
        SEAM(pb + 3);
#ifdef DBG_CHECK_MIX
        if (layer == DBG_LAYER) { PHASE_BEGIN(); check_wo(F, layer); xcd_barrier(bar); }
#endif
#ifdef DBG_TWOPASS
        { PHASE_BEGIN(); CK(pb + 3, WS_X, (size_t)T * D * 4); CKBAR(); }
#endif
        if (IN(pb + 4)) { PHASE_BEGIN();
            if (moe) route_phase(F, X, inp(I_GFFN) + (size_t)layer * D, H);
            else norm_rows(F, X, inp(I_GFFN) + (size_t)layer * D, H, MK_FP8_GU != 0);
        }
        SEAM(pb + 4);
#ifdef DBG_CHECK_MOE
        if (moe) { PHASE_BEGIN(); check_route(F); xcd_barrier(bar); }
#endif
#ifdef DBG_TWOPASS
        { PHASE_BEGIN(); CK(pb + 4, WS_H, (size_t)T * D * 2); if (moe) CK(pb + 4, WS_RTW, (size_t)T * 8); CKBAR(); }
#endif
        if (moe) {
            if (IN(pb + 5)) { PHASE_BEGIN(); scatter_phase(F); }
            SEAM(pb + 5);
        }
        if (IN(pb + 6) && !skipffn) { PHASE_BEGIN();
            pg8::Gemm g; pg8::GroupOrder S; pg8::EpiSwiGLU E;
            constexpr int KG = MK_FP8_GU ? D / 2 : D;
            if (moe) { unsigned cnt[8]; load_counts(F, cnt); g = pg8::Gemm{wsp<bf16>(F, WS_HP), wsp<bf16>(F, WS_WEGU), MOE_ROWS, 2 * FE, KG}; S.init_counts(cnt, 2 * FE, F.G, (int)blockIdx.x, (LAS int*)(F.lds + TP_OFF)); E = pg8::EpiSwiGLU{wsp<bf16>(F, WS_ACT), FE, 2 * FE / 256, MK_FP8_GU ? (const float*)wsp<float>(F, WS_RSP) : nullptr, (const float*)wsp<float>(F, WS_WSC) + 3}; }
            else { g = pg8::Gemm{H, wsp<bf16>(F, WS_WFGU), T, 2 * FF, KG}; S.init_dense(T, 2 * FF, F.G, (int)blockIdx.x); E = pg8::EpiSwiGLU{wsp<bf16>(F, WS_ACT), FF, 2 * FF / 256, MK_FP8_GU ? (const float*)wsp<float>(F, WS_RS) : nullptr, (const float*)wsp<float>(F, WS_WSC) + 2}; }
            for (int rep_ = 0; rep_ < DBG_REP_GU; ++rep_) { pg8::gemm_phase<pg8::EpiSwiGLU, pg8::GroupOrder, MK_FP8_GU ? MK_ALIGN_GU : MK_ALIGN, MK_FP8_GU ? MK_SP2_GU : MK_SP2, (MK_FP8_GU != 0)>(F.lds + RING_OFF, g, S, E); }
        }
        SEAM(pb + 6);
#ifdef DBG_CHECK_FFN
        if (layer == 0) { PHASE_BEGIN(); snap_x(F, 0, 2); xcd_barrier(bar); }
#endif
#ifdef DBG_CHECK_ACT
        if (layer == 0) { PHASE_BEGIN(); check_act(F); xcd_barrier(bar); }
#endif
#ifdef DBG_TWOPASS
        { PHASE_BEGIN(); if (!moe) CK(pb + 6, WS_ACT, (size_t)T * FF * 2); CKBAR(); }
#endif
        if (IN(pb + 7) && !skipffn) { PHASE_BEGIN();
            if (moe && MK_MOE_SPLITK) {
                unsigned cnt[8]; load_counts(F, cnt);
                pg8::Gemm g{wsp<bf16>(F, WS_ACT), wsp<bf16>(F, WS_WEDN), MOE_ROWS, D, FE / 2, FE}; pg8::GroupOrder S; S.init_counts(cnt, D, F.G, (int)blockIdx.x, (LAS int*)(F.lds + TP_OFF), 2);
                pg8::EpiYPart E{wsp<bf16>(F, WS_Y), (size_t)MOE_ROWS * D, D / 256};
                pg8::gemm_phase<pg8::EpiYPart, pg8::GroupOrder, MK_ALIGN, MK_SP2>(F.lds + RING_OFF, g, S, E);
            } else {
            pg8::Gemm g; pg8::GroupOrder S; pg8::EpiResid E;
            if (moe) { unsigned cnt[8]; load_counts(F, cnt); g = pg8::Gemm{wsp<bf16>(F, WS_ACT), wsp<bf16>(F, WS_WEDN), MOE_ROWS, D, FE}; S.init_counts(cnt, D, F.G, (int)blockIdx.x, (LAS int*)(F.lds + TP_OFF)); E = pg8::EpiResid{nullptr, wsp<float>(F, WS_Y), D / 256}; }
            else { g = pg8::Gemm{wsp<bf16>(F, WS_ACT), wsp<bf16>(F, WS_WFDN), T, D, FF}; S.init_dense(T, D, F.G, (int)blockIdx.x); E = pg8::EpiResid{X, X, D / 256}; }
            GEMM_SITE(6, pg8::EpiResid, g, S, E);
            }
        }
        SEAM(pb + 7);
#ifdef DBG_CHECK_MOE
        if (moe) { PHASE_BEGIN(); check_experts(F); xcd_barrier(bar); }
#endif
#ifdef DBG_CHECK_FFN
        if (layer == 0) { PHASE_BEGIN(); check_down(F); xcd_barrier(bar); }
#endif
#ifdef DBG_TWOPASS
        { PHASE_BEGIN(); if (!moe) CK(pb + 7, WS_X, (size_t)T * D * 4); CKBAR(); }
#endif
        if (IN(pb + 8)) { PHASE_BEGIN();
            if (moe) combine_norm_phase(F, X, inp(I_GPLE) + (size_t)layer * D, H, MK_I8_PLE != 0);
            else norm_rows(F, X, inp(I_GPLE) + (size_t)layer * D, H, MK_I8_PLE != 0);
        }
        SEAM(pb + 8);
#ifdef DBG_CHECK_MOE
        if (moe) { PHASE_BEGIN(); check_combine(F); xcd_barrier(bar); }
#endif
#ifdef DBG_CHECK_FFN
        if (layer == DBG_LAYER) { PHASE_BEGIN(); check_norm3(F, layer); snap_x(F, 1, 4); xcd_barrier(bar); }
#endif
#ifdef DBG_TWOPASS
        { PHASE_BEGIN(); CK(pb + 8, WS_X, (size_t)T * D * 4); CK(pb + 8, WS_H, (size_t)T * D * 2); CKBAR(); }
#endif
#ifdef DBG_SKIP_PLE
        if (false) {
#else
        if (IN(pb + 9)) { PHASE_BEGIN();
#endif
            pg8::Gemm g{H, wsp<bf16>(F, WS_WPG) + (size_t)layer * D * D / (MK_I8_PLE ? 2 : 1), T, D, MK_I8_PLE ? D / 2 : D}; pg8::GroupOrder S; S.init_dense(T, D, F.G, (int)blockIdx.x);
            pg8::EpiPleGate E{X, wsp<bf16>(F, WS_PROJ) + (size_t)layer * T * D, MK_I8_PLE ? (const float*)wsp<float>(F, WS_RS) : nullptr, (const float*)wsp<float>(F, WS_WSC) + 11 + layer};
            pg8::gemm_phase<pg8::EpiPleGate, pg8::GroupOrder, MK_ALIGN, MK_SP2, (MK_I8_PLE != 0)>(F.lds + RING_OFF, g, S, E);
        }
        SEAM(pb + 9);
#ifdef DBG_CHECK_FFN
        if (layer == DBG_LAYER) { PHASE_BEGIN(); check_ple(F, layer); xcd_barrier(bar); }
#endif
#ifdef DBG_TWOPASS
        { PHASE_BEGIN(); CK(pb + 9, WS_X, (size_t)T * D * 4); CKBAR(); }
#endif
        if (IN(pb + 10)) { PHASE_BEGIN();
            if (layer + 1 < DEPTH) norm_rows(F, X, inp(I_GMIX) + (size_t)(layer + 1) * D, H, MK_I8_INPROJ != 0);
            else final_norm(F, X, inp(I_GFIN), outp());
        }
        if (layer + 1 < DEPTH) SEAM(pb + 10);
#ifdef DBG_TWOPASS
        if (layer + 1 < DEPTH) { PHASE_BEGIN(); CK(pb + 10, WS_H, (size_t)T * D * 2); CKBAR(); }
        else { xcd_barrier(bar); PHASE_BEGIN(); cksum_ptr(F, (const v4u*)outp(), (size_t)T * D * 4, CW_CK + dbg_pass * 64 + pb + 10); CKBAR(); }
#endif
    }
#ifdef DBG_TWOPASS
    if (dbg_pass == 1) { PHASE_BEGIN();
      if (blockIdx.x == 0 && F.tid == 0) { unsigned idx = 0u;
          for (int k = NPH - 1; k >= 0; --k) if (__hip_atomic_load((unsigned*)(F.ctl + CW_CK + k), RLX_AGENT) != __hip_atomic_load((unsigned*)(F.ctl + CW_CK + 64 + k), RLX_AGENT)) idx = (unsigned)(k + 1);
          unsigned idx2 = 0u; for (int k = 36; k >= 32; --k) if (__hip_atomic_load((unsigned*)(F.ctl + CW_CK + k), RLX_AGENT) != __hip_atomic_load((unsigned*)(F.ctl + CW_CK + 64 + k), RLX_AGENT)) idx2 = (unsigned)(k - 31);
          __hip_atomic_store((unsigned*)(F.ctl + 16), idx + 32u * idx2, RLX_AGENT); }
      xcd_barrier(bar); }
#endif
#ifdef DBG_CODE_OUT
    if (args.pass == 1 || !DBG_TWOPASS_ON) { xcd_barrier(bar); PHASE_BEGIN(); final_norm(F, inp(I_X), inp(I_GFIN), outp(), 1.f + (float)__hip_atomic_load((unsigned*)(F.ctl + 16), RLX_AGENT) + (float)((__hip_atomic_load((unsigned*)(F.ctl + 17), RLX_AGENT) + 63u) / 64u)); }
#endif
#undef IN
#undef SEAM
#undef H
#undef X
}

extern "C" void kernel_launch(void* const* d_in, const int* in_sizes, int n_in, void* d_out, int out_size, void* d_ws, size_t ws_size, hipStream_t stream) {
    static int grid = 0;
    if (grid == 0) {
        if (n_in != N_IN || in_sizes[0] != T * D || out_size != T * D || ws_size < WS_END) {
            fprintf(stderr, "kernel_launch: built for %d inputs, x/out of %d floats, >= %zu bytes of workspace; got n_in %d, in0 %d, out %d, ws %zu; nothing launched\n", N_IN, T * D, (size_t)WS_END, n_in, n_in > 0 ? in_sizes[0] : -1, out_size, ws_size);
            grid = -1; return; }
        int dev = 0, cus = 0, per_cu = 0;
        if (hipGetDevice(&dev) != hipSuccess || hipDeviceGetAttribute(&cus, hipDeviceAttributeMultiprocessorCount, dev) != hipSuccess) { fprintf(stderr, "kernel_launch: device query failed\n"); grid = -1; return; }
        if (hipFuncSetAttribute((const void*)mk_fwd, hipFuncAttributeMaxDynamicSharedMemorySize, LDS_BYTES) != hipSuccess) { fprintf(stderr, "kernel_launch: hipFuncSetAttribute failed\n"); grid = -1; return; }
        if (hipOccupancyMaxActiveBlocksPerMultiprocessor(&per_cu, (const void*)mk_fwd, NWAVES * 64, LDS_BYTES) != hipSuccess || per_cu < 1) { fprintf(stderr, "kernel_launch: occupancy query reports %d workgroups per CU\n", per_cu); }
        (void)hipGetLastError();
        grid = cus;
    }
    if (grid < 0) return;
    if (hipMemsetAsync((char*)d_ws + WS_CTL, 0, CTL_ZERO_BYTES, stream) != hipSuccess) { fprintf(stderr, "kernel_launch: hipMemsetAsync failed\n"); return; }
    Args a{};
    for (int i = 0; i < N_IN; ++i) a.in[i] = (const float*)d_in[i];
    a.out = (float*)d_out; a.ws = (unsigned char*)d_ws;
#if MK_PER_PHASE
#ifdef DBG_STOP
    for (int ph = 0; ph <= DBG_STOP; ++ph) { a.ph_lo = ph; a.ph_hi = ph + 1; hipLaunchKernelGGL(mk_fwd, dim3(grid), dim3(NWAVES * 64), LDS_BYTES, stream, a); }
    a.ph_lo = 100; a.ph_hi = 101; hipLaunchKernelGGL(mk_fwd, dim3(grid), dim3(NWAVES * 64), LDS_BYTES, stream, a);
#else
    for (int ph = 0; ph < NPH; ++ph) { a.ph_lo = ph; a.ph_hi = ph + 1; hipLaunchKernelGGL(mk_fwd, dim3(grid), dim3(NWAVES * 64), LDS_BYTES, stream, a); }
#endif
#else
#ifdef DBG_TWOPASS
    a.ph_lo = 0; a.ph_hi = NPH; a.pass = 0; hipLaunchKernelGGL(mk_fwd, dim3(grid), dim3(NWAVES * 64), LDS_BYTES, stream, a);
    (void)hipMemsetAsync((char*)d_ws + WS_CTL + CW_BAR * 4, 0, XCD_BAR_WORDS * 4, stream); (void)hipMemsetAsync((char*)d_ws + WS_CTL + CW_GCNT * 4, 0, 2048, stream);
    a.pass = 1; hipLaunchKernelGGL(mk_fwd, dim3(grid), dim3(NWAVES * 64), LDS_BYTES, stream, a);
#else
    a.ph_lo = 0; a.ph_hi = NPH; hipLaunchKernelGGL(mk_fwd, dim3(grid), dim3(NWAVES * 64), LDS_BYTES, stream, a);
#endif
#endif
    const hipError_t le = hipPeekAtLastError();
    if (le != hipSuccess) fprintf(stderr, "kernel_launch: launch failed: %s\n", hipGetErrorName(le));
}
```
